# Optimizing an MI355X kernel written in HIP

```python
import jax, jax.numpy as jnp
from jax import lax
import numpy as np

D_MODEL = 1024
BATCH = 1
SEQ = 16384
DEPTH = 4

ATT_HEAD_DIM = 64
ATT_WIDTH = D_MODEL // 2
ATT_HEADS = ATT_WIDTH // ATT_HEAD_DIM
Q_BLOCK = 128
LRU_WIDTH = D_MODEL
LRU_BLOCK_DIM = 64
LRU_BLOCKS = LRU_WIDTH // LRU_BLOCK_DIM
LRU_CONV = 4
LRU_C = 8.0
RWKV_HEAD_DIM = 64
RWKV_WIDTH = D_MODEL // 2
RWKV_HEADS = RWKV_WIDTH // RWKV_HEAD_DIM
DECAY_LORA = 64
AAA_LORA = 64
GATE_LORA = 128
RWKV_GN_EPS = 64e-5
D_FF = ((8 * D_MODEL // 3 + 127) // 128) * 128
N_BRANCH = 3
N_SUB = 3
N_ADA = 3 * N_SUB
LN_EPS = 1e-5
DEEPNORM_ALPHA = (2 * DEPTH) ** 0.25
DEEPNORM_BETA = (8 * DEPTH) ** -0.25
ATT_COLS = 3 * ATT_WIDTH + ATT_HEADS
LRU_COLS = 2 * LRU_WIDTH
RWKV_COLS = 3 * RWKV_WIDTH + DECAY_LORA + AAA_LORA + GATE_LORA
GATE_COLS = N_BRANCH * D_MODEL
D_IN = ATT_COLS + LRU_COLS + RWKV_COLS + GATE_COLS

kernel_name = "hybrid_fox_rglru_rwkv7_macaron_deepnorm"


def _split(z, sizes):
    return jnp.split(z, np.cumsum(sizes)[:-1].tolist(), axis=-1)


def _ln_stats(x):
    xf = x.astype(jnp.float32)
    mu = jnp.mean(xf, axis=-1, keepdims=True)
    var = jnp.mean(jnp.square(xf - mu), axis=-1, keepdims=True)
    return (xf - mu) * lax.rsqrt(var + LN_EPS)


def _post_norm(x, g, b):
    return (_ln_stats(x) * g + b).astype(x.dtype)


def _modulate(x, shift, scale):
    return (_ln_stats(x) * (1 + scale[:, None, :]) + shift[:, None, :]).astype(x.dtype)


def _prev_token(z):
    return jnp.pad(z, ((0, 0), (1, 0), (0, 0)))[:, :-1]


def _swiglu(h, w_up, w_down):
    u, gte = _split(h @ w_up, [D_FF, D_FF])
    return (jax.nn.silu(u) * gte) @ w_down


def _fox_attention(q, k, v, f_logit, f_bias):
    B, S, _ = q.shape
    H, dh = ATT_HEADS, ATT_HEAD_DIM
    heads = lambda t: t.reshape(B, S, H, dh).transpose(0, 2, 1, 3)
    q, k, v = heads(q), heads(k), heads(v)
    log_f = jax.nn.log_sigmoid((f_logit + f_bias).astype(jnp.float32))
    F = jnp.cumsum(log_f, axis=1).transpose(0, 2, 1)
    nb = S // Q_BLOCK
    qb = q.reshape(B, H, nb, Q_BLOCK, dh).transpose(2, 0, 1, 3, 4)
    Fb = F.reshape(B, H, nb, Q_BLOCK).transpose(2, 0, 1, 3)
    qpos = jnp.arange(S).reshape(nb, Q_BLOCK)
    kpos = jnp.arange(S)
    scale = dh ** -0.5

    def block(args):
        qi, Fi, pi = args
        s = jnp.einsum('bhqd,bhkd->bhqk', qi, k).astype(jnp.float32) * scale
        s = s + (Fi[..., :, None] - F[..., None, :])
        s = jnp.where(kpos[None, :] <= pi[:, None], s, -jnp.inf)
        p = jax.nn.softmax(s, axis=-1).astype(v.dtype)
        return jnp.einsum('bhqk,bhkd->bhqd', p, v)

    o = lax.map(block, (qb, Fb, qpos))
    return o.transpose(1, 0, 3, 2, 4).reshape(B, S, H * dh)


def _causal_dwconv(x, w, b):
    S = x.shape[1]
    K = w.shape[0]
    xp = jnp.pad(x, ((0, 0), (K - 1, 0), (0, 0)))
    y = xp[:, 0:S] * w[0]
    for j in range(1, K):
        y = y + xp[:, j:j + S] * w[j]
    return y + b


def _lin_combine(left, right):
    a_l, b_l = left
    a_r, b_r = right
    return a_l * a_r, a_r * b_l + b_r


def _rg_lru_branch(xb, yb, conv_w, conv_b, ga_w, ga_b, gx_w, gx_b, lam):
    B, S, _ = xb.shape
    xc = _causal_dwconv(xb, conv_w, conv_b)
    xh = xc.reshape(B, S, LRU_BLOCKS, LRU_BLOCK_DIM)
    r = jax.nn.sigmoid(jnp.einsum('bsni,nij->bsnj', xh, ga_w).reshape(B, S, LRU_WIDTH) + ga_b)
    i = jax.nn.sigmoid(jnp.einsum('bsni,nij->bsnj', xh, gx_w).reshape(B, S, LRU_WIDTH) + gx_b)
    log_a = -LRU_C * r.astype(jnp.float32) * jax.nn.softplus(-lam.astype(jnp.float32))
    a = jnp.exp(log_a)
    u = jnp.sqrt(-jnp.expm1(2 * log_a)) * (i * xc).astype(jnp.float32)
    _, h = lax.associative_scan(_lin_combine, (a, u), axis=1)
    return h.astype(xb.dtype) * jax.nn.gelu(yb)


def _rwkv7_branch(z, mu, w0, w2, a0, a2, g2, k_k, k_a, r_k, gn_w, gn_b):
    B, S, _ = z.shape
    H, N = RWKV_HEADS, RWKV_HEAD_DIM
    f32 = jnp.float32
    z = z + (_prev_token(z) - z) * mu
    r, k, v, wl, al, gl = _split(z, [RWKV_WIDTH] * 3 + [DECAY_LORA, AAA_LORA, GATE_LORA])
    w = -jax.nn.softplus(-(w0 + jnp.tanh(wl) @ w2).astype(f32)) - 0.5
    decay = jnp.exp(-jnp.exp(w))
    a = jax.nn.sigmoid((a0 + al @ a2).astype(f32))
    g = jax.nn.sigmoid(gl) @ g2
    heads = lambda t: t.reshape(B, S, H, N)
    kk = heads((k * k_k).astype(f32))
    kk = kk / jnp.maximum(jnp.linalg.norm(kk, axis=-1, keepdims=True), 1e-12)
    kf = k.astype(f32) * (1 + (a - 1) * k_a.astype(f32))
    rh, kh, vh, ah = heads(r.astype(f32)), heads(kf), heads(v.astype(f32)), heads(a)
    xs = tuple(t.transpose(1, 0, 2, 3) for t in (rh, heads(decay), kh, vh, -kk, kk * ah))

    def step(state, inp):
        r_t, w_t, k_t, v_t, a_t, b_t = inp
        sa = jnp.einsum('bhvk,bhk->bhv', state, a_t)
        state = (state * w_t[:, :, None, :] + sa[..., None] * b_t[:, :, None, :]
                 + v_t[..., None] * k_t[:, :, None, :])
        return state, jnp.einsum('bhvk,bhk->bhv', state, r_t)

    state0 = jnp.zeros((B, H, N, N), f32)
    _, ys = lax.scan(step, state0, xs)
    y = ys.transpose(1, 0, 2, 3)
    m = jnp.mean(y, axis=-1, keepdims=True)
    var = jnp.mean(jnp.square(y - m), axis=-1, keepdims=True)
    y = (y - m) * lax.rsqrt(var + RWKV_GN_EPS) * gn_w.reshape(H, N) + gn_b.reshape(H, N)
    bonus = jnp.sum(rh * kh * r_k, axis=-1, keepdims=True) * vh
    return (y + bonus).reshape(B, S, RWKV_WIDTH).astype(z.dtype) * g


def _mixer(h, w_in, f_bias, conv_w, conv_b, ga_w, ga_b, gx_w, gx_b, lam,
           mu, w0, w2, a0, a2, g2, k_k, k_a, r_k, gn_w, gn_b, wpa, wpb, wpc, w_out):
    z = h @ w_in
    za, zb, zc, zg = _split(z, [ATT_COLS, LRU_COLS, RWKV_COLS, GATE_COLS])
    q, k, v, fl = _split(za, [ATT_WIDTH] * 3 + [ATT_HEADS])
    o_a = _fox_attention(q, k, v, fl, f_bias) @ wpa
    xb, yb = _split(zb, [LRU_WIDTH, LRU_WIDTH])
    o_b = _rg_lru_branch(xb, yb, conv_w, conv_b, ga_w, ga_b, gx_w, gx_b, lam) @ wpb
    o_c = _rwkv7_branch(zc, mu, w0, w2, a0, a2, g2, k_k, k_a, r_k, gn_w, gn_b) @ wpc
    g_a, g_b, g_c = _split(jax.nn.sigmoid(zg), [D_MODEL] * N_BRANCH)
    return (g_a * o_a + g_b * o_b + g_c * o_c) @ w_out


def setup_inputs(seed: int = 0) -> dict:
    key = jax.random.key(seed)
    ks = iter(jax.random.split(key, 40))
    f32 = jnp.float32
    nrm = lambda shape, s: jax.random.normal(next(ks), shape, f32) * s
    uni = lambda shape, lo, hi: jax.random.uniform(next(ks), shape, f32, minval=lo, maxval=hi)
    L, D = DEPTH, D_MODEL
    u = uni((L, LRU_WIDTH), 0.9, 0.999)
    s = u ** (1.0 / LRU_C)
    lam = jnp.log(s) - jnp.log1p(-s)
    return {
        "x": nrm((BATCH, SEQ, D), 1.0),
        "c": nrm((BATCH, D), 1.0),
        "ada_w": nrm((L, D, N_ADA * D), D ** -0.5),
        "ada_b": nrm((L, N_ADA * D), 0.01),
        "ln_g": 1.0 + nrm((L, N_SUB, D), 0.02),
        "ln_b": nrm((L, N_SUB, D), 0.02),
        "ffn_up": nrm((L, 2, D, 2 * D_FF), D ** -0.5),
        "ffn_down": nrm((L, 2, D_FF, D), D_FF ** -0.5 * DEEPNORM_BETA),
        "w_in": nrm((L, D, D_IN), D ** -0.5),
        "fox_f_bias": uni((L, ATT_HEADS), 1.0, 6.0),
        "lru_conv_w": nrm((L, LRU_CONV, LRU_WIDTH), LRU_CONV ** -0.5),
        "lru_conv_b": nrm((L, LRU_WIDTH), 0.01),
        "lru_ga_w": nrm((L, LRU_BLOCKS, LRU_BLOCK_DIM, LRU_BLOCK_DIM), LRU_BLOCK_DIM ** -0.5),
        "lru_ga_b": nrm((L, LRU_WIDTH), 0.01),
        "lru_gx_w": nrm((L, LRU_BLOCKS, LRU_BLOCK_DIM, LRU_BLOCK_DIM), LRU_BLOCK_DIM ** -0.5),
        "lru_gx_b": nrm((L, LRU_WIDTH), 0.01),
        "lru_lambda": lam,
        "rwkv_mu": uni((L, RWKV_COLS), 0.0, 1.0),
        "rwkv_w0": uni((L, RWKV_WIDTH), -6.0, -1.0),
        "rwkv_w2": nrm((L, DECAY_LORA, RWKV_WIDTH), 0.1 * DECAY_LORA ** -0.5),
        "rwkv_a0": nrm((L, RWKV_WIDTH), 0.1),
        "rwkv_a2": nrm((L, AAA_LORA, RWKV_WIDTH), 0.1 * AAA_LORA ** -0.5),
        "rwkv_g2": nrm((L, GATE_LORA, RWKV_WIDTH), GATE_LORA ** -0.5),
        "rwkv_k_k": 0.85 + nrm((L, RWKV_WIDTH), 0.05),
        "rwkv_k_a": 1.0 + nrm((L, RWKV_WIDTH), 0.05),
        "rwkv_r_k": nrm((L, RWKV_HEADS, RWKV_HEAD_DIM), 0.1),
        "rwkv_gn_w": 1.0 + nrm((L, RWKV_WIDTH), 0.02),
        "rwkv_gn_b": nrm((L, RWKV_WIDTH), 0.02),
        "w_proj_a": nrm((L, ATT_WIDTH, D), ATT_WIDTH ** -0.5 * DEEPNORM_BETA),
        "w_proj_b": nrm((L, LRU_WIDTH, D), LRU_WIDTH ** -0.5 * DEEPNORM_BETA),
        "w_proj_c": nrm((L, RWKV_WIDTH, D), RWKV_WIDTH ** -0.5 * DEEPNORM_BETA),
        "w_out": nrm((L, D, D), D ** -0.5 * DEEPNORM_BETA),
    }


def reference(x, c, ada_w, ada_b, ln_g, ln_b, ffn_up, ffn_down, w_in, fox_f_bias,
              lru_conv_w, lru_conv_b, lru_ga_w, lru_ga_b, lru_gx_w, lru_gx_b, lru_lambda,
              rwkv_mu, rwkv_w0, rwkv_w2, rwkv_a0, rwkv_a2, rwkv_g2, rwkv_k_k, rwkv_k_a, rwkv_r_k,
              rwkv_gn_w, rwkv_gn_b, w_proj_a, w_proj_b, w_proj_c, w_out):
    c_act = jax.nn.silu(c)
    for l in range(DEPTH):
        ada = c_act @ ada_w[l] + ada_b[l]
        sh1, sc1, g1, sh2, sc2, g2, sh3, sc3, g3 = jnp.split(ada, N_ADA, axis=-1)
        h = _modulate(x, sh1, sc1)
        y = 0.5 * g1[:, None, :] * _swiglu(h, ffn_up[l, 0], ffn_down[l, 0])
        x = _post_norm(DEEPNORM_ALPHA * x + y, ln_g[l, 0], ln_b[l, 0])
        h = _modulate(x, sh2, sc2)
        y = g2[:, None, :] * _mixer(
            h, w_in[l], fox_f_bias[l],
            lru_conv_w[l], lru_conv_b[l], lru_ga_w[l], lru_ga_b[l], lru_gx_w[l], lru_gx_b[l], lru_lambda[l],
            rwkv_mu[l], rwkv_w0[l], rwkv_w2[l], rwkv_a0[l], rwkv_a2[l], rwkv_g2[l], rwkv_k_k[l], rwkv_k_a[l],
            rwkv_r_k[l], rwkv_gn_w[l], rwkv_gn_b[l],
            w_proj_a[l], w_proj_b[l], w_proj_c[l], w_out[l])
        x = _post_norm(DEEPNORM_ALPHA * x + y, ln_g[l, 1], ln_b[l, 1])
        h = _modulate(x, sh3, sc3)
        y = 0.5 * g3[:, None, :] * _swiglu(h, ffn_up[l, 1], ffn_down[l, 1])
        x = _post_norm(DEEPNORM_ALPHA * x + y, ln_g[l, 2], ln_b[l, 2])
    return x
```

```cpp
#include <hip/hip_runtime.h>
#include <hip/hip_cooperative_groups.h>
#include <cstdio>
#include <cstdint>
namespace cg = cooperative_groups;
namespace pg8 {
#define PG8_LAS __attribute__((address_space(3)))
typedef unsigned short bf16_t;
typedef short bf16x8 __attribute__((ext_vector_type(8)));
typedef float f32x4 __attribute__((ext_vector_type(4)));
typedef unsigned u32x4 __attribute__((ext_vector_type(4)));
constexpr int BM = 256, BK = 64, HALF = 128, HTB = HALF * BK * 2  , STAGE_BYTES = 8 * HTB, NXCD = 8, WGM = 8;

__host__ __device__ __forceinline__ int lds_byte(int r, int c) { const int st = (r >> 4) * 2 + (c >> 5), rr = r & 15, cc = c & 31, ob = rr * 64 + cc * 2; return st * 1024 + (ob ^ (((ob >> 9) & 1) << 5)); }
__host__ __device__ __forceinline__ void stage_rc(int b, int& R, int& C) { const int st = b / 1024, sb = b % 1024, swz = sb ^ (((sb >> 9) & 1) << 5); R = (st >> 1) * 16 + swz / 64; C = (st & 1) * 32 + (swz % 64) / 2; }
__host__ __device__ __forceinline__ int perm32(int rho) { const int n = rho >> 4, i = rho & 15; return 8 * (i >> 2) + 4 * n + (i & 3); }

struct Unit { int pm, pn; };
struct Gemm { const bf16_t* A; const bf16_t* Bt; int M, N, K, lda; };

struct StaticOrder {
    int nM, nN, nwg, G, c;
    __host__ __device__ void init(int M, int N, int G_, int c_) { nM = M / BM; nN = N / BM; nwg = nM * nN; G = G_; c = c_; }
    __host__ __device__ bool next(int i, Unit& u) const {
        const long L = (long)i * G + c; if (L >= nwg) return false;
        int wgid = (int)L; { const int q = nwg / NXCD, r = nwg % NXCD, xcd = wgid % NXCD, off = wgid / NXCD; wgid = (xcd < r ? xcd * (q + 1) : r * (q + 1) + (xcd - r) * q) + off; }
        const int nig = WGM * nN, gid = wgid / nig, fm = gid * WGM, gsz = (nM - fm) < WGM ? (nM - fm) : WGM;
        u.pm = fm + ((wgid % nig) % gsz); u.pn = (wgid % nig) / gsz; return true;
    }
    __device__ __forceinline__ void a_ready(const Unit&) const {}
    __device__ __forceinline__ void done(const Unit&) const {}
};

__device__ __forceinline__ unsigned cvt_pk_bf16(float lo, float hi) { unsigned r; asm volatile("v_cvt_pk_bf16_f32 %0, %1, %2" : "=v"(r) : "v"(lo), "v"(hi)); return r; }
typedef float f32x2 __attribute__((ext_vector_type(2)));
__device__ __forceinline__ f32x2 gelu_pk(f32x2 v) {
    const f32x2 av = __builtin_elementwise_abs(v), d = av * 0.2316418882f + 1.0f;
    f32x2 t; t.x = __builtin_amdgcn_rcpf(d.x); t.y = __builtin_amdgcn_rcpf(d.y);
    f32x2 q = t * 0.5307027145f + (-0.7265760135f); q = q * t + 0.7107068705f; q = q * t + (-0.142248368f); q = q * t + 0.127414796f; q = q * t;
    const f32x2 s = (v * v) * (-0.72134752044f);
    f32x2 e; e.x = __builtin_amdgcn_exp2f(s.x); e.y = __builtin_amdgcn_exp2f(s.y);
    const f32x2 m = v * (q * e), r = v - m;
    f32x2 o; o.x = v.x < 0.f ? m.x : r.x; o.y = v.y < 0.f ? m.y : r.y; return o;
}

template <int ACT  > struct EpiBf16 {
    static constexpr bool PERM = true, AFTER_DRAIN = false; static_assert(ACT == 0 || ACT == 1, "EpiBf16: ACT is 0 (none) or 1 (gelu_pk)");
    bf16_t* O; int ldc; const float* bias; int split_cols; size_t split_stride; float scale0;
    __device__ __forceinline__ void operator()(const f32x4 (&acc)[2][2][4][2], const Unit& u, int wr, int wc, int fr, int fq) const {
        const int row0 = u.pm * BM + wr * 64 + fr; int colt = u.pn * BM; bf16_t* base = O;
        float sc = 1.f; if (split_cols) { const int t = colt / split_cols; base += (size_t)t * split_stride; colt -= t * split_cols; if (t == 0) sc = scale0; }
        const int col0 = colt + wc * 32 + 8 * fq, bcol0 = u.pn * BM + wc * 32 + 8 * fq;
        f32x4 bv[2][2];
#pragma unroll
        for (int bj = 0; bj < 2; ++bj)
#pragma unroll
            for (int n = 0; n < 2; ++n) bv[bj][n] = bias ? *(const f32x4*)(bias + bcol0 + bj * HALF + 4 * n) : (f32x4){0.f, 0.f, 0.f, 0.f};
#pragma unroll
        for (int ai = 0; ai < 2; ++ai)
#pragma unroll
            for (int m = 0; m < 4; ++m) { bf16_t* rowp = base + (size_t)(row0 + ai * HALF + m * 16) * ldc + col0;
#pragma unroll
                for (int bj = 0; bj < 2; ++bj) { f32x4 v0 = acc[ai][bj][m][0] + bv[bj][0], v1 = acc[ai][bj][m][1] + bv[bj][1];
                    if (ACT == 1) { f32x2 a = gelu_pk((f32x2){v0[0], v0[1]}), b = gelu_pk((f32x2){v0[2], v0[3]}), c = gelu_pk((f32x2){v1[0], v1[1]}), d = gelu_pk((f32x2){v1[2], v1[3]});
                        v0 = (f32x4){a.x, a.y, b.x, b.y}; v1 = (f32x4){c.x, c.y, d.x, d.y}; }
                    v0 = v0 * sc; v1 = v1 * sc; u32x4 w; w.x = cvt_pk_bf16(v0[0], v0[1]); w.y = cvt_pk_bf16(v0[2], v0[3]); w.z = cvt_pk_bf16(v1[0], v1[1]); w.w = cvt_pk_bf16(v1[2], v1[3]);
                    *(u32x4*)(rowp + bj * HALF) = w; } }
    }
};

struct PanelStats {
    unsigned* xbuf;
    unsigned* cnt;
    unsigned* tmo;
    int ntn; float eps;
    unsigned code;
    __device__ __forceinline__ bool run(const f32x4 (&v)[2][2][4][2], const Unit& u, int wr, int wc, int fr, int fq, PG8_LAS unsigned char* lds, int wid, int lane) const {
        typedef float f32x2v __attribute__((ext_vector_type(2)));
        PG8_LAS f32x2v* P = (PG8_LAS f32x2v*)lds;
        PG8_LAS f32x2v* S = (PG8_LAS f32x2v*)(lds + 8192);
        PG8_LAS unsigned* flag = (PG8_LAS unsigned*)(lds + 8192 + 2048);
#pragma unroll
        for (int ai = 0; ai < 2; ++ai)
#pragma unroll
            for (int m = 0; m < 4; ++m) {
                float s = 0.f;
#pragma unroll
                for (int bj = 0; bj < 2; ++bj)
#pragma unroll
                    for (int n = 0; n < 2; ++n) { const f32x4 x = v[ai][bj][m][n]; s += (x[0] + x[1]) + (x[2] + x[3]); }
                s += __shfl_xor(s, 16); s += __shfl_xor(s, 32);
                const float mw = s * (1.0f / 64.0f); float q = 0.f;
#pragma unroll
                for (int bj = 0; bj < 2; ++bj)
#pragma unroll
                    for (int n = 0; n < 2; ++n) { const f32x4 d = v[ai][bj][m][n] - mw; q += (d[0] * d[0] + d[1] * d[1]) + (d[2] * d[2] + d[3] * d[3]); }
                q += __shfl_xor(q, 16); q += __shfl_xor(q, 32);
                if (fq == 0) P[(ai * HALF + wr * 64 + m * 16 + fr) * 4 + wc] = (f32x2v){mw, q};
            }
        asm volatile("s_waitcnt lgkmcnt(0)" ::: "memory"); __builtin_amdgcn_s_barrier(); asm volatile("" ::: "memory");
#if defined(BROKEN_EXCHANGE_NO_WAIT)
#warning BROKEN CONTROL BUILD: the row-statistics exchange does not wait; results are wrong by design
        if (blockIdx.x >= 64) { const long long t0_ = clock64(); while (clock64() - t0_ < 60000) __builtin_amdgcn_s_sleep(8); }
#endif
        const int row = wid * 32 + (lane & 31);
        if (lane < 32) {
            const f32x2v a = P[row * 4 + 0], b = P[row * 4 + 1], c = P[row * 4 + 2], d = P[row * 4 + 3];
            const float mt = (a.x + b.x + c.x + d.x) * 0.25f;
            const float da = a.x - mt, db = b.x - mt, dc = c.x - mt, dd = d.x - mt;
            const float m2 = (a.y + b.y) + (c.y + d.y) + 64.0f * ((da * da + db * db) + (dc * dc + dd * dd));
            unsigned long long* slot = (unsigned long long*)xbuf + ((size_t)(u.pm * BM + row) * 4 + u.pn);
            __hip_atomic_store(slot, ((unsigned long long)__float_as_uint(m2) << 32) | __float_as_uint(mt), __ATOMIC_RELAXED, __HIP_MEMORY_SCOPE_AGENT);
        }
        asm volatile("s_waitcnt vmcnt(0)" ::: "memory");
        if (lane == 0) __hip_atomic_fetch_add(cnt + 64 * u.pm, 1u, __ATOMIC_RELAXED, __HIP_MEMORY_SCOPE_AGENT);
        if (wid == 0) {
            bool dead = false; const unsigned long long t0 = __builtin_amdgcn_s_memrealtime(); const unsigned want = 8u * (unsigned)ntn;
            for (;;) {
#if defined(BROKEN_EXCHANGE_NO_WAIT)
                break;
#endif
                if ((unsigned)__builtin_amdgcn_readfirstlane(__hip_atomic_load(cnt + 64 * u.pm, __ATOMIC_RELAXED, __HIP_MEMORY_SCOPE_AGENT)) >= want) break;
                if (__builtin_amdgcn_s_memrealtime() - t0 > 2000000ull) {
                    if (lane == 0) { unsigned expect = 0u; __hip_atomic_compare_exchange_strong(tmo + 1, &expect, code | (unsigned)(u.pm & 0xff), __ATOMIC_RELAXED, __ATOMIC_RELAXED, __HIP_MEMORY_SCOPE_AGENT);
                                     __hip_atomic_store(tmo, 1u, __ATOMIC_RELAXED, __HIP_MEMORY_SCOPE_AGENT); }
                    dead = true; break; }
                __builtin_amdgcn_s_sleep(2);
            }
            __builtin_amdgcn_fence(__ATOMIC_ACQUIRE, "agent");
            if (lane == 0) flag[0] = dead ? 1u : 0u;
        }
        asm volatile("s_waitcnt vmcnt(0) lgkmcnt(0)" ::: "memory"); __builtin_amdgcn_s_barrier(); asm volatile("" ::: "memory");
        const bool bad = flag[0] != 0u;
        if (lane < 32) {
            const unsigned long long* slot = (const unsigned long long*)xbuf + (size_t)(u.pm * BM + row) * 4; float mt[4], m2[4]; float ms = 0.f;
#pragma unroll
            for (int t = 0; t < 4; ++t) { if (t < ntn) { const unsigned long long w = __hip_atomic_load(slot + t, __ATOMIC_RELAXED, __HIP_MEMORY_SCOPE_AGENT); mt[t] = __uint_as_float((unsigned)w); m2[t] = __uint_as_float((unsigned)(w >> 32)); } else { mt[t] = 0.f; m2[t] = 0.f; } ms += mt[t]; }
            const float mean = ms / (float)ntn; float q = 0.f;
#pragma unroll
            for (int t = 0; t < 4; ++t) if (t < ntn) { const float dm = mt[t] - mean; q += m2[t] + 256.0f * dm * dm; }
            S[row] = (f32x2v){mean, 1.0f / sqrtf(q / (256.0f * (float)ntn) + eps)};
        }
        asm volatile("s_waitcnt lgkmcnt(0)" ::: "memory"); __builtin_amdgcn_s_barrier(); asm volatile("" ::: "memory");
        return bad;
    }
};
struct EpiLnRes {
    static constexpr bool PERM = false, AFTER_DRAIN = true;
    const float* base; float* out; int ldc; const float* bias; PanelStats st; unsigned poison;
    __device__ __forceinline__ void fused(f32x4 (&acc)[2][2][4][2], const Unit& u, int wr, int wc, int fr, int fq, PG8_LAS unsigned char* lds, int wid, int lane) const {
        typedef float f32x2v __attribute__((ext_vector_type(2)));
        const PG8_LAS f32x2v* S = (const PG8_LAS f32x2v*)(lds + 8192);
        const int col0 = u.pn * BM + wc * 32 + 4 * fq;
#pragma unroll
        for (int bj = 0; bj < 2; ++bj)
#pragma unroll
            for (int n = 0; n < 2; ++n) { const f32x4 bv = bias ? *(const f32x4*)(bias + col0 + bj * HALF + n * 16) : (f32x4){0.f, 0.f, 0.f, 0.f};
#pragma unroll
                for (int ai = 0; ai < 2; ++ai)
#pragma unroll
                    for (int m = 0; m < 4; ++m) acc[ai][bj][m][n] += bv; }
        f32x4 pre[4][2][2];
#pragma unroll
        for (int m = 0; m < 4; ++m) { const size_t off = (size_t)(u.pm * BM + wr * 64 + m * 16 + fr) * ldc + col0;
#pragma unroll
            for (int bj = 0; bj < 2; ++bj)
#pragma unroll
                for (int n = 0; n < 2; ++n) pre[m][bj][n] = *(const f32x4*)(base + off + bj * HALF + n * 16); }
        const bool bad = st.run(acc, u, wr, wc, fr, fq, lds, wid, lane) || poison != 0u;
        const float qnan = __builtin_nanf("");
#pragma unroll
        for (int ai = 0; ai < 2; ++ai)
#pragma unroll
            for (int m = 0; m < 4; ++m) { const int r = ai * HALF + wr * 64 + m * 16 + fr; const f32x2v sr = S[r]; const size_t off = (size_t)(u.pm * BM + r) * ldc + col0;
#pragma unroll
                for (int bj = 0; bj < 2; ++bj)
#pragma unroll
                    for (int n = 0; n < 2; ++n) { const f32x4 bs = ai == 0 ? pre[m][bj][n] : *(const f32x4*)(base + off + bj * HALF + n * 16); f32x4 o = bs + (acc[ai][bj][m][n] - sr.x) * sr.y;
                        if (bad) o = (f32x4){qnan, qnan, qnan, qnan}; *(f32x4*)(out + off + bj * HALF + n * 16) = o; }
                if (m & 1) asm volatile("" ::: "memory"); }
    }
};
struct EpiLnResLn {
    static constexpr bool PERM = false, AFTER_DRAIN = true;
    const float* base; float* out; bf16_t* xn; int ldc; const float* bias; PanelStats st1, st2; unsigned poison;
    __device__ __forceinline__ void fused(f32x4 (&acc)[2][2][4][2], const Unit& u, int wr, int wc, int fr, int fq, PG8_LAS unsigned char* lds, int wid, int lane) const {
        typedef float f32x2v __attribute__((ext_vector_type(2))); typedef unsigned u32x2v __attribute__((ext_vector_type(2)));
        const PG8_LAS f32x2v* S = (const PG8_LAS f32x2v*)(lds + 8192);
        const int col0 = u.pn * BM + wc * 32 + 4 * fq;
#pragma unroll
        for (int bj = 0; bj < 2; ++bj)
#pragma unroll
            for (int n = 0; n < 2; ++n) { const f32x4 bv = bias ? *(const f32x4*)(bias + col0 + bj * HALF + n * 16) : (f32x4){0.f, 0.f, 0.f, 0.f};
#pragma unroll
                for (int ai = 0; ai < 2; ++ai)
#pragma unroll
                    for (int m = 0; m < 4; ++m) acc[ai][bj][m][n] += bv; }
        bool bad = st1.run(acc, u, wr, wc, fr, fq, lds, wid, lane) || poison != 0u;
        const float qnan = __builtin_nanf("");
#pragma unroll
        for (int ai = 0; ai < 2; ++ai)
#pragma unroll
            for (int m = 0; m < 4; ++m) { const int r = ai * HALF + wr * 64 + m * 16 + fr; const f32x2v sr = S[r]; const size_t off = (size_t)(u.pm * BM + r) * ldc + col0;
#pragma unroll
                for (int bj = 0; bj < 2; ++bj)
#pragma unroll
                    for (int n = 0; n < 2; ++n) { const f32x4 bs = *(const f32x4*)(base + off + bj * HALF + n * 16); acc[ai][bj][m][n] = bs + (acc[ai][bj][m][n] - sr.x) * sr.y; }
                asm volatile("" : "+v"(acc[ai][0][m][0]), "+v"(acc[ai][0][m][1]), "+v"(acc[ai][1][m][0]), "+v"(acc[ai][1][m][1]));
                if (m & 1) asm volatile("" ::: "memory"); }
        const bool bad1 = bad;
        bad = st2.run(acc, u, wr, wc, fr, fq, lds, wid, lane) || bad;
#pragma unroll
        for (int ai = 0; ai < 2; ++ai)
#pragma unroll
            for (int m = 0; m < 4; ++m) { const int r = ai * HALF + wr * 64 + m * 16 + fr; const f32x2v sr = S[r]; const size_t off = (size_t)(u.pm * BM + r) * ldc + col0;
#pragma unroll
                for (int bj = 0; bj < 2; ++bj)
#pragma unroll
                    for (int n = 0; n < 2; ++n) { const f32x4 x1 = acc[ai][bj][m][n]; *(f32x4*)(out + off + bj * HALF + n * 16) = bad1 ? (f32x4){qnan, qnan, qnan, qnan} : x1;
                        const f32x4 o = (x1 - sr.x) * sr.y; u32x2v w; w.x = cvt_pk_bf16(o[0], o[1]); w.y = cvt_pk_bf16(o[2], o[3]);
                        if (bad) { w.x = 0x7fc07fc0u; w.y = 0x7fc07fc0u; } *(u32x2v*)(xn + off + bj * HALF + n * 16) = w; }
                asm volatile("" ::: "memory"); }
    }
};

template <class Epi, class Sched, bool ALIGN_EPI = false, bool SP2 = false>
__device__ __forceinline__ void gemm_phase(PG8_LAS unsigned char* lds, const Gemm g, const Sched& S, const Epi& E) {
    int tid_l = threadIdx.x; asm volatile("" : "+v"(tid_l));
    const int tid = tid_l, wid = __builtin_amdgcn_readfirstlane(tid >> 6), lane = tid & 63, wr = wid >> 2, wc = wid & 3, fr = lane & 15, fq = lane >> 4;
    const int K = g.K, nt = K / BK;
    unsigned voffA[2], voffB[2];
#pragma unroll
    for (int i = 0; i < 2; ++i) { int R, C; stage_rc(tid * 16 + i * 8192, R, C); const int Rb = Epi::PERM ? ((R & ~31) + perm32(R & 31)) : R;
        voffA[i] = (unsigned)(R * g.lda + C) * 2u; voffB[i] = (unsigned)(Rb * K + C) * 2u; }
    const size_t kstep = (size_t)(BK * 2);
    const size_t hstep = (size_t)HALF * K * 2;
    const size_t tstep = 2 * hstep; const size_t hstepA = (size_t)HALF * g.lda * 2, tstepA = 2 * hstepA;
    const unsigned ldsw = (unsigned)wid * 1024u;
    const int aoff = lds_byte(wr * 64 + fr, fq * 8), boff = lds_byte(wc * 32 + fr, fq * 8);
#define PG8_SA(b, h) (((b) * 2 + (h)) * HTB)
#define PG8_SB(b, h) ((4 + (b) * 2 + (h)) * HTB)
#define PG8_STAGE(bufoff, gbase, voff) do { _Pragma("unroll") for (int _i = 0; _i < 2; ++_i) \
        __builtin_amdgcn_global_load_lds((const unsigned*)((const char*)(gbase) + (voff)[_i]), (PG8_LAS unsigned*)(lds + (bufoff) + ldsw + _i * 8192), 16, 0, 0); } while (0)
#define PG8_LDA(dst, b, h) do { _Pragma("unroll") for (int m = 0; m < 4; ++m) _Pragma("unroll") for (int k = 0; k < 2; ++k) dst[m][k] = *(const PG8_LAS bf16x8*)(lds + PG8_SA(b, h) + aoff + m * 2048 + k * 1024); } while (0)
#define PG8_LDB(dst, b, h) do { _Pragma("unroll") for (int n = 0; n < 2; ++n) _Pragma("unroll") for (int k = 0; k < 2; ++k) dst[n][k] = *(const PG8_LAS bf16x8*)(lds + PG8_SB(b, h) + boff + n * 2048 + k * 1024); } while (0)
#define PG8_MMA(ai, bj, At, Bt) do { __builtin_amdgcn_s_setprio(1); _Pragma("unroll") for (int m = 0; m < 4; ++m) _Pragma("unroll") for (int n = 0; n < 2; ++n) _Pragma("unroll") for (int k = 0; k < 2; ++k) \
        acc[ai][bj][m][n] = __builtin_amdgcn_mfma_f32_16x16x32_bf16(Bt[n][k], At[m][k], acc[ai][bj][m][n], 0, 0, 0); __builtin_amdgcn_s_setprio(0); } while (0)
#define PG8_WAIT_V(n) asm volatile("s_waitcnt vmcnt(" #n ")" ::: "memory")
#define PG8_WAIT_L(n) asm volatile("s_waitcnt lgkmcnt(" #n ")" ::: "memory")
#define PG8_BAR __builtin_amdgcn_s_barrier()
#define PG8_SCHED __builtin_amdgcn_sched_barrier(0)
    Unit cur, nxt; int ui = 0;
    if (!S.next(0, cur)) return;
    f32x4 acc[2][2][4][2];
#pragma unroll
    for (int a = 0; a < 2; ++a)
#pragma unroll
        for (int b = 0; b < 2; ++b)
#pragma unroll
            for (int m = 0; m < 4; ++m)
#pragma unroll
                for (int n = 0; n < 2; ++n) acc[a][b][m][n] = (f32x4){0.f, 0.f, 0.f, 0.f};
    bf16x8 At[4][2], B0[2][2], B1[2][2];
    const char* cA = (const char*)g.A + (size_t)cur.pm * tstepA; const char* cB = (const char*)g.Bt + (size_t)cur.pn * tstep;
    S.a_ready(cur);
    if constexpr (SP2) {
        PG8_STAGE(PG8_SB(0, 0), cB, voffB); PG8_STAGE(PG8_SB(0, 1), cB + hstep, voffB); PG8_STAGE(PG8_SA(0, 0), cA, voffA); PG8_STAGE(PG8_SA(0, 1), cA + hstepA, voffA);
        if (wr == 1) PG8_BAR;
        PG8_WAIT_V(2); PG8_BAR;
        PG8_STAGE(PG8_SB(1, 0), cB + kstep, voffB); PG8_STAGE(PG8_SA(1, 0), cA + kstep, voffA); PG8_STAGE(PG8_SB(1, 1), cB + hstep + kstep, voffB);
        PG8_WAIT_V(6); PG8_BAR;
    } else {
        PG8_STAGE(PG8_SB(0, 0), cB, voffB); PG8_STAGE(PG8_SA(0, 0), cA, voffA); PG8_STAGE(PG8_SB(0, 1), cB + hstep, voffB); PG8_STAGE(PG8_SA(0, 1), cA + hstepA, voffA);
        if (wr == 1) PG8_BAR;
        PG8_WAIT_V(4); PG8_BAR;
        PG8_STAGE(PG8_SB(1, 0), cB + kstep, voffB); PG8_STAGE(PG8_SA(1, 0), cA + kstep, voffA); PG8_STAGE(PG8_SB(1, 1), cB + hstep + kstep, voffB);
        PG8_WAIT_V(6); PG8_BAR;
    }
    for (;;) {
        const bool has_next = S.next(ui + 1, nxt);
        const char* nA = has_next ? (const char*)g.A + (size_t)nxt.pm * tstepA : cA; const char* nB = has_next ? (const char*)g.Bt + (size_t)nxt.pn * tstep : cB;
        for (int t = 0; t < nt; t += 2) {
            const bool last = (t == nt - 2);
            const char* a1 = cA + (size_t)(t + 1) * kstep;
            const char* a2 = last ? nA : cA + (size_t)(t + 2) * kstep; const char* b2 = last ? nB : cB + (size_t)(t + 2) * kstep;
            const char* a3 = a2 + kstep; const char* b3 = b2 + kstep;
            if (last && has_next) S.a_ready(nxt);
            if constexpr (SP2) {
            PG8_LDB(B0, 0, 0); PG8_LDB(B1, 0, 1); PG8_SCHED; PG8_LDA(At, 0, 0); PG8_STAGE(PG8_SA(1, 1), a1 + hstepA, voffA);
            PG8_WAIT_V(8); PG8_WAIT_L(0); PG8_BAR; PG8_MMA(0, 0, At, B0); PG8_MMA(0, 1, At, B1); PG8_BAR; PG8_SCHED;
            PG8_LDA(At, 0, 1); PG8_STAGE(PG8_SB(0, 0), b2, voffB); PG8_STAGE(PG8_SB(0, 1), b2 + hstep, voffB); PG8_STAGE(PG8_SA(0, 0), a2, voffA);
            PG8_WAIT_V(8); PG8_WAIT_L(0); PG8_BAR; PG8_MMA(1, 0, At, B0); PG8_MMA(1, 1, At, B1); PG8_BAR; PG8_SCHED;
            PG8_LDB(B0, 1, 0); PG8_LDB(B1, 1, 1); PG8_SCHED; PG8_LDA(At, 1, 0); PG8_STAGE(PG8_SA(0, 1), a2 + hstepA, voffA);
            PG8_WAIT_V(8); PG8_WAIT_L(0); PG8_BAR; PG8_MMA(0, 0, At, B0); PG8_MMA(0, 1, At, B1); PG8_BAR; PG8_SCHED;
            PG8_LDA(At, 1, 1); PG8_STAGE(PG8_SB(1, 0), b3, voffB); PG8_STAGE(PG8_SB(1, 1), b3 + hstep, voffB); PG8_STAGE(PG8_SA(1, 0), a3, voffA);
            PG8_WAIT_V(8); PG8_WAIT_L(0); PG8_BAR; PG8_MMA(1, 0, At, B0); PG8_MMA(1, 1, At, B1); PG8_BAR; PG8_SCHED;
            } else {
            PG8_LDB(B0, 0, 0); PG8_SCHED; PG8_LDA(At, 0, 0); PG8_STAGE(PG8_SA(1, 1), a1 + hstepA, voffA);
            PG8_WAIT_L(8); PG8_BAR; PG8_WAIT_L(0); PG8_MMA(0, 0, At, B0); PG8_BAR; PG8_SCHED;
            PG8_LDB(B1, 0, 1); PG8_STAGE(PG8_SB(0, 0), b2, voffB);
            PG8_BAR; PG8_WAIT_L(0); PG8_MMA(0, 1, At, B1); PG8_BAR;
            PG8_LDA(At, 0, 1); PG8_STAGE(PG8_SA(0, 0), a2, voffA);
            PG8_BAR; PG8_WAIT_L(0); PG8_MMA(1, 0, At, B0); PG8_BAR; PG8_SCHED;
            PG8_STAGE(PG8_SB(0, 1), b2 + hstep, voffB);
            PG8_WAIT_V(6); PG8_BAR; PG8_MMA(1, 1, At, B1); PG8_BAR;
            PG8_LDB(B0, 1, 0); PG8_SCHED; PG8_LDA(At, 1, 0); PG8_STAGE(PG8_SA(0, 1), a2 + hstepA, voffA);
            PG8_WAIT_L(8); PG8_BAR; PG8_WAIT_L(0); PG8_MMA(0, 0, At, B0); PG8_BAR; PG8_SCHED;
            PG8_LDB(B1, 1, 1); PG8_STAGE(PG8_SB(1, 0), b3, voffB);
            PG8_BAR; PG8_WAIT_L(0); PG8_MMA(0, 1, At, B1); PG8_BAR;
            PG8_LDA(At, 1, 1); PG8_STAGE(PG8_SA(1, 0), a3, voffA);
            PG8_BAR; PG8_WAIT_L(0); PG8_MMA(1, 0, At, B0); PG8_BAR; PG8_SCHED;
            PG8_STAGE(PG8_SB(1, 1), b3 + hstep, voffB);
            PG8_WAIT_V(6); PG8_BAR; PG8_MMA(1, 1, At, B1); PG8_BAR;
            }
        }
        if constexpr (ALIGN_EPI) { if (wr == 0) PG8_BAR; }
        if constexpr (!Epi::AFTER_DRAIN) { E(acc, cur, wr, wc, fr, fq); S.done(cur); }
        if (!has_next) break;
#pragma unroll
        for (int a = 0; a < 2; ++a)
#pragma unroll
            for (int b = 0; b < 2; ++b)
#pragma unroll
                for (int m = 0; m < 4; ++m)
#pragma unroll
                    for (int n = 0; n < 2; ++n) acc[a][b][m][n] = (f32x4){0.f, 0.f, 0.f, 0.f};
        cur = nxt; cA = nA; cB = nB; ++ui;
        if constexpr (ALIGN_EPI) { if (wr == 1) PG8_BAR; }
    }
    PG8_WAIT_V(0);
    if constexpr (!ALIGN_EPI) { if (wr == 0) PG8_BAR; }
    PG8_BAR;
    if constexpr (Epi::AFTER_DRAIN) { E.fused(acc, cur, wr, wc, fr, fq, lds, wid, lane); S.done(cur); }
#undef PG8_SA
#undef PG8_SB
#undef PG8_STAGE
#undef PG8_LDA
#undef PG8_LDB
#undef PG8_MMA
#undef PG8_WAIT_V
#undef PG8_WAIT_L
#undef PG8_BAR
#undef PG8_SCHED
}
}

#ifndef PG8_SP2
#define PG8_SP2 true
#endif
#ifndef PG8_ALIGN
#define PG8_ALIGN true
#endif
#include <hip/hip_bf16.h>
#include <cmath>
namespace attn_body {
using bf16=__hip_bfloat16;
using bf16x8=__attribute__((ext_vector_type(8)))short;
using s16x4=__attribute__((ext_vector_type(4)))short;
using f32x16=__attribute__((ext_vector_type(16)))float;
using u32x4=__attribute__((ext_vector_type(4)))unsigned;
using f32x4v=__attribute__((ext_vector_type(4)))float;
constexpr int BATCH=1,NHEAD=8,SEQ=16384,D=64,DM=8704;
constexpr int NW=8,QBLK=32,QB=QBLK*NW,KVBLK=64,NQB=SEQ/QB;
constexpr int ATTN_PITCH=DM, ATTN_UNIT_ROWS=QB;
__device__ __forceinline__ int crow(int r,int hi){return (r&3)+8*(r>>2)+4*hi;}
#define SBAR() __builtin_amdgcn_sched_barrier(0)
__device__ __forceinline__ void cmask(f32x16&p0,f32x16&p1,int jb,int qrel,int hi){
  const float NEG=-INFINITY; int kb=64*jb+4*hi;
  #pragma unroll
  for(int r=0;r<16;++r){int kv=kb+(r&3)+8*(r>>2); if(kv>qrel)p0[r]=NEG; if(kv+32>qrel)p1[r]=NEG;}
}

constexpr int NSLOT=3, SLOTB=8192;
constexpr int LDS_K=0, LDS_V=NSLOT*SLOTB, LDS_WS=2*NSLOT*SLOTB, LDS_OST=LDS_WS+NW*64*4, LDS_F=LDS_OST+NW*4096, LDS_BYTES=LDS_F+SEQ*4;
constexpr float C2=0.125f*1.4426950408889634f;
__device__ __forceinline__ void glds16(const void*gsrc,unsigned lds_dst){unsigned keep;
  asm volatile("s_mov_b32 %0, m0\n\ts_mov_b32 m0, %2\n\ts_nop 0\n\tglobal_load_lds_dwordx4 %1, off\n\ts_mov_b32 m0, %0":"=&s"(keep):"v"(gsrc),"s"(lds_dst):"memory");}
__device__ __forceinline__ float max3f(float a,float b,float c){float r;asm("v_max3_f32 %0, %1, %2, %3":"=v"(r):"v"(a),"v"(b),"v"(c));return r;}
__device__ __forceinline__ float max2f(float a,float b){float r;asm("v_max_f32_e32 %0, %1, %2":"=v"(r):"v"(a),"v"(b));return r;}
__device__ __forceinline__ float fadd_s(float a,float b){float r;asm("v_add_f32_e32 %0, %1, %2":"=v"(r):"v"(a),"v"(b));return r;}
__device__ __forceinline__ float fsub_s(float a,float b){float r;asm("v_sub_f32_e32 %0, %1, %2":"=v"(r):"v"(a),"v"(b));return r;}
typedef float f32x2_t __attribute__((ext_vector_type(2))); typedef __bf16 bf16x2_t __attribute__((ext_vector_type(2)));
__device__ __forceinline__ unsigned cvtpk_s(float lo,float hi){f32x2_t v={lo,hi};bf16x2_t b=__builtin_convertvector(v,bf16x2_t);return __builtin_bit_cast(unsigned,b);}
#define WAIT_BAR(N) asm volatile("s_waitcnt vmcnt(" #N ") lgkmcnt(0)\n\ts_barrier":::"memory")


__device__ __forceinline__ bf16x8 mkbias(float x,int hi){
  const unsigned xb=__float_as_uint(x); const unsigned hb=xb&0xffff0000u; const float r1=x-__uint_as_float(hb);
  const unsigned mb=__float_as_uint(r1)&0xffff0000u; const float r2=r1-__uint_as_float(mb); const unsigned lb=__float_as_uint(r2)&0xffff0000u;
  u32x4 w; w.x=(hb>>16)|mb; w.y=(lb>>16)|0x3f800000u; w.z=0x3f803f80u; w.w=0u; if(hi){w.x=0u;w.y=0u;w.z=0u;}
  return __builtin_bit_cast(bf16x8,w);
}
__device__ __forceinline__ bf16x8 mkq(float x,int hi){
  const unsigned xb=__float_as_uint(x); const unsigned hb=xb&0xffff0000u; const float r1=x-__uint_as_float(hb);
  const unsigned mb=__float_as_uint(r1)&0xffff0000u; const float r2=r1-__uint_as_float(mb); const unsigned lb=__float_as_uint(r2)&0xffff0000u;
  u32x4 w; w.x=0x3f803f80u; w.y=0x3f80u|hb; w.z=(mb>>16)|lb; w.w=0u; if(hi){w.x=0u;w.y=0u;w.z=0u;}
  return __builtin_bit_cast(bf16x8,w);
}
__device__ __forceinline__ void qkt(f32x16&p0,f32x16&p1,const char*Kslot,const bf16x8*qr,int r32,int hi,bf16x8 kb0,bf16x8 kb1,bf16x8 qone){ const f32x16 negm=f32x16{};
  const char*kb=Kslot+hi*1024+r32*16;
  #pragma unroll
  for(int d0=0;d0<4;++d0){
    const bf16x8 b0=*reinterpret_cast<const bf16x8*>(kb+d0*2048);
    const bf16x8 b1=*reinterpret_cast<const bf16x8*>(kb+d0*2048+512);
    if(d0==0){p0=__builtin_amdgcn_mfma_f32_32x32x16_bf16(b0,qr[0],negm,0,0,0);p1=__builtin_amdgcn_mfma_f32_32x32x16_bf16(b1,qr[0],negm,0,0,0);}
    else{p0=__builtin_amdgcn_mfma_f32_32x32x16_bf16(b0,qr[d0],p0,0,0,0);p1=__builtin_amdgcn_mfma_f32_32x32x16_bf16(b1,qr[d0],p1,0,0,0);}}
  p0=__builtin_amdgcn_mfma_f32_32x32x16_bf16(kb0,qone,p0,0,0,0);p1=__builtin_amdgcn_mfma_f32_32x32x16_bf16(kb1,qone,p1,0,0,0);
}
typedef __attribute__((address_space(3))) const char* lds_cptr;
typedef short v4i16_t __attribute__((ext_vector_type(4)));
__device__ __forceinline__ void kload8(bf16x8*kf,lds_cptr kp){
  kf[0]=*(const __attribute__((address_space(3))) bf16x8*)(kp);      kf[1]=*(const __attribute__((address_space(3))) bf16x8*)(kp+512);
  kf[2]=*(const __attribute__((address_space(3))) bf16x8*)(kp+2048); kf[3]=*(const __attribute__((address_space(3))) bf16x8*)(kp+2560);
  kf[4]=*(const __attribute__((address_space(3))) bf16x8*)(kp+4096); kf[5]=*(const __attribute__((address_space(3))) bf16x8*)(kp+4608);
  kf[6]=*(const __attribute__((address_space(3))) bf16x8*)(kp+6144); kf[7]=*(const __attribute__((address_space(3))) bf16x8*)(kp+6656);
}
__device__ __forceinline__ void kload2(bf16x8*kf,lds_cptr kp,int j){ kf[2*j]=*(const __attribute__((address_space(3))) bf16x8*)(kp+j*2048); kf[2*j+1]=*(const __attribute__((address_space(3))) bf16x8*)(kp+j*2048+512); }
__device__ __forceinline__ s16x4 vtr(lds_cptr p){ return __builtin_bit_cast(s16x4,__builtin_amdgcn_ds_read_tr16_b64_v4i16((__attribute__((address_space(3))) v4i16_t*)p)); }
__device__ __forceinline__ float rowmax(const f32x16&p0,const f32x16&p1){
  float a=max3f(p0[0],p0[1],p1[0]),b=max3f(p0[2],p0[3],p1[1]);a=max3f(a,p1[2],p1[3]);
  #pragma unroll
  for(int r=4;r<16;r+=4){a=max3f(a,p0[r],p0[r+1]);b=max3f(b,p0[r+2],p0[r+3]);a=max3f(a,p1[r],p1[r+1]);b=max3f(b,p1[r+2],p1[r+3]);}
  const float m=max2f(a,b);
  auto rr=__builtin_amdgcn_permlane32_swap(__float_as_uint(m),__float_as_uint(m),false,false);
  return max2f(__uint_as_float(rr[0]),__uint_as_float(rr[1]));
}
__device__ __forceinline__ void pv(f32x16*o,int vb,bf16x8 pa0,bf16x8 pa1,bf16x8 pa2,bf16x8 pa3){
  #pragma unroll
  for(int d0=0;d0<2;++d0){s16x4 lo[4],hi[4];
    #pragma unroll
    for(int ks=0;ks<4;++ks){
      asm volatile("ds_read_b64_tr_b16 %0,%1 offset:%c2":"=&v"(lo[ks]):"v"(vb),"i"(d0*4096+ks*1024):"memory");
      asm volatile("ds_read_b64_tr_b16 %0,%1 offset:%c2":"=&v"(hi[ks]):"v"(vb),"i"(d0*4096+ks*1024+512):"memory");}
    asm volatile("s_waitcnt lgkmcnt(0)":::"memory");SBAR();
    #define PK(k) (bf16x8){lo[k][0],lo[k][1],lo[k][2],lo[k][3],hi[k][0],hi[k][1],hi[k][2],hi[k][3]}
    o[d0]=__builtin_amdgcn_mfma_f32_32x32x16_bf16(pa0,PK(0),o[d0],0,0,0);
    o[d0]=__builtin_amdgcn_mfma_f32_32x32x16_bf16(pa1,PK(1),o[d0],0,0,0);
    o[d0]=__builtin_amdgcn_mfma_f32_32x32x16_bf16(pa2,PK(2),o[d0],0,0,0);
    o[d0]=__builtin_amdgcn_mfma_f32_32x32x16_bf16(pa3,PK(3),o[d0],0,0,0);
    #undef PK
  }
}

#ifndef ATTN_STORE16
#define ATTN_STORE16(p,v) (*(u32x4*)(p)=(v))
#endif
template<int THRL> __device__ __forceinline__ void attn_unit(int b,int h,int qb,const bf16*Q,const bf16*__restrict__ K,const bf16*__restrict__ V,bf16*O,const float*FL2,char*shm){
  int tid_l=threadIdx.x; asm volatile("":"+v"(tid_l));
  const int tid=tid_l,lane=tid&63,r32=lane&31,hi=lane>>5; const int wid=__builtin_amdgcn_readfirstlane(tid>>6);
  const long rowbase=(long)b*SEQ; const int q0=qb*QB;
  const bf16*Qw=Q+(rowbase+q0+wid*QBLK)*DM+h*D;
  const bf16*Kh=K+rowbase*DM+h*D,*Vh=V+rowbase*DM+h*D;
  const lds_cptr shm3=(lds_cptr)shm;
  const unsigned lds0=(unsigned)(uintptr_t)shm;
  float*wsf=(float*)(shm+LDS_WS)+wid*64;
  const bf16*ksrc=Kh+(long)lane*DM+wid*8;
  const bf16*vsrc=Vh+(long)(16*(wid&3)+(lane>>2))*DM+(wid>>2)*32+(lane&3)*8;
  const unsigned kdst=lds0+LDS_K+wid*1024, vdst=lds0+LDS_V+wid*1024;
  #define DMA_K(t,slot) glds16(ksrc+(long)(t)*KVBLK*DM,(unsigned)__builtin_amdgcn_readfirstlane(kdst+(slot)))
  #define DMA_V(t,slot) glds16(vsrc+(long)(t)*KVBLK*DM,(unsigned)__builtin_amdgcn_readfirstlane(vdst+(slot)))
  const int vb0=(int)(lds0+LDS_V)+((lane>>4)&1)*32+(lane&3)*8+(4*hi+((lane&15)>>2))*64;
  const char*Kbase=shm+LDS_K; bf16x8 kf[8];
  const lds_cptr kp0=shm3+LDS_K+hi*1024+r32*16; const lds_cptr vp0=shm3+LDS_V+((lane>>4)&1)*32+(lane&3)*8+(4*hi+((lane&15)>>2))*64;
  const int NT=(q0+QB)/KVBLK;
  const __attribute__((address_space(3))) float* Fl=(const __attribute__((address_space(3))) float*)(shm3+LDS_F);
  float fref;
  { const float*Fg=FL2+(long)h*SEQ; const int nF=q0+QB;
    for(int i=tid*4;i<nF;i+=NW*64*4){ const f32x4v v4=*reinterpret_cast<const f32x4v*>(Fg+i); *(__attribute__((address_space(3))) f32x4v*)(shm3+LDS_F+i*4)=v4; }
    fref=Fg[nF-1]; }
  asm volatile("s_waitcnt vmcnt(0) lgkmcnt(0)":::"memory");
  bf16x8 qone=mkq(0.f,hi);
  #define MKB(t,off) mkbias(fref-Fl[(t)*KVBLK+(off)+r32],hi)
  DMA_K(0,0);DMA_V(0,0);DMA_K(1,SLOTB);
  bf16x8 qr[4];
  #pragma unroll
  for(int d0=0;d0<4;++d0)qr[d0]=*reinterpret_cast<const bf16x8*>(&Qw[(long)r32*DM+d0*16+hi*8]);
  float mhat=0.f,l_reg=0.f;f32x16 o[2];o[0]=f32x16{};o[1]=f32x16{};
  const int qrel=wid*QBLK+r32;
  #define CMASK(P0,P1,t) do{int jb_=(t)-(NT-4); if(jb_>=0)cmask(P0,P1,jb_,qrel,hi);}while(0)
  bool resc=false;
  #define START(P0,P1) do{ const float rm=rowmax(P0,P1); resc=false; \
    { const float dl=rm; mhat=fadd_s(mhat,dl); \
      _Pragma("unroll") for(int r=0;r<16;++r){P0[r]=fsub_s(P0[r],dl);P1[r]=fsub_s(P1[r],dl);} \
      qone=mkq(-mhat,hi); } \
    _Pragma("unroll") for(int r=0;r<16;++r)P0[r]=__builtin_amdgcn_exp2f(P0[r]); }while(0)
  #define RESC() do{ if(resc){ asm volatile("s_waitcnt lgkmcnt(0)":::"memory"); \
      _Pragma("unroll") for(int d_=0;d_<2;++d_) _Pragma("unroll") for(int r=0;r<16;++r)o[d_][r]*=wsf[crow(r,hi)]; } }while(0)
  f32x16 pA0,pA1,pB0,pB1;
  int sl_prev=0,sl_cur=0,sl_next=SLOTB;
  #define ROT() do{sl_prev=sl_cur;sl_cur=sl_next;sl_next=(sl_next==(NSLOT-1)*SLOTB)?0:sl_next+SLOTB;}while(0)
  DMA_K(2,2*SLOTB);
  WAIT_BAR(3);
  qkt(pA0,pA1,Kbase,qr,r32,hi,MKB(0,0),MKB(0,32),qone);asm volatile("s_nop 15\n\ts_nop 7":"+v"(pA0),"+v"(pA1));CMASK(pA0,pA1,0);
  START(pA0,pA1);
  _Pragma("unroll") for(int r=0;r<16;++r)pA1[r]=__builtin_amdgcn_exp2f(pA1[r]);
  WAIT_BAR(0);
  DMA_K(3,0);DMA_V(1,SLOTB);
  ROT();
  kload8(kf,kp0+sl_cur);
  WAIT_BAR(2);
  s16x4 vlo[8],vhi[8]; u32x4 pw0,pw1,pw2,pw3;
  #define PKW(P,B) cvtpk_s(P[B],P[B+1])
  #define PAF(k) __builtin_bit_cast(bf16x8,pw##k)
  #define VFR(i) (bf16x8){vlo[i][0],vlo[i][1],vlo[i][2],vlo[i][3],vhi[i][0],vhi[i][1],vhi[i][2],vhi[i][3]}
  #define PIN(x) asm volatile("":"+v"(x))
  #define MX3(a,b,c) __builtin_fmaxf(__builtin_fmaxf((a),(b)),(c))
  #define GAPA(MF,A0,A1,A2,A3,W0,W1,PW) do{ MF; sacc+=A0; sacc+=A1; sacc+=A2; sacc+=A3; PIN(sacc); W0; W1; PIN(PW); SBAR(); }while(0)
  #define EX(v) __builtin_amdgcn_exp2f(v)
  #define GAPB(MF,X,B) do{ MF; X[B]=EX(X[B]); X[B+1]=EX(X[B+1]); X[B+2]=EX(X[B+2]); X[B+3]=EX(X[B+3]); PIN(X); SBAR(); }while(0)
  #define VRD(i) do{ vlo[i]=vtr(vp_+(((i)>>2)*4096+((i)&3)*1024)); vhi[i]=vtr(vp_+(((i)>>2)*4096+((i)&3)*1024+512)); }while(0)
  #define KRD(G,j) do{ if(G){ kload2(kf,kp0+sl_next,j); SBAR(); } }while(0)
  #define STEP(C0,C1,P0,P1,t,GK,GV,GL) do{ SBAR(); \
    const bf16x8 kbA_=MKB(t,0), kbB_=MKB(t,32); \
    const lds_cptr vp_=vp0+sl_prev; \
    VRD(0); SBAR(); float sacc=(P0[0]+P0[1]); \
    GAPA(C0=__builtin_amdgcn_mfma_f32_32x32x16_bf16(kf[0],qr[0],f32x16{},0,0,0), P0[2],P0[3],P0[4],P0[5],     pw0[0]=PKW(P0,0), pw0[1]=PKW(P0,2), pw0); \
    VRD(4); SBAR(); GAPA(C1=__builtin_amdgcn_mfma_f32_32x32x16_bf16(kf[1],qr[0],f32x16{},0,0,0), P0[6],P0[7],P0[8],P0[9],     pw0[2]=PKW(P0,4), pw0[3]=PKW(P0,6), pw0); \
    VRD(1); SBAR(); GAPA(C0=__builtin_amdgcn_mfma_f32_32x32x16_bf16(kf[2],qr[1],C0,0,0,0),   P0[10],P0[11],P0[12],P0[13], pw1[0]=PKW(P0,8), pw1[1]=PKW(P0,10), pw1); \
    VRD(5); SBAR(); GAPA(C1=__builtin_amdgcn_mfma_f32_32x32x16_bf16(kf[3],qr[1],C1,0,0,0),   P0[14],P0[15],P1[0],P1[1],   pw1[2]=PKW(P0,12),pw1[3]=PKW(P0,14), pw1); \
    VRD(2); SBAR(); GAPA(C0=__builtin_amdgcn_mfma_f32_32x32x16_bf16(kf[4],qr[2],C0,0,0,0),   P1[2],P1[3],P1[4],P1[5],     pw2[0]=PKW(P1,0), pw2[1]=PKW(P1,2), pw2); \
    VRD(6); SBAR(); GAPA(C1=__builtin_amdgcn_mfma_f32_32x32x16_bf16(kf[5],qr[2],C1,0,0,0),   P1[6],P1[7],P1[8],P1[9],     pw2[2]=PKW(P1,4), pw2[3]=PKW(P1,6), pw2); \
    VRD(3); SBAR(); GAPA(C0=__builtin_amdgcn_mfma_f32_32x32x16_bf16(kf[6],qr[3],C0,0,0,0),   P1[10],P1[11],P1[12],P1[13], pw3[0]=PKW(P1,8), pw3[1]=PKW(P1,10), pw3); \
    VRD(7); SBAR(); GAPA(C1=__builtin_amdgcn_mfma_f32_32x32x16_bf16(kf[7],qr[3],C1,0,0,0),   P1[14],P1[15],0.f,0.f,       pw3[2]=PKW(P1,12),pw3[3]=PKW(P1,14), pw3); \
    C0=__builtin_amdgcn_mfma_f32_32x32x16_bf16(kbA_,qone,C0,0,0,0); C1=__builtin_amdgcn_mfma_f32_32x32x16_bf16(kbB_,qone,C1,0,0,0); \
    l_reg+=sacc; \
    if(GK){DMA_K((t)+3,sl_cur);} if(GV){DMA_V((t)+1,sl_next);} \
    CMASK(C0,C1,t); \
    { float a=MX3(C0[0],C0[1],C1[0]),b=MX3(C0[2],C0[3],C1[1]); a=MX3(a,C1[2],C1[3]); \
      _Pragma("unroll") for(int r=4;r<16;r+=4){a=MX3(a,C0[r],C0[r+1]);b=MX3(b,C0[r+2],C0[r+3]);a=MX3(a,C1[r],C1[r+1]);b=MX3(b,C1[r+2],C1[r+3]);} \
      float rm=__builtin_fmaxf(a,b); { auto rr=__builtin_amdgcn_permlane32_swap(__float_as_uint(rm),__float_as_uint(rm),false,false); rm=__builtin_fmaxf(__uint_as_float(rr[0]),__uint_as_float(rr[1])); } \
      resc=false; \
      if(__builtin_expect(__any(rm>(float)THRL),0)){ const float dl=__builtin_fmaxf(rm,0.f); mhat+=dl; \
        _Pragma("unroll") for(int r=0;r<16;++r){C0[r]-=dl;C1[r]-=dl;} \
        qone=mkq(-mhat,hi); \
        const float f=__builtin_amdgcn_exp2f(-dl); l_reg*=f; if(hi==0)wsf[r32]=f; resc=true; } } \
    SBAR(); \
    GAPB(o[0]=__builtin_amdgcn_mfma_f32_32x32x16_bf16(PAF(0),VFR(0),o[0],0,0,0), C0,0); \
    GAPB(o[1]=__builtin_amdgcn_mfma_f32_32x32x16_bf16(PAF(0),VFR(4),o[1],0,0,0), C0,4); \
    KRD(GL,0); GAPB(o[0]=__builtin_amdgcn_mfma_f32_32x32x16_bf16(PAF(1),VFR(1),o[0],0,0,0), C0,8); \
    KRD(GL,1); GAPB(o[1]=__builtin_amdgcn_mfma_f32_32x32x16_bf16(PAF(1),VFR(5),o[1],0,0,0), C0,12); \
    KRD(GL,2); GAPB(o[0]=__builtin_amdgcn_mfma_f32_32x32x16_bf16(PAF(2),VFR(2),o[0],0,0,0), C1,0); \
    KRD(GL,3); GAPB(o[1]=__builtin_amdgcn_mfma_f32_32x32x16_bf16(PAF(2),VFR(6),o[1],0,0,0), C1,4); \
    GAPB(o[0]=__builtin_amdgcn_mfma_f32_32x32x16_bf16(PAF(3),VFR(3),o[0],0,0,0), C1,8); \
    GAPB(o[1]=__builtin_amdgcn_mfma_f32_32x32x16_bf16(PAF(3),VFR(7),o[1],0,0,0), C1,12); \
    }while(0)
  int t=1;
  #undef CMASK
  #define CMASK(P0,P1,t) do{}while(0)
  for(;t+5<NT;t+=2){
    STEP(pB0,pB1,pA0,pA1,t,true,true,true);     WAIT_BAR(2); RESC(); ROT();
    STEP(pA0,pA1,pB0,pB1,t+1,true,true,true);   WAIT_BAR(2); RESC(); ROT();
  }
  #undef CMASK
  #define CMASK(P0,P1,t) do{int jb_=(t)-(NT-4); if(jb_>=0)cmask(P0,P1,jb_,qrel,hi);}while(0)
  #define ENDW(tt) do{ if((tt)+3<NT){WAIT_BAR(2);} else if((tt)+2<NT){WAIT_BAR(1);} else {WAIT_BAR(0);} }while(0)
  for(;t+1<NT;t+=2){
    STEP(pB0,pB1,pA0,pA1,t,(t+3<NT),(t+1<NT),(t+1<NT));       ENDW(t);   RESC(); ROT();
    STEP(pA0,pA1,pB0,pB1,t+1,(t+4<NT),(t+2<NT),(t+2<NT));     ENDW(t+1); RESC(); ROT();
  }
  STEP(pB0,pB1,pA0,pA1,NT-1,false,false,false); RESC();
  { float sacc=pB0[0]+pB0[1]; _Pragma("unroll") for(int r=2;r<16;++r)sacc+=pB0[r]; _Pragma("unroll") for(int r=0;r<16;++r)sacc+=pB1[r]; l_reg+=sacc;
    pw0=(u32x4){PKW(pB0,0),PKW(pB0,2),PKW(pB0,4),PKW(pB0,6)};pw1=(u32x4){PKW(pB0,8),PKW(pB0,10),PKW(pB0,12),PKW(pB0,14)};pw2=(u32x4){PKW(pB1,0),PKW(pB1,2),PKW(pB1,4),PKW(pB1,6)};pw3=(u32x4){PKW(pB1,8),PKW(pB1,10),PKW(pB1,12),PKW(pB1,14)};
    SBAR(); pv(o,vb0+sl_cur,PAF(0),PAF(1),PAF(2),PAF(3)); }
  #undef PKW
  #undef PAF
  #undef VFR
  #undef PIN
  #undef MX3
  #undef GAPA
  #undef GAPB
  #undef EX
  #undef VRD
  #undef KRD
  #undef STEP
  #undef ENDW
  {auto rr=__builtin_amdgcn_permlane32_swap(__float_as_uint(l_reg),__float_as_uint(l_reg),false,false);l_reg=__uint_as_float(rr[0])+__uint_as_float(rr[1]);}
  if(hi==0)wsf[32+r32]=l_reg;asm volatile("s_waitcnt lgkmcnt(0)":::"memory");
  float rli[16];
  #pragma unroll
  for(int r=0;r<16;++r)rli[r]=__builtin_amdgcn_rcpf(wsf[32+crow(r,hi)]);
  bf16*Ow=O+(rowbase+q0+wid*QBLK)*DM+h*D;
  { bf16*stg=(bf16*)(shm+LDS_OST)+wid*2048;
    #pragma unroll
    for(int r=0;r<16;++r){const int orow=crow(r,hi);
      #pragma unroll
      for(int d0=0;d0<2;++d0)stg[orow*64+d0*32+r32]=__float2bfloat16(o[d0][r]*rli[r]);}
    asm volatile("s_waitcnt lgkmcnt(0)":::"memory");
    #pragma unroll
    for(int i=0;i<4;++i){const int row=i*8+(lane>>3),ch=lane&7; const u32x4 v=*(const u32x4*)(stg+row*64+ch*8); ATTN_STORE16(Ow+(long)row*DM+ch*8,v);} }
  asm volatile("s_waitcnt lgkmcnt(0)\n\ts_barrier":::"memory");
  #undef DMA_K
  #undef DMA_V
  #undef MKB
  #undef CMASK
  #undef START
  #undef RESC
  #undef ROT
}
constexpr int ATTN_LDS_BYTES=LDS_BYTES;
struct AttnTensors { const bf16* Q; const bf16* K; const bf16* V; bf16* O; const float* FL2; };
struct AttnUnit { int bh; int qb; };
struct StaticOrder {
  int vcu;
  __device__ __forceinline__ explicit StaticOrder(int grid,int block):vcu((block%8)*(grid/8)+block/8){}
  __device__ __forceinline__ bool next(int i,AttnUnit&u)const{ if(i>=2)return false; const int s=vcu&31; u.bh=vcu>>5; u.qb=(i==0)?s:63-s; return true; }
  __device__ __forceinline__ void a_ready(const AttnUnit&)const{}
  __device__ __forceinline__ void done(const AttnUnit&)const{}
};
template<class Sched,int THRL=8> __device__ __forceinline__ void attn_phase(char*lds,const AttnTensors&T,const Sched&S){
  AttnUnit u;
  for(int i=0;S.next(i,u);++i){ S.a_ready(u); attn_unit<THRL>(u.bh/NHEAD,u.bh%NHEAD,u.qb,T.Q,T.K,T.V,T.O,T.FL2,lds); S.done(u); }
}
#undef SBAR
#undef WAIT_BAR
}
#define LAS __attribute__((address_space(3)))
typedef unsigned short bf16;
typedef unsigned v4u __attribute__((ext_vector_type(4)));
typedef unsigned v2u __attribute__((ext_vector_type(2)));
typedef float f32x4 __attribute__((ext_vector_type(4)));
typedef short bf16x8 __attribute__((ext_vector_type(8)));
typedef const __attribute__((address_space(4))) unsigned* cu32p;
typedef const __attribute__((address_space(4))) float* cf32p;

constexpr int M = 16384, D = 1024, DFF = 2816, ZP = 8704, NL = 4, NWAVES = 8, NTHR = 512;
constexpr int ZQ = 0, ZK = 512, ZV = 1024, ZXB = 1536, ZYB = 2560, ZRW = 3584, ZGT = 5376, ZFL = 8448;
constexpr float ALPHA = 1.6817928305074292f, LN_EPS = 1e-5f, GN_EPS = 64e-5f, LOG2E = 1.4426950408889634f;
constexpr int NCH = 256, LC = 64;

constexpr size_t MiB = 1u << 20;
constexpr size_t WS_ADA = 1 * MiB, WS_FL2 = 2 * MiB, WS_LAEND = 3 * MiB, WS_LHEND = 4 * MiB, WS_LCAR = 5 * MiB, WS_BON = 6 * MiB;
constexpr size_t WS_W = 8 * MiB;
constexpr size_t W_UP0 = WS_W, W_UP1 = WS_W + 11 * MiB, W_DN0 = WS_W + 22 * MiB, W_DN1 = WS_W + 22 * MiB + 5632 * 1024, W_IN = WS_W + 33 * MiB,
                 W_PA = WS_W + 50 * MiB, W_PB = WS_W + 51 * MiB, W_PC = WS_W + 53 * MiB, W_OUT = WS_W + 54 * MiB, W_LORA = WS_W + 56 * MiB;
constexpr size_t WS_HB = 65 * MiB, WS_Y = 97 * MiB, WS_HLOC = 97 * MiB, WS_ACUM = 129 * MiB, WS_P = 97 * MiB, WS_G = 129 * MiB;
constexpr size_t WS_RWO = 161 * MiB, WS_CODES = 177 * MiB, WS_LORA = 185 * MiB, WS_S0 = 185 * MiB;
constexpr size_t WS_RW_W = 233 * MiB, WS_RW_R = 265 * MiB, WS_RW_KF = 281 * MiB, WS_RW_V = 297 * MiB, WS_RW_KK = 313 * MiB, WS_RW_B = 329 * MiB, WS_GB = 345 * MiB;
constexpr size_t WS_Z = 361 * MiB, WS_ACT = 361 * MiB, WS_END = 697 * MiB;
struct RwSet { size_t w, r, kf, kk, b; };
__device__ __forceinline__ RwSet rw_set(int l) { return (l & 1) ? RwSet{WS_HB, 633 * MiB, 649 * MiB, 665 * MiB, 681 * MiB} : RwSet{WS_RW_W, WS_RW_R, WS_RW_KF, WS_RW_KK, WS_RW_B}; }
constexpr int LDS_BYTES = attn_body::ATTN_LDS_BYTES;
static_assert(LDS_BYTES >= pg8::STAGE_BYTES && LDS_BYTES <= 160 * 1024, "LDS map");

__device__ __forceinline__ unsigned f2bf(float f) { unsigned u = __builtin_bit_cast(unsigned, f); return (u + 0x7fffu + ((u >> 16) & 1u)) >> 16; }
__device__ __forceinline__ unsigned pk2(float lo, float hi) { return f2bf(lo) | (f2bf(hi) << 16); }
__device__ __forceinline__ float bflo(unsigned u) { return __uint_as_float(u << 16); }
__device__ __forceinline__ float bfhi(unsigned u) { return __uint_as_float(u & 0xffff0000u); }
__device__ __forceinline__ float bf1(bf16 b) { return __uint_as_float(((unsigned)b) << 16); }
__device__ __forceinline__ float wave_sum(float v) {
#pragma unroll
    for (int o = 1; o < 64; o <<= 1) v += __shfl_xor(v, o);
    return v;
}
__device__ __forceinline__ float sigm(float x) { return __builtin_amdgcn_rcpf(1.f + __expf(-x)); }
__device__ __forceinline__ float tanh_(float z) { return 1.f - 2.f * __builtin_amdgcn_rcpf(1.f + __expf(2.f * z)); }
__device__ __forceinline__ float gelu_tanh(float x) { return 0.5f * x * (1.f + tanh_(0.7978845608028654f * (x + 0.044715f * x * x * x))); }
__device__ __forceinline__ float softplus_(float x) { return fmaxf(x, 0.f) + log1pf(__expf(-fabsf(x))); }
#define LDS_WAIT() asm volatile("s_waitcnt lgkmcnt(0)" ::: "memory")

struct Args { const float* in[32]; float* out; unsigned char* ws; };
typedef const __attribute__((address_space(4))) Args* CA;

struct EpiSwiGLU {
    static constexpr bool PERM = true, AFTER_DRAIN = false; bf16* O; int ldc;
    __device__ __forceinline__ void operator()(const pg8::f32x4 (&acc)[2][2][4][2], const pg8::Unit& u, int wr, int wc, int fr, int fq) const {
        const int row0 = u.pm * 256 + wr * 64 + fr, col0 = u.pn * 128 + wc * 32 + 8 * fq;
#pragma unroll
        for (int ai = 0; ai < 2; ++ai)
#pragma unroll
            for (int m = 0; m < 4; ++m) {
                bf16* rowp = O + (size_t)(row0 + ai * 128 + m * 16) * ldc + col0; float o[8];
#pragma unroll
                for (int n = 0; n < 2; ++n)
#pragma unroll
                    for (int i = 0; i < 4; ++i) { const float uu = acc[ai][0][m][n][i], gg = acc[ai][1][m][n][i]; o[n * 4 + i] = uu * sigm(uu) * gg; }
                v4u w; w.x = pk2(o[0], o[1]); w.y = pk2(o[2], o[3]); w.z = pk2(o[4], o[5]); w.w = pk2(o[6], o[7]); *(v4u*)rowp = w; }
    }
};
struct EpiGateF32 {
    static constexpr bool PERM = false, AFTER_DRAIN = false; float* Y; const float* gate; float mul;
    __device__ __forceinline__ void operator()(const pg8::f32x4 (&acc)[2][2][4][2], const pg8::Unit& u, int wr, int wc, int fr, int fq) const {
        const int row0 = u.pm * 256 + wr * 64 + fr, col0 = u.pn * 256 + wc * 32 + 4 * fq;
#pragma unroll
        for (int bj = 0; bj < 2; ++bj)
#pragma unroll
            for (int n = 0; n < 2; ++n) { const int c = col0 + bj * 128 + n * 16; const f32x4 gv = *(const f32x4*)(gate + c) * mul;
#pragma unroll
                for (int ai = 0; ai < 2; ++ai)
#pragma unroll
                    for (int m = 0; m < 4; ++m) *(f32x4*)(Y + (size_t)(row0 + ai * 128 + m * 16) * D + c) = acc[ai][bj][m][n] * gv; }
    }
};
struct EpiIn {
    static constexpr bool PERM = true, AFTER_DRAIN = false; bf16* Z;
    __device__ __forceinline__ void operator()(const pg8::f32x4 (&acc)[2][2][4][2], const pg8::Unit& u, int wr, int wc, int fr, int fq) const {
        const int row0 = u.pm * 256 + wr * 64 + fr, col0 = u.pn * 256 + wc * 32 + 8 * fq;
        const int mode = (u.pn < 2) ? 1 : ((u.pn >= 21 && u.pn < 33) ? 2 : 0);
#pragma unroll
        for (int ai = 0; ai < 2; ++ai)
#pragma unroll
            for (int m = 0; m < 4; ++m) { bf16* rowp = Z + (size_t)(row0 + ai * 128 + m * 16) * ZP + col0;
#pragma unroll
                for (int bj = 0; bj < 2; ++bj) { float o[8];
#pragma unroll
                    for (int n = 0; n < 2; ++n)
#pragma unroll
                        for (int i = 0; i < 4; ++i) { float v = acc[ai][bj][m][n][i]; if (mode == 1) v *= attn_body::C2; else if (mode == 2) v = sigm(v); o[n * 4 + i] = v; }
                    v4u w; w.x = pk2(o[0], o[1]); w.y = pk2(o[2], o[3]); w.z = pk2(o[4], o[5]); w.w = pk2(o[6], o[7]); *(v4u*)(rowp + bj * 128) = w; } }
    }
};
struct EpiPlain {
    static constexpr bool PERM = true, AFTER_DRAIN = false; bf16* O; int ldc;
    __device__ __forceinline__ void operator()(const pg8::f32x4 (&acc)[2][2][4][2], const pg8::Unit& u, int wr, int wc, int fr, int fq) const {
        const int row0 = u.pm * 256 + wr * 64 + fr, col0 = u.pn * 256 + wc * 32 + 8 * fq;
#pragma unroll
        for (int ai = 0; ai < 2; ++ai)
#pragma unroll
            for (int m = 0; m < 4; ++m) { bf16* rowp = O + (size_t)(row0 + ai * 128 + m * 16) * ldc + col0;
#pragma unroll
                for (int bj = 0; bj < 2; ++bj) { const pg8::f32x4 v0 = acc[ai][bj][m][0], v1 = acc[ai][bj][m][1];
                    v4u w; w.x = pk2(v0[0], v0[1]); w.y = pk2(v0[2], v0[3]); w.z = pk2(v1[0], v1[1]); w.w = pk2(v1[2], v1[3]); *(v4u*)(rowp + bj * 128) = w; } }
    }
};
template <int PASS> struct EpiProj {
    static constexpr bool PERM = false, AFTER_DRAIN = false; float* Y; const bf16* Z; bf16* MIX;
    __device__ __forceinline__ void operator()(const pg8::f32x4 (&acc)[2][2][4][2], const pg8::Unit& u, int wr, int wc, int fr, int fq) const {
        const int row0 = u.pm * 256 + wr * 64 + fr, col0 = u.pn * 256 + wc * 32 + 4 * fq;
#pragma unroll
        for (int ai = 0; ai < 2; ++ai)
#pragma unroll
            for (int m = 0; m < 4; ++m) { const size_t row = (size_t)(row0 + ai * 128 + m * 16);
#pragma unroll
                for (int bj = 0; bj < 2; ++bj)
#pragma unroll
                    for (int n = 0; n < 2; ++n) { const int c = col0 + bj * 128 + n * 16;
                        const v2u gw = *(const v2u*)(Z + row * ZP + ZGT + PASS * 1024 + c);
                        f32x4 gv; gv.x = bflo(gw.x); gv.y = bfhi(gw.x); gv.z = bflo(gw.y); gv.w = bfhi(gw.y);
                        f32x4 v = acc[ai][bj][m][n] * gv; float* yp = Y + row * D + c;
                        if (PASS > 0) v += *(const f32x4*)yp;
                        if (PASS < 2) *(f32x4*)yp = v; else { v2u w; w.x = pk2(v.x, v.y); w.y = pk2(v.z, v.w); *(v2u*)(MIX + row * D + c) = w; } } }
    }
};

__device__ __forceinline__ void cvt_item(const float* W, int ldw, int sk0, int sn0, int nvalid, bf16* WT, int ldo, int orow0, int dk0, LAS float* scr, int lane) {
    const int n_ = lane & 31;
#pragma unroll 8
    for (int i = 0; i < 32; ++i) { const int kk = 2 * i + (lane >> 5); scr[kk * 33 + n_] = (n_ < nvalid) ? W[(size_t)(sk0 + kk) * ldw + sn0 + n_] : 0.f; }
    LDS_WAIT(); asm volatile("" ::: "memory");
    const int c = lane & 7;
#pragma unroll
    for (int j = 0; j < 4; ++j) { const int n = (lane >> 3) + 8 * j; const LAS float* s = scr + (8 * c) * 33 + n;
        v4u o; o.x = pk2(s[0 * 33], s[1 * 33]); o.y = pk2(s[2 * 33], s[3 * 33]); o.z = pk2(s[4 * 33], s[5 * 33]); o.w = pk2(s[6 * 33], s[7 * 33]);
        *(v4u*)(WT + (size_t)(orow0 + n) * ldo + dk0 + 8 * c) = o; }
    LDS_WAIT(); asm volatile("" ::: "memory");
}
__device__ __forceinline__ void convert_layer(CA a, int l, LAS unsigned char* lds, int gw, int NGW, int wave, int lane) {
    LAS float* scr = (LAS float*)(lds + wave * 16384);
    unsigned char* ws = a->ws;
    constexpr int I_UP = 16 * 176, I_DN = 44 * 32, I_IN = 16 * 272, I_PA = 8 * 32, I_PB = 16 * 32, I_LO = 4 * 48;
    constexpr int NITEMS = 2 * I_UP + 2 * I_DN + I_IN + 2 * I_PA + 2 * I_PB + I_LO;
    for (int it = gw; it < NITEMS; it += NGW) {
        int r = it;
        if (r < 2 * I_UP) { const int s = r / I_UP; r -= s * I_UP; const int kb = r / 176, ob = r % 176, orow0 = 32 * ob, pn = orow0 >> 8, wi = orow0 & 255;
            const int sn0 = (wi < 128) ? (128 * pn + wi) : (DFF + 128 * pn + wi - 128);
            cvt_item(a->in[6] + (size_t)(l * 2 + s) * D * 2 * DFF, 2 * DFF, 64 * kb, sn0, 32, (bf16*)(ws + (s ? W_UP1 : W_UP0)), D, orow0, 64 * kb, scr, lane); continue; }
        r -= 2 * I_UP;
        if (r < 2 * I_DN) { const int s = r / I_DN; r -= s * I_DN; const int kb = r / 32, ob = r % 32;
            cvt_item(a->in[7] + (size_t)(l * 2 + s) * DFF * D, D, 64 * kb, 32 * ob, 32, (bf16*)(ws + (s ? W_DN1 : W_DN0)), DFF, 32 * ob, 64 * kb, scr, lane); continue; }
        r -= 2 * I_DN;
        if (r < I_IN) { const int kb = r / 272, ob = r % 272, orow0 = 32 * ob; int sn0, nv;
            if (orow0 < 1536) { sn0 = orow0; nv = 32; } else if (orow0 < ZFL) { sn0 = orow0 + 8; nv = 32; } else if (orow0 == ZFL) { sn0 = 1536; nv = 8; } else { sn0 = 0; nv = 0; }
            cvt_item(a->in[8] + (size_t)l * D * 8456, 8456, 64 * kb, sn0, nv, (bf16*)(ws + W_IN), D, orow0, 64 * kb, scr, lane); continue; }
        r -= I_IN;
        if (r < I_PA) { const int kb = r / 32, ob = r % 32; cvt_item(a->in[28] + (size_t)l * 512 * D, D, 64 * kb, 32 * ob, 32, (bf16*)(ws + W_PA), 512, 32 * ob, 64 * kb, scr, lane); continue; }
        r -= I_PA;
        if (r < I_PB) { const int kb = r / 32, ob = r % 32; cvt_item(a->in[29] + (size_t)l * D * D, D, 64 * kb, 32 * ob, 32, (bf16*)(ws + W_PB), D, 32 * ob, 64 * kb, scr, lane); continue; }
        r -= I_PB;
        if (r < I_PA) { const int kb = r / 32, ob = r % 32; cvt_item(a->in[30] + (size_t)l * 512 * D, D, 64 * kb, 32 * ob, 32, (bf16*)(ws + W_PC), 512, 32 * ob, 64 * kb, scr, lane); continue; }
        r -= I_PA;
        if (r < I_PB) { const int kb = r / 32, ob = r % 32; cvt_item(a->in[31] + (size_t)l * D * D, D, 64 * kb, 32 * ob, 32, (bf16*)(ws + W_OUT), D, 32 * ob, 64 * kb, scr, lane); continue; }
        r -= I_PB;
        {
            const int kb = r / 48, ob = r % 48, reg = ob / 16, nb = ob % 16; const float* W = a->in[19]; int sk0 = 0, nv = 0;
            if (reg == 0 && kb == 0) { W = a->in[19] + (size_t)l * 64 * 512; nv = 32; }
            else if (reg == 1 && kb == 1) { W = a->in[21] + (size_t)l * 64 * 512; nv = 32; }
            else if (reg == 2 && kb >= 2) { W = a->in[22] + (size_t)l * 128 * 512; sk0 = 64 * (kb - 2); nv = 32; }
            cvt_item(W, 512, sk0, 32 * nb, nv, (bf16*)(ws + W_LORA), 256, 32 * ob, 64 * kb, scr, lane); }
    }
}

__device__ __forceinline__ void row_stats(const f32x4 (&v)[4], float& mean, float& rstd) {
    float s = 0.f;
#pragma unroll
    for (int j = 0; j < 4; ++j) s += (v[j].x + v[j].y) + (v[j].z + v[j].w);
    mean = wave_sum(s) * (1.f / D); float s2 = 0.f;
#pragma unroll
    for (int j = 0; j < 4; ++j) { const f32x4 d = v[j] - mean; s2 += (d.x * d.x + d.y * d.y) + (d.z * d.z + d.w * d.w); }
    rstd = 1.f / sqrtf(wave_sum(s2) * (1.f / D) + LN_EPS);
}
__device__ __forceinline__ void store_mod(const f32x4 (&v)[4], float mean, float rstd, const float* sh, const float* sc, bf16* hrow, int lane) {
#pragma unroll
    for (int j = 0; j < 4; ++j) { const int c = 4 * lane + 256 * j; const f32x4 s1 = *(const f32x4*)(sc + c) + 1.f, s0 = *(const f32x4*)(sh + c);
        const f32x4 h = (v[j] - mean) * rstd * s1 + s0; v2u w; w.x = pk2(h.x, h.y); w.y = pk2(h.z, h.w); *(v2u*)(hrow + c) = w; }
}
__device__ __forceinline__ void ln_phase(const float* xsrc, const float* Y, float* xout, bf16* H, const float* lng, const float* lnb, const float* sh, const float* sc, bool do_mod, int gw, int NGW, int lane) {
    for (int m = gw; m < M; m += NGW) {
        f32x4 v[4];
#pragma unroll
        for (int j = 0; j < 4; ++j) { const size_t o = (size_t)m * D + 4 * lane + 256 * j; v[j] = *(const f32x4*)(xsrc + o) * ALPHA + *(const f32x4*)(Y + o); }
        float mean, rstd; row_stats(v, mean, rstd);
#pragma unroll
        for (int j = 0; j < 4; ++j) { const int c = 4 * lane + 256 * j; v[j] = (v[j] - mean) * rstd * *(const f32x4*)(lng + c) + *(const f32x4*)(lnb + c); *(f32x4*)(xout + (size_t)m * D + c) = v[j]; }
        if (do_mod) { row_stats(v, mean, rstd); store_mod(v, mean, rstd, sh, sc, H + (size_t)m * D, lane); }
    }
}
__device__ __forceinline__ void mod_phase(const float* x, bf16* H, const float* sh, const float* sc, int gw, int NGW, int lane) {
    for (int m = gw; m < M; m += NGW) {
        f32x4 v[4];
#pragma unroll
        for (int j = 0; j < 4; ++j) v[j] = *(const f32x4*)(x + (size_t)m * D + 4 * lane + 256 * j);
        float mean, rstd; row_stats(v, mean, rstd); store_mod(v, mean, rstd, sh, sc, H + (size_t)m * D, lane);
    }
}
__device__ __forceinline__ void ada_phase(CA a, LAS unsigned char* lds, int tid, int lane, int wave) {
    LAS float* cact = (LAS float*)lds; LAS float* part = cact + 1024;
    for (int i = tid; i < D; i += NTHR) { const float c = a->in[1][i]; cact[i] = c * sigm(c); }
    __syncthreads();
    float* ADA = (float*)(a->ws + WS_ADA);
    for (int task = blockIdx.x; task < NL * 144; task += gridDim.x) {
        const int l = task / 144, col = (task % 144) * 64 + lane; const float* W = a->in[2] + (size_t)l * D * 9216 + col; float s = 0.f;
#pragma unroll 16
        for (int k = wave * 128; k < wave * 128 + 128; ++k) s += cact[k] * W[(size_t)k * 9216];
        part[wave * 64 + lane] = s; __syncthreads();
        if (wave == 0) { float t = 0.f;
#pragma unroll
            for (int w = 0; w < 8; ++w) t += part[w * 64 + lane];
            ADA[l * 9216 + col] = t + a->in[3][l * 9216 + col]; }
        __syncthreads();
    }
}

__device__ __forceinline__ void fscan_head(const bf16* Z, const float* fbias, float* FL2, int h, LAS unsigned char* lds, int tid, int lane, int wave) {
    LAS float* wt = (LAS float*)lds; const float fb = fbias[h]; float lf[32]; float run = 0.f;
#pragma unroll
    for (int i = 0; i < 32; ++i) { const float x = bf1(Z[(size_t)(tid * 32 + i) * ZP + ZFL + h]) + fb; run += -softplus_(-x); lf[i] = run; }
    float inc = run;
#pragma unroll
    for (int o = 1; o < 64; o <<= 1) { const float t = __shfl_up(inc, o); if (lane >= o) inc += t; }
    if (lane == 63) wt[wave] = inc;
    __syncthreads();
    float base = inc - run;
    for (int w = 0; w < wave; ++w) base += wt[w];
#pragma unroll
    for (int i = 0; i < 32; ++i) FL2[(size_t)h * M + tid * 32 + i] = (base + lf[i]) * LOG2E;
    __syncthreads();
}
__device__ __forceinline__ void codes_phase(const bf16* Z, const float* mu, bf16* CODES, int gtid, int NGT) {
    for (int it = gtid; it < M * 32; it += NGT) { const int t = it >> 5, j0 = (it & 31) * 8;
        const v4u z = *(const v4u*)(Z + (size_t)t * ZP + ZRW + 1536 + j0); v4u zp = (v4u){0u, 0u, 0u, 0u};
        if (t > 0) zp = *(const v4u*)(Z + (size_t)(t - 1) * ZP + ZRW + 1536 + j0);
        float o[8];
#pragma unroll
        for (int q = 0; q < 4; ++q) { const float a0 = bflo(z[q]), a1 = bfhi(z[q]), p0 = bflo(zp[q]), p1 = bfhi(zp[q]); const float m0 = mu[1536 + j0 + 2 * q], m1 = mu[1536 + j0 + 2 * q + 1];
            o[2 * q] = a0 + (p0 - a0) * m0; o[2 * q + 1] = a1 + (p1 - a1) * m1; }
#pragma unroll
        for (int q = 0; q < 8; ++q) { if (j0 < 64) o[q] = tanh_(o[q]); else if (j0 >= 128) o[q] = sigm(o[q]); }
        v4u w; w.x = pk2(o[0], o[1]); w.y = pk2(o[2], o[3]); w.z = pk2(o[4], o[5]); w.w = pk2(o[6], o[7]); *(v4u*)(CODES + (size_t)t * 256 + j0) = w; }
}
__device__ __forceinline__ void lru_l1(CA a, int l, const bf16* Z, bf16* HLOC, bf16* ACUM, float* AEND, float* HEND, LAS unsigned char* lds, int tid, int lane, int wave) {
    LAS float* xcf = (LAS float*)lds; LAS bf16* xcb = (LAS bf16*)(lds + 16640); LAS bf16* wga = (LAS bf16*)(lds + 25856); LAS bf16* wgx = (LAS bf16*)(lds + 35072);
    LAS float* la = (LAS float*)(lds + 44288); LAS float* lu = (LAS float*)(lds + 60928); LAS float* agg = (LAS float*)(lds + 77568);
    const float* cw = a->in[10] + (size_t)l * 4 * D; const float* cb = a->in[11] + (size_t)l * D;
    const float* gaw = a->in[12] + (size_t)l * 16 * 4096; const float* gab = a->in[13] + (size_t)l * D;
    const float* gxw = a->in[14] + (size_t)l * 16 * 4096; const float* gxb = a->in[15] + (size_t)l * D; const float* lam = a->in[16] + (size_t)l * D;
    int nprev = -1;
    for (int task = blockIdx.x; task < NCH * 16; task += gridDim.x) {
        const int c = task >> 4, n = task & 15, t0 = c * LC;
        {
            const int tok = tid >> 3, cg8 = (tid & 7) * 8, ch0 = n * 64 + cg8; float acc[8];
#pragma unroll
            for (int q = 0; q < 8; ++q) acc[q] = cb[ch0 + q];
#pragma unroll
            for (int j = 0; j < 4; ++j) { const int tt = t0 + tok - 3 + j;
                if (tt >= 0) { const v4u x = *(const v4u*)(Z + (size_t)tt * ZP + ZXB + ch0);
#pragma unroll
                    for (int q = 0; q < 4; ++q) { acc[2 * q] += cw[j * D + ch0 + 2 * q] * bflo(x[q]); acc[2 * q + 1] += cw[j * D + ch0 + 2 * q + 1] * bfhi(x[q]); } } }
#pragma unroll
            for (int q = 0; q < 8; ++q) xcf[tok * 65 + cg8 + q] = acc[q];
            v4u w; w.x = pk2(acc[0], acc[1]); w.y = pk2(acc[2], acc[3]); w.z = pk2(acc[4], acc[5]); w.w = pk2(acc[6], acc[7]); *(LAS v4u*)(xcb + tok * 72 + cg8) = w;
        }
        if (n != nprev) {
            const int i = tid >> 3, j0 = (tid & 7) * 8;
#pragma unroll
            for (int q = 0; q < 8; ++q) { wga[(j0 + q) * 72 + i] = (bf16)f2bf(gaw[(size_t)n * 4096 + i * 64 + j0 + q]); wgx[(j0 + q) * 72 + i] = (bf16)f2bf(gxw[(size_t)n * 4096 + i * 64 + j0 + q]); }
            nprev = n;
        }
        __syncthreads();
        {
            const int tb = wave & 3, cbp = wave >> 2, fr = lane & 15, fq = lane >> 4;
            bf16x8 af[2];
#pragma unroll
            for (int kk = 0; kk < 2; ++kk) af[kk] = *(const LAS bf16x8*)(xcb + (tb * 16 + fr) * 72 + kk * 32 + fq * 8);
#pragma unroll
            for (int c2 = 0; c2 < 2; ++c2) { const int cbk = 2 * cbp + c2; f32x4 ar = (f32x4){0.f, 0.f, 0.f, 0.f}, ai = ar;
#pragma unroll
                for (int kk = 0; kk < 2; ++kk) { const bf16x8 b0 = *(const LAS bf16x8*)(wga + (cbk * 16 + fr) * 72 + kk * 32 + fq * 8), b1 = *(const LAS bf16x8*)(wgx + (cbk * 16 + fr) * 72 + kk * 32 + fq * 8);
                    ar = __builtin_amdgcn_mfma_f32_16x16x32_bf16(af[kk], b0, ar, 0, 0, 0); ai = __builtin_amdgcn_mfma_f32_16x16x32_bf16(af[kk], b1, ai, 0, 0, 0); }
                const int ch = cbk * 16 + fr, gch = n * 64 + ch; const float bga = gab[gch], bgx = gxb[gch], sp = log1pf(__expf(-lam[gch]));
#pragma unroll
                for (int rg = 0; rg < 4; ++rg) { const int tok = tb * 16 + fq * 4 + rg; const float r = sigm(ar[rg] + bga), ig = sigm(ai[rg] + bgx);
                    const float log_a = -8.f * r * sp, av = __expf(log_a), uv = sqrtf(-expm1f(2.f * log_a)) * (ig * xcf[tok * 65 + ch]);
                    la[tok * 65 + ch] = av; lu[tok * 65 + ch] = uv; } }
        }
        __syncthreads();
        {
            float hl[8], al[8]; float A = 1.f, h = 0.f;
#pragma unroll
            for (int s = 0; s < 8; ++s) { const float av = la[(wave * 8 + s) * 65 + lane], uv = lu[(wave * 8 + s) * 65 + lane]; h = av * h + uv; A *= av; hl[s] = h; al[s] = A; }
            agg[(wave * 2 + 0) * 64 + lane] = A; agg[(wave * 2 + 1) * 64 + lane] = h;
            __syncthreads();
            float cA = 1.f, cH = 0.f;
            for (int w = 0; w < wave; ++w) { const float A2 = agg[(w * 2 + 0) * 64 + lane], h2 = agg[(w * 2 + 1) * 64 + lane]; cH = A2 * cH + h2; cA *= A2; }
            float hf = 0.f, Af = 1.f;
#pragma unroll
            for (int s = 0; s < 8; ++s) { hf = hl[s] + al[s] * cH; Af = al[s] * cA; const size_t o = (size_t)(t0 + wave * 8 + s) * D + n * 64 + lane; HLOC[o] = (bf16)f2bf(hf); ACUM[o] = (bf16)f2bf(Af); }
            if (wave == 7) { AEND[c * D + n * 64 + lane] = Af; HEND[c * D + n * 64 + lane] = hf; }
        }
        __syncthreads();
    }
}
__device__ __forceinline__ void lru_l2(const float* AEND, const float* HEND, float* CAR, int gw, int lane) {
    if (gw < 16) { const int ch = gw * 64 + lane; float carry = 0.f;
#pragma unroll 8
        for (int c = 0; c < NCH; ++c) { CAR[c * D + ch] = carry; carry = AEND[c * D + ch] * carry + HEND[c * D + ch]; } }
}
__device__ __forceinline__ void lru_l3(bf16* Z, const bf16* HLOC, const bf16* ACUM, const float* CAR, int gtid, int NGT) {
    for (int it = gtid; it < M * 128; it += NGT) { const int t = it >> 7, ch0 = (it & 127) * 8; const size_t o = (size_t)t * D + ch0;
        const v4u hl = *(const v4u*)(HLOC + o), ac = *(const v4u*)(ACUM + o), yb = *(const v4u*)(Z + (size_t)t * ZP + ZYB + ch0);
        const f32x4 c0 = *(const f32x4*)(CAR + (t >> 6) * D + ch0), c1 = *(const f32x4*)(CAR + (t >> 6) * D + ch0 + 4); float o8[8];
#pragma unroll
        for (int q = 0; q < 4; ++q) { const float ca = (q < 2) ? c0[2 * q] : c1[2 * q - 4], cb_ = (q < 2) ? c0[2 * q + 1] : c1[2 * q - 3];
            o8[2 * q] = (bflo(hl[q]) + bflo(ac[q]) * ca) * gelu_tanh(bflo(yb[q])); o8[2 * q + 1] = (bfhi(hl[q]) + bfhi(ac[q]) * cb_) * gelu_tanh(bfhi(yb[q])); }
        v4u w; w.x = pk2(o8[0], o8[1]); w.y = pk2(o8[2], o8[3]); w.z = pk2(o8[4], o8[5]); w.w = pk2(o8[6], o8[7]); *(v4u*)(Z + (size_t)t * ZP + ZYB + ch0) = w; }
}
__device__ __forceinline__ void rw_prep(CA a, int l, const bf16* Z, const bf16* LORA, float* Wd, bf16* R, bf16* KF, bf16* V, bf16* KK, bf16* Bv, bf16* GB, float* BON, int gw, int NGW, int lane) {
    const float* mu = a->in[17] + (size_t)l * 1792; const float* w0 = a->in[18] + (size_t)l * 512; const float* a0 = a->in[20] + (size_t)l * 512;
    const float* k_k = a->in[23] + (size_t)l * 512; const float* k_a = a->in[24] + (size_t)l * 512; const float* r_k = a->in[25] + (size_t)l * 512;
    for (int it = gw; it < M * 8; it += NGW) { const int t = it >> 3, h = it & 7, col = h * 64 + lane; const bf16* zr = Z + (size_t)t * ZP + ZRW + col;
        float r = bf1(zr[0]), k = bf1(zr[512]), v = bf1(zr[1024]); float rp = 0.f, kp = 0.f, vp = 0.f;
        if (t > 0) { rp = bf1(zr[-ZP]); kp = bf1(zr[512 - ZP]); vp = bf1(zr[1024 - ZP]); }
        r += (rp - r) * mu[col]; k += (kp - k) * mu[512 + col]; v += (vp - v) * mu[1024 + col];
        const bf16* lo = LORA + (size_t)t * 1536 + col; const float lw = bf1(lo[0]), lav = bf1(lo[512]);
        const float wv = -softplus_(-(w0[col] + lw)) - 0.5f, decay = __expf(-__expf(wv)); const float av = sigm(a0[col] + lav);
        float kk = k * k_k[col]; const float nrm = sqrtf(wave_sum(kk * kk)); kk = kk / fmaxf(nrm, 1e-12f);
        const float kf = k * (1.f + (av - 1.f) * k_a[col]); const float bon = wave_sum(r * kf * r_k[col]);
        const size_t o = (size_t)t * 512 + col;
        Wd[o] = decay; R[o] = (bf16)f2bf(r); KF[o] = (bf16)f2bf(kf); V[o] = (bf16)f2bf(v); KK[o] = (bf16)f2bf(kk); Bv[o] = (bf16)f2bf(kk * av); GB[o] = lo[1024];
        if (lane == 0) BON[t * 8 + h] = bon; }
}
template <bool WITH_V> __device__ __forceinline__ void rw_step(float (&st)[64], cu32p pk, cu32p pb, cu32p pf, cf32p pw, float vv) {
    float s0 = 0.f, s1 = 0.f, s2 = 0.f, s3 = 0.f;
#pragma unroll
    for (int k2 = 0; k2 < 32; k2 += 2) { const unsigned u0 = pk[k2], u1 = pk[k2 + 1]; s0 += st[2 * k2] * bflo(u0); s1 += st[2 * k2 + 1] * bfhi(u0); s2 += st[2 * k2 + 2] * bflo(u1); s3 += st[2 * k2 + 3] * bfhi(u1); }
    const float sa = -((s0 + s1) + (s2 + s3));
#pragma unroll
    for (int k2 = 0; k2 < 32; ++k2) { const unsigned ub = pb[k2]; float t0 = sa * bflo(ub), t1 = sa * bfhi(ub);
        if (WITH_V) { const unsigned uf = pf[k2]; t0 += vv * bflo(uf); t1 += vv * bfhi(uf); }
        st[2 * k2] = st[2 * k2] * pw[2 * k2] + t0; st[2 * k2 + 1] = st[2 * k2 + 1] * pw[2 * k2 + 1] + t1; }
}
__device__ __forceinline__ void rw_r1(const unsigned char* ws, const RwSet rs, float* P, float* G, int gw, int NGW, int lane) {
    for (int T = gw; T < NCH * 8 * 2; T += NGW) { const int kind = T & 1, h = (T >> 1) & 7, c = T >> 4; float st[64];
#pragma unroll
        for (int k = 0; k < 64; ++k) st[k] = (kind == 0 && k == lane) ? 1.f : 0.f;
        const bf16* Vb = (const bf16*)(ws + WS_RW_V);
        for (int t = c * LC; t < c * LC + LC; ++t) { const size_t o = (size_t)t * 512 + h * 64;
            cu32p pk = (cu32p)(uintptr_t)(ws + rs.kk + o * 2), pb = (cu32p)(uintptr_t)(ws + rs.b + o * 2), pf = (cu32p)(uintptr_t)(ws + rs.kf + o * 2); cf32p pw = (cf32p)(uintptr_t)(ws + rs.w + o * 4);
            if (kind == 0) rw_step<false>(st, pk, pb, pf, pw, 0.f); else rw_step<true>(st, pk, pb, pf, pw, bf1(Vb[o + lane])); }
        float* dst = (kind == 0 ? P : G) + ((size_t)(h * NCH + c) * 64 + lane) * 64;
#pragma unroll
        for (int k = 0; k < 64; k += 4) *(f32x4*)(dst + k) = (f32x4){st[k], st[k + 1], st[k + 2], st[k + 3]}; }
}
__device__ __forceinline__ void rw_r2(const float* P, const float* G, float* S0, LAS unsigned char* lds, int lane, int wave) {
    LAS float* red = (LAS float*)lds;
    for (int rp = blockIdx.x; rp < 256; rp += gridDim.x) { const int h = rp >> 5, v0 = (rp & 31) * 2; float s0 = 0.f, s1 = 0.f;
        const float* Ph = P + (size_t)h * NCH * 4096 + (size_t)(8 * wave) * 64 + lane; const float* Gh = G + (size_t)h * NCH * 4096 + (size_t)v0 * 64 + lane; float* Sh = S0 + (size_t)h * NCH * 4096 + (size_t)v0 * 64 + lane;
        float pq[8][8], gq[8][2];
#pragma unroll
        for (int d = 0; d < 8; ++d) {
#pragma unroll
            for (int jj = 0; jj < 8; ++jj) pq[d][jj] = Ph[(size_t)d * 4096 + jj * 64];
            gq[d][0] = Gh[(size_t)d * 4096]; gq[d][1] = Gh[(size_t)d * 4096 + 64]; }
        for (int c0 = 0; c0 < NCH; c0 += 8) {
#pragma unroll
            for (int d = 0; d < 8; ++d) { const int c = c0 + d;
                if (wave == 0) { Sh[(size_t)c * 4096] = s0; Sh[(size_t)c * 4096 + 64] = s1; }
                float p0 = 0.f, p1 = 0.f;
#pragma unroll
                for (int jj = 0; jj < 8; ++jj) { const float a0 = __builtin_bit_cast(float, __builtin_amdgcn_readlane(__builtin_bit_cast(int, s0), 8 * wave + jj)), a1 = __builtin_bit_cast(float, __builtin_amdgcn_readlane(__builtin_bit_cast(int, s1), 8 * wave + jj));
                    p0 += a0 * pq[d][jj]; p1 += a1 * pq[d][jj]; }
                LAS float* rd = red + (c & 1) * 1024;
                rd[(wave * 2 + 0) * 64 + lane] = p0; rd[(wave * 2 + 1) * 64 + lane] = p1;
                const float g0 = gq[d][0], g1 = gq[d][1];
                if (c + 8 < NCH) {
#pragma unroll
                    for (int jj = 0; jj < 8; ++jj) pq[d][jj] = Ph[(size_t)(c + 8) * 4096 + jj * 64];
                    gq[d][0] = Gh[(size_t)(c + 8) * 4096]; gq[d][1] = Gh[(size_t)(c + 8) * 4096 + 64]; }
                __syncthreads();
                float n0 = g0, n1 = g1;
#pragma unroll
                for (int w = 0; w < 8; ++w) { n0 += rd[(w * 2 + 0) * 64 + lane]; n1 += rd[(w * 2 + 1) * 64 + lane]; }
                s0 = n0; s1 = n1; }
        }
        __syncthreads();
    }
}
__device__ __forceinline__ void rw_r3(CA a, int l, const unsigned char* ws, const RwSet rs, const float* S0, const float* BON, bf16* RWO, LAS unsigned char* lds, int gw, int NGW, int lane, int wave) {
    LAS float* yl = (LAS float*)(lds + wave * 16640);
    const float* gnw = a->in[26] + (size_t)l * 512; const float* gnb = a->in[27] + (size_t)l * 512;
    const bf16* Vb = (const bf16*)(ws + WS_RW_V); const bf16* GB = (const bf16*)(ws + WS_GB);
    for (int T = gw; T < NCH * 8; T += NGW) { const int h = T & 7, c = T >> 3; float st[64];
        const float* src = S0 + ((size_t)(h * NCH + c) * 64 + lane) * 64;
#pragma unroll
        for (int k = 0; k < 64; k += 4) { const f32x4 v4 = *(const f32x4*)(src + k); st[k] = v4.x; st[k + 1] = v4.y; st[k + 2] = v4.z; st[k + 3] = v4.w; }
        for (int tt = 0; tt < LC; ++tt) { const size_t o = (size_t)(c * LC + tt) * 512 + h * 64;
            cu32p pk = (cu32p)(uintptr_t)(ws + rs.kk + o * 2), pb = (cu32p)(uintptr_t)(ws + rs.b + o * 2), pf = (cu32p)(uintptr_t)(ws + rs.kf + o * 2), pr = (cu32p)(uintptr_t)(ws + rs.r + o * 2); cf32p pw = (cf32p)(uintptr_t)(ws + rs.w + o * 4);
            rw_step<true>(st, pk, pb, pf, pw, bf1(Vb[o + lane]));
            float y0 = 0.f, y1 = 0.f, y2 = 0.f, y3 = 0.f;
#pragma unroll
            for (int k2 = 0; k2 < 32; k2 += 2) { const unsigned u0 = pr[k2], u1 = pr[k2 + 1]; y0 += st[2 * k2] * bflo(u0); y1 += st[2 * k2 + 1] * bfhi(u0); y2 += st[2 * k2 + 2] * bflo(u1); y3 += st[2 * k2 + 3] * bfhi(u1); }
            yl[tt * 65 + lane] = (y0 + y1) + (y2 + y3); }
        LDS_WAIT(); asm volatile("" ::: "memory");
        {
            const int t = c * LC + lane; float y[64]; float s = 0.f;
#pragma unroll
            for (int v = 0; v < 64; ++v) { y[v] = yl[lane * 65 + v]; s += y[v]; }
            const float mean = s * (1.f / 64.f); float q = 0.f;
#pragma unroll
            for (int v = 0; v < 64; ++v) { const float d = y[v] - mean; q += d * d; }
            const float rstd = 1.f / sqrtf(q * (1.f / 64.f) + GN_EPS); const float bon = BON[t * 8 + h];
            const size_t o = (size_t)t * 512 + h * 64;
#pragma unroll
            for (int v8 = 0; v8 < 64; v8 += 8) { const v4u vv = *(const v4u*)(Vb + o + v8), gg = *(const v4u*)(GB + o + v8); float ov[8];
#pragma unroll
                for (int q2 = 0; q2 < 4; ++q2) { const int v = v8 + 2 * q2;
                    ov[2 * q2] = ((y[v] - mean) * rstd * gnw[h * 64 + v] + gnb[h * 64 + v] + bon * bflo(vv[q2])) * bflo(gg[q2]);
                    ov[2 * q2 + 1] = ((y[v + 1] - mean) * rstd * gnw[h * 64 + v + 1] + gnb[h * 64 + v + 1] + bon * bfhi(vv[q2])) * bfhi(gg[q2]); }
                v4u w; w.x = pk2(ov[0], ov[1]); w.y = pk2(ov[2], ov[3]); w.z = pk2(ov[4], ov[5]); w.w = pk2(ov[6], ov[7]); *(v4u*)(RWO + o + v8) = w; }
        }
        LDS_WAIT(); asm volatile("" ::: "memory");
    }
}

__global__ void __launch_bounds__(NTHR, 2) fwd_mega(Args args_unused) {
    extern __shared__ __attribute__((aligned(16))) unsigned char lds_raw[];
    LAS unsigned char* lds = (LAS unsigned char*)lds_raw;
    cg::grid_group grid = cg::this_grid();
    const int wave = __builtin_amdgcn_readfirstlane((int)threadIdx.x >> 6);
    const int G = gridDim.x, gw = blockIdx.x * NWAVES + wave, NGW = G * NWAVES, NGT = G * NTHR;
#define SYNC() do { grid.sync(); } while (0)
#define PH_BEGIN { CA a = (CA)__builtin_amdgcn_kernarg_segment_ptr(); asm volatile("" : "+s"(a)); unsigned char* ws = a->ws; (void)ws; \
        int tid_l = threadIdx.x; asm volatile("" : "+v"(tid_l)); const int tid = tid_l, lane = tid & 63, gtid = blockIdx.x * NTHR + tid; (void)lane; (void)gtid;
#define PH_END }
#define WSP(T, off) ((T*)(ws + (off)))
#define ADA_L (WSP(float, WS_ADA) + l * 9216)
#define GEMM(EPI, Aptr, LDA, Bptr, N_, K_, ...) do { int kk_ = (K_); asm volatile("" : "+s"(kk_));   pg8::Gemm g_{(const pg8::bf16_t*)(Aptr), (const pg8::bf16_t*)(Bptr), M, (N_), kk_, (LDA)}; pg8::StaticOrder S_; S_.init(M, (N_), G, (int)blockIdx.x); \
        EPI E_{__VA_ARGS__}; pg8::gemm_phase<EPI, pg8::StaticOrder, PG8_ALIGN, PG8_SP2>(lds, g_, S_, E_); } while (0)

    PH_BEGIN ada_phase(a, lds, tid, lane, wave); PH_END
    SYNC();
    PH_BEGIN mod_phase(a->in[0], WSP(bf16, WS_HB), WSP(float, WS_ADA), WSP(float, WS_ADA) + D, gw, NGW, lane); convert_layer(a, 0, lds, gw, NGW, wave, lane); PH_END
    SYNC();

    for (int l = 0; l < NL; ++l) {
        PH_BEGIN GEMM(EpiSwiGLU, WSP(bf16, WS_HB), D, ws + W_UP0, 2 * DFF, D, WSP(bf16, WS_ACT), DFF); PH_END
        SYNC();
        PH_BEGIN GEMM(EpiGateF32, WSP(bf16, WS_ACT), DFF, ws + W_DN0, D, DFF, WSP(float, WS_Y), ADA_L + 2 * D, 0.5f); PH_END
        SYNC();
        PH_BEGIN ln_phase(l == 0 ? a->in[0] : a->out, WSP(float, WS_Y), a->out, WSP(bf16, WS_HB), a->in[4] + (size_t)l * 3 * D, a->in[5] + (size_t)l * 3 * D, ADA_L + 3 * D, ADA_L + 4 * D, true, gw, NGW, lane); PH_END
        SYNC();
        PH_BEGIN GEMM(EpiIn, WSP(bf16, WS_HB), D, ws + W_IN, ZP, D, WSP(bf16, WS_Z)); PH_END
        SYNC();
        PH_BEGIN if (blockIdx.x < 8) fscan_head(WSP(bf16, WS_Z), a->in[9] + l * 8, WSP(float, WS_FL2), blockIdx.x, lds, tid, lane, wave); PH_END
        PH_BEGIN codes_phase(WSP(bf16, WS_Z), a->in[17] + (size_t)l * 1792, WSP(bf16, WS_CODES), gtid, NGT); PH_END
        PH_BEGIN lru_l1(a, l, WSP(bf16, WS_Z), WSP(bf16, WS_HLOC), WSP(bf16, WS_ACUM), WSP(float, WS_LAEND), WSP(float, WS_LHEND), lds, tid, lane, wave); PH_END
        SYNC();
        PH_BEGIN GEMM(EpiPlain, ws + WS_CODES, 256, ws + W_LORA, 1536, 256, WSP(bf16, WS_LORA), 1536); PH_END
        PH_BEGIN lru_l2(WSP(const float, WS_LAEND), WSP(const float, WS_LHEND), WSP(float, WS_LCAR), gw, lane); PH_END
        SYNC();
        PH_BEGIN const RwSet rs = rw_set(l); rw_prep(a, l, WSP(bf16, WS_Z), WSP(const bf16, WS_LORA), WSP(float, rs.w), WSP(bf16, rs.r), WSP(bf16, rs.kf), WSP(bf16, WS_RW_V), WSP(bf16, rs.kk), WSP(bf16, rs.b), WSP(bf16, WS_GB), WSP(float, WS_BON), gw, NGW, lane); PH_END
        PH_BEGIN lru_l3(WSP(bf16, WS_Z), WSP(const bf16, WS_HLOC), WSP(const bf16, WS_ACUM), WSP(const float, WS_LCAR), gtid, NGT); PH_END
        SYNC();
        PH_BEGIN rw_r1(ws, rw_set(l), WSP(float, WS_P), WSP(float, WS_G), gw, NGW, lane); PH_END
        SYNC();
        PH_BEGIN rw_r2(WSP(const float, WS_P), WSP(const float, WS_G), WSP(float, WS_S0), lds, lane, wave); PH_END
        SYNC();
        PH_BEGIN rw_r3(a, l, ws, rw_set(l), WSP(const float, WS_S0), WSP(const float, WS_BON), WSP(bf16, WS_RWO), lds, gw, NGW, lane, wave); PH_END
        __syncthreads();
        PH_BEGIN
            bf16* Zb = WSP(bf16, WS_Z);
            const attn_body::AttnTensors AT{(const attn_body::bf16*)(Zb + ZQ), (const attn_body::bf16*)(Zb + ZK), (const attn_body::bf16*)(Zb + ZV), (attn_body::bf16*)(Zb + ZQ), WSP(const float, WS_FL2)};
            const attn_body::StaticOrder S((int)G, (int)blockIdx.x);
            attn_body::attn_phase<attn_body::StaticOrder>((char*)lds_raw, AT, S);
        PH_END
        SYNC();
        PH_BEGIN GEMM(EpiProj<0>, WSP(bf16, WS_Z) + ZQ, ZP, ws + W_PA, D, 512, WSP(float, WS_Y), WSP(bf16, WS_Z), WSP(bf16, WS_HB)); PH_END
        __builtin_amdgcn_fence(__ATOMIC_SEQ_CST, "agent");
        PH_BEGIN GEMM(EpiProj<1>, WSP(bf16, WS_Z) + ZYB, ZP, ws + W_PB, D, D, WSP(float, WS_Y), WSP(bf16, WS_Z), WSP(bf16, WS_HB)); PH_END
        __builtin_amdgcn_fence(__ATOMIC_SEQ_CST, "agent");
        PH_BEGIN GEMM(EpiProj<2>, ws + WS_RWO, 512, ws + W_PC, D, 512, WSP(float, WS_Y), WSP(bf16, WS_Z), WSP(bf16, WS_HB)); PH_END
        SYNC();
        PH_BEGIN GEMM(EpiGateF32, WSP(bf16, WS_HB), D, ws + W_OUT, D, D, WSP(float, WS_Y), ADA_L + 5 * D, 1.0f); PH_END
        SYNC();
        PH_BEGIN ln_phase(a->out, WSP(float, WS_Y), a->out, WSP(bf16, WS_HB), a->in[4] + (size_t)(l * 3 + 1) * D, a->in[5] + (size_t)(l * 3 + 1) * D, ADA_L + 6 * D, ADA_L + 7 * D, true, gw, NGW, lane); PH_END
        SYNC();
        PH_BEGIN GEMM(EpiSwiGLU, WSP(bf16, WS_HB), D, ws + W_UP1, 2 * DFF, D, WSP(bf16, WS_ACT), DFF); PH_END
        SYNC();
        PH_BEGIN GEMM(EpiGateF32, WSP(bf16, WS_ACT), DFF, ws + W_DN1, D, DFF, WSP(float, WS_Y), ADA_L + 8 * D, 0.5f); PH_END
        SYNC();
        PH_BEGIN ln_phase(a->out, WSP(float, WS_Y), a->out, WSP(bf16, WS_HB), a->in[4] + (size_t)(l * 3 + 2) * D, a->in[5] + (size_t)(l * 3 + 2) * D, ADA_L + 9216, ADA_L + 9216 + D, l + 1 < NL, gw, NGW, lane); PH_END
        if (l + 1 < NL) { PH_BEGIN convert_layer(a, l + 1, lds, gw, NGW, wave, lane); PH_END SYNC(); }
    }
#undef SYNC
#undef GEMM
}

extern "C" void kernel_launch(void* const* d_in, const int* in_sizes, int n_in, void* d_out, int out_size, void* d_ws, size_t ws_size, hipStream_t stream) {
    static int grid = 0;
    if (grid == 0) {
        if (n_in != 32 || out_size != M * D || ws_size < WS_END) { fprintf(stderr, "kernel_launch: unexpected shapes (n_in %d, out %d, ws %zu)\n", n_in, out_size, ws_size); grid = -1; return; }
        int dev = 0, cus = 0, per_cu = 0;
        hipGetDevice(&dev); hipDeviceGetAttribute(&cus, hipDeviceAttributeMultiprocessorCount, dev);
        hipFuncSetAttribute((const void*)fwd_mega, hipFuncAttributeMaxDynamicSharedMemorySize, LDS_BYTES);
        if (hipOccupancyMaxActiveBlocksPerMultiprocessor(&per_cu, (const void*)fwd_mega, NTHR, LDS_BYTES) != hipSuccess || per_cu < 1) { fprintf(stderr, "kernel_launch: occupancy query says %d blocks per CU\n", per_cu); per_cu = 1; }
        (void)hipGetLastError();
        grid = cus * per_cu;
        fprintf(stderr, "kernel_launch: grid %d (cus %d x %d), lds %d\n", grid, cus, per_cu, LDS_BYTES);
    }
    if (grid < 0) return;
    Args a{};
    for (int i = 0; i < 32; ++i) a.in[i] = (const float*)d_in[i];
    a.out = (float*)d_out; a.ws = (unsigned char*)d_ws;
    void* kargs[] = {&a};
    hipError_t e = hipLaunchCooperativeKernel((const void*)fwd_mega, dim3(grid), dim3(NTHR), kargs, LDS_BYTES, stream);
    if (e != hipSuccess) fprintf(stderr, "kernel_launch: cooperative launch failed: %s (grid %d)\n", hipGetErrorString(e), grid);
}
```

```cpp
#include <hip/hip_runtime.h>
#include <hip/hip_cooperative_groups.h>
#include <cstdio>
#include <cstdint>
namespace cg = cooperative_groups;
namespace pg8 {
#define PG8_LAS __attribute__((address_space(3)))
typedef unsigned short bf16_t;
typedef short bf16x8 __attribute__((ext_vector_type(8)));
typedef float f32x4 __attribute__((ext_vector_type(4)));
typedef unsigned u32x4 __attribute__((ext_vector_type(4)));
constexpr int BM = 256, BK = 64, HALF = 128, HTB = HALF * BK * 2  , STAGE_BYTES = 8 * HTB, NXCD = 8, WGM = 8;

__host__ __device__ __forceinline__ int lds_byte(int r, int c) { const int st = (r >> 4) * 2 + (c >> 5), rr = r & 15, cc = c & 31, ob = rr * 64 + cc * 2; return st * 1024 + (ob ^ (((ob >> 9) & 1) << 5)); }
__host__ __device__ __forceinline__ void stage_rc(int b, int& R, int& C) { const int st = b / 1024, sb = b % 1024, swz = sb ^ (((sb >> 9) & 1) << 5); R = (st >> 1) * 16 + swz / 64; C = (st & 1) * 32 + (swz % 64) / 2; }
__host__ __device__ __forceinline__ int perm32(int rho) { const int n = rho >> 4, i = rho & 15; return 8 * (i >> 2) + 4 * n + (i & 3); }

struct Unit { int pm, pn; };
struct Gemm { const bf16_t* A; const bf16_t* Bt; int M, N, K, lda; };

struct StaticOrder {
    int nM, nN, nwg, G, c;
    __host__ __device__ void init(int M, int N, int G_, int c_) { nM = M / BM; nN = N / BM; nwg = nM * nN; G = G_; c = c_; }
    __host__ __device__ bool next(int i, Unit& u) const {
        const long L = (long)i * G + c; if (L >= nwg) return false;
        int wgid = (int)L; { const int q = nwg / NXCD, r = nwg % NXCD, xcd = wgid % NXCD, off = wgid / NXCD; wgid = (xcd < r ? xcd * (q + 1) : r * (q + 1) + (xcd - r) * q) + off; }
        const int nig = WGM * nN, gid = wgid / nig, fm = gid * WGM, gsz = (nM - fm) < WGM ? (nM - fm) : WGM;
        u.pm = fm + ((wgid % nig) % gsz); u.pn = (wgid % nig) / gsz; return true;
    }
    __device__ __forceinline__ void a_ready(const Unit&) const {}
    __device__ __forceinline__ void done(const Unit&) const {}
};

__device__ __forceinline__ unsigned cvt_pk_bf16(float lo, float hi) { unsigned r; asm volatile("v_cvt_pk_bf16_f32 %0, %1, %2" : "=v"(r) : "v"(lo), "v"(hi)); return r; }
typedef float f32x2 __attribute__((ext_vector_type(2)));
__device__ __forceinline__ f32x2 gelu_pk(f32x2 v) {
    const f32x2 av = __builtin_elementwise_abs(v), d = av * 0.2316418882f + 1.0f;
    f32x2 t; t.x = __builtin_amdgcn_rcpf(d.x); t.y = __builtin_amdgcn_rcpf(d.y);
    f32x2 q = t * 0.5307027145f + (-0.7265760135f); q = q * t + 0.7107068705f; q = q * t + (-0.142248368f); q = q * t + 0.127414796f; q = q * t;
    const f32x2 s = (v * v) * (-0.72134752044f);
    f32x2 e; e.x = __builtin_amdgcn_exp2f(s.x); e.y = __builtin_amdgcn_exp2f(s.y);
    const f32x2 m = v * (q * e), r = v - m;
    f32x2 o; o.x = v.x < 0.f ? m.x : r.x; o.y = v.y < 0.f ? m.y : r.y; return o;
}

template <int ACT  > struct EpiBf16 {
    static constexpr bool PERM = true, AFTER_DRAIN = false; static_assert(ACT == 0 || ACT == 1, "EpiBf16: ACT is 0 (none) or 1 (gelu_pk)");
    bf16_t* O; int ldc; const float* bias; int split_cols; size_t split_stride; float scale0;
    __device__ __forceinline__ void operator()(const f32x4 (&acc)[2][2][4][2], const Unit& u, int wr, int wc, int fr, int fq) const {
        const int row0 = u.pm * BM + wr * 64 + fr; int colt = u.pn * BM; bf16_t* base = O;
        float sc = 1.f; if (split_cols) { const int t = colt / split_cols; base += (size_t)t * split_stride; colt -= t * split_cols; if (t == 0) sc = scale0; }
        const int col0 = colt + wc * 32 + 8 * fq, bcol0 = u.pn * BM + wc * 32 + 8 * fq;
        f32x4 bv[2][2];
#pragma unroll
        for (int bj = 0; bj < 2; ++bj)
#pragma unroll
            for (int n = 0; n < 2; ++n) bv[bj][n] = bias ? *(const f32x4*)(bias + bcol0 + bj * HALF + 4 * n) : (f32x4){0.f, 0.f, 0.f, 0.f};
#pragma unroll
        for (int ai = 0; ai < 2; ++ai)
#pragma unroll
            for (int m = 0; m < 4; ++m) { bf16_t* rowp = base + (size_t)(row0 + ai * HALF + m * 16) * ldc + col0;
#pragma unroll
                for (int bj = 0; bj < 2; ++bj) { f32x4 v0 = acc[ai][bj][m][0] + bv[bj][0], v1 = acc[ai][bj][m][1] + bv[bj][1];
                    if (ACT == 1) { f32x2 a = gelu_pk((f32x2){v0[0], v0[1]}), b = gelu_pk((f32x2){v0[2], v0[3]}), c = gelu_pk((f32x2){v1[0], v1[1]}), d = gelu_pk((f32x2){v1[2], v1[3]});
                        v0 = (f32x4){a.x, a.y, b.x, b.y}; v1 = (f32x4){c.x, c.y, d.x, d.y}; }
                    v0 = v0 * sc; v1 = v1 * sc; u32x4 w; w.x = cvt_pk_bf16(v0[0], v0[1]); w.y = cvt_pk_bf16(v0[2], v0[3]); w.z = cvt_pk_bf16(v1[0], v1[1]); w.w = cvt_pk_bf16(v1[2], v1[3]);
                    *(u32x4*)(rowp + bj * HALF) = w; } }
    }
};

struct PanelStats {
    unsigned* xbuf;
    unsigned* cnt;
    unsigned* tmo;
    int ntn; float eps;
    unsigned code;
    __device__ __forceinline__ bool run(const f32x4 (&v)[2][2][4][2], const Unit& u, int wr, int wc, int fr, int fq, PG8_LAS unsigned char* lds, int wid, int lane) const {
        typedef float f32x2v __attribute__((ext_vector_type(2)));
        PG8_LAS f32x2v* P = (PG8_LAS f32x2v*)lds;
        PG8_LAS f32x2v* S = (PG8_LAS f32x2v*)(lds + 8192);
        PG8_LAS unsigned* flag = (PG8_LAS unsigned*)(lds + 8192 + 2048);
#pragma unroll
        for (int ai = 0; ai < 2; ++ai)
#pragma unroll
            for (int m = 0; m < 4; ++m) {
                float s = 0.f;
#pragma unroll
                for (int bj = 0; bj < 2; ++bj)
#pragma unroll
                    for (int n = 0; n < 2; ++n) { const f32x4 x = v[ai][bj][m][n]; s += (x[0] + x[1]) + (x[2] + x[3]); }
                s += __shfl_xor(s, 16); s += __shfl_xor(s, 32);
                const float mw = s * (1.0f / 64.0f); float q = 0.f;
#pragma unroll
                for (int bj = 0; bj < 2; ++bj)
#pragma unroll
                    for (int n = 0; n < 2; ++n) { const f32x4 d = v[ai][bj][m][n] - mw; q += (d[0] * d[0] + d[1] * d[1]) + (d[2] * d[2] + d[3] * d[3]); }
                q += __shfl_xor(q, 16); q += __shfl_xor(q, 32);
                if (fq == 0) P[(ai * HALF + wr * 64 + m * 16 + fr) * 4 + wc] = (f32x2v){mw, q};
            }
        asm volatile("s_waitcnt lgkmcnt(0)" ::: "memory"); __builtin_amdgcn_s_barrier(); asm volatile("" ::: "memory");
#if defined(BROKEN_EXCHANGE_NO_WAIT)
#warning BROKEN CONTROL BUILD: the row-statistics exchange does not wait; results are wrong by design
        if (blockIdx.x >= 64) { const long long t0_ = clock64(); while (clock64() - t0_ < 60000) __builtin_amdgcn_s_sleep(8); }
#endif
        const int row = wid * 32 + (lane & 31);
        if (lane < 32) {
            const f32x2v a = P[row * 4 + 0], b = P[row * 4 + 1], c = P[row * 4 + 2], d = P[row * 4 + 3];
            const float mt = (a.x + b.x + c.x + d.x) * 0.25f;
            const float da = a.x - mt, db = b.x - mt, dc = c.x - mt, dd = d.x - mt;
            const float m2 = (a.y + b.y) + (c.y + d.y) + 64.0f * ((da * da + db * db) + (dc * dc + dd * dd));
            unsigned long long* slot = (unsigned long long*)xbuf + ((size_t)(u.pm * BM + row) * 4 + u.pn);
            __hip_atomic_store(slot, ((unsigned long long)__float_as_uint(m2) << 32) | __float_as_uint(mt), __ATOMIC_RELAXED, __HIP_MEMORY_SCOPE_AGENT);
        }
        asm volatile("s_waitcnt vmcnt(0)" ::: "memory");
        if (lane == 0) __hip_atomic_fetch_add(cnt + 64 * u.pm, 1u, __ATOMIC_RELAXED, __HIP_MEMORY_SCOPE_AGENT);
        if (wid == 0) {
            bool dead = false; const unsigned long long t0 = __builtin_amdgcn_s_memrealtime(); const unsigned want = 8u * (unsigned)ntn;
            for (;;) {
#if defined(BROKEN_EXCHANGE_NO_WAIT)
                break;
#endif
                if ((unsigned)__builtin_amdgcn_readfirstlane(__hip_atomic_load(cnt + 64 * u.pm, __ATOMIC_RELAXED, __HIP_MEMORY_SCOPE_AGENT)) >= want) break;
                if (__builtin_amdgcn_s_memrealtime() - t0 > 2000000ull) {
                    if (lane == 0) { unsigned expect = 0u; __hip_atomic_compare_exchange_strong(tmo + 1, &expect, code | (unsigned)(u.pm & 0xff), __ATOMIC_RELAXED, __ATOMIC_RELAXED, __HIP_MEMORY_SCOPE_AGENT);
                                     __hip_atomic_store(tmo, 1u, __ATOMIC_RELAXED, __HIP_MEMORY_SCOPE_AGENT); }
                    dead = true; break; }
                __builtin_amdgcn_s_sleep(2);
            }
            __builtin_amdgcn_fence(__ATOMIC_ACQUIRE, "agent");
            if (lane == 0) flag[0] = dead ? 1u : 0u;
        }
        asm volatile("s_waitcnt vmcnt(0) lgkmcnt(0)" ::: "memory"); __builtin_amdgcn_s_barrier(); asm volatile("" ::: "memory");
        const bool bad = flag[0] != 0u;
        if (lane < 32) {
            const unsigned long long* slot = (const unsigned long long*)xbuf + (size_t)(u.pm * BM + row) * 4; float mt[4], m2[4]; float ms = 0.f;
#pragma unroll
            for (int t = 0; t < 4; ++t) { if (t < ntn) { const unsigned long long w = __hip_atomic_load(slot + t, __ATOMIC_RELAXED, __HIP_MEMORY_SCOPE_AGENT); mt[t] = __uint_as_float((unsigned)w); m2[t] = __uint_as_float((unsigned)(w >> 32)); } else { mt[t] = 0.f; m2[t] = 0.f; } ms += mt[t]; }
            const float mean = ms / (float)ntn; float q = 0.f;
#pragma unroll
            for (int t = 0; t < 4; ++t) if (t < ntn) { const float dm = mt[t] - mean; q += m2[t] + 256.0f * dm * dm; }
            S[row] = (f32x2v){mean, 1.0f / sqrtf(q / (256.0f * (float)ntn) + eps)};
        }
        asm volatile("s_waitcnt lgkmcnt(0)" ::: "memory"); __builtin_amdgcn_s_barrier(); asm volatile("" ::: "memory");
        return bad;
    }
};
struct EpiLnRes {
    static constexpr bool PERM = false, AFTER_DRAIN = true;
    const float* base; float* out; int ldc; const float* bias; PanelStats st; unsigned poison;
    __device__ __forceinline__ void fused(f32x4 (&acc)[2][2][4][2], const Unit& u, int wr, int wc, int fr, int fq, PG8_LAS unsigned char* lds, int wid, int lane) const {
        typedef float f32x2v __attribute__((ext_vector_type(2)));
        const PG8_LAS f32x2v* S = (const PG8_LAS f32x2v*)(lds + 8192);
        const int col0 = u.pn * BM + wc * 32 + 4 * fq;
#pragma unroll
        for (int bj = 0; bj < 2; ++bj)
#pragma unroll
            for (int n = 0; n < 2; ++n) { const f32x4 bv = bias ? *(const f32x4*)(bias + col0 + bj * HALF + n * 16) : (f32x4){0.f, 0.f, 0.f, 0.f};
#pragma unroll
                for (int ai = 0; ai < 2; ++ai)
#pragma unroll
                    for (int m = 0; m < 4; ++m) acc[ai][bj][m][n] += bv; }
        f32x4 pre[4][2][2];
#pragma unroll
        for (int m = 0; m < 4; ++m) { const size_t off = (size_t)(u.pm * BM + wr * 64 + m * 16 + fr) * ldc + col0;
#pragma unroll
            for (int bj = 0; bj < 2; ++bj)
#pragma unroll
                for (int n = 0; n < 2; ++n) pre[m][bj][n] = *(const f32x4*)(base + off + bj * HALF + n * 16); }
        const bool bad = st.run(acc, u, wr, wc, fr, fq, lds, wid, lane) || poison != 0u;
        const float qnan = __builtin_nanf("");
#pragma unroll
        for (int ai = 0; ai < 2; ++ai)
#pragma unroll
            for (int m = 0; m < 4; ++m) { const int r = ai * HALF + wr * 64 + m * 16 + fr; const f32x2v sr = S[r]; const size_t off = (size_t)(u.pm * BM + r) * ldc + col0;
#pragma unroll
                for (int bj = 0; bj < 2; ++bj)
#pragma unroll
                    for (int n = 0; n < 2; ++n) { const f32x4 bs = ai == 0 ? pre[m][bj][n] : *(const f32x4*)(base + off + bj * HALF + n * 16); f32x4 o = bs + (acc[ai][bj][m][n] - sr.x) * sr.y;
                        if (bad) o = (f32x4){qnan, qnan, qnan, qnan}; *(f32x4*)(out + off + bj * HALF + n * 16) = o; }
                if (m & 1) asm volatile("" ::: "memory"); }
    }
};
struct EpiLnResLn {
    static constexpr bool PERM = false, AFTER_DRAIN = true;
    const float* base; float* out; bf16_t* xn; int ldc; const float* bias; PanelStats st1, st2; unsigned poison;
    __device__ __forceinline__ void fused(f32x4 (&acc)[2][2][4][2], const Unit& u, int wr, int wc, int fr, int fq, PG8_LAS unsigned char* lds, int wid, int lane) const {
        typedef float f32x2v __attribute__((ext_vector_type(2))); typedef unsigned u32x2v __attribute__((ext_vector_type(2)));
        const PG8_LAS f32x2v* S = (const PG8_LAS f32x2v*)(lds + 8192);
        const int col0 = u.pn * BM + wc * 32 + 4 * fq;
#pragma unroll
        for (int bj = 0; bj < 2; ++bj)
#pragma unroll
            for (int n = 0; n < 2; ++n) { const f32x4 bv = bias ? *(const f32x4*)(bias + col0 + bj * HALF + n * 16) : (f32x4){0.f, 0.f, 0.f, 0.f};
#pragma unroll
                for (int ai = 0; ai < 2; ++ai)
#pragma unroll
                    for (int m = 0; m < 4; ++m) acc[ai][bj][m][n] += bv; }
        bool bad = st1.run(acc, u, wr, wc, fr, fq, lds, wid, lane) || poison != 0u;
        const float qnan = __builtin_nanf("");
#pragma unroll
        for (int ai = 0; ai < 2; ++ai)
#pragma unroll
            for (int m = 0; m < 4; ++m) { const int r = ai * HALF + wr * 64 + m * 16 + fr; const f32x2v sr = S[r]; const size_t off = (size_t)(u.pm * BM + r) * ldc + col0;
#pragma unroll
                for (int bj = 0; bj < 2; ++bj)
#pragma unroll
                    for (int n = 0; n < 2; ++n) { const f32x4 bs = *(const f32x4*)(base + off + bj * HALF + n * 16); acc[ai][bj][m][n] = bs + (acc[ai][bj][m][n] - sr.x) * sr.y; }
                asm volatile("" : "+v"(acc[ai][0][m][0]), "+v"(acc[ai][0][m][1]), "+v"(acc[ai][1][m][0]), "+v"(acc[ai][1][m][1]));
                if (m & 1) asm volatile("" ::: "memory"); }
        const bool bad1 = bad;
        bad = st2.run(acc, u, wr, wc, fr, fq, lds, wid, lane) || bad;
#pragma unroll
        for (int ai = 0; ai < 2; ++ai)
#pragma unroll
            for (int m = 0; m < 4; ++m) { const int r = ai * HALF + wr * 64 + m * 16 + fr; const f32x2v sr = S[r]; const size_t off = (size_t)(u.pm * BM + r) * ldc + col0;
#pragma unroll
                for (int bj = 0; bj < 2; ++bj)
#pragma unroll
                    for (int n = 0; n < 2; ++n) { const f32x4 x1 = acc[ai][bj][m][n]; *(f32x4*)(out + off + bj * HALF + n * 16) = bad1 ? (f32x4){qnan, qnan, qnan, qnan} : x1;
                        const f32x4 o = (x1 - sr.x) * sr.y; u32x2v w; w.x = cvt_pk_bf16(o[0], o[1]); w.y = cvt_pk_bf16(o[2], o[3]);
                        if (bad) { w.x = 0x7fc07fc0u; w.y = 0x7fc07fc0u; } *(u32x2v*)(xn + off + bj * HALF + n * 16) = w; }
                asm volatile("" ::: "memory"); }
    }
};

template <class Epi, class Sched, bool ALIGN_EPI = false, bool SP2 = false>
__device__ __forceinline__ void gemm_phase(PG8_LAS unsigned char* lds, const Gemm g, const Sched& S, const Epi& E) {
    int tid_l = threadIdx.x; asm volatile("" : "+v"(tid_l));
    const int tid = tid_l, wid = __builtin_amdgcn_readfirstlane(tid >> 6), lane = tid & 63, wr = wid >> 2, wc = wid & 3, fr = lane & 15, fq = lane >> 4;
    const int K = g.K, nt = K / BK;
    unsigned voffA[2], voffB[2];
#pragma unroll
    for (int i = 0; i < 2; ++i) { int R, C; stage_rc(tid * 16 + i * 8192, R, C); const int Rb = Epi::PERM ? ((R & ~31) + perm32(R & 31)) : R;
        voffA[i] = (unsigned)(R * g.lda + C) * 2u; voffB[i] = (unsigned)(Rb * K + C) * 2u; }
    const size_t kstep = (size_t)(BK * 2);
    const size_t hstep = (size_t)HALF * K * 2;
    const size_t tstep = 2 * hstep; const size_t hstepA = (size_t)HALF * g.lda * 2, tstepA = 2 * hstepA;
    const unsigned ldsw = (unsigned)wid * 1024u;
    const int aoff = lds_byte(wr * 64 + fr, fq * 8), boff = lds_byte(wc * 32 + fr, fq * 8);
#define PG8_SA(b, h) (((b) * 2 + (h)) * HTB)
#define PG8_SB(b, h) ((4 + (b) * 2 + (h)) * HTB)
#define PG8_STAGE(bufoff, gbase, voff) do { _Pragma("unroll") for (int _i = 0; _i < 2; ++_i) \
        __builtin_amdgcn_global_load_lds((const unsigned*)((const char*)(gbase) + (voff)[_i]), (PG8_LAS unsigned*)(lds + (bufoff) + ldsw + _i * 8192), 16, 0, 0); } while (0)
#define PG8_LDA(dst, b, h) do { _Pragma("unroll") for (int m = 0; m < 4; ++m) _Pragma("unroll") for (int k = 0; k < 2; ++k) dst[m][k] = *(const PG8_LAS bf16x8*)(lds + PG8_SA(b, h) + aoff + m * 2048 + k * 1024); } while (0)
#define PG8_LDB(dst, b, h) do { _Pragma("unroll") for (int n = 0; n < 2; ++n) _Pragma("unroll") for (int k = 0; k < 2; ++k) dst[n][k] = *(const PG8_LAS bf16x8*)(lds + PG8_SB(b, h) + boff + n * 2048 + k * 1024); } while (0)
#define PG8_MMA(ai, bj, At, Bt) do { __builtin_amdgcn_s_setprio(1); _Pragma("unroll") for (int m = 0; m < 4; ++m) _Pragma("unroll") for (int n = 0; n < 2; ++n) _Pragma("unroll") for (int k = 0; k < 2; ++k) \
        acc[ai][bj][m][n] = __builtin_amdgcn_mfma_f32_16x16x32_bf16(Bt[n][k], At[m][k], acc[ai][bj][m][n], 0, 0, 0); __builtin_amdgcn_s_setprio(0); } while (0)
#define PG8_WAIT_V(n) asm volatile("s_waitcnt vmcnt(" #n ")" ::: "memory")
#define PG8_WAIT_L(n) asm volatile("s_waitcnt lgkmcnt(" #n ")" ::: "memory")
#define PG8_BAR __builtin_amdgcn_s_barrier()
#define PG8_SCHED __builtin_amdgcn_sched_barrier(0)
    Unit cur, nxt; int ui = 0;
    if (!S.next(0, cur)) return;
    f32x4 acc[2][2][4][2];
#pragma unroll
    for (int a = 0; a < 2; ++a)
#pragma unroll
        for (int b = 0; b < 2; ++b)
#pragma unroll
            for (int m = 0; m < 4; ++m)
#pragma unroll
                for (int n = 0; n < 2; ++n) acc[a][b][m][n] = (f32x4){0.f, 0.f, 0.f, 0.f};
    bf16x8 At[4][2], B0[2][2], B1[2][2];
    const char* cA = (const char*)g.A + (size_t)cur.pm * tstepA; const char* cB = (const char*)g.Bt + (size_t)cur.pn * tstep;
    S.a_ready(cur);
    if constexpr (SP2) {
        PG8_STAGE(PG8_SB(0, 0), cB, voffB); PG8_STAGE(PG8_SB(0, 1), cB + hstep, voffB); PG8_STAGE(PG8_SA(0, 0), cA, voffA); PG8_STAGE(PG8_SA(0, 1), cA + hstepA, voffA);
        if (wr == 1) PG8_BAR;
        PG8_WAIT_V(2); PG8_BAR;
        PG8_STAGE(PG8_SB(1, 0), cB + kstep, voffB); PG8_STAGE(PG8_SA(1, 0), cA + kstep, voffA); PG8_STAGE(PG8_SB(1, 1), cB + hstep + kstep, voffB);
        PG8_WAIT_V(6); PG8_BAR;
    } else {
        PG8_STAGE(PG8_SB(0, 0), cB, voffB); PG8_STAGE(PG8_SA(0, 0), cA, voffA); PG8_STAGE(PG8_SB(0, 1), cB + hstep, voffB); PG8_STAGE(PG8_SA(0, 1), cA + hstepA, voffA);
        if (wr == 1) PG8_BAR;
        PG8_WAIT_V(4); PG8_BAR;
        PG8_STAGE(PG8_SB(1, 0), cB + kstep, voffB); PG8_STAGE(PG8_SA(1, 0), cA + kstep, voffA); PG8_STAGE(PG8_SB(1, 1), cB + hstep + kstep, voffB);
        PG8_WAIT_V(6); PG8_BAR;
    }
    for (;;) {
        const bool has_next = S.next(ui + 1, nxt);
        const char* nA = has_next ? (const char*)g.A + (size_t)nxt.pm * tstepA : cA; const char* nB = has_next ? (const char*)g.Bt + (size_t)nxt.pn * tstep : cB;
        for (int t = 0; t < nt; t += 2) {
            const bool last = (t == nt - 2);
            const char* a1 = cA + (size_t)(t + 1) * kstep;
            const char* a2 = last ? nA : cA + (size_t)(t + 2) * kstep; const char* b2 = last ? nB : cB + (size_t)(t + 2) * kstep;
            const char* a3 = a2 + kstep; const char* b3 = b2 + kstep;
            if (last && has_next) S.a_ready(nxt);
            if constexpr (SP2) {
            PG8_LDB(B0, 0, 0); PG8_LDB(B1, 0, 1); PG8_SCHED; PG8_LDA(At, 0, 0); PG8_STAGE(PG8_SA(1, 1), a1 + hstepA, voffA);
            PG8_WAIT_V(8); PG8_WAIT_L(0); PG8_BAR; PG8_MMA(0, 0, At, B0); PG8_MMA(0, 1, At, B1); PG8_BAR; PG8_SCHED;
            PG8_LDA(At, 0, 1); PG8_STAGE(PG8_SB(0, 0), b2, voffB); PG8_STAGE(PG8_SB(0, 1), b2 + hstep, voffB); PG8_STAGE(PG8_SA(0, 0), a2, voffA);
            PG8_WAIT_V(8); PG8_WAIT_L(0); PG8_BAR; PG8_MMA(1, 0, At, B0); PG8_MMA(1, 1, At, B1); PG8_BAR; PG8_SCHED;
            PG8_LDB(B0, 1, 0); PG8_LDB(B1, 1, 1); PG8_SCHED; PG8_LDA(At, 1, 0); PG8_STAGE(PG8_SA(0, 1), a2 + hstepA, voffA);
            PG8_WAIT_V(8); PG8_WAIT_L(0); PG8_BAR; PG8_MMA(0, 0, At, B0); PG8_MMA(0, 1, At, B1); PG8_BAR; PG8_SCHED;
            PG8_LDA(At, 1, 1); PG8_STAGE(PG8_SB(1, 0), b3, voffB); PG8_STAGE(PG8_SB(1, 1), b3 + hstep, voffB); PG8_STAGE(PG8_SA(1, 0), a3, voffA);
            PG8_WAIT_V(8); PG8_WAIT_L(0); PG8_BAR; PG8_MMA(1, 0, At, B0); PG8_MMA(1, 1, At, B1); PG8_BAR; PG8_SCHED;
            } else {
            PG8_LDB(B0, 0, 0); PG8_SCHED; PG8_LDA(At, 0, 0); PG8_STAGE(PG8_SA(1, 1), a1 + hstepA, voffA);
            PG8_WAIT_L(8); PG8_BAR; PG8_WAIT_L(0); PG8_MMA(0, 0, At, B0); PG8_BAR; PG8_SCHED;
            PG8_LDB(B1, 0, 1); PG8_STAGE(PG8_SB(0, 0), b2, voffB);
            PG8_BAR; PG8_WAIT_L(0); PG8_MMA(0, 1, At, B1); PG8_BAR;
            PG8_LDA(At, 0, 1); PG8_STAGE(PG8_SA(0, 0), a2, voffA);
            PG8_BAR; PG8_WAIT_L(0); PG8_MMA(1, 0, At, B0); PG8_BAR; PG8_SCHED;
            PG8_STAGE(PG8_SB(0, 1), b2 + hstep, voffB);
            PG8_WAIT_V(6); PG8_BAR; PG8_MMA(1, 1, At, B1); PG8_BAR;
            PG8_LDB(B0, 1, 0); PG8_SCHED; PG8_LDA(At, 1, 0); PG8_STAGE(PG8_SA(0, 1), a2 + hstepA, voffA);
            PG8_WAIT_L(8); PG8_BAR; PG8_WAIT_L(0); PG8_MMA(0, 0, At, B0); PG8_BAR; PG8_SCHED;
            PG8_LDB(B1, 1, 1); PG8_STAGE(PG8_SB(1, 0), b3, voffB);
            PG8_BAR; PG8_WAIT_L(0); PG8_MMA(0, 1, At, B1); PG8_BAR;
            PG8_LDA(At, 1, 1); PG8_STAGE(PG8_SA(1, 0), a3, voffA);
            PG8_BAR; PG8_WAIT_L(0); PG8_MMA(1, 0, At, B0); PG8_BAR; PG8_SCHED;
            PG8_STAGE(PG8_SB(1, 1), b3 + hstep, voffB);
            PG8_WAIT_V(6); PG8_BAR; PG8_MMA(1, 1, At, B1); PG8_BAR;
            }
        }
        if constexpr (ALIGN_EPI) { if (wr == 0) PG8_BAR; }
        if constexpr (!Epi::AFTER_DRAIN) { E(acc, cur, wr, wc, fr, fq); S.done(cur); }
        if (!has_next) break;
#pragma unroll
        for (int a = 0; a < 2; ++a)
#pragma unroll
            for (int b = 0; b < 2; ++b)
#pragma unroll
                for (int m = 0; m < 4; ++m)
#pragma unroll
                    for (int n = 0; n < 2; ++n) acc[a][b][m][n] = (f32x4){0.f, 0.f, 0.f, 0.f};
        cur = nxt; cA = nA; cB = nB; ++ui;
        if constexpr (ALIGN_EPI) { if (wr == 1) PG8_BAR; }
    }
    PG8_WAIT_V(0);
    if constexpr (!ALIGN_EPI) { if (wr == 0) PG8_BAR; }
    PG8_BAR;
    if constexpr (Epi::AFTER_DRAIN) { E.fused(acc, cur, wr, wc, fr, fq, lds, wid, lane); S.done(cur); }
#undef PG8_SA
#undef PG8_SB
#undef PG8_STAGE
#undef PG8_LDA
#undef PG8_LDB
#undef PG8_MMA
#undef PG8_WAIT_V
#undef PG8_WAIT_L
#undef PG8_BAR
#undef PG8_SCHED
}
}

#ifndef PG8_SP2
#define PG8_SP2 true
#endif
#ifndef PG8_ALIGN
#define PG8_ALIGN true
#endif
#include <hip/hip_bf16.h>
#include <cmath>
namespace attn_body {
using bf16=__hip_bfloat16;
using bf16x8=__attribute__((ext_vector_type(8)))short;
using s16x4=__attribute__((ext_vector_type(4)))short;
using f32x16=__attribute__((ext_vector_type(16)))float;
using u32x4=__attribute__((ext_vector_type(4)))unsigned;
using f32x4v=__attribute__((ext_vector_type(4)))float;
constexpr int BATCH=1,NHEAD=8,SEQ=16384,D=64,DM=8704;
constexpr int NW=8,QBLK=32,QB=QBLK*NW,KVBLK=64,NQB=SEQ/QB;
constexpr int ATTN_PITCH=DM, ATTN_UNIT_ROWS=QB;
__device__ __forceinline__ int crow(int r,int hi){return (r&3)+8*(r>>2)+4*hi;}
#define SBAR() __builtin_amdgcn_sched_barrier(0)
__device__ __forceinline__ void cmask(f32x16&p0,f32x16&p1,int jb,int qrel,int hi){
  const float NEG=-INFINITY; int kb=64*jb+4*hi;
  #pragma unroll
  for(int r=0;r<16;++r){int kv=kb+(r&3)+8*(r>>2); if(kv>qrel)p0[r]=NEG; if(kv+32>qrel)p1[r]=NEG;}
}

constexpr int NSLOT=3, SLOTB=8192;
constexpr int LDS_K=0, LDS_V=NSLOT*SLOTB, LDS_WS=2*NSLOT*SLOTB, LDS_OST=LDS_WS+NW*64*4, LDS_F=LDS_OST+NW*4096, LDS_BYTES=LDS_F+SEQ*4;
constexpr float C2=0.125f*1.4426950408889634f;
__device__ __forceinline__ void glds16(const void*gsrc,unsigned lds_dst){unsigned keep;
  asm volatile("s_mov_b32 %0, m0\n\ts_mov_b32 m0, %2\n\ts_nop 0\n\tglobal_load_lds_dwordx4 %1, off\n\ts_mov_b32 m0, %0":"=&s"(keep):"v"(gsrc),"s"(lds_dst):"memory");}
__device__ __forceinline__ float max3f(float a,float b,float c){float r;asm("v_max3_f32 %0, %1, %2, %3":"=v"(r):"v"(a),"v"(b),"v"(c));return r;}
__device__ __forceinline__ float max2f(float a,float b){float r;asm("v_max_f32_e32 %0, %1, %2":"=v"(r):"v"(a),"v"(b));return r;}
__device__ __forceinline__ float fadd_s(float a,float b){float r;asm("v_add_f32_e32 %0, %1, %2":"=v"(r):"v"(a),"v"(b));return r;}
__device__ __forceinline__ float fsub_s(float a,float b){float r;asm("v_sub_f32_e32 %0, %1, %2":"=v"(r):"v"(a),"v"(b));return r;}
typedef float f32x2_t __attribute__((ext_vector_type(2))); typedef __bf16 bf16x2_t __attribute__((ext_vector_type(2)));
__device__ __forceinline__ unsigned cvtpk_s(float lo,float hi){f32x2_t v={lo,hi};bf16x2_t b=__builtin_convertvector(v,bf16x2_t);return __builtin_bit_cast(unsigned,b);}
#define WAIT_BAR(N) asm volatile("s_waitcnt vmcnt(" #N ") lgkmcnt(0)\n\ts_barrier":::"memory")


__device__ __forceinline__ bf16x8 mkbias(float x,int hi){
  const unsigned xb=__float_as_uint(x); const unsigned hb=xb&0xffff0000u; const float r1=x-__uint_as_float(hb);
  const unsigned mb=__float_as_uint(r1)&0xffff0000u; const float r2=r1-__uint_as_float(mb); const unsigned lb=__float_as_uint(r2)&0xffff0000u;
  u32x4 w; w.x=(hb>>16)|mb; w.y=(lb>>16)|0x3f800000u; w.z=0x3f803f80u; w.w=0u; if(hi){w.x=0u;w.y=0u;w.z=0u;}
  return __builtin_bit_cast(bf16x8,w);
}
__device__ __forceinline__ bf16x8 mkq(float x,int hi){
  const unsigned xb=__float_as_uint(x); const unsigned hb=xb&0xffff0000u; const float r1=x-__uint_as_float(hb);
  const unsigned mb=__float_as_uint(r1)&0xffff0000u; const float r2=r1-__uint_as_float(mb); const unsigned lb=__float_as_uint(r2)&0xffff0000u;
  u32x4 w; w.x=0x3f803f80u; w.y=0x3f80u|hb; w.z=(mb>>16)|lb; w.w=0u; if(hi){w.x=0u;w.y=0u;w.z=0u;}
  return __builtin_bit_cast(bf16x8,w);
}
__device__ __forceinline__ void qkt(f32x16&p0,f32x16&p1,const char*Kslot,const bf16x8*qr,int r32,int hi,bf16x8 kb0,bf16x8 kb1,bf16x8 qone){ const f32x16 negm=f32x16{};
  const char*kb=Kslot+hi*1024+r32*16;
  #pragma unroll
  for(int d0=0;d0<4;++d0){
    const bf16x8 b0=*reinterpret_cast<const bf16x8*>(kb+d0*2048);
    const bf16x8 b1=*reinterpret_cast<const bf16x8*>(kb+d0*2048+512);
    if(d0==0){p0=__builtin_amdgcn_mfma_f32_32x32x16_bf16(b0,qr[0],negm,0,0,0);p1=__builtin_amdgcn_mfma_f32_32x32x16_bf16(b1,qr[0],negm,0,0,0);}
    else{p0=__builtin_amdgcn_mfma_f32_32x32x16_bf16(b0,qr[d0],p0,0,0,0);p1=__builtin_amdgcn_mfma_f32_32x32x16_bf16(b1,qr[d0],p1,0,0,0);}}
  p0=__builtin_amdgcn_mfma_f32_32x32x16_bf16(kb0,qone,p0,0,0,0);p1=__builtin_amdgcn_mfma_f32_32x32x16_bf16(kb1,qone,p1,0,0,0);
}
typedef __attribute__((address_space(3))) const char* lds_cptr;
typedef short v4i16_t __attribute__((ext_vector_type(4)));
__device__ __forceinline__ void kload8(bf16x8*kf,lds_cptr kp){
  kf[0]=*(const __attribute__((address_space(3))) bf16x8*)(kp);      kf[1]=*(const __attribute__((address_space(3))) bf16x8*)(kp+512);
  kf[2]=*(const __attribute__((address_space(3))) bf16x8*)(kp+2048); kf[3]=*(const __attribute__((address_space(3))) bf16x8*)(kp+2560);
  kf[4]=*(const __attribute__((address_space(3))) bf16x8*)(kp+4096); kf[5]=*(const __attribute__((address_space(3))) bf16x8*)(kp+4608);
  kf[6]=*(const __attribute__((address_space(3))) bf16x8*)(kp+6144); kf[7]=*(const __attribute__((address_space(3))) bf16x8*)(kp+6656);
}
__device__ __forceinline__ void kload2(bf16x8*kf,lds_cptr kp,int j){ kf[2*j]=*(const __attribute__((address_space(3))) bf16x8*)(kp+j*2048); kf[2*j+1]=*(const __attribute__((address_space(3))) bf16x8*)(kp+j*2048+512); }
__device__ __forceinline__ s16x4 vtr(lds_cptr p){ return __builtin_bit_cast(s16x4,__builtin_amdgcn_ds_read_tr16_b64_v4i16((__attribute__((address_space(3))) v4i16_t*)p)); }
__device__ __forceinline__ float rowmax(const f32x16&p0,const f32x16&p1){
  float a=max3f(p0[0],p0[1],p1[0]),b=max3f(p0[2],p0[3],p1[1]);a=max3f(a,p1[2],p1[3]);
  #pragma unroll
  for(int r=4;r<16;r+=4){a=max3f(a,p0[r],p0[r+1]);b=max3f(b,p0[r+2],p0[r+3]);a=max3f(a,p1[r],p1[r+1]);b=max3f(b,p1[r+2],p1[r+3]);}
  const float m=max2f(a,b);
  auto rr=__builtin_amdgcn_permlane32_swap(__float_as_uint(m),__float_as_uint(m),false,false);
  return max2f(__uint_as_float(rr[0]),__uint_as_float(rr[1]));
}
__device__ __forceinline__ void pv(f32x16*o,int vb,bf16x8 pa0,bf16x8 pa1,bf16x8 pa2,bf16x8 pa3){
  #pragma unroll
  for(int d0=0;d0<2;++d0){s16x4 lo[4],hi[4];
    #pragma unroll
    for(int ks=0;ks<4;++ks){
      asm volatile("ds_read_b64_tr_b16 %0,%1 offset:%c2":"=&v"(lo[ks]):"v"(vb),"i"(d0*4096+ks*1024):"memory");
      asm volatile("ds_read_b64_tr_b16 %0,%1 offset:%c2":"=&v"(hi[ks]):"v"(vb),"i"(d0*4096+ks*1024+512):"memory");}
    asm volatile("s_waitcnt lgkmcnt(0)":::"memory");SBAR();
    #define PK(k) (bf16x8){lo[k][0],lo[k][1],lo[k][2],lo[k][3],hi[k][0],hi[k][1],hi[k][2],hi[k][3]}
    o[d0]=__builtin_amdgcn_mfma_f32_32x32x16_bf16(pa0,PK(0),o[d0],0,0,0);
    o[d0]=__builtin_amdgcn_mfma_f32_32x32x16_bf16(pa1,PK(1),o[d0],0,0,0);
    o[d0]=__builtin_amdgcn_mfma_f32_32x32x16_bf16(pa2,PK(2),o[d0],0,0,0);
    o[d0]=__builtin_amdgcn_mfma_f32_32x32x16_bf16(pa3,PK(3),o[d0],0,0,0);
    #undef PK
  }
}

#ifndef ATTN_STORE16
#define ATTN_STORE16(p,v) (*(u32x4*)(p)=(v))
#endif
template<int THRL> __device__ __forceinline__ void attn_unit(int b,int h,int qb,const bf16*Q,const bf16*__restrict__ K,const bf16*__restrict__ V,bf16*O,const float*FL2,char*shm){
  int tid_l=threadIdx.x; asm volatile("":"+v"(tid_l));
  const int tid=tid_l,lane=tid&63,r32=lane&31,hi=lane>>5; const int wid=__builtin_amdgcn_readfirstlane(tid>>6);
  const long rowbase=(long)b*SEQ; const int q0=qb*QB;
  const bf16*Qw=Q+(rowbase+q0+wid*QBLK)*DM+h*D;
  const bf16*Kh=K+rowbase*DM+h*D,*Vh=V+rowbase*DM+h*D;
  const lds_cptr shm3=(lds_cptr)shm;
  const unsigned lds0=(unsigned)(uintptr_t)shm;
  float*wsf=(float*)(shm+LDS_WS)+wid*64;
  const bf16*ksrc=Kh+(long)lane*DM+wid*8;
  const bf16*vsrc=Vh+(long)(16*(wid&3)+(lane>>2))*DM+(wid>>2)*32+(lane&3)*8;
  const unsigned kdst=lds0+LDS_K+wid*1024, vdst=lds0+LDS_V+wid*1024;
  #define DMA_K(t,slot) glds16(ksrc+(long)(t)*KVBLK*DM,(unsigned)__builtin_amdgcn_readfirstlane(kdst+(slot)))
  #define DMA_V(t,slot) glds16(vsrc+(long)(t)*KVBLK*DM,(unsigned)__builtin_amdgcn_readfirstlane(vdst+(slot)))
  const int vb0=(int)(lds0+LDS_V)+((lane>>4)&1)*32+(lane&3)*8+(4*hi+((lane&15)>>2))*64;
  const char*Kbase=shm+LDS_K; bf16x8 kf[8];
  const lds_cptr kp0=shm3+LDS_K+hi*1024+r32*16; const lds_cptr vp0=shm3+LDS_V+((lane>>4)&1)*32+(lane&3)*8+(4*hi+((lane&15)>>2))*64;
  const int NT=(q0+QB)/KVBLK;
  const __attribute__((address_space(3))) float* Fl=(const __attribute__((address_space(3))) float*)(shm3+LDS_F);
  float fref;
  { const float*Fg=FL2+(long)h*SEQ; const int nF=q0+QB;
    for(int i=tid*4;i<nF;i+=NW*64*4){ const f32x4v v4=*reinterpret_cast<const f32x4v*>(Fg+i); *(__attribute__((address_space(3))) f32x4v*)(shm3+LDS_F+i*4)=v4; }
    fref=Fg[nF-1]; }
  asm volatile("s_waitcnt vmcnt(0) lgkmcnt(0)":::"memory");
  bf16x8 qone=mkq(0.f,hi);
  #define MKB(t,off) mkbias(fref-Fl[(t)*KVBLK+(off)+r32],hi)
  DMA_K(0,0);DMA_V(0,0);DMA_K(1,SLOTB);
  bf16x8 qr[4];
  #pragma unroll
  for(int d0=0;d0<4;++d0)qr[d0]=*reinterpret_cast<const bf16x8*>(&Qw[(long)r32*DM+d0*16+hi*8]);
  float mhat=0.f,l_reg=0.f;f32x16 o[2];o[0]=f32x16{};o[1]=f32x16{};
  const int qrel=wid*QBLK+r32;
  #define CMASK(P0,P1,t) do{int jb_=(t)-(NT-4); if(jb_>=0)cmask(P0,P1,jb_,qrel,hi);}while(0)
  bool resc=false;
  #define START(P0,P1) do{ const float rm=rowmax(P0,P1); resc=false; \
    { const float dl=rm; mhat=fadd_s(mhat,dl); \
      _Pragma("unroll") for(int r=0;r<16;++r){P0[r]=fsub_s(P0[r],dl);P1[r]=fsub_s(P1[r],dl);} \
      qone=mkq(-mhat,hi); } \
    _Pragma("unroll") for(int r=0;r<16;++r)P0[r]=__builtin_amdgcn_exp2f(P0[r]); }while(0)
  #define RESC() do{ if(resc){ asm volatile("s_waitcnt lgkmcnt(0)":::"memory"); \
      _Pragma("unroll") for(int d_=0;d_<2;++d_) _Pragma("unroll") for(int r=0;r<16;++r)o[d_][r]*=wsf[crow(r,hi)]; } }while(0)
  f32x16 pA0,pA1,pB0,pB1;
  int sl_prev=0,sl_cur=0,sl_next=SLOTB;
  #define ROT() do{sl_prev=sl_cur;sl_cur=sl_next;sl_next=(sl_next==(NSLOT-1)*SLOTB)?0:sl_next+SLOTB;}while(0)
  DMA_K(2,2*SLOTB);
  WAIT_BAR(3);
  qkt(pA0,pA1,Kbase,qr,r32,hi,MKB(0,0),MKB(0,32),qone);asm volatile("s_nop 15\n\ts_nop 7":"+v"(pA0),"+v"(pA1));CMASK(pA0,pA1,0);
  START(pA0,pA1);
  _Pragma("unroll") for(int r=0;r<16;++r)pA1[r]=__builtin_amdgcn_exp2f(pA1[r]);
  WAIT_BAR(0);
  DMA_K(3,0);DMA_V(1,SLOTB);
  ROT();
  kload8(kf,kp0+sl_cur);
  WAIT_BAR(2);
  s16x4 vlo[8],vhi[8]; u32x4 pw0,pw1,pw2,pw3;
  #define PKW(P,B) cvtpk_s(P[B],P[B+1])
  #define PAF(k) __builtin_bit_cast(bf16x8,pw##k)
  #define VFR(i) (bf16x8){vlo[i][0],vlo[i][1],vlo[i][2],vlo[i][3],vhi[i][0],vhi[i][1],vhi[i][2],vhi[i][3]}
  #define PIN(x) asm volatile("":"+v"(x))
  #define MX3(a,b,c) __builtin_fmaxf(__builtin_fmaxf((a),(b)),(c))
  #define GAPA(MF,A0,A1,A2,A3,W0,W1,PW) do{ MF; sacc+=A0; sacc+=A1; sacc+=A2; sacc+=A3; PIN(sacc); W0; W1; PIN(PW); SBAR(); }while(0)
  #define EX(v) __builtin_amdgcn_exp2f(v)
  #define GAPB(MF,X,B) do{ MF; X[B]=EX(X[B]); X[B+1]=EX(X[B+1]); X[B+2]=EX(X[B+2]); X[B+3]=EX(X[B+3]); PIN(X); SBAR(); }while(0)
  #define VRD(i) do{ vlo[i]=vtr(vp_+(((i)>>2)*4096+((i)&3)*1024)); vhi[i]=vtr(vp_+(((i)>>2)*4096+((i)&3)*1024+512)); }while(0)
  #define KRD(G,j) do{ if(G){ kload2(kf,kp0+sl_next,j); SBAR(); } }while(0)
  #define STEP(C0,C1,P0,P1,t,GK,GV,GL) do{ SBAR(); \
    const bf16x8 kbA_=MKB(t,0), kbB_=MKB(t,32); \
    const lds_cptr vp_=vp0+sl_prev; \
    VRD(0); SBAR(); float sacc=(P0[0]+P0[1]); \
    GAPA(C0=__builtin_amdgcn_mfma_f32_32x32x16_bf16(kf[0],qr[0],f32x16{},0,0,0), P0[2],P0[3],P0[4],P0[5],     pw0[0]=PKW(P0,0), pw0[1]=PKW(P0,2), pw0); \
    VRD(4); SBAR(); GAPA(C1=__builtin_amdgcn_mfma_f32_32x32x16_bf16(kf[1],qr[0],f32x16{},0,0,0), P0[6],P0[7],P0[8],P0[9],     pw0[2]=PKW(P0,4), pw0[3]=PKW(P0,6), pw0); \
    VRD(1); SBAR(); GAPA(C0=__builtin_amdgcn_mfma_f32_32x32x16_bf16(kf[2],qr[1],C0,0,0,0),   P0[10],P0[11],P0[12],P0[13], pw1[0]=PKW(P0,8), pw1[1]=PKW(P0,10), pw1); \
    VRD(5); SBAR(); GAPA(C1=__builtin_amdgcn_mfma_f32_32x32x16_bf16(kf[3],qr[1],C1,0,0,0),   P0[14],P0[15],P1[0],P1[1],   pw1[2]=PKW(P0,12),pw1[3]=PKW(P0,14), pw1); \
    VRD(2); SBAR(); GAPA(C0=__builtin_amdgcn_mfma_f32_32x32x16_bf16(kf[4],qr[2],C0,0,0,0),   P1[2],P1[3],P1[4],P1[5],     pw2[0]=PKW(P1,0), pw2[1]=PKW(P1,2), pw2); \
    VRD(6); SBAR(); GAPA(C1=__builtin_amdgcn_mfma_f32_32x32x16_bf16(kf[5],qr[2],C1,0,0,0),   P1[6],P1[7],P1[8],P1[9],     pw2[2]=PKW(P1,4), pw2[3]=PKW(P1,6), pw2); \
    VRD(3); SBAR(); GAPA(C0=__builtin_amdgcn_mfma_f32_32x32x16_bf16(kf[6],qr[3],C0,0,0,0),   P1[10],P1[11],P1[12],P1[13], pw3[0]=PKW(P1,8), pw3[1]=PKW(P1,10), pw3); \
    VRD(7); SBAR(); GAPA(C1=__builtin_amdgcn_mfma_f32_32x32x16_bf16(kf[7],qr[3],C1,0,0,0),   P1[14],P1[15],0.f,0.f,       pw3[2]=PKW(P1,12),pw3[3]=PKW(P1,14), pw3); \
    C0=__builtin_amdgcn_mfma_f32_32x32x16_bf16(kbA_,qone,C0,0,0,0); C1=__builtin_amdgcn_mfma_f32_32x32x16_bf16(kbB_,qone,C1,0,0,0); \
    l_reg+=sacc; \
    if(GK){DMA_K((t)+3,sl_cur);} if(GV){DMA_V((t)+1,sl_next);} \
    CMASK(C0,C1,t); \
    { float a=MX3(C0[0],C0[1],C1[0]),b=MX3(C0[2],C0[3],C1[1]); a=MX3(a,C1[2],C1[3]); \
      _Pragma("unroll") for(int r=4;r<16;r+=4){a=MX3(a,C0[r],C0[r+1]);b=MX3(b,C0[r+2],C0[r+3]);a=MX3(a,C1[r],C1[r+1]);b=MX3(b,C1[r+2],C1[r+3]);} \
      float rm=__builtin_fmaxf(a,b); { auto rr=__builtin_amdgcn_permlane32_swap(__float_as_uint(rm),__float_as_uint(rm),false,false); rm=__builtin_fmaxf(__uint_as_float(rr[0]),__uint_as_float(rr[1])); } \
      resc=false; \
      if(__builtin_expect(__any(rm>(float)THRL),0)){ const float dl=__builtin_fmaxf(rm,0.f); mhat+=dl; \
        _Pragma("unroll") for(int r=0;r<16;++r){C0[r]-=dl;C1[r]-=dl;} \
        qone=mkq(-mhat,hi); \
        const float f=__builtin_amdgcn_exp2f(-dl); l_reg*=f; if(hi==0)wsf[r32]=f; resc=true; } } \
    SBAR(); \
    GAPB(o[0]=__builtin_amdgcn_mfma_f32_32x32x16_bf16(PAF(0),VFR(0),o[0],0,0,0), C0,0); \
    GAPB(o[1]=__builtin_amdgcn_mfma_f32_32x32x16_bf16(PAF(0),VFR(4),o[1],0,0,0), C0,4); \
    KRD(GL,0); GAPB(o[0]=__builtin_amdgcn_mfma_f32_32x32x16_bf16(PAF(1),VFR(1),o[0],0,0,0), C0,8); \
    KRD(GL,1); GAPB(o[1]=__builtin_amdgcn_mfma_f32_32x32x16_bf16(PAF(1),VFR(5),o[1],0,0,0), C0,12); \
    KRD(GL,2); GAPB(o[0]=__builtin_amdgcn_mfma_f32_32x32x16_bf16(PAF(2),VFR(2),o[0],0,0,0), C1,0); \
    KRD(GL,3); GAPB(o[1]=__builtin_amdgcn_mfma_f32_32x32x16_bf16(PAF(2),VFR(6),o[1],0,0,0), C1,4); \
    GAPB(o[0]=__builtin_amdgcn_mfma_f32_32x32x16_bf16(PAF(3),VFR(3),o[0],0,0,0), C1,8); \
    GAPB(o[1]=__builtin_amdgcn_mfma_f32_32x32x16_bf16(PAF(3),VFR(7),o[1],0,0,0), C1,12); \
    }while(0)
  int t=1;
  #undef CMASK
  #define CMASK(P0,P1,t) do{}while(0)
  for(;t+5<NT;t+=2){
    STEP(pB0,pB1,pA0,pA1,t,true,true,true);     WAIT_BAR(2); RESC(); ROT();
    STEP(pA0,pA1,pB0,pB1,t+1,true,true,true);   WAIT_BAR(2); RESC(); ROT();
  }
  #undef CMASK
  #define CMASK(P0,P1,t) do{int jb_=(t)-(NT-4); if(jb_>=0)cmask(P0,P1,jb_,qrel,hi);}while(0)
  #define ENDW(tt) do{ if((tt)+3<NT){WAIT_BAR(2);} else if((tt)+2<NT){WAIT_BAR(1);} else {WAIT_BAR(0);} }while(0)
  for(;t+1<NT;t+=2){
    STEP(pB0,pB1,pA0,pA1,t,(t+3<NT),(t+1<NT),(t+1<NT));       ENDW(t);   RESC(); ROT();
    STEP(pA0,pA1,pB0,pB1,t+1,(t+4<NT),(t+2<NT),(t+2<NT));     ENDW(t+1); RESC(); ROT();
  }
  STEP(pB0,pB1,pA0,pA1,NT-1,false,false,false); RESC();
  { float sacc=pB0[0]+pB0[1]; _Pragma("unroll") for(int r=2;r<16;++r)sacc+=pB0[r]; _Pragma("unroll") for(int r=0;r<16;++r)sacc+=pB1[r]; l_reg+=sacc;
    pw0=(u32x4){PKW(pB0,0),PKW(pB0,2),PKW(pB0,4),PKW(pB0,6)};pw1=(u32x4){PKW(pB0,8),PKW(pB0,10),PKW(pB0,12),PKW(pB0,14)};pw2=(u32x4){PKW(pB1,0),PKW(pB1,2),PKW(pB1,4),PKW(pB1,6)};pw3=(u32x4){PKW(pB1,8),PKW(pB1,10),PKW(pB1,12),PKW(pB1,14)};
    SBAR(); pv(o,vb0+sl_cur,PAF(0),PAF(1),PAF(2),PAF(3)); }
  #undef PKW
  #undef PAF
  #undef VFR
  #undef PIN
  #undef MX3
  #undef GAPA
  #undef GAPB
  #undef EX
  #undef VRD
  #undef KRD
  #undef STEP
  #undef ENDW
  {auto rr=__builtin_amdgcn_permlane32_swap(__float_as_uint(l_reg),__float_as_uint(l_reg),false,false);l_reg=__uint_as_float(rr[0])+__uint_as_float(rr[1]);}
  if(hi==0)wsf[32+r32]=l_reg;asm volatile("s_waitcnt lgkmcnt(0)":::"memory");
  float rli[16];
  #pragma unroll
  for(int r=0;r<16;++r)rli[r]=__builtin_amdgcn_rcpf(wsf[32+crow(r,hi)]);
  bf16*Ow=O+(rowbase+q0+wid*QBLK)*DM+h*D;
  { bf16*stg=(bf16*)(shm+LDS_OST)+wid*2048;
    #pragma unroll
    for(int r=0;r<16;++r){const int orow=crow(r,hi);
      #pragma unroll
      for(int d0=0;d0<2;++d0)stg[orow*64+d0*32+r32]=__float2bfloat16(o[d0][r]*rli[r]);}
    asm volatile("s_waitcnt lgkmcnt(0)":::"memory");
    #pragma unroll
    for(int i=0;i<4;++i){const int row=i*8+(lane>>3),ch=lane&7; const u32x4 v=*(const u32x4*)(stg+row*64+ch*8); ATTN_STORE16(Ow+(long)row*DM+ch*8,v);} }
  asm volatile("s_waitcnt lgkmcnt(0)\n\ts_barrier":::"memory");
  #undef DMA_K
  #undef DMA_V
  #undef MKB
  #undef CMASK
  #undef START
  #undef RESC
  #undef ROT
}
constexpr int ATTN_LDS_BYTES=LDS_BYTES;
struct AttnTensors { const bf16* Q; const bf16* K; const bf16* V; bf16* O; const float* FL2; };
struct AttnUnit { int bh; int qb; };
struct StaticOrder {
  int vcu;
  __device__ __forceinline__ explicit StaticOrder(int grid,int block):vcu((block%8)*(grid/8)+block/8){}
  __device__ __forceinline__ bool next(int i,AttnUnit&u)const{ if(i>=2)return false; const int s=vcu&31; u.bh=vcu>>5; u.qb=(i==0)?s:63-s; return true; }
  __device__ __forceinline__ void a_ready(const AttnUnit&)const{}
  __device__ __forceinline__ void done(const AttnUnit&)const{}
};
template<class Sched,int THRL=8> __device__ __forceinline__ void attn_phase(char*lds,const AttnTensors&T,const Sched&S){
  AttnUnit u;
  for(int i=0;S.next(i,u);++i){ S.a_ready(u); attn_unit<THRL>(u.bh/NHEAD,u.bh%NHEAD,u.qb,T.Q,T.K,T.V,T.O,T.FL2,lds); S.done(u); }
}
#undef SBAR
#undef WAIT_BAR
}
#define LAS __attribute__((address_space(3)))
typedef unsigned short bf16;
typedef unsigned v4u __attribute__((ext_vector_type(4)));
typedef unsigned v2u __attribute__((ext_vector_type(2)));
typedef float f32x4 __attribute__((ext_vector_type(4)));
typedef short bf16x8 __attribute__((ext_vector_type(8)));
typedef const __attribute__((address_space(4))) unsigned* cu32p;
typedef const __attribute__((address_space(4))) float* cf32p;

constexpr int M = 16384, D = 1024, DFF = 2816, ZP = 8704, NL = 4, NWAVES = 8, NTHR = 512;
constexpr int ZQ = 0, ZK = 512, ZV = 1024, ZXB = 1536, ZYB = 2560, ZRW = 3584, ZGT = 5376, ZFL = 8448;
constexpr float ALPHA = 1.6817928305074292f, LN_EPS = 1e-5f, GN_EPS = 64e-5f, LOG2E = 1.4426950408889634f;
constexpr int NCH = 256, LC = 64;

constexpr size_t MiB = 1u << 20;
constexpr size_t WS_ADA = 1 * MiB, WS_FL2 = 2 * MiB, WS_LAEND = 3 * MiB, WS_LHEND = 4 * MiB, WS_LCAR = 5 * MiB, WS_BON = 6 * MiB;
constexpr size_t WS_W = 8 * MiB;
constexpr size_t W_UP0 = WS_W, W_UP1 = WS_W + 11 * MiB, W_DN0 = WS_W + 22 * MiB, W_DN1 = WS_W + 22 * MiB + 5632 * 1024, W_IN = WS_W + 33 * MiB,
                 W_PA = WS_W + 50 * MiB, W_PB = WS_W + 51 * MiB, W_PC = WS_W + 53 * MiB, W_OUT = WS_W + 54 * MiB, W_LORA = WS_W + 56 * MiB;
constexpr size_t WS_HB = 65 * MiB, WS_Y = 97 * MiB, WS_HLOC = 97 * MiB, WS_ACUM = 129 * MiB, WS_P = 97 * MiB, WS_G = 129 * MiB;
constexpr size_t WS_RWO = 161 * MiB, WS_CODES = 177 * MiB, WS_LORA = 185 * MiB, WS_S0 = 185 * MiB;
constexpr size_t WS_RW_W = 233 * MiB, WS_RW_R = 265 * MiB, WS_RW_KF = 281 * MiB, WS_RW_V = 297 * MiB, WS_RW_KK = 313 * MiB, WS_RW_B = 329 * MiB, WS_GB = 345 * MiB;
constexpr size_t WS_Z = 361 * MiB, WS_ACT = 361 * MiB, WS_END = 697 * MiB;
struct RwSet { size_t w, r, kf, kk, b; };
__device__ __forceinline__ RwSet rw_set(int l) { return (l & 1) ? RwSet{WS_HB, 633 * MiB, 649 * MiB, 665 * MiB, 681 * MiB} : RwSet{WS_RW_W, WS_RW_R, WS_RW_KF, WS_RW_KK, WS_RW_B}; }
constexpr int LDS_BYTES = attn_body::ATTN_LDS_BYTES;
static_assert(LDS_BYTES >= pg8::STAGE_BYTES && LDS_BYTES <= 160 * 1024, "LDS map");

__device__ __forceinline__ unsigned f2bf(float f) { unsigned u = __builtin_bit_cast(unsigned, f); return (u + 0x7fffu + ((u >> 16) & 1u)) >> 16; }
__device__ __forceinline__ unsigned pk2(float lo, float hi) { return f2bf(lo) | (f2bf(hi) << 16); }
__device__ __forceinline__ float bflo(unsigned u) { return __uint_as_float(u << 16); }
__device__ __forceinline__ float bfhi(unsigned u) { return __uint_as_float(u & 0xffff0000u); }
__device__ __forceinline__ float bf1(bf16 b) { return __uint_as_float(((unsigned)b) << 16); }
__device__ __forceinline__ float wave_sum(float v) {
#pragma unroll
    for (int o = 1; o < 64; o <<= 1) v += __shfl_xor(v, o);
    return v;
}
__device__ __forceinline__ float sigm(float x) { return __builtin_amdgcn_rcpf(1.f + __expf(-x)); }
__device__ __forceinline__ float tanh_(float z) { return 1.f - 2.f * __builtin_amdgcn_rcpf(1.f + __expf(2.f * z)); }
__device__ __forceinline__ float gelu_tanh(float x) { return 0.5f * x * (1.f + tanh_(0.7978845608028654f * (x + 0.044715f * x * x * x))); }
__device__ __forceinline__ float softplus_(float x) { return fmaxf(x, 0.f) + log1pf(__expf(-fabsf(x))); }
#define LDS_WAIT() asm volatile("s_waitcnt lgkmcnt(0)" ::: "memory")

struct Args { const float* in[32]; float* out; unsigned char* ws; };
typedef const __attribute__((address_space(4))) Args* CA;

struct EpiSwiGLU {
    static constexpr bool PERM = true, AFTER_DRAIN = false; bf16* O; int ldc;
    __device__ __forceinline__ void operator()(const pg8::f32x4 (&acc)[2][2][4][2], const pg8::Unit& u, int wr, int wc, int fr, int fq) const {
        const int row0 = u.pm * 256 + wr * 64 + fr, col0 = u.pn * 128 + wc * 32 + 8 * fq;
#pragma unroll
        for (int ai = 0; ai < 2; ++ai)
#pragma unroll
            for (int m = 0; m < 4; ++m) {
                bf16* rowp = O + (size_t)(row0 + ai * 128 + m * 16) * ldc + col0; float o[8];
#pragma unroll
                for (int n = 0; n < 2; ++n)
#pragma unroll
                    for (int i = 0; i < 4; ++i) { const float uu = acc[ai][0][m][n][i], gg = acc[ai][1][m][n][i]; o[n * 4 + i] = uu * sigm(uu) * gg; }
                v4u w; w.x = pk2(o[0], o[1]); w.y = pk2(o[2], o[3]); w.z = pk2(o[4], o[5]); w.w = pk2(o[6], o[7]); *(v4u*)rowp = w; }
    }
};
struct EpiGateF32 {
    static constexpr bool PERM = false, AFTER_DRAIN = false; float* Y; const float* gate; float mul;
    __device__ __forceinline__ void operator()(const pg8::f32x4 (&acc)[2][2][4][2], const pg8::Unit& u, int wr, int wc, int fr, int fq) const {
        const int row0 = u.pm * 256 + wr * 64 + fr, col0 = u.pn * 256 + wc * 32 + 4 * fq;
#pragma unroll
        for (int bj = 0; bj < 2; ++bj)
#pragma unroll
            for (int n = 0; n < 2; ++n) { const int c = col0 + bj * 128 + n * 16; const f32x4 gv = *(const f32x4*)(gate + c) * mul;
#pragma unroll
                for (int ai = 0; ai < 2; ++ai)
#pragma unroll
                    for (int m = 0; m < 4; ++m) *(f32x4*)(Y + (size_t)(row0 + ai * 128 + m * 16) * D + c) = acc[ai][bj][m][n] * gv; }
    }
};
struct EpiIn {
    static constexpr bool PERM = true, AFTER_DRAIN = false; bf16* Z;
    __device__ __forceinline__ void operator()(const pg8::f32x4 (&acc)[2][2][4][2], const pg8::Unit& u, int wr, int wc, int fr, int fq) const {
        const int row0 = u.pm * 256 + wr * 64 + fr, col0 = u.pn * 256 + wc * 32 + 8 * fq;
        const int mode = (u.pn < 2) ? 1 : ((u.pn >= 21 && u.pn < 33) ? 2 : 0);
#pragma unroll
        for (int ai = 0; ai < 2; ++ai)
#pragma unroll
            for (int m = 0; m < 4; ++m) { bf16* rowp = Z + (size_t)(row0 + ai * 128 + m * 16) * ZP + col0;
#pragma unroll
                for (int bj = 0; bj < 2; ++bj) { float o[8];
#pragma unroll
                    for (int n = 0; n < 2; ++n)
#pragma unroll
                        for (int i = 0; i < 4; ++i) { float v = acc[ai][bj][m][n][i]; if (mode == 1) v *= attn_body::C2; else if (mode == 2) v = sigm(v); o[n * 4 + i] = v; }
                    v4u w; w.x = pk2(o[0], o[1]); w.y = pk2(o[2], o[3]); w.z = pk2(o[4], o[5]); w.w = pk2(o[6], o[7]); *(v4u*)(rowp + bj * 128) = w; } }
    }
};
struct EpiPlain {
    static constexpr bool PERM = true, AFTER_DRAIN = false; bf16* O; int ldc;
    __device__ __forceinline__ void operator()(const pg8::f32x4 (&acc)[2][2][4][2], const pg8::Unit& u, int wr, int wc, int fr, int fq) const {
        const int row0 = u.pm * 256 + wr * 64 + fr, col0 = u.pn * 256 + wc * 32 + 8 * fq;
#pragma unroll
        for (int ai = 0; ai < 2; ++ai)
#pragma unroll
            for (int m = 0; m < 4; ++m) { bf16* rowp = O + (size_t)(row0 + ai * 128 + m * 16) * ldc + col0;
#pragma unroll
                for (int bj = 0; bj < 2; ++bj) { const pg8::f32x4 v0 = acc[ai][bj][m][0], v1 = acc[ai][bj][m][1];
                    v4u w; w.x = pk2(v0[0], v0[1]); w.y = pk2(v0[2], v0[3]); w.z = pk2(v1[0], v1[1]); w.w = pk2(v1[2], v1[3]); *(v4u*)(rowp + bj * 128) = w; } }
    }
};
template <int PASS> struct EpiProj {
    static constexpr bool PERM = false, AFTER_DRAIN = false; float* Y; const bf16* Z; bf16* MIX;
    __device__ __forceinline__ void operator()(const pg8::f32x4 (&acc)[2][2][4][2], const pg8::Unit& u, int wr, int wc, int fr, int fq) const {
        const int row0 = u.pm * 256 + wr * 64 + fr, col0 = u.pn * 256 + wc * 32 + 4 * fq;
#pragma unroll
        for (int ai = 0; ai < 2; ++ai)
#pragma unroll
            for (int m = 0; m < 4; ++m) { const size_t row = (size_t)(row0 + ai * 128 + m * 16);
#pragma unroll
                for (int bj = 0; bj < 2; ++bj)
#pragma unroll
                    for (int n = 0; n < 2; ++n) { const int c = col0 + bj * 128 + n * 16;
                        const v2u gw = *(const v2u*)(Z + row * ZP + ZGT + PASS * 1024 + c);
                        f32x4 gv; gv.x = bflo(gw.x); gv.y = bfhi(gw.x); gv.z = bflo(gw.y); gv.w = bfhi(gw.y);
                        f32x4 v = acc[ai][bj][m][n] * gv; float* yp = Y + row * D + c;
                        if (PASS > 0) v += *(const f32x4*)yp;
                        if (PASS < 2) *(f32x4*)yp = v; else { v2u w; w.x = pk2(v.x, v.y); w.y = pk2(v.z, v.w); *(v2u*)(MIX + row * D + c) = w; } } }
    }
};

__device__ __forceinline__ void cvt_item(const float* W, int ldw, int sk0, int sn0, int nvalid, bf16* WT, int ldo, int orow0, int dk0, LAS float* scr, int lane) {
    const int n_ = lane & 31;
#pragma unroll 8
    for (int i = 0; i < 32; ++i) { const int kk = 2 * i + (lane >> 5); scr[kk * 33 + n_] = (n_ < nvalid) ? W[(size_t)(sk0 + kk) * ldw + sn0 + n_] : 0.f; }
    LDS_WAIT(); asm volatile("" ::: "memory");
    const int c = lane & 7;
#pragma unroll
    for (int j = 0; j < 4; ++j) { const int n = (lane >> 3) + 8 * j; const LAS float* s = scr + (8 * c) * 33 + n;
        v4u o; o.x = pk2(s[0 * 33], s[1 * 33]); o.y = pk2(s[2 * 33], s[3 * 33]); o.z = pk2(s[4 * 33], s[5 * 33]); o.w = pk2(s[6 * 33], s[7 * 33]);
        *(v4u*)(WT + (size_t)(orow0 + n) * ldo + dk0 + 8 * c) = o; }
    LDS_WAIT(); asm volatile("" ::: "memory");
}
__device__ __forceinline__ void convert_layer(CA a, int l, LAS unsigned char* lds, int gw, int NGW, int wave, int lane) {
    LAS float* scr = (LAS float*)(lds + wave * 16384);
    unsigned char* ws = a->ws;
    constexpr int I_UP = 16 * 176, I_DN = 44 * 32, I_IN = 16 * 272, I_PA = 8 * 32, I_PB = 16 * 32, I_LO = 4 * 48;
    constexpr int NITEMS = 2 * I_UP + 2 * I_DN + I_IN + 2 * I_PA + 2 * I_PB + I_LO;
    for (int it = gw; it < NITEMS; it += NGW) {
        int r = it;
        if (r < 2 * I_UP) { const int s = r / I_UP; r -= s * I_UP; const int kb = r / 176, ob = r % 176, orow0 = 32 * ob, pn = orow0 >> 8, wi = orow0 & 255;
            const int sn0 = (wi < 128) ? (128 * pn + wi) : (DFF + 128 * pn + wi - 128);
            cvt_item(a->in[6] + (size_t)(l * 2 + s) * D * 2 * DFF, 2 * DFF, 64 * kb, sn0, 32, (bf16*)(ws + (s ? W_UP1 : W_UP0)), D, orow0, 64 * kb, scr, lane); continue; }
        r -= 2 * I_UP;
        if (r < 2 * I_DN) { const int s = r / I_DN; r -= s * I_DN; const int kb = r / 32, ob = r % 32;
            cvt_item(a->in[7] + (size_t)(l * 2 + s) * DFF * D, D, 64 * kb, 32 * ob, 32, (bf16*)(ws + (s ? W_DN1 : W_DN0)), DFF, 32 * ob, 64 * kb, scr, lane); continue; }
        r -= 2 * I_DN;
        if (r < I_IN) { const int kb = r / 272, ob = r % 272, orow0 = 32 * ob; int sn0, nv;
            if (orow0 < 1536) { sn0 = orow0; nv = 32; } else if (orow0 < ZFL) { sn0 = orow0 + 8; nv = 32; } else if (orow0 == ZFL) { sn0 = 1536; nv = 8; } else { sn0 = 0; nv = 0; }
            cvt_item(a->in[8] + (size_t)l * D * 8456, 8456, 64 * kb, sn0, nv, (bf16*)(ws + W_IN), D, orow0, 64 * kb, scr, lane); continue; }
        r -= I_IN;
        if (r < I_PA) { const int kb = r / 32, ob = r % 32; cvt_item(a->in[28] + (size_t)l * 512 * D, D, 64 * kb, 32 * ob, 32, (bf16*)(ws + W_PA), 512, 32 * ob, 64 * kb, scr, lane); continue; }
        r -= I_PA;
        if (r < I_PB) { const int kb = r / 32, ob = r % 32; cvt_item(a->in[29] + (size_t)l * D * D, D, 64 * kb, 32 * ob, 32, (bf16*)(ws + W_PB), D, 32 * ob, 64 * kb, scr, lane); continue; }
        r -= I_PB;
        if (r < I_PA) { const int kb = r / 32, ob = r % 32; cvt_item(a->in[30] + (size_t)l * 512 * D, D, 64 * kb, 32 * ob, 32, (bf16*)(ws + W_PC), 512, 32 * ob, 64 * kb, scr, lane); continue; }
        r -= I_PA;
        if (r < I_PB) { const int kb = r / 32, ob = r % 32; cvt_item(a->in[31] + (size_t)l * D * D, D, 64 * kb, 32 * ob, 32, (bf16*)(ws + W_OUT), D, 32 * ob, 64 * kb, scr, lane); continue; }
        r -= I_PB;
        {
            const int kb = r / 48, ob = r % 48, reg = ob / 16, nb = ob % 16; const float* W = a->in[19]; int sk0 = 0, nv = 0;
            if (reg == 0 && kb == 0) { W = a->in[19] + (size_t)l * 64 * 512; nv = 32; }
            else if (reg == 1 && kb == 1) { W = a->in[21] + (size_t)l * 64 * 512; nv = 32; }
            else if (reg == 2 && kb >= 2) { W = a->in[22] + (size_t)l * 128 * 512; sk0 = 64 * (kb - 2); nv = 32; }
            cvt_item(W, 512, sk0, 32 * nb, nv, (bf16*)(ws + W_LORA), 256, 32 * ob, 64 * kb, scr, lane); }
    }
}

__device__ __forceinline__ void row_stats(const f32x4 (&v)[4], float& mean, float& rstd) {
    float s = 0.f;
#pragma unroll
    for (int j = 0; j < 4; ++j) s += (v[j].x + v[j].y) + (v[j].z + v[j].w);
    mean = wave_sum(s) * (1.f / D); float s2 = 0.f;
#pragma unroll
    for (int j = 0; j < 4; ++j) { const f32x4 d = v[j] - mean; s2 += (d.x * d.x + d.y * d.y) + (d.z * d.z + d.w * d.w); }
    rstd = 1.f / sqrtf(wave_sum(s2) * (1.f / D) + LN_EPS);
}
__device__ __forceinline__ void store_mod(const f32x4 (&v)[4], float mean, float rstd, const float* sh, const float* sc, bf16* hrow, int lane) {
#pragma unroll
    for (int j = 0; j < 4; ++j) { const int c = 4 * lane + 256 * j; const f32x4 s1 = *(const f32x4*)(sc + c) + 1.f, s0 = *(const f32x4*)(sh + c);
        const f32x4 h = (v[j] - mean) * rstd * s1 + s0; v2u w; w.x = pk2(h.x, h.y); w.y = pk2(h.z, h.w); *(v2u*)(hrow + c) = w; }
}
__device__ __forceinline__ void ln_phase(const float* xsrc, const float* Y, float* xout, bf16* H, const float* lng, const float* lnb, const float* sh, const float* sc, bool do_mod, int gw, int NGW, int lane) {
    for (int m = gw; m < M; m += NGW) {
        f32x4 v[4];
#pragma unroll
        for (int j = 0; j < 4; ++j) { const size_t o = (size_t)m * D + 4 * lane + 256 * j; v[j] = *(const f32x4*)(xsrc + o) * ALPHA + *(const f32x4*)(Y + o); }
        float mean, rstd; row_stats(v, mean, rstd);
#pragma unroll
        for (int j = 0; j < 4; ++j) { const int c = 4 * lane + 256 * j; v[j] = (v[j] - mean) * rstd * *(const f32x4*)(lng + c) + *(const f32x4*)(lnb + c); *(f32x4*)(xout + (size_t)m * D + c) = v[j]; }
        if (do_mod) { row_stats(v, mean, rstd); store_mod(v, mean, rstd, sh, sc, H + (size_t)m * D, lane); }
    }
}
__device__ __forceinline__ void mod_phase(const float* x, bf16* H, const float* sh, const float* sc, int gw, int NGW, int lane) {
    for (int m = gw; m < M; m += NGW) {
        f32x4 v[4];
#pragma unroll
        for (int j = 0; j < 4; ++j) v[j] = *(const f32x4*)(x + (size_t)m * D + 4 * lane + 256 * j);
        float mean, rstd; row_stats(v, mean, rstd); store_mod(v, mean, rstd, sh, sc, H + (size_t)m * D, lane);
    }
}
__device__ __forceinline__ void ada_phase(CA a, LAS unsigned char* lds, int tid, int lane, int wave) {
    LAS float* cact = (LAS float*)lds; LAS float* part = cact + 1024;
    for (int i = tid; i < D; i += NTHR) { const float c = a->in[1][i]; cact[i] = c * sigm(c); }
    __syncthreads();
    float* ADA = (float*)(a->ws + WS_ADA);
    for (int task = blockIdx.x; task < NL * 144; task += gridDim.x) {
        const int l = task / 144, col = (task % 144) * 64 + lane; const float* W = a->in[2] + (size_t)l * D * 9216 + col; float s = 0.f;
#pragma unroll 16
        for (int k = wave * 128; k < wave * 128 + 128; ++k) s += cact[k] * W[(size_t)k * 9216];
        part[wave * 64 + lane] = s; __syncthreads();
        if (wave == 0) { float t = 0.f;
#pragma unroll
            for (int w = 0; w < 8; ++w) t += part[w * 64 + lane];
            ADA[l * 9216 + col] = t + a->in[3][l * 9216 + col]; }
        __syncthreads();
    }
}

__device__ __forceinline__ void fscan_head(const bf16* Z, const float* fbias, float* FL2, int h, LAS unsigned char* lds, int tid, int lane, int wave) {
    LAS float* wt = (LAS float*)lds; const float fb = fbias[h]; float lf[32]; float run = 0.f;
#pragma unroll
    for (int i = 0; i < 32; ++i) { const float x = bf1(Z[(size_t)(tid * 32 + i) * ZP + ZFL + h]) + fb; run += -softplus_(-x); lf[i] = run; }
    float inc = run;
#pragma unroll
    for (int o = 1; o < 64; o <<= 1) { const float t = __shfl_up(inc, o); if (lane >= o) inc += t; }
    if (lane == 63) wt[wave] = inc;
    __syncthreads();
    float base = inc - run;
    for (int w = 0; w < wave; ++w) base += wt[w];
#pragma unroll
    for (int i = 0; i < 32; ++i) FL2[(size_t)h * M + tid * 32 + i] = (base + lf[i]) * LOG2E;
    __syncthreads();
}
__device__ __forceinline__ void codes_phase(const bf16* Z, const float* mu, bf16* CODES, int gtid, int NGT) {
    for (int it = gtid; it < M * 32; it += NGT) { const int t = it >> 5, j0 = (it & 31) * 8;
        const v4u z = *(const v4u*)(Z + (size_t)t * ZP + ZRW + 1536 + j0); v4u zp = (v4u){0u, 0u, 0u, 0u};
        if (t > 0) zp = *(const v4u*)(Z + (size_t)(t - 1) * ZP + ZRW + 1536 + j0);
        float o[8];
#pragma unroll
        for (int q = 0; q < 4; ++q) { const float a0 = bflo(z[q]), a1 = bfhi(z[q]), p0 = bflo(zp[q]), p1 = bfhi(zp[q]); const float m0 = mu[1536 + j0 + 2 * q], m1 = mu[1536 + j0 + 2 * q + 1];
            o[2 * q] = a0 + (p0 - a0) * m0; o[2 * q + 1] = a1 + (p1 - a1) * m1; }
#pragma unroll
        for (int q = 0; q < 8; ++q) { if (j0 < 64) o[q] = tanh_(o[q]); else if (j0 >= 128) o[q] = sigm(o[q]); }
        v4u w; w.x = pk2(o[0], o[1]); w.y = pk2(o[2], o[3]); w.z = pk2(o[4], o[5]); w.w = pk2(o[6], o[7]); *(v4u*)(CODES + (size_t)t * 256 + j0) = w; }
}
__device__ __forceinline__ void lru_l1(CA a, int l, const bf16* Z, bf16* HLOC, bf16* ACUM, float* AEND, float* HEND, LAS unsigned char* lds, int tid, int lane, int wave) {
    LAS float* xcf = (LAS float*)lds; LAS bf16* xcb = (LAS bf16*)(lds + 16640); LAS bf16* wga = (LAS bf16*)(lds + 25856); LAS bf16* wgx = (LAS bf16*)(lds + 35072);
    LAS float* la = (LAS float*)(lds + 44288); LAS float* lu = (LAS float*)(lds + 60928); LAS float* agg = (LAS float*)(lds + 77568);
    const float* cw = a->in[10] + (size_t)l * 4 * D; const float* cb = a->in[11] + (size_t)l * D;
    const float* gaw = a->in[12] + (size_t)l * 16 * 4096; const float* gab = a->in[13] + (size_t)l * D;
    const float* gxw = a->in[14] + (size_t)l * 16 * 4096; const float* gxb = a->in[15] + (size_t)l * D; const float* lam = a->in[16] + (size_t)l * D;
    int nprev = -1;
    for (int task = blockIdx.x; task < NCH * 16; task += gridDim.x) {
        const int c = task >> 4, n = task & 15, t0 = c * LC;
        {
            const int tok = tid >> 3, cg8 = (tid & 7) * 8, ch0 = n * 64 + cg8; float acc[8];
#pragma unroll
            for (int q = 0; q < 8; ++q) acc[q] = cb[ch0 + q];
#pragma unroll
            for (int j = 0; j < 4; ++j) { const int tt = t0 + tok - 3 + j;
                if (tt >= 0) { const v4u x = *(const v4u*)(Z + (size_t)tt * ZP + ZXB + ch0);
#pragma unroll
                    for (int q = 0; q < 4; ++q) { acc[2 * q] += cw[j * D + ch0 + 2 * q] * bflo(x[q]); acc[2 * q + 1] += cw[j * D + ch0 + 2 * q + 1] * bfhi(x[q]); } } }
#pragma unroll
            for (int q = 0; q < 8; ++q) xcf[tok * 65 + cg8 + q] = acc[q];
            v4u w; w.x = pk2(acc[0], acc[1]); w.y = pk2(acc[2], acc[3]); w.z = pk2(acc[4], acc[5]); w.w = pk2(acc[6], acc[7]); *(LAS v4u*)(xcb + tok * 72 + cg8) = w;
        }
        if (n != nprev) {
            const int i = tid >> 3, j0 = (tid & 7) * 8;
#pragma unroll
            for (int q = 0; q < 8; ++q) { wga[(j0 + q) * 72 + i] = (bf16)f2bf(gaw[(size_t)n * 4096 + i * 64 + j0 + q]); wgx[(j0 + q) * 72 + i] = (bf16)f2bf(gxw[(size_t)n * 4096 + i * 64 + j0 + q]); }
            nprev = n;
        }
        __syncthreads();
        {
            const int tb = wave & 3, cbp = wave >> 2, fr = lane & 15, fq = lane >> 4;
            bf16x8 af[2];
#pragma unroll
            for (int kk = 0; kk < 2; ++kk) af[kk] = *(const LAS bf16x8*)(xcb + (tb * 16 + fr) * 72 + kk * 32 + fq * 8);
#pragma unroll
            for (int c2 = 0; c2 < 2; ++c2) { const int cbk = 2 * cbp + c2; f32x4 ar = (f32x4){0.f, 0.f, 0.f, 0.f}, ai = ar;
#pragma unroll
                for (int kk = 0; kk < 2; ++kk) { const bf16x8 b0 = *(const LAS bf16x8*)(wga + (cbk * 16 + fr) * 72 + kk * 32 + fq * 8), b1 = *(const LAS bf16x8*)(wgx + (cbk * 16 + fr) * 72 + kk * 32 + fq * 8);
                    ar = __builtin_amdgcn_mfma_f32_16x16x32_bf16(af[kk], b0, ar, 0, 0, 0); ai = __builtin_amdgcn_mfma_f32_16x16x32_bf16(af[kk], b1, ai, 0, 0, 0); }
                const int ch = cbk * 16 + fr, gch = n * 64 + ch; const float bga = gab[gch], bgx = gxb[gch], sp = log1pf(__expf(-lam[gch]));
#pragma unroll
                for (int rg = 0; rg < 4; ++rg) { const int tok = tb * 16 + fq * 4 + rg; const float r = sigm(ar[rg] + bga), ig = sigm(ai[rg] + bgx);
                    const float log_a = -8.f * r * sp, av = __expf(log_a), uv = sqrtf(-expm1f(2.f * log_a)) * (ig * xcf[tok * 65 + ch]);
                    la[tok * 65 + ch] = av; lu[tok * 65 + ch] = uv; } }
        }
        __syncthreads();
        {
            float hl[8], al[8]; float A = 1.f, h = 0.f;
#pragma unroll
            for (int s = 0; s < 8; ++s) { const float av = la[(wave * 8 + s) * 65 + lane], uv = lu[(wave * 8 + s) * 65 + lane]; h = av * h + uv; A *= av; hl[s] = h; al[s] = A; }
            agg[(wave * 2 + 0) * 64 + lane] = A; agg[(wave * 2 + 1) * 64 + lane] = h;
            __syncthreads();
            float cA = 1.f, cH = 0.f;
            for (int w = 0; w < wave; ++w) { const float A2 = agg[(w * 2 + 0) * 64 + lane], h2 = agg[(w * 2 + 1) * 64 + lane]; cH = A2 * cH + h2; cA *= A2; }
            float hf = 0.f, Af = 1.f;
#pragma unroll
            for (int s = 0; s < 8; ++s) { hf = hl[s] + al[s] * cH; Af = al[s] * cA; const size_t o = (size_t)(t0 + wave * 8 + s) * D + n * 64 + lane; HLOC[o] = (bf16)f2bf(hf); ACUM[o] = (bf16)f2bf(Af); }
            if (wave == 7) { AEND[c * D + n * 64 + lane] = Af; HEND[c * D + n * 64 + lane] = hf; }
        }
        __syncthreads();
    }
}
__device__ __forceinline__ void lru_l2(const float* AEND, const float* HEND, float* CAR, int gw, int lane) {
    if (gw < 16) { const int ch = gw * 64 + lane; float carry = 0.f;
#pragma unroll 8
        for (int c = 0; c < NCH; ++c) { CAR[c * D + ch] = carry; carry = AEND[c * D + ch] * carry + HEND[c * D + ch]; } }
}
__device__ __forceinline__ void lru_l3(bf16* Z, const bf16* HLOC, const bf16* ACUM, const float* CAR, int gtid, int NGT) {
    for (int it = gtid; it < M * 128; it += NGT) { const int t = it >> 7, ch0 = (it & 127) * 8; const size_t o = (size_t)t * D + ch0;
        const v4u hl = *(const v4u*)(HLOC + o), ac = *(const v4u*)(ACUM + o), yb = *(const v4u*)(Z + (size_t)t * ZP + ZYB + ch0);
        const f32x4 c0 = *(const f32x4*)(CAR + (t >> 6) * D + ch0), c1 = *(const f32x4*)(CAR + (t >> 6) * D + ch0 + 4); float o8[8];
#pragma unroll
        for (int q = 0; q < 4; ++q) { const float ca = (q < 2) ? c0[2 * q] : c1[2 * q - 4], cb_ = (q < 2) ? c0[2 * q + 1] : c1[2 * q - 3];
            o8[2 * q] = (bflo(hl[q]) + bflo(ac[q]) * ca) * gelu_tanh(bflo(yb[q])); o8[2 * q + 1] = (bfhi(hl[q]) + bfhi(ac[q]) * cb_) * gelu_tanh(bfhi(yb[q])); }
        v4u w; w.x = pk2(o8[0], o8[1]); w.y = pk2(o8[2], o8[3]); w.z = pk2(o8[4], o8[5]); w.w = pk2(o8[6], o8[7]); *(v4u*)(Z + (size_t)t * ZP + ZYB + ch0) = w; }
}
__device__ __forceinline__ void rw_prep(CA a, int l, const bf16* Z, const bf16* LORA, float* Wd, bf16* R, bf16* KF, bf16* V, bf16* KK, bf16* Bv, bf16* GB, float* BON, int gw, int NGW, int lane) {
    const float* mu = a->in[17] + (size_t)l * 1792; const float* w0 = a->in[18] + (size_t)l * 512; const float* a0 = a->in[20] + (size_t)l * 512;
    const float* k_k = a->in[23] + (size_t)l * 512; const float* k_a = a->in[24] + (size_t)l * 512; const float* r_k = a->in[25] + (size_t)l * 512;
    for (int it = gw; it < M * 8; it += NGW) { const int t = it >> 3, h = it & 7, col = h * 64 + lane; const bf16* zr = Z + (size_t)t * ZP + ZRW + col;
        float r = bf1(zr[0]), k = bf1(zr[512]), v = bf1(zr[1024]); float rp = 0.f, kp = 0.f, vp = 0.f;
        if (t > 0) { rp = bf1(zr[-ZP]); kp = bf1(zr[512 - ZP]); vp = bf1(zr[1024 - ZP]); }
        r += (rp - r) * mu[col]; k += (kp - k) * mu[512 + col]; v += (vp - v) * mu[1024 + col];
        const bf16* lo = LORA + (size_t)t * 1536 + col; const float lw = bf1(lo[0]), lav = bf1(lo[512]);
        const float wv = -softplus_(-(w0[col] + lw)) - 0.5f, decay = __expf(-__expf(wv)); const float av = sigm(a0[col] + lav);
        float kk = k * k_k[col]; const float nrm = sqrtf(wave_sum(kk * kk)); kk = kk / fmaxf(nrm, 1e-12f);
        const float kf = k * (1.f + (av - 1.f) * k_a[col]); const float bon = wave_sum(r * kf * r_k[col]);
        const size_t o = (size_t)t * 512 + col;
        Wd[o] = decay; R[o] = (bf16)f2bf(r); KF[o] = (bf16)f2bf(kf); V[o] = (bf16)f2bf(v); KK[o] = (bf16)f2bf(kk); Bv[o] = (bf16)f2bf(kk * av); GB[o] = lo[1024];
        if (lane == 0) BON[t * 8 + h] = bon; }
}
template <bool WITH_V> __device__ __forceinline__ void rw_step(float (&st)[64], cu32p pk, cu32p pb, cu32p pf, cf32p pw, float vv) {
    float s0 = 0.f, s1 = 0.f, s2 = 0.f, s3 = 0.f;
#pragma unroll
    for (int k2 = 0; k2 < 32; k2 += 2) { const unsigned u0 = pk[k2], u1 = pk[k2 + 1]; s0 += st[2 * k2] * bflo(u0); s1 += st[2 * k2 + 1] * bfhi(u0); s2 += st[2 * k2 + 2] * bflo(u1); s3 += st[2 * k2 + 3] * bfhi(u1); }
    const float sa = -((s0 + s1) + (s2 + s3));
#pragma unroll
    for (int k2 = 0; k2 < 32; ++k2) { const unsigned ub = pb[k2]; float t0 = sa * bflo(ub), t1 = sa * bfhi(ub);
        if (WITH_V) { const unsigned uf = pf[k2]; t0 += vv * bflo(uf); t1 += vv * bfhi(uf); }
        st[2 * k2] = st[2 * k2] * pw[2 * k2] + t0; st[2 * k2 + 1] = st[2 * k2 + 1] * pw[2 * k2 + 1] + t1; }
}
__device__ __forceinline__ void rw_touch(const unsigned char* ws, const RwSet rs, int h, int c, bool with_r, int lane) {
    const size_t o = ((size_t)(c * LC + lane) * 512 + h * 64); unsigned acc = 0u;
    const unsigned char* p16[4] = {ws + rs.kk + o * 2, ws + rs.b + o * 2, ws + rs.kf + o * 2, ws + rs.r + o * 2};
#pragma unroll
    for (int q = 0; q < 4; ++q) if (q < 3 || with_r) { acc ^= *(const unsigned*)(p16[q]); acc ^= *(const unsigned*)(p16[q] + 64); }
    const unsigned char* pw = ws + rs.w + o * 4;
#pragma unroll
    for (int q = 0; q < 4; ++q) acc ^= *(const unsigned*)(pw + 64 * q);
    asm volatile("" :: "v"(acc));
}
__device__ __forceinline__ void rw_step2(float (&sp)[64], float (&sg)[64], cu32p pk, cu32p pb, cu32p pf, cf32p pw, float vv) {
    float p0 = 0.f, p1 = 0.f, g0 = 0.f, g1 = 0.f;
#pragma unroll
    for (int k2 = 0; k2 < 32; ++k2) { const unsigned u0 = pk[k2]; const float lo = bflo(u0), hi = bfhi(u0); p0 += sp[2 * k2] * lo; p1 += sp[2 * k2 + 1] * hi; g0 += sg[2 * k2] * lo; g1 += sg[2 * k2 + 1] * hi; }
    const float sap = -(p0 + p1), sag = -(g0 + g1);
#pragma unroll
    for (int k2 = 0; k2 < 32; ++k2) { const unsigned ub = pb[k2], uf = pf[k2]; const float bl = bflo(ub), bh = bfhi(ub), w0 = pw[2 * k2], w1 = pw[2 * k2 + 1];
        sp[2 * k2] = sp[2 * k2] * w0 + sap * bl; sp[2 * k2 + 1] = sp[2 * k2 + 1] * w1 + sap * bh;
        sg[2 * k2] = sg[2 * k2] * w0 + (sag * bl + vv * bflo(uf)); sg[2 * k2 + 1] = sg[2 * k2 + 1] * w1 + (sag * bh + vv * bfhi(uf)); }
}
__device__ __forceinline__ void rw_r1(const unsigned char* ws, const RwSet rs, float* P, float* G, int gw, int NGW, int lane) {
    for (int T = gw; T < NCH * 8; T += NGW) { const int h = T & 7, c = T >> 3; float sp[64], sg[64];
        rw_touch(ws, rs, h, c, false, lane);
#pragma unroll
        for (int k = 0; k < 64; ++k) { sp[k] = (k == lane) ? 1.f : 0.f; sg[k] = 0.f; }
        const bf16* Vb = (const bf16*)(ws + WS_RW_V);
        for (int t = c * LC; t < c * LC + LC; ++t) { const size_t o = (size_t)t * 512 + h * 64;
            cu32p pk = (cu32p)(uintptr_t)(ws + rs.kk + o * 2), pb = (cu32p)(uintptr_t)(ws + rs.b + o * 2), pf = (cu32p)(uintptr_t)(ws + rs.kf + o * 2); cf32p pw = (cf32p)(uintptr_t)(ws + rs.w + o * 4);
            rw_step2(sp, sg, pk, pb, pf, pw, bf1(Vb[o + lane])); }
        float* dp = P + ((size_t)(h * NCH + c) * 64 + lane) * 64; float* dg = G + ((size_t)(h * NCH + c) * 64 + lane) * 64;
#pragma unroll
        for (int k = 0; k < 64; k += 4) { *(f32x4*)(dp + k) = (f32x4){sp[k], sp[k + 1], sp[k + 2], sp[k + 3]}; *(f32x4*)(dg + k) = (f32x4){sg[k], sg[k + 1], sg[k + 2], sg[k + 3]}; } }
}
__device__ __forceinline__ void rw_r2(const float* P, const float* G, float* S0, LAS unsigned char* lds, int lane, int wave) {
    LAS float* red = (LAS float*)lds;
    for (int rp = blockIdx.x; rp < 256; rp += gridDim.x) { const int h = rp >> 5, v0 = (rp & 31) * 2; float s0 = 0.f, s1 = 0.f;
        const float* Ph = P + (size_t)h * NCH * 4096 + (size_t)(8 * wave) * 64 + lane; const float* Gh = G + (size_t)h * NCH * 4096 + (size_t)v0 * 64 + lane; float* Sh = S0 + (size_t)h * NCH * 4096 + (size_t)v0 * 64 + lane;
        float pq[8][8], gq[8][2];
#pragma unroll
        for (int d = 0; d < 8; ++d) {
#pragma unroll
            for (int jj = 0; jj < 8; ++jj) pq[d][jj] = Ph[(size_t)d * 4096 + jj * 64];
            gq[d][0] = Gh[(size_t)d * 4096]; gq[d][1] = Gh[(size_t)d * 4096 + 64]; }
        for (int c0 = 0; c0 < NCH; c0 += 8) {
#pragma unroll
            for (int d = 0; d < 8; ++d) { const int c = c0 + d;
                if (wave == 0) { Sh[(size_t)c * 4096] = s0; Sh[(size_t)c * 4096 + 64] = s1; }
                float p0 = 0.f, p1 = 0.f;
#pragma unroll
                for (int jj = 0; jj < 8; ++jj) { const float a0 = __builtin_bit_cast(float, __builtin_amdgcn_readlane(__builtin_bit_cast(int, s0), 8 * wave + jj)), a1 = __builtin_bit_cast(float, __builtin_amdgcn_readlane(__builtin_bit_cast(int, s1), 8 * wave + jj));
                    p0 += a0 * pq[d][jj]; p1 += a1 * pq[d][jj]; }
                LAS float* rd = red + (c & 1) * 1024;
                rd[(wave * 2 + 0) * 64 + lane] = p0; rd[(wave * 2 + 1) * 64 + lane] = p1;
                const float g0 = gq[d][0], g1 = gq[d][1];
                if (c + 8 < NCH) {
#pragma unroll
                    for (int jj = 0; jj < 8; ++jj) pq[d][jj] = Ph[(size_t)(c + 8) * 4096 + jj * 64];
                    gq[d][0] = Gh[(size_t)(c + 8) * 4096]; gq[d][1] = Gh[(size_t)(c + 8) * 4096 + 64]; }
                __syncthreads();
                float n0 = g0, n1 = g1;
#pragma unroll
                for (int w = 0; w < 8; ++w) { n0 += rd[(w * 2 + 0) * 64 + lane]; n1 += rd[(w * 2 + 1) * 64 + lane]; }
                s0 = n0; s1 = n1; }
        }
        __syncthreads();
    }
}
__device__ __forceinline__ void rw_r3(CA a, int l, const unsigned char* ws, const RwSet rs, const float* S0, const float* BON, bf16* RWO, LAS unsigned char* lds, int gw, int NGW, int lane, int wave) {
    LAS float* yl = (LAS float*)(lds + wave * 16640);
    const float* gnw = a->in[26] + (size_t)l * 512; const float* gnb = a->in[27] + (size_t)l * 512;
    const bf16* Vb = (const bf16*)(ws + WS_RW_V); const bf16* GB = (const bf16*)(ws + WS_GB);
    for (int T = gw; T < NCH * 8; T += NGW) { const int h = T & 7, c = T >> 3; float st[64];
        rw_touch(ws, rs, h, c, true, lane);
        const float* src = S0 + ((size_t)(h * NCH + c) * 64 + lane) * 64;
#pragma unroll
        for (int k = 0; k < 64; k += 4) { const f32x4 v4 = *(const f32x4*)(src + k); st[k] = v4.x; st[k + 1] = v4.y; st[k + 2] = v4.z; st[k + 3] = v4.w; }
        for (int tt = 0; tt < LC; ++tt) { const size_t o = (size_t)(c * LC + tt) * 512 + h * 64;
            cu32p pk = (cu32p)(uintptr_t)(ws + rs.kk + o * 2), pb = (cu32p)(uintptr_t)(ws + rs.b + o * 2), pf = (cu32p)(uintptr_t)(ws + rs.kf + o * 2), pr = (cu32p)(uintptr_t)(ws + rs.r + o * 2); cf32p pw = (cf32p)(uintptr_t)(ws + rs.w + o * 4);
            rw_step<true>(st, pk, pb, pf, pw, bf1(Vb[o + lane]));
            float y0 = 0.f, y1 = 0.f, y2 = 0.f, y3 = 0.f;
#pragma unroll
            for (int k2 = 0; k2 < 32; k2 += 2) { const unsigned u0 = pr[k2], u1 = pr[k2 + 1]; y0 += st[2 * k2] * bflo(u0); y1 += st[2 * k2 + 1] * bfhi(u0); y2 += st[2 * k2 + 2] * bflo(u1); y3 += st[2 * k2 + 3] * bfhi(u1); }
            yl[tt * 65 + lane] = (y0 + y1) + (y2 + y3); }
        LDS_WAIT(); asm volatile("" ::: "memory");
        {
            const int t = c * LC + lane; float y[64]; float s = 0.f;
#pragma unroll
            for (int v = 0; v < 64; ++v) { y[v] = yl[lane * 65 + v]; s += y[v]; }
            const float mean = s * (1.f / 64.f); float q = 0.f;
#pragma unroll
            for (int v = 0; v < 64; ++v) { const float d = y[v] - mean; q += d * d; }
            const float rstd = 1.f / sqrtf(q * (1.f / 64.f) + GN_EPS); const float bon = BON[t * 8 + h];
            const size_t o = (size_t)t * 512 + h * 64;
#pragma unroll
            for (int v8 = 0; v8 < 64; v8 += 8) { const v4u vv = *(const v4u*)(Vb + o + v8), gg = *(const v4u*)(GB + o + v8); float ov[8];
#pragma unroll
                for (int q2 = 0; q2 < 4; ++q2) { const int v = v8 + 2 * q2;
                    ov[2 * q2] = ((y[v] - mean) * rstd * gnw[h * 64 + v] + gnb[h * 64 + v] + bon * bflo(vv[q2])) * bflo(gg[q2]);
                    ov[2 * q2 + 1] = ((y[v + 1] - mean) * rstd * gnw[h * 64 + v + 1] + gnb[h * 64 + v + 1] + bon * bfhi(vv[q2])) * bfhi(gg[q2]); }
                v4u w; w.x = pk2(ov[0], ov[1]); w.y = pk2(ov[2], ov[3]); w.z = pk2(ov[4], ov[5]); w.w = pk2(ov[6], ov[7]); *(v4u*)(RWO + o + v8) = w; }
        }
        LDS_WAIT(); asm volatile("" ::: "memory");
    }
}

__global__ void __launch_bounds__(NTHR, 2) fwd_mega(Args args_unused) {
    extern __shared__ __attribute__((aligned(16))) unsigned char lds_raw[];
    LAS unsigned char* lds = (LAS unsigned char*)lds_raw;
    cg::grid_group grid = cg::this_grid();
    const int wave = __builtin_amdgcn_readfirstlane((int)threadIdx.x >> 6);
    const int G = gridDim.x, gw = blockIdx.x * NWAVES + wave, NGW = G * NWAVES, NGT = G * NTHR;
#define SYNC() do { grid.sync(); } while (0)
#define PH_BEGIN { CA a = (CA)__builtin_amdgcn_kernarg_segment_ptr(); asm volatile("" : "+s"(a)); unsigned char* ws = a->ws; (void)ws; \
        int tid_l = threadIdx.x; asm volatile("" : "+v"(tid_l)); const int tid = tid_l, lane = tid & 63, gtid = blockIdx.x * NTHR + tid; (void)lane; (void)gtid;
#define PH_END }
#define WSP(T, off) ((T*)(ws + (off)))
#define ADA_L (WSP(float, WS_ADA) + l * 9216)
#define GEMM(EPI, Aptr, LDA, Bptr, N_, K_, ...) do { int kk_ = (K_); asm volatile("" : "+s"(kk_));   pg8::Gemm g_{(const pg8::bf16_t*)(Aptr), (const pg8::bf16_t*)(Bptr), M, (N_), kk_, (LDA)}; pg8::StaticOrder S_; S_.init(M, (N_), G, (int)blockIdx.x); \
        EPI E_{__VA_ARGS__}; pg8::gemm_phase<EPI, pg8::StaticOrder, PG8_ALIGN, PG8_SP2>(lds, g_, S_, E_); } while (0)

    PH_BEGIN ada_phase(a, lds, tid, lane, wave); PH_END
    SYNC();
    PH_BEGIN mod_phase(a->in[0], WSP(bf16, WS_HB), WSP(float, WS_ADA), WSP(float, WS_ADA) + D, gw, NGW, lane); convert_layer(a, 0, lds, gw, NGW, wave, lane); PH_END
    SYNC();

    for (int l = 0; l < NL; ++l) {
        PH_BEGIN GEMM(EpiSwiGLU, WSP(bf16, WS_HB), D, ws + W_UP0, 2 * DFF, D, WSP(bf16, WS_ACT), DFF); PH_END
        SYNC();
        PH_BEGIN GEMM(EpiGateF32, WSP(bf16, WS_ACT), DFF, ws + W_DN0, D, DFF, WSP(float, WS_Y), ADA_L + 2 * D, 0.5f); PH_END
        SYNC();
        PH_BEGIN ln_phase(l == 0 ? a->in[0] : a->out, WSP(float, WS_Y), a->out, WSP(bf16, WS_HB), a->in[4] + (size_t)l * 3 * D, a->in[5] + (size_t)l * 3 * D, ADA_L + 3 * D, ADA_L + 4 * D, true, gw, NGW, lane); PH_END
        SYNC();
        PH_BEGIN GEMM(EpiIn, WSP(bf16, WS_HB), D, ws + W_IN, ZP, D, WSP(bf16, WS_Z)); PH_END
        SYNC();
        PH_BEGIN if (blockIdx.x < 8) fscan_head(WSP(bf16, WS_Z), a->in[9] + l * 8, WSP(float, WS_FL2), blockIdx.x, lds, tid, lane, wave); PH_END
        PH_BEGIN codes_phase(WSP(bf16, WS_Z), a->in[17] + (size_t)l * 1792, WSP(bf16, WS_CODES), gtid, NGT); PH_END
        PH_BEGIN lru_l1(a, l, WSP(bf16, WS_Z), WSP(bf16, WS_HLOC), WSP(bf16, WS_ACUM), WSP(float, WS_LAEND), WSP(float, WS_LHEND), lds, tid, lane, wave); PH_END
        SYNC();
        PH_BEGIN GEMM(EpiPlain, ws + WS_CODES, 256, ws + W_LORA, 1536, 256, WSP(bf16, WS_LORA), 1536); PH_END
        PH_BEGIN lru_l2(WSP(const float, WS_LAEND), WSP(const float, WS_LHEND), WSP(float, WS_LCAR), gw, lane); PH_END
        SYNC();
        PH_BEGIN const RwSet rs = rw_set(l); rw_prep(a, l, WSP(bf16, WS_Z), WSP(const bf16, WS_LORA), WSP(float, rs.w), WSP(bf16, rs.r), WSP(bf16, rs.kf), WSP(bf16, WS_RW_V), WSP(bf16, rs.kk), WSP(bf16, rs.b), WSP(bf16, WS_GB), WSP(float, WS_BON), gw, NGW, lane); PH_END
        PH_BEGIN lru_l3(WSP(bf16, WS_Z), WSP(const bf16, WS_HLOC), WSP(const bf16, WS_ACUM), WSP(const float, WS_LCAR), gtid, NGT); PH_END
        SYNC();
        PH_BEGIN rw_r1(ws, rw_set(l), WSP(float, WS_P), WSP(float, WS_G), gw, NGW, lane); PH_END
        SYNC();
        PH_BEGIN rw_r2(WSP(const float, WS_P), WSP(const float, WS_G), WSP(float, WS_S0), lds, lane, wave); PH_END
        SYNC();
        PH_BEGIN rw_r3(a, l, ws, rw_set(l), WSP(const float, WS_S0), WSP(const float, WS_BON), WSP(bf16, WS_RWO), lds, gw, NGW, lane, wave); PH_END
        __syncthreads();
        PH_BEGIN
            bf16* Zb = WSP(bf16, WS_Z);
            const attn_body::AttnTensors AT{(const attn_body::bf16*)(Zb + ZQ), (const attn_body::bf16*)(Zb + ZK), (const attn_body::bf16*)(Zb + ZV), (attn_body::bf16*)(Zb + ZXB), WSP(const float, WS_FL2)};
            const attn_body::StaticOrder S((int)G, (int)blockIdx.x);
            attn_body::attn_phase<attn_body::StaticOrder>((char*)lds_raw, AT, S);
        PH_END
        SYNC();
        PH_BEGIN GEMM(EpiProj<0>, WSP(bf16, WS_Z) + ZXB, ZP, ws + W_PA, D, 512, WSP(float, WS_Y), WSP(bf16, WS_Z), WSP(bf16, WS_HB)); PH_END
        __builtin_amdgcn_fence(__ATOMIC_SEQ_CST, "agent");
        PH_BEGIN GEMM(EpiProj<1>, WSP(bf16, WS_Z) + ZYB, ZP, ws + W_PB, D, D, WSP(float, WS_Y), WSP(bf16, WS_Z), WSP(bf16, WS_HB)); PH_END
        __builtin_amdgcn_fence(__ATOMIC_SEQ_CST, "agent");
        PH_BEGIN GEMM(EpiProj<2>, ws + WS_RWO, 512, ws + W_PC, D, 512, WSP(float, WS_Y), WSP(bf16, WS_Z), WSP(bf16, WS_HB)); PH_END
        SYNC();
        PH_BEGIN GEMM(EpiGateF32, WSP(bf16, WS_HB), D, ws + W_OUT, D, D, WSP(float, WS_Y), ADA_L + 5 * D, 1.0f); PH_END
        SYNC();
        PH_BEGIN ln_phase(a->out, WSP(float, WS_Y), a->out, WSP(bf16, WS_HB), a->in[4] + (size_t)(l * 3 + 1) * D, a->in[5] + (size_t)(l * 3 + 1) * D, ADA_L + 6 * D, ADA_L + 7 * D, true, gw, NGW, lane); PH_END
        SYNC();
        PH_BEGIN GEMM(EpiSwiGLU, WSP(bf16, WS_HB), D, ws + W_UP1, 2 * DFF, D, WSP(bf16, WS_ACT), DFF); PH_END
        SYNC();
        PH_BEGIN GEMM(EpiGateF32, WSP(bf16, WS_ACT), DFF, ws + W_DN1, D, DFF, WSP(float, WS_Y), ADA_L + 8 * D, 0.5f); PH_END
        SYNC();
        PH_BEGIN ln_phase(a->out, WSP(float, WS_Y), a->out, WSP(bf16, WS_HB), a->in[4] + (size_t)(l * 3 + 2) * D, a->in[5] + (size_t)(l * 3 + 2) * D, ADA_L + 9216, ADA_L + 9216 + D, l + 1 < NL, gw, NGW, lane); PH_END
        if (l + 1 < NL) { PH_BEGIN convert_layer(a, l + 1, lds, gw, NGW, wave, lane); PH_END SYNC(); }
    }
#undef SYNC
#undef GEMM
}

extern "C" void kernel_launch(void* const* d_in, const int* in_sizes, int n_in, void* d_out, int out_size, void* d_ws, size_t ws_size, hipStream_t stream) {
    static int grid = 0;
    if (grid == 0) {
        if (n_in != 32 || out_size != M * D || ws_size < WS_END) { fprintf(stderr, "kernel_launch: unexpected shapes (n_in %d, out %d, ws %zu)\n", n_in, out_size, ws_size); grid = -1; return; }
        int dev = 0, cus = 0, per_cu = 0;
        hipGetDevice(&dev); hipDeviceGetAttribute(&cus, hipDeviceAttributeMultiprocessorCount, dev);
        hipFuncSetAttribute((const void*)fwd_mega, hipFuncAttributeMaxDynamicSharedMemorySize, LDS_BYTES);
        if (hipOccupancyMaxActiveBlocksPerMultiprocessor(&per_cu, (const void*)fwd_mega, NTHR, LDS_BYTES) != hipSuccess || per_cu < 1) { fprintf(stderr, "kernel_launch: occupancy query says %d blocks per CU\n", per_cu); per_cu = 1; }
        (void)hipGetLastError();
        grid = cus * per_cu;
        fprintf(stderr, "kernel_launch: grid %d (cus %d x %d), lds %d\n", grid, cus, per_cu, LDS_BYTES);
    }
    if (grid < 0) return;
    Args a{};
    for (int i = 0; i < 32; ++i) a.in[i] = (const float*)d_in[i];
    a.out = (float*)d_out; a.ws = (unsigned char*)d_ws;
    void* kargs[] = {&a};
    hipError_t e = hipLaunchCooperativeKernel((const void*)fwd_mega, dim3(grid), dim3(NTHR), kargs, LDS_BYTES, stream);
    if (e != hipSuccess) fprintf(stderr, "kernel_launch: cooperative launch failed: %s (grid %d)\n", hipGetErrorString(e), grid);
}
```

```cpp
#include <hip/hip_runtime.h>
#include <hip/hip_cooperative_groups.h>
#include <cstdio>
#include <cstdint>
namespace cg = cooperative_groups;
namespace pg8 {
#define PG8_LAS __attribute__((address_space(3)))
typedef unsigned short bf16_t;
typedef short bf16x8 __attribute__((ext_vector_type(8)));
typedef float f32x4 __attribute__((ext_vector_type(4)));
typedef unsigned u32x4 __attribute__((ext_vector_type(4)));
constexpr int BM = 256, BK = 64, HALF = 128, HTB = HALF * BK * 2  , STAGE_BYTES = 8 * HTB, NXCD = 8, WGM = 8;

__host__ __device__ __forceinline__ int lds_byte(int r, int c) { const int st = (r >> 4) * 2 + (c >> 5), rr = r & 15, cc = c & 31, ob = rr * 64 + cc * 2; return st * 1024 + (ob ^ (((ob >> 9) & 1) << 5)); }
__host__ __device__ __forceinline__ void stage_rc(int b, int& R, int& C) { const int st = b / 1024, sb = b % 1024, swz = sb ^ (((sb >> 9) & 1) << 5); R = (st >> 1) * 16 + swz / 64; C = (st & 1) * 32 + (swz % 64) / 2; }
__host__ __device__ __forceinline__ int perm32(int rho) { const int n = rho >> 4, i = rho & 15; return 8 * (i >> 2) + 4 * n + (i & 3); }

struct Unit { int pm, pn; };
struct Gemm { const bf16_t* A; const bf16_t* Bt; int M, N, K, lda; };

struct StaticOrder {
    int nM, nN, nwg, G, c;
    __host__ __device__ void init(int M, int N, int G_, int c_) { nM = M / BM; nN = N / BM; nwg = nM * nN; G = G_; c = c_; }
    __host__ __device__ bool next(int i, Unit& u) const {
        const long L = (long)i * G + c; if (L >= nwg) return false;
        int wgid = (int)L; { const int q = nwg / NXCD, r = nwg % NXCD, xcd = wgid % NXCD, off = wgid / NXCD; wgid = (xcd < r ? xcd * (q + 1) : r * (q + 1) + (xcd - r) * q) + off; }
        const int nig = WGM * nN, gid = wgid / nig, fm = gid * WGM, gsz = (nM - fm) < WGM ? (nM - fm) : WGM;
        u.pm = fm + ((wgid % nig) % gsz); u.pn = (wgid % nig) / gsz; return true;
    }
    __device__ __forceinline__ void a_ready(const Unit&) const {}
    __device__ __forceinline__ void done(const Unit&) const {}
};

__device__ __forceinline__ unsigned cvt_pk_bf16(float lo, float hi) { unsigned r; asm volatile("v_cvt_pk_bf16_f32 %0, %1, %2" : "=v"(r) : "v"(lo), "v"(hi)); return r; }
typedef float f32x2 __attribute__((ext_vector_type(2)));
__device__ __forceinline__ f32x2 gelu_pk(f32x2 v) {
    const f32x2 av = __builtin_elementwise_abs(v), d = av * 0.2316418882f + 1.0f;
    f32x2 t; t.x = __builtin_amdgcn_rcpf(d.x); t.y = __builtin_amdgcn_rcpf(d.y);
    f32x2 q = t * 0.5307027145f + (-0.7265760135f); q = q * t + 0.7107068705f; q = q * t + (-0.142248368f); q = q * t + 0.127414796f; q = q * t;
    const f32x2 s = (v * v) * (-0.72134752044f);
    f32x2 e; e.x = __builtin_amdgcn_exp2f(s.x); e.y = __builtin_amdgcn_exp2f(s.y);
    const f32x2 m = v * (q * e), r = v - m;
    f32x2 o; o.x = v.x < 0.f ? m.x : r.x; o.y = v.y < 0.f ? m.y : r.y; return o;
}

template <int ACT  > struct EpiBf16 {
    static constexpr bool PERM = true, AFTER_DRAIN = false; static_assert(ACT == 0 || ACT == 1, "EpiBf16: ACT is 0 (none) or 1 (gelu_pk)");
    bf16_t* O; int ldc; const float* bias; int split_cols; size_t split_stride; float scale0;
    __device__ __forceinline__ void operator()(const f32x4 (&acc)[2][2][4][2], const Unit& u, int wr, int wc, int fr, int fq) const {
        const int row0 = u.pm * BM + wr * 64 + fr; int colt = u.pn * BM; bf16_t* base = O;
        float sc = 1.f; if (split_cols) { const int t = colt / split_cols; base += (size_t)t * split_stride; colt -= t * split_cols; if (t == 0) sc = scale0; }
        const int col0 = colt + wc * 32 + 8 * fq, bcol0 = u.pn * BM + wc * 32 + 8 * fq;
        f32x4 bv[2][2];
#pragma unroll
        for (int bj = 0; bj < 2; ++bj)
#pragma unroll
            for (int n = 0; n < 2; ++n) bv[bj][n] = bias ? *(const f32x4*)(bias + bcol0 + bj * HALF + 4 * n) : (f32x4){0.f, 0.f, 0.f, 0.f};
#pragma unroll
        for (int ai = 0; ai < 2; ++ai)
#pragma unroll
            for (int m = 0; m < 4; ++m) { bf16_t* rowp = base + (size_t)(row0 + ai * HALF + m * 16) * ldc + col0;
#pragma unroll
                for (int bj = 0; bj < 2; ++bj) { f32x4 v0 = acc[ai][bj][m][0] + bv[bj][0], v1 = acc[ai][bj][m][1] + bv[bj][1];
                    if (ACT == 1) { f32x2 a = gelu_pk((f32x2){v0[0], v0[1]}), b = gelu_pk((f32x2){v0[2], v0[3]}), c = gelu_pk((f32x2){v1[0], v1[1]}), d = gelu_pk((f32x2){v1[2], v1[3]});
                        v0 = (f32x4){a.x, a.y, b.x, b.y}; v1 = (f32x4){c.x, c.y, d.x, d.y}; }
                    v0 = v0 * sc; v1 = v1 * sc; u32x4 w; w.x = cvt_pk_bf16(v0[0], v0[1]); w.y = cvt_pk_bf16(v0[2], v0[3]); w.z = cvt_pk_bf16(v1[0], v1[1]); w.w = cvt_pk_bf16(v1[2], v1[3]);
                    *(u32x4*)(rowp + bj * HALF) = w; } }
    }
};

struct PanelStats {
    unsigned* xbuf;
    unsigned* cnt;
    unsigned* tmo;
    int ntn; float eps;
    unsigned code;
    __device__ __forceinline__ bool run(const f32x4 (&v)[2][2][4][2], const Unit& u, int wr, int wc, int fr, int fq, PG8_LAS unsigned char* lds, int wid, int lane) const {
        typedef float f32x2v __attribute__((ext_vector_type(2)));
        PG8_LAS f32x2v* P = (PG8_LAS f32x2v*)lds;
        PG8_LAS f32x2v* S = (PG8_LAS f32x2v*)(lds + 8192);
        PG8_LAS unsigned* flag = (PG8_LAS unsigned*)(lds + 8192 + 2048);
#pragma unroll
        for (int ai = 0; ai < 2; ++ai)
#pragma unroll
            for (int m = 0; m < 4; ++m) {
                float s = 0.f;
#pragma unroll
                for (int bj = 0; bj < 2; ++bj)
#pragma unroll
                    for (int n = 0; n < 2; ++n) { const f32x4 x = v[ai][bj][m][n]; s += (x[0] + x[1]) + (x[2] + x[3]); }
                s += __shfl_xor(s, 16); s += __shfl_xor(s, 32);
                const float mw = s * (1.0f / 64.0f); float q = 0.f;
#pragma unroll
                for (int bj = 0; bj < 2; ++bj)
#pragma unroll
                    for (int n = 0; n < 2; ++n) { const f32x4 d = v[ai][bj][m][n] - mw; q += (d[0] * d[0] + d[1] * d[1]) + (d[2] * d[2] + d[3] * d[3]); }
                q += __shfl_xor(q, 16); q += __shfl_xor(q, 32);
                if (fq == 0) P[(ai * HALF + wr * 64 + m * 16 + fr) * 4 + wc] = (f32x2v){mw, q};
            }
        asm volatile("s_waitcnt lgkmcnt(0)" ::: "memory"); __builtin_amdgcn_s_barrier(); asm volatile("" ::: "memory");
#if defined(BROKEN_EXCHANGE_NO_WAIT)
#warning BROKEN CONTROL BUILD: the row-statistics exchange does not wait; results are wrong by design
        if (blockIdx.x >= 64) { const long long t0_ = clock64(); while (clock64() - t0_ < 60000) __builtin_amdgcn_s_sleep(8); }
#endif
        const int row = wid * 32 + (lane & 31);
        if (lane < 32) {
            const f32x2v a = P[row * 4 + 0], b = P[row * 4 + 1], c = P[row * 4 + 2], d = P[row * 4 + 3];
            const float mt = (a.x + b.x + c.x + d.x) * 0.25f;
            const float da = a.x - mt, db = b.x - mt, dc = c.x - mt, dd = d.x - mt;
            const float m2 = (a.y + b.y) + (c.y + d.y) + 64.0f * ((da * da + db * db) + (dc * dc + dd * dd));
            unsigned long long* slot = (unsigned long long*)xbuf + ((size_t)(u.pm * BM + row) * 4 + u.pn);
            __hip_atomic_store(slot, ((unsigned long long)__float_as_uint(m2) << 32) | __float_as_uint(mt), __ATOMIC_RELAXED, __HIP_MEMORY_SCOPE_AGENT);
        }
        asm volatile("s_waitcnt vmcnt(0)" ::: "memory");
        if (lane == 0) __hip_atomic_fetch_add(cnt + 64 * u.pm, 1u, __ATOMIC_RELAXED, __HIP_MEMORY_SCOPE_AGENT);
        if (wid == 0) {
            bool dead = false; const unsigned long long t0 = __builtin_amdgcn_s_memrealtime(); const unsigned want = 8u * (unsigned)ntn;
            for (;;) {
#if defined(BROKEN_EXCHANGE_NO_WAIT)
                break;
#endif
                if ((unsigned)__builtin_amdgcn_readfirstlane(__hip_atomic_load(cnt + 64 * u.pm, __ATOMIC_RELAXED, __HIP_MEMORY_SCOPE_AGENT)) >= want) break;
                if (__builtin_amdgcn_s_memrealtime() - t0 > 2000000ull) {
                    if (lane == 0) { unsigned expect = 0u; __hip_atomic_compare_exchange_strong(tmo + 1, &expect, code | (unsigned)(u.pm & 0xff), __ATOMIC_RELAXED, __ATOMIC_RELAXED, __HIP_MEMORY_SCOPE_AGENT);
                                     __hip_atomic_store(tmo, 1u, __ATOMIC_RELAXED, __HIP_MEMORY_SCOPE_AGENT); }
                    dead = true; break; }
                __builtin_amdgcn_s_sleep(2);
            }
            __builtin_amdgcn_fence(__ATOMIC_ACQUIRE, "agent");
            if (lane == 0) flag[0] = dead ? 1u : 0u;
        }
        asm volatile("s_waitcnt vmcnt(0) lgkmcnt(0)" ::: "memory"); __builtin_amdgcn_s_barrier(); asm volatile("" ::: "memory");
        const bool bad = flag[0] != 0u;
        if (lane < 32) {
            const unsigned long long* slot = (const unsigned long long*)xbuf + (size_t)(u.pm * BM + row) * 4; float mt[4], m2[4]; float ms = 0.f;
#pragma unroll
            for (int t = 0; t < 4; ++t) { if (t < ntn) { const unsigned long long w = __hip_atomic_load(slot + t, __ATOMIC_RELAXED, __HIP_MEMORY_SCOPE_AGENT); mt[t] = __uint_as_float((unsigned)w); m2[t] = __uint_as_float((unsigned)(w >> 32)); } else { mt[t] = 0.f; m2[t] = 0.f; } ms += mt[t]; }
            const float mean = ms / (float)ntn; float q = 0.f;
#pragma unroll
            for (int t = 0; t < 4; ++t) if (t < ntn) { const float dm = mt[t] - mean; q += m2[t] + 256.0f * dm * dm; }
            S[row] = (f32x2v){mean, 1.0f / sqrtf(q / (256.0f * (float)ntn) + eps)};
        }
        asm volatile("s_waitcnt lgkmcnt(0)" ::: "memory"); __builtin_amdgcn_s_barrier(); asm volatile("" ::: "memory");
        return bad;
    }
};
struct EpiLnRes {
    static constexpr bool PERM = false, AFTER_DRAIN = true;
    const float* base; float* out; int ldc; const float* bias; PanelStats st; unsigned poison;
    __device__ __forceinline__ void fused(f32x4 (&acc)[2][2][4][2], const Unit& u, int wr, int wc, int fr, int fq, PG8_LAS unsigned char* lds, int wid, int lane) const {
        typedef float f32x2v __attribute__((ext_vector_type(2)));
        const PG8_LAS f32x2v* S = (const PG8_LAS f32x2v*)(lds + 8192);
        const int col0 = u.pn * BM + wc * 32 + 4 * fq;
#pragma unroll
        for (int bj = 0; bj < 2; ++bj)
#pragma unroll
            for (int n = 0; n < 2; ++n) { const f32x4 bv = bias ? *(const f32x4*)(bias + col0 + bj * HALF + n * 16) : (f32x4){0.f, 0.f, 0.f, 0.f};
#pragma unroll
                for (int ai = 0; ai < 2; ++ai)
#pragma unroll
                    for (int m = 0; m < 4; ++m) acc[ai][bj][m][n] += bv; }
        f32x4 pre[4][2][2];
#pragma unroll
        for (int m = 0; m < 4; ++m) { const size_t off = (size_t)(u.pm * BM + wr * 64 + m * 16 + fr) * ldc + col0;
#pragma unroll
            for (int bj = 0; bj < 2; ++bj)
#pragma unroll
                for (int n = 0; n < 2; ++n) pre[m][bj][n] = *(const f32x4*)(base + off + bj * HALF + n * 16); }
        const bool bad = st.run(acc, u, wr, wc, fr, fq, lds, wid, lane) || poison != 0u;
        const float qnan = __builtin_nanf("");
#pragma unroll
        for (int ai = 0; ai < 2; ++ai)
#pragma unroll
            for (int m = 0; m < 4; ++m) { const int r = ai * HALF + wr * 64 + m * 16 + fr; const f32x2v sr = S[r]; const size_t off = (size_t)(u.pm * BM + r) * ldc + col0;
#pragma unroll
                for (int bj = 0; bj < 2; ++bj)
#pragma unroll
                    for (int n = 0; n < 2; ++n) { const f32x4 bs = ai == 0 ? pre[m][bj][n] : *(const f32x4*)(base + off + bj * HALF + n * 16); f32x4 o = bs + (acc[ai][bj][m][n] - sr.x) * sr.y;
                        if (bad) o = (f32x4){qnan, qnan, qnan, qnan}; *(f32x4*)(out + off + bj * HALF + n * 16) = o; }
                if (m & 1) asm volatile("" ::: "memory"); }
    }
};
struct EpiLnResLn {
    static constexpr bool PERM = false, AFTER_DRAIN = true;
    const float* base; float* out; bf16_t* xn; int ldc; const float* bias; PanelStats st1, st2; unsigned poison;
    __device__ __forceinline__ void fused(f32x4 (&acc)[2][2][4][2], const Unit& u, int wr, int wc, int fr, int fq, PG8_LAS unsigned char* lds, int wid, int lane) const {
        typedef float f32x2v __attribute__((ext_vector_type(2))); typedef unsigned u32x2v __attribute__((ext_vector_type(2)));
        const PG8_LAS f32x2v* S = (const PG8_LAS f32x2v*)(lds + 8192);
        const int col0 = u.pn * BM + wc * 32 + 4 * fq;
#pragma unroll
        for (int bj = 0; bj < 2; ++bj)
#pragma unroll
            for (int n = 0; n < 2; ++n) { const f32x4 bv = bias ? *(const f32x4*)(bias + col0 + bj * HALF + n * 16) : (f32x4){0.f, 0.f, 0.f, 0.f};
#pragma unroll
                for (int ai = 0; ai < 2; ++ai)
#pragma unroll
                    for (int m = 0; m < 4; ++m) acc[ai][bj][m][n] += bv; }
        bool bad = st1.run(acc, u, wr, wc, fr, fq, lds, wid, lane) || poison != 0u;
        const float qnan = __builtin_nanf("");
#pragma unroll
        for (int ai = 0; ai < 2; ++ai)
#pragma unroll
            for (int m = 0; m < 4; ++m) { const int r = ai * HALF + wr * 64 + m * 16 + fr; const f32x2v sr = S[r]; const size_t off = (size_t)(u.pm * BM + r) * ldc + col0;
#pragma unroll
                for (int bj = 0; bj < 2; ++bj)
#pragma unroll
                    for (int n = 0; n < 2; ++n) { const f32x4 bs = *(const f32x4*)(base + off + bj * HALF + n * 16); acc[ai][bj][m][n] = bs + (acc[ai][bj][m][n] - sr.x) * sr.y; }
                asm volatile("" : "+v"(acc[ai][0][m][0]), "+v"(acc[ai][0][m][1]), "+v"(acc[ai][1][m][0]), "+v"(acc[ai][1][m][1]));
                if (m & 1) asm volatile("" ::: "memory"); }
        const bool bad1 = bad;
        bad = st2.run(acc, u, wr, wc, fr, fq, lds, wid, lane) || bad;
#pragma unroll
        for (int ai = 0; ai < 2; ++ai)
#pragma unroll
            for (int m = 0; m < 4; ++m) { const int r = ai * HALF + wr * 64 + m * 16 + fr; const f32x2v sr = S[r]; const size_t off = (size_t)(u.pm * BM + r) * ldc + col0;
#pragma unroll
                for (int bj = 0; bj < 2; ++bj)
#pragma unroll
                    for (int n = 0; n < 2; ++n) { const f32x4 x1 = acc[ai][bj][m][n]; *(f32x4*)(out + off + bj * HALF + n * 16) = bad1 ? (f32x4){qnan, qnan, qnan, qnan} : x1;
                        const f32x4 o = (x1 - sr.x) * sr.y; u32x2v w; w.x = cvt_pk_bf16(o[0], o[1]); w.y = cvt_pk_bf16(o[2], o[3]);
                        if (bad) { w.x = 0x7fc07fc0u; w.y = 0x7fc07fc0u; } *(u32x2v*)(xn + off + bj * HALF + n * 16) = w; }
                asm volatile("" ::: "memory"); }
    }
};

template <class Epi, class Sched, bool ALIGN_EPI = false, bool SP2 = false>
__device__ __forceinline__ void gemm_phase(PG8_LAS unsigned char* lds, const Gemm g, const Sched& S, const Epi& E) {
    int tid_l = threadIdx.x; asm volatile("" : "+v"(tid_l));
    const int tid = tid_l, wid = __builtin_amdgcn_readfirstlane(tid >> 6), lane = tid & 63, wr = wid >> 2, wc = wid & 3, fr = lane & 15, fq = lane >> 4;
    const int K = g.K, nt = K / BK;
    unsigned voffA[2], voffB[2];
#pragma unroll
    for (int i = 0; i < 2; ++i) { int R, C; stage_rc(tid * 16 + i * 8192, R, C); const int Rb = Epi::PERM ? ((R & ~31) + perm32(R & 31)) : R;
        voffA[i] = (unsigned)(R * g.lda + C) * 2u; voffB[i] = (unsigned)(Rb * K + C) * 2u; }
    const size_t kstep = (size_t)(BK * 2);
    const size_t hstep = (size_t)HALF * K * 2;
    const size_t tstep = 2 * hstep; const size_t hstepA = (size_t)HALF * g.lda * 2, tstepA = 2 * hstepA;
    const unsigned ldsw = (unsigned)wid * 1024u;
    const int aoff = lds_byte(wr * 64 + fr, fq * 8), boff = lds_byte(wc * 32 + fr, fq * 8);
#define PG8_SA(b, h) (((b) * 2 + (h)) * HTB)
#define PG8_SB(b, h) ((4 + (b) * 2 + (h)) * HTB)
#define PG8_STAGE(bufoff, gbase, voff) do { _Pragma("unroll") for (int _i = 0; _i < 2; ++_i) \
        __builtin_amdgcn_global_load_lds((const unsigned*)((const char*)(gbase) + (voff)[_i]), (PG8_LAS unsigned*)(lds + (bufoff) + ldsw + _i * 8192), 16, 0, 0); } while (0)
#define PG8_LDA(dst, b, h) do { _Pragma("unroll") for (int m = 0; m < 4; ++m) _Pragma("unroll") for (int k = 0; k < 2; ++k) dst[m][k] = *(const PG8_LAS bf16x8*)(lds + PG8_SA(b, h) + aoff + m * 2048 + k * 1024); } while (0)
#define PG8_LDB(dst, b, h) do { _Pragma("unroll") for (int n = 0; n < 2; ++n) _Pragma("unroll") for (int k = 0; k < 2; ++k) dst[n][k] = *(const PG8_LAS bf16x8*)(lds + PG8_SB(b, h) + boff + n * 2048 + k * 1024); } while (0)
#define PG8_MMA(ai, bj, At, Bt) do { __builtin_amdgcn_s_setprio(1); _Pragma("unroll") for (int m = 0; m < 4; ++m) _Pragma("unroll") for (int n = 0; n < 2; ++n) _Pragma("unroll") for (int k = 0; k < 2; ++k) \
        acc[ai][bj][m][n] = __builtin_amdgcn_mfma_f32_16x16x32_bf16(Bt[n][k], At[m][k], acc[ai][bj][m][n], 0, 0, 0); __builtin_amdgcn_s_setprio(0); } while (0)
#define PG8_WAIT_V(n) asm volatile("s_waitcnt vmcnt(" #n ")" ::: "memory")
#define PG8_WAIT_L(n) asm volatile("s_waitcnt lgkmcnt(" #n ")" ::: "memory")
#define PG8_BAR __builtin_amdgcn_s_barrier()
#define PG8_SCHED __builtin_amdgcn_sched_barrier(0)
    Unit cur, nxt; int ui = 0;
    if (!S.next(0, cur)) return;
    f32x4 acc[2][2][4][2];
#pragma unroll
    for (int a = 0; a < 2; ++a)
#pragma unroll
        for (int b = 0; b < 2; ++b)
#pragma unroll
            for (int m = 0; m < 4; ++m)
#pragma unroll
                for (int n = 0; n < 2; ++n) acc[a][b][m][n] = (f32x4){0.f, 0.f, 0.f, 0.f};
    bf16x8 At[4][2], B0[2][2], B1[2][2];
    const char* cA = (const char*)g.A + (size_t)cur.pm * tstepA; const char* cB = (const char*)g.Bt + (size_t)cur.pn * tstep;
    S.a_ready(cur);
    if constexpr (SP2) {
        PG8_STAGE(PG8_SB(0, 0), cB, voffB); PG8_STAGE(PG8_SB(0, 1), cB + hstep, voffB); PG8_STAGE(PG8_SA(0, 0), cA, voffA); PG8_STAGE(PG8_SA(0, 1), cA + hstepA, voffA);
        if (wr == 1) PG8_BAR;
        PG8_WAIT_V(2); PG8_BAR;
        PG8_STAGE(PG8_SB(1, 0), cB + kstep, voffB); PG8_STAGE(PG8_SA(1, 0), cA + kstep, voffA); PG8_STAGE(PG8_SB(1, 1), cB + hstep + kstep, voffB);
        PG8_WAIT_V(6); PG8_BAR;
    } else {
        PG8_STAGE(PG8_SB(0, 0), cB, voffB); PG8_STAGE(PG8_SA(0, 0), cA, voffA); PG8_STAGE(PG8_SB(0, 1), cB + hstep, voffB); PG8_STAGE(PG8_SA(0, 1), cA + hstepA, voffA);
        if (wr == 1) PG8_BAR;
        PG8_WAIT_V(4); PG8_BAR;
        PG8_STAGE(PG8_SB(1, 0), cB + kstep, voffB); PG8_STAGE(PG8_SA(1, 0), cA + kstep, voffA); PG8_STAGE(PG8_SB(1, 1), cB + hstep + kstep, voffB);
        PG8_WAIT_V(6); PG8_BAR;
    }
    for (;;) {
        const bool has_next = S.next(ui + 1, nxt);
        const char* nA = has_next ? (const char*)g.A + (size_t)nxt.pm * tstepA : cA; const char* nB = has_next ? (const char*)g.Bt + (size_t)nxt.pn * tstep : cB;
        for (int t = 0; t < nt; t += 2) {
            const bool last = (t == nt - 2);
            const char* a1 = cA + (size_t)(t + 1) * kstep;
            const char* a2 = last ? nA : cA + (size_t)(t + 2) * kstep; const char* b2 = last ? nB : cB + (size_t)(t + 2) * kstep;
            const char* a3 = a2 + kstep; const char* b3 = b2 + kstep;
            if (last && has_next) S.a_ready(nxt);
            if constexpr (SP2) {
            PG8_LDB(B0, 0, 0); PG8_LDB(B1, 0, 1); PG8_SCHED; PG8_LDA(At, 0, 0); PG8_STAGE(PG8_SA(1, 1), a1 + hstepA, voffA);
            PG8_WAIT_V(8); PG8_WAIT_L(0); PG8_BAR; PG8_MMA(0, 0, At, B0); PG8_MMA(0, 1, At, B1); PG8_BAR; PG8_SCHED;
            PG8_LDA(At, 0, 1); PG8_STAGE(PG8_SB(0, 0), b2, voffB); PG8_STAGE(PG8_SB(0, 1), b2 + hstep, voffB); PG8_STAGE(PG8_SA(0, 0), a2, voffA);
            PG8_WAIT_V(8); PG8_WAIT_L(0); PG8_BAR; PG8_MMA(1, 0, At, B0); PG8_MMA(1, 1, At, B1); PG8_BAR; PG8_SCHED;
            PG8_LDB(B0, 1, 0); PG8_LDB(B1, 1, 1); PG8_SCHED; PG8_LDA(At, 1, 0); PG8_STAGE(PG8_SA(0, 1), a2 + hstepA, voffA);
            PG8_WAIT_V(8); PG8_WAIT_L(0); PG8_BAR; PG8_MMA(0, 0, At, B0); PG8_MMA(0, 1, At, B1); PG8_BAR; PG8_SCHED;
            PG8_LDA(At, 1, 1); PG8_STAGE(PG8_SB(1, 0), b3, voffB); PG8_STAGE(PG8_SB(1, 1), b3 + hstep, voffB); PG8_STAGE(PG8_SA(1, 0), a3, voffA);
            PG8_WAIT_V(8); PG8_WAIT_L(0); PG8_BAR; PG8_MMA(1, 0, At, B0); PG8_MMA(1, 1, At, B1); PG8_BAR; PG8_SCHED;
            } else {
            PG8_LDB(B0, 0, 0); PG8_SCHED; PG8_LDA(At, 0, 0); PG8_STAGE(PG8_SA(1, 1), a1 + hstepA, voffA);
            PG8_WAIT_L(8); PG8_BAR; PG8_WAIT_L(0); PG8_MMA(0, 0, At, B0); PG8_BAR; PG8_SCHED;
            PG8_LDB(B1, 0, 1); PG8_STAGE(PG8_SB(0, 0), b2, voffB);
            PG8_BAR; PG8_WAIT_L(0); PG8_MMA(0, 1, At, B1); PG8_BAR;
            PG8_LDA(At, 0, 1); PG8_STAGE(PG8_SA(0, 0), a2, voffA);
            PG8_BAR; PG8_WAIT_L(0); PG8_MMA(1, 0, At, B0); PG8_BAR; PG8_SCHED;
            PG8_STAGE(PG8_SB(0, 1), b2 + hstep, voffB);
            PG8_WAIT_V(6); PG8_BAR; PG8_MMA(1, 1, At, B1); PG8_BAR;
            PG8_LDB(B0, 1, 0); PG8_SCHED; PG8_LDA(At, 1, 0); PG8_STAGE(PG8_SA(0, 1), a2 + hstepA, voffA);
            PG8_WAIT_L(8); PG8_BAR; PG8_WAIT_L(0); PG8_MMA(0, 0, At, B0); PG8_BAR; PG8_SCHED;
            PG8_LDB(B1, 1, 1); PG8_STAGE(PG8_SB(1, 0), b3, voffB);
            PG8_BAR; PG8_WAIT_L(0); PG8_MMA(0, 1, At, B1); PG8_BAR;
            PG8_LDA(At, 1, 1); PG8_STAGE(PG8_SA(1, 0), a3, voffA);
            PG8_BAR; PG8_WAIT_L(0); PG8_MMA(1, 0, At, B0); PG8_BAR; PG8_SCHED;
            PG8_STAGE(PG8_SB(1, 1), b3 + hstep, voffB);
            PG8_WAIT_V(6); PG8_BAR; PG8_MMA(1, 1, At, B1); PG8_BAR;
            }
        }
        if constexpr (ALIGN_EPI) { if (wr == 0) PG8_BAR; }
        if constexpr (!Epi::AFTER_DRAIN) { E(acc, cur, wr, wc, fr, fq); S.done(cur); }
        if (!has_next) break;
#pragma unroll
        for (int a = 0; a < 2; ++a)
#pragma unroll
            for (int b = 0; b < 2; ++b)
#pragma unroll
                for (int m = 0; m < 4; ++m)
#pragma unroll
                    for (int n = 0; n < 2; ++n) acc[a][b][m][n] = (f32x4){0.f, 0.f, 0.f, 0.f};
        cur = nxt; cA = nA; cB = nB; ++ui;
        if constexpr (ALIGN_EPI) { if (wr == 1) PG8_BAR; }
    }
    PG8_WAIT_V(0);
    if constexpr (!ALIGN_EPI) { if (wr == 0) PG8_BAR; }
    PG8_BAR;
    if constexpr (Epi::AFTER_DRAIN) { E.fused(acc, cur, wr, wc, fr, fq, lds, wid, lane); S.done(cur); }
#undef PG8_SA
#undef PG8_SB
#undef PG8_STAGE
#undef PG8_LDA
#undef PG8_LDB
#undef PG8_MMA
#undef PG8_WAIT_V
#undef PG8_WAIT_L
#undef PG8_BAR
#undef PG8_SCHED
}
}

#ifndef PG8_SP2
#define PG8_SP2 true
#endif
#ifndef PG8_ALIGN
#define PG8_ALIGN true
#endif
#include <hip/hip_bf16.h>
#include <cmath>
namespace attn_body {
using bf16=__hip_bfloat16;
using bf16x8=__attribute__((ext_vector_type(8)))short;
using s16x4=__attribute__((ext_vector_type(4)))short;
using f32x16=__attribute__((ext_vector_type(16)))float;
using u32x4=__attribute__((ext_vector_type(4)))unsigned;
using f32x4v=__attribute__((ext_vector_type(4)))float;
constexpr int BATCH=1,NHEAD=8,SEQ=16384,D=64,DM=8704;
constexpr int NW=8,QBLK=32,QB=QBLK*NW,KVBLK=64,NQB=SEQ/QB;
constexpr int ATTN_PITCH=DM, ATTN_UNIT_ROWS=QB;
__device__ __forceinline__ int crow(int r,int hi){return (r&3)+8*(r>>2)+4*hi;}
#define SBAR() __builtin_amdgcn_sched_barrier(0)
__device__ __forceinline__ void cmask(f32x16&p0,f32x16&p1,int jb,int qrel,int hi){
  const float NEG=-INFINITY; int kb=64*jb+4*hi;
  #pragma unroll
  for(int r=0;r<16;++r){int kv=kb+(r&3)+8*(r>>2); if(kv>qrel)p0[r]=NEG; if(kv+32>qrel)p1[r]=NEG;}
}

constexpr int NSLOT=3, SLOTB=8192;
constexpr int LDS_K=0, LDS_V=NSLOT*SLOTB, LDS_WS=2*NSLOT*SLOTB, LDS_OST=LDS_WS+NW*64*4, LDS_F=LDS_OST+NW*4096, LDS_BYTES=LDS_F+SEQ*4;
constexpr float C2=0.125f*1.4426950408889634f;
__device__ __forceinline__ void glds16(const void*gsrc,unsigned lds_dst){unsigned keep;
  asm volatile("s_mov_b32 %0, m0\n\ts_mov_b32 m0, %2\n\ts_nop 0\n\tglobal_load_lds_dwordx4 %1, off\n\ts_mov_b32 m0, %0":"=&s"(keep):"v"(gsrc),"s"(lds_dst):"memory");}
__device__ __forceinline__ float max3f(float a,float b,float c){float r;asm("v_max3_f32 %0, %1, %2, %3":"=v"(r):"v"(a),"v"(b),"v"(c));return r;}
__device__ __forceinline__ float max2f(float a,float b){float r;asm("v_max_f32_e32 %0, %1, %2":"=v"(r):"v"(a),"v"(b));return r;}
__device__ __forceinline__ float fadd_s(float a,float b){float r;asm("v_add_f32_e32 %0, %1, %2":"=v"(r):"v"(a),"v"(b));return r;}
__device__ __forceinline__ float fsub_s(float a,float b){float r;asm("v_sub_f32_e32 %0, %1, %2":"=v"(r):"v"(a),"v"(b));return r;}
typedef float f32x2_t __attribute__((ext_vector_type(2))); typedef __bf16 bf16x2_t __attribute__((ext_vector_type(2)));
__device__ __forceinline__ unsigned cvtpk_s(float lo,float hi){f32x2_t v={lo,hi};bf16x2_t b=__builtin_convertvector(v,bf16x2_t);return __builtin_bit_cast(unsigned,b);}
#define WAIT_BAR(N) asm volatile("s_waitcnt vmcnt(" #N ") lgkmcnt(0)\n\ts_barrier":::"memory")


__device__ __forceinline__ bf16x8 mkbias(float x,int hi){
  const unsigned xb=__float_as_uint(x); const unsigned hb=xb&0xffff0000u; const float r1=x-__uint_as_float(hb);
  const unsigned mb=__float_as_uint(r1)&0xffff0000u; const float r2=r1-__uint_as_float(mb); const unsigned lb=__float_as_uint(r2)&0xffff0000u;
  u32x4 w; w.x=(hb>>16)|mb; w.y=(lb>>16)|0x3f800000u; w.z=0x3f803f80u; w.w=0u; if(hi){w.x=0u;w.y=0u;w.z=0u;}
  return __builtin_bit_cast(bf16x8,w);
}
__device__ __forceinline__ bf16x8 mkq(float x,int hi){
  const unsigned xb=__float_as_uint(x); const unsigned hb=xb&0xffff0000u; const float r1=x-__uint_as_float(hb);
  const unsigned mb=__float_as_uint(r1)&0xffff0000u; const float r2=r1-__uint_as_float(mb); const unsigned lb=__float_as_uint(r2)&0xffff0000u;
  u32x4 w; w.x=0x3f803f80u; w.y=0x3f80u|hb; w.z=(mb>>16)|lb; w.w=0u; if(hi){w.x=0u;w.y=0u;w.z=0u;}
  return __builtin_bit_cast(bf16x8,w);
}
__device__ __forceinline__ void qkt(f32x16&p0,f32x16&p1,const char*Kslot,const bf16x8*qr,int r32,int hi,bf16x8 kb0,bf16x8 kb1,bf16x8 qone){ const f32x16 negm=f32x16{};
  const char*kb=Kslot+hi*1024+r32*16;
  #pragma unroll
  for(int d0=0;d0<4;++d0){
    const bf16x8 b0=*reinterpret_cast<const bf16x8*>(kb+d0*2048);
    const bf16x8 b1=*reinterpret_cast<const bf16x8*>(kb+d0*2048+512);
    if(d0==0){p0=__builtin_amdgcn_mfma_f32_32x32x16_bf16(b0,qr[0],negm,0,0,0);p1=__builtin_amdgcn_mfma_f32_32x32x16_bf16(b1,qr[0],negm,0,0,0);}
    else{p0=__builtin_amdgcn_mfma_f32_32x32x16_bf16(b0,qr[d0],p0,0,0,0);p1=__builtin_amdgcn_mfma_f32_32x32x16_bf16(b1,qr[d0],p1,0,0,0);}}
  p0=__builtin_amdgcn_mfma_f32_32x32x16_bf16(kb0,qone,p0,0,0,0);p1=__builtin_amdgcn_mfma_f32_32x32x16_bf16(kb1,qone,p1,0,0,0);
}
typedef __attribute__((address_space(3))) const char* lds_cptr;
typedef short v4i16_t __attribute__((ext_vector_type(4)));
__device__ __forceinline__ void kload8(bf16x8*kf,lds_cptr kp){
  kf[0]=*(const __attribute__((address_space(3))) bf16x8*)(kp);      kf[1]=*(const __attribute__((address_space(3))) bf16x8*)(kp+512);
  kf[2]=*(const __attribute__((address_space(3))) bf16x8*)(kp+2048); kf[3]=*(const __attribute__((address_space(3))) bf16x8*)(kp+2560);
  kf[4]=*(const __attribute__((address_space(3))) bf16x8*)(kp+4096); kf[5]=*(const __attribute__((address_space(3))) bf16x8*)(kp+4608);
  kf[6]=*(const __attribute__((address_space(3))) bf16x8*)(kp+6144); kf[7]=*(const __attribute__((address_space(3))) bf16x8*)(kp+6656);
}
__device__ __forceinline__ void kload2(bf16x8*kf,lds_cptr kp,int j){ kf[2*j]=*(const __attribute__((address_space(3))) bf16x8*)(kp+j*2048); kf[2*j+1]=*(const __attribute__((address_space(3))) bf16x8*)(kp+j*2048+512); }
__device__ __forceinline__ s16x4 vtr(lds_cptr p){ return __builtin_bit_cast(s16x4,__builtin_amdgcn_ds_read_tr16_b64_v4i16((__attribute__((address_space(3))) v4i16_t*)p)); }
__device__ __forceinline__ float rowmax(const f32x16&p0,const f32x16&p1){
  float a=max3f(p0[0],p0[1],p1[0]),b=max3f(p0[2],p0[3],p1[1]);a=max3f(a,p1[2],p1[3]);
  #pragma unroll
  for(int r=4;r<16;r+=4){a=max3f(a,p0[r],p0[r+1]);b=max3f(b,p0[r+2],p0[r+3]);a=max3f(a,p1[r],p1[r+1]);b=max3f(b,p1[r+2],p1[r+3]);}
  const float m=max2f(a,b);
  auto rr=__builtin_amdgcn_permlane32_swap(__float_as_uint(m),__float_as_uint(m),false,false);
  return max2f(__uint_as_float(rr[0]),__uint_as_float(rr[1]));
}
__device__ __forceinline__ void pv(f32x16*o,int vb,bf16x8 pa0,bf16x8 pa1,bf16x8 pa2,bf16x8 pa3){
  #pragma unroll
  for(int d0=0;d0<2;++d0){s16x4 lo[4],hi[4];
    #pragma unroll
    for(int ks=0;ks<4;++ks){
      asm volatile("ds_read_b64_tr_b16 %0,%1 offset:%c2":"=&v"(lo[ks]):"v"(vb),"i"(d0*4096+ks*1024):"memory");
      asm volatile("ds_read_b64_tr_b16 %0,%1 offset:%c2":"=&v"(hi[ks]):"v"(vb),"i"(d0*4096+ks*1024+512):"memory");}
    asm volatile("s_waitcnt lgkmcnt(0)":::"memory");SBAR();
    #define PK(k) (bf16x8){lo[k][0],lo[k][1],lo[k][2],lo[k][3],hi[k][0],hi[k][1],hi[k][2],hi[k][3]}
    o[d0]=__builtin_amdgcn_mfma_f32_32x32x16_bf16(pa0,PK(0),o[d0],0,0,0);
    o[d0]=__builtin_amdgcn_mfma_f32_32x32x16_bf16(pa1,PK(1),o[d0],0,0,0);
    o[d0]=__builtin_amdgcn_mfma_f32_32x32x16_bf16(pa2,PK(2),o[d0],0,0,0);
    o[d0]=__builtin_amdgcn_mfma_f32_32x32x16_bf16(pa3,PK(3),o[d0],0,0,0);
    #undef PK
  }
}

#ifndef ATTN_STORE16
#define ATTN_STORE16(p,v) (*(u32x4*)(p)=(v))
#endif
template<int THRL> __device__ __forceinline__ void attn_unit(int b,int h,int qb,const bf16*Q,const bf16*__restrict__ K,const bf16*__restrict__ V,bf16*O,const float*FL2,char*shm){
  int tid_l=threadIdx.x; asm volatile("":"+v"(tid_l));
  const int tid=tid_l,lane=tid&63,r32=lane&31,hi=lane>>5; const int wid=__builtin_amdgcn_readfirstlane(tid>>6);
  const long rowbase=(long)b*SEQ; const int q0=qb*QB;
  const bf16*Qw=Q+(rowbase+q0+wid*QBLK)*DM+h*D;
  const bf16*Kh=K+rowbase*DM+h*D,*Vh=V+rowbase*DM+h*D;
  const lds_cptr shm3=(lds_cptr)shm;
  const unsigned lds0=(unsigned)(uintptr_t)shm;
  float*wsf=(float*)(shm+LDS_WS)+wid*64;
  const bf16*ksrc=Kh+(long)lane*DM+wid*8;
  const bf16*vsrc=Vh+(long)(16*(wid&3)+(lane>>2))*DM+(wid>>2)*32+(lane&3)*8;
  const unsigned kdst=lds0+LDS_K+wid*1024, vdst=lds0+LDS_V+wid*1024;
  #define DMA_K(t,slot) glds16(ksrc+(long)(t)*KVBLK*DM,(unsigned)__builtin_amdgcn_readfirstlane(kdst+(slot)))
  #define DMA_V(t,slot) glds16(vsrc+(long)(t)*KVBLK*DM,(unsigned)__builtin_amdgcn_readfirstlane(vdst+(slot)))
  const int vb0=(int)(lds0+LDS_V)+((lane>>4)&1)*32+(lane&3)*8+(4*hi+((lane&15)>>2))*64;
  const char*Kbase=shm+LDS_K; bf16x8 kf[8];
  const lds_cptr kp0=shm3+LDS_K+hi*1024+r32*16; const lds_cptr vp0=shm3+LDS_V+((lane>>4)&1)*32+(lane&3)*8+(4*hi+((lane&15)>>2))*64;
  const int NT=(q0+QB)/KVBLK;
  const __attribute__((address_space(3))) float* Fl=(const __attribute__((address_space(3))) float*)(shm3+LDS_F);
  float fref;
  { const float*Fg=FL2+(long)h*SEQ; const int nF=q0+QB;
    for(int i=tid*4;i<nF;i+=NW*64*4){ const f32x4v v4=*reinterpret_cast<const f32x4v*>(Fg+i); *(__attribute__((address_space(3))) f32x4v*)(shm3+LDS_F+i*4)=v4; }
    fref=Fg[nF-1]; }
  asm volatile("s_waitcnt vmcnt(0) lgkmcnt(0)":::"memory");
  bf16x8 qone=mkq(0.f,hi);
  #define MKB(t,off) mkbias(fref-Fl[(t)*KVBLK+(off)+r32],hi)
  DMA_K(0,0);DMA_V(0,0);DMA_K(1,SLOTB);
  bf16x8 qr[4];
  #pragma unroll
  for(int d0=0;d0<4;++d0)qr[d0]=*reinterpret_cast<const bf16x8*>(&Qw[(long)r32*DM+d0*16+hi*8]);
  float mhat=0.f,l_reg=0.f;f32x16 o[2];o[0]=f32x16{};o[1]=f32x16{};
  const int qrel=wid*QBLK+r32;
  #define CMASK(P0,P1,t) do{int jb_=(t)-(NT-4); if(jb_>=0)cmask(P0,P1,jb_,qrel,hi);}while(0)
  bool resc=false;
  #define START(P0,P1) do{ const float rm=rowmax(P0,P1); resc=false; \
    { const float dl=rm; mhat=fadd_s(mhat,dl); \
      _Pragma("unroll") for(int r=0;r<16;++r){P0[r]=fsub_s(P0[r],dl);P1[r]=fsub_s(P1[r],dl);} \
      qone=mkq(-mhat,hi); } \
    _Pragma("unroll") for(int r=0;r<16;++r)P0[r]=__builtin_amdgcn_exp2f(P0[r]); }while(0)
  #define RESC() do{ if(resc){ asm volatile("s_waitcnt lgkmcnt(0)":::"memory"); \
      _Pragma("unroll") for(int d_=0;d_<2;++d_) _Pragma("unroll") for(int r=0;r<16;++r)o[d_][r]*=wsf[crow(r,hi)]; } }while(0)
  f32x16 pA0,pA1,pB0,pB1;
  int sl_prev=0,sl_cur=0,sl_next=SLOTB;
  #define ROT() do{sl_prev=sl_cur;sl_cur=sl_next;sl_next=(sl_next==(NSLOT-1)*SLOTB)?0:sl_next+SLOTB;}while(0)
  DMA_K(2,2*SLOTB);
  WAIT_BAR(3);
  qkt(pA0,pA1,Kbase,qr,r32,hi,MKB(0,0),MKB(0,32),qone);asm volatile("s_nop 15\n\ts_nop 7":"+v"(pA0),"+v"(pA1));CMASK(pA0,pA1,0);
  START(pA0,pA1);
  _Pragma("unroll") for(int r=0;r<16;++r)pA1[r]=__builtin_amdgcn_exp2f(pA1[r]);
  WAIT_BAR(0);
  DMA_K(3,0);DMA_V(1,SLOTB);
  ROT();
  kload8(kf,kp0+sl_cur);
  WAIT_BAR(2);
  s16x4 vlo[8],vhi[8]; u32x4 pw0,pw1,pw2,pw3;
  #define PKW(P,B) cvtpk_s(P[B],P[B+1])
  #define PAF(k) __builtin_bit_cast(bf16x8,pw##k)
  #define VFR(i) (bf16x8){vlo[i][0],vlo[i][1],vlo[i][2],vlo[i][3],vhi[i][0],vhi[i][1],vhi[i][2],vhi[i][3]}
  #define PIN(x) asm volatile("":"+v"(x))
  #define MX3(a,b,c) __builtin_fmaxf(__builtin_fmaxf((a),(b)),(c))
  #define GAPA(MF,A0,A1,A2,A3,W0,W1,PW) do{ MF; sacc+=A0; sacc+=A1; sacc+=A2; sacc+=A3; PIN(sacc); W0; W1; PIN(PW); SBAR(); }while(0)
  #define EX(v) __builtin_amdgcn_exp2f(v)
  #define GAPB(MF,X,B) do{ MF; X[B]=EX(X[B]); X[B+1]=EX(X[B+1]); X[B+2]=EX(X[B+2]); X[B+3]=EX(X[B+3]); PIN(X); SBAR(); }while(0)
  #define VRD(i) do{ vlo[i]=vtr(vp_+(((i)>>2)*4096+((i)&3)*1024)); vhi[i]=vtr(vp_+(((i)>>2)*4096+((i)&3)*1024+512)); }while(0)
  #define KRD(G,j) do{ if(G){ kload2(kf,kp0+sl_next,j); SBAR(); } }while(0)
  #define STEP(C0,C1,P0,P1,t,GK,GV,GL) do{ SBAR(); \
    const bf16x8 kbA_=MKB(t,0), kbB_=MKB(t,32); \
    const lds_cptr vp_=vp0+sl_prev; \
    VRD(0); SBAR(); float sacc=(P0[0]+P0[1]); \
    GAPA(C0=__builtin_amdgcn_mfma_f32_32x32x16_bf16(kf[0],qr[0],f32x16{},0,0,0), P0[2],P0[3],P0[4],P0[5],     pw0[0]=PKW(P0,0), pw0[1]=PKW(P0,2), pw0); \
    VRD(4); SBAR(); GAPA(C1=__builtin_amdgcn_mfma_f32_32x32x16_bf16(kf[1],qr[0],f32x16{},0,0,0), P0[6],P0[7],P0[8],P0[9],     pw0[2]=PKW(P0,4), pw0[3]=PKW(P0,6), pw0); \
    VRD(1); SBAR(); GAPA(C0=__builtin_amdgcn_mfma_f32_32x32x16_bf16(kf[2],qr[1],C0,0,0,0),   P0[10],P0[11],P0[12],P0[13], pw1[0]=PKW(P0,8), pw1[1]=PKW(P0,10), pw1); \
    VRD(5); SBAR(); GAPA(C1=__builtin_amdgcn_mfma_f32_32x32x16_bf16(kf[3],qr[1],C1,0,0,0),   P0[14],P0[15],P1[0],P1[1],   pw1[2]=PKW(P0,12),pw1[3]=PKW(P0,14), pw1); \
    VRD(2); SBAR(); GAPA(C0=__builtin_amdgcn_mfma_f32_32x32x16_bf16(kf[4],qr[2],C0,0,0,0),   P1[2],P1[3],P1[4],P1[5],     pw2[0]=PKW(P1,0), pw2[1]=PKW(P1,2), pw2); \
    VRD(6); SBAR(); GAPA(C1=__builtin_amdgcn_mfma_f32_32x32x16_bf16(kf[5],qr[2],C1,0,0,0),   P1[6],P1[7],P1[8],P1[9],     pw2[2]=PKW(P1,4), pw2[3]=PKW(P1,6), pw2); \
    VRD(3); SBAR(); GAPA(C0=__builtin_amdgcn_mfma_f32_32x32x16_bf16(kf[6],qr[3],C0,0,0,0),   P1[10],P1[11],P1[12],P1[13], pw3[0]=PKW(P1,8), pw3[1]=PKW(P1,10), pw3); \
    VRD(7); SBAR(); GAPA(C1=__builtin_amdgcn_mfma_f32_32x32x16_bf16(kf[7],qr[3],C1,0,0,0),   P1[14],P1[15],0.f,0.f,       pw3[2]=PKW(P1,12),pw3[3]=PKW(P1,14), pw3); \
    C0=__builtin_amdgcn_mfma_f32_32x32x16_bf16(kbA_,qone,C0,0,0,0); C1=__builtin_amdgcn_mfma_f32_32x32x16_bf16(kbB_,qone,C1,0,0,0); \
    l_reg+=sacc; \
    if(GK){DMA_K((t)+3,sl_cur);} if(GV){DMA_V((t)+1,sl_next);} \
    CMASK(C0,C1,t); \
    { float a=MX3(C0[0],C0[1],C1[0]),b=MX3(C0[2],C0[3],C1[1]); a=MX3(a,C1[2],C1[3]); \
      _Pragma("unroll") for(int r=4;r<16;r+=4){a=MX3(a,C0[r],C0[r+1]);b=MX3(b,C0[r+2],C0[r+3]);a=MX3(a,C1[r],C1[r+1]);b=MX3(b,C1[r+2],C1[r+3]);} \
      float rm=__builtin_fmaxf(a,b); { auto rr=__builtin_amdgcn_permlane32_swap(__float_as_uint(rm),__float_as_uint(rm),false,false); rm=__builtin_fmaxf(__uint_as_float(rr[0]),__uint_as_float(rr[1])); } \
      resc=false; \
      if(__builtin_expect(__any(rm>(float)THRL),0)){ const float dl=__builtin_fmaxf(rm,0.f); mhat+=dl; \
        _Pragma("unroll") for(int r=0;r<16;++r){C0[r]-=dl;C1[r]-=dl;} \
        qone=mkq(-mhat,hi); \
        const float f=__builtin_amdgcn_exp2f(-dl); l_reg*=f; if(hi==0)wsf[r32]=f; resc=true; } } \
    SBAR(); \
    GAPB(o[0]=__builtin_amdgcn_mfma_f32_32x32x16_bf16(PAF(0),VFR(0),o[0],0,0,0), C0,0); \
    GAPB(o[1]=__builtin_amdgcn_mfma_f32_32x32x16_bf16(PAF(0),VFR(4),o[1],0,0,0), C0,4); \
    KRD(GL,0); GAPB(o[0]=__builtin_amdgcn_mfma_f32_32x32x16_bf16(PAF(1),VFR(1),o[0],0,0,0), C0,8); \
    KRD(GL,1); GAPB(o[1]=__builtin_amdgcn_mfma_f32_32x32x16_bf16(PAF(1),VFR(5),o[1],0,0,0), C0,12); \
    KRD(GL,2); GAPB(o[0]=__builtin_amdgcn_mfma_f32_32x32x16_bf16(PAF(2),VFR(2),o[0],0,0,0), C1,0); \
    KRD(GL,3); GAPB(o[1]=__builtin_amdgcn_mfma_f32_32x32x16_bf16(PAF(2),VFR(6),o[1],0,0,0), C1,4); \
    GAPB(o[0]=__builtin_amdgcn_mfma_f32_32x32x16_bf16(PAF(3),VFR(3),o[0],0,0,0), C1,8); \
    GAPB(o[1]=__builtin_amdgcn_mfma_f32_32x32x16_bf16(PAF(3),VFR(7),o[1],0,0,0), C1,12); \
    }while(0)
  int t=1;
  #undef CMASK
  #define CMASK(P0,P1,t) do{}while(0)
  for(;t+5<NT;t+=2){
    STEP(pB0,pB1,pA0,pA1,t,true,true,true);     WAIT_BAR(2); RESC(); ROT();
    STEP(pA0,pA1,pB0,pB1,t+1,true,true,true);   WAIT_BAR(2); RESC(); ROT();
  }
  #undef CMASK
  #define CMASK(P0,P1,t) do{int jb_=(t)-(NT-4); if(jb_>=0)cmask(P0,P1,jb_,qrel,hi);}while(0)
  #define ENDW(tt) do{ if((tt)+3<NT){WAIT_BAR(2);} else if((tt)+2<NT){WAIT_BAR(1);} else {WAIT_BAR(0);} }while(0)
  for(;t+1<NT;t+=2){
    STEP(pB0,pB1,pA0,pA1,t,(t+3<NT),(t+1<NT),(t+1<NT));       ENDW(t);   RESC(); ROT();
    STEP(pA0,pA1,pB0,pB1,t+1,(t+4<NT),(t+2<NT),(t+2<NT));     ENDW(t+1); RESC(); ROT();
  }
  STEP(pB0,pB1,pA0,pA1,NT-1,false,false,false); RESC();
  { float sacc=pB0[0]+pB0[1]; _Pragma("unroll") for(int r=2;r<16;++r)sacc+=pB0[r]; _Pragma("unroll") for(int r=0;r<16;++r)sacc+=pB1[r]; l_reg+=sacc;
    pw0=(u32x4){PKW(pB0,0),PKW(pB0,2),PKW(pB0,4),PKW(pB0,6)};pw1=(u32x4){PKW(pB0,8),PKW(pB0,10),PKW(pB0,12),PKW(pB0,14)};pw2=(u32x4){PKW(pB1,0),PKW(pB1,2),PKW(pB1,4),PKW(pB1,6)};pw3=(u32x4){PKW(pB1,8),PKW(pB1,10),PKW(pB1,12),PKW(pB1,14)};
    SBAR(); pv(o,vb0+sl_cur,PAF(0),PAF(1),PAF(2),PAF(3)); }
  #undef PKW
  #undef PAF
  #undef VFR
  #undef PIN
  #undef MX3
  #undef GAPA
  #undef GAPB
  #undef EX
  #undef VRD
  #undef KRD
  #undef STEP
  #undef ENDW
  {auto rr=__builtin_amdgcn_permlane32_swap(__float_as_uint(l_reg),__float_as_uint(l_reg),false,false);l_reg=__uint_as_float(rr[0])+__uint_as_float(rr[1]);}
  if(hi==0)wsf[32+r32]=l_reg;asm volatile("s_waitcnt lgkmcnt(0)":::"memory");
  float rli[16];
  #pragma unroll
  for(int r=0;r<16;++r)rli[r]=__builtin_amdgcn_rcpf(wsf[32+crow(r,hi)]);
  bf16*Ow=O+(rowbase+q0+wid*QBLK)*DM+h*D;
  { bf16*stg=(bf16*)(shm+LDS_OST)+wid*2048;
    #pragma unroll
    for(int r=0;r<16;++r){const int orow=crow(r,hi);
      #pragma unroll
      for(int d0=0;d0<2;++d0)stg[orow*64+d0*32+r32]=__float2bfloat16(o[d0][r]*rli[r]);}
    asm volatile("s_waitcnt lgkmcnt(0)":::"memory");
    #pragma unroll
    for(int i=0;i<4;++i){const int row=i*8+(lane>>3),ch=lane&7; const u32x4 v=*(const u32x4*)(stg+row*64+ch*8); ATTN_STORE16(Ow+(long)row*DM+ch*8,v);} }
  asm volatile("s_waitcnt lgkmcnt(0)\n\ts_barrier":::"memory");
  #undef DMA_K
  #undef DMA_V
  #undef MKB
  #undef CMASK
  #undef START
  #undef RESC
  #undef ROT
}
constexpr int ATTN_LDS_BYTES=LDS_BYTES;
struct AttnTensors { const bf16* Q; const bf16* K; const bf16* V; bf16* O; const float* FL2; };
struct AttnUnit { int bh; int qb; };
struct StaticOrder {
  int vcu;
  __device__ __forceinline__ explicit StaticOrder(int grid,int block):vcu((block%8)*(grid/8)+block/8){}
  __device__ __forceinline__ bool next(int i,AttnUnit&u)const{ if(i>=2)return false; const int s=vcu&31; u.bh=vcu>>5; u.qb=(i==0)?s:63-s; return true; }
  __device__ __forceinline__ void a_ready(const AttnUnit&)const{}
  __device__ __forceinline__ void done(const AttnUnit&)const{}
};
template<class Sched,int THRL=8> __device__ __forceinline__ void attn_phase(char*lds,const AttnTensors&T,const Sched&S){
  AttnUnit u;
  for(int i=0;S.next(i,u);++i){ S.a_ready(u); attn_unit<THRL>(u.bh/NHEAD,u.bh%NHEAD,u.qb,T.Q,T.K,T.V,T.O,T.FL2,lds); S.done(u); }
}
#undef SBAR
#undef WAIT_BAR
}
#define LAS __attribute__((address_space(3)))
typedef unsigned short bf16;
typedef unsigned v4u __attribute__((ext_vector_type(4)));
typedef unsigned v2u __attribute__((ext_vector_type(2)));
typedef float f32x4 __attribute__((ext_vector_type(4)));
typedef short bf16x8 __attribute__((ext_vector_type(8)));
typedef const __attribute__((address_space(4))) unsigned* cu32p;
typedef const __attribute__((address_space(4))) float* cf32p;

constexpr int M = 16384, D = 1024, DFF = 2816, ZP = 8704, NL = 4, NWAVES = 8, NTHR = 512;
constexpr int ZQ = 0, ZK = 512, ZV = 1024, ZXB = 1536, ZYB = 2560, ZRW = 3584, ZGT = 5376, ZFL = 8448;
constexpr float ALPHA = 1.6817928305074292f, LN_EPS = 1e-5f, GN_EPS = 64e-5f, LOG2E = 1.4426950408889634f;
constexpr int NCH = 256, LC = 64;

constexpr size_t MiB = 1u << 20;
constexpr size_t WS_ADA = 1 * MiB, WS_FL2 = 2 * MiB, WS_LAEND = 3 * MiB, WS_LHEND = 4 * MiB, WS_LCAR = 5 * MiB, WS_BON = 6 * MiB;
constexpr size_t WS_W = 8 * MiB;
constexpr size_t W_UP0 = WS_W, W_UP1 = WS_W + 11 * MiB, W_DN0 = WS_W + 22 * MiB, W_DN1 = WS_W + 22 * MiB + 5632 * 1024, W_IN = WS_W + 33 * MiB,
                 W_PA = WS_W + 50 * MiB, W_PB = WS_W + 51 * MiB, W_PC = WS_W + 53 * MiB, W_OUT = WS_W + 54 * MiB, W_LORA = WS_W + 56 * MiB;
constexpr size_t WS_HB = 65 * MiB, WS_Y = 97 * MiB, WS_HLOC = 97 * MiB, WS_ACUM = 129 * MiB, WS_P = 97 * MiB, WS_G = 129 * MiB;
constexpr size_t WS_RWO = 161 * MiB, WS_CODES = 177 * MiB, WS_LORA = 185 * MiB, WS_S0 = 185 * MiB;
constexpr size_t WS_RW_W = 233 * MiB, WS_RW_R = 265 * MiB, WS_RW_KF = 281 * MiB, WS_RW_V = 297 * MiB, WS_RW_KK = 313 * MiB, WS_RW_B = 329 * MiB, WS_GB = 345 * MiB;
constexpr size_t WS_Z = 361 * MiB, WS_ACT = 361 * MiB, WS_END = 697 * MiB;
struct RwSet { size_t w, r, kf, kk, b; };
__device__ __forceinline__ RwSet rw_set(int l) { return (l & 1) ? RwSet{WS_HB, 633 * MiB, 649 * MiB, 665 * MiB, 681 * MiB} : RwSet{WS_RW_W, WS_RW_R, WS_RW_KF, WS_RW_KK, WS_RW_B}; }
constexpr int MISC_OFF = attn_body::ATTN_LDS_BYTES, LDS_BYTES = attn_body::ATTN_LDS_BYTES + 64;
constexpr size_t CTL_ZERO_BYTES = 16384;
constexpr int LDS_PHASE_BYTES = attn_body::ATTN_LDS_BYTES;
static_assert(LDS_BYTES >= pg8::STAGE_BYTES && LDS_BYTES <= 160 * 1024, "LDS map");

__device__ __forceinline__ unsigned f2bf(float f) { unsigned u = __builtin_bit_cast(unsigned, f); return (u + 0x7fffu + ((u >> 16) & 1u)) >> 16; }
__device__ __forceinline__ unsigned pk2(float lo, float hi) { return f2bf(lo) | (f2bf(hi) << 16); }
__device__ __forceinline__ float bflo(unsigned u) { return __uint_as_float(u << 16); }
__device__ __forceinline__ float bfhi(unsigned u) { return __uint_as_float(u & 0xffff0000u); }
__device__ __forceinline__ float bf1(bf16 b) { return __uint_as_float(((unsigned)b) << 16); }
__device__ __forceinline__ float wave_sum(float v) {
#pragma unroll
    for (int o = 1; o < 64; o <<= 1) v += __shfl_xor(v, o);
    return v;
}
__device__ __forceinline__ float sigm(float x) { return __builtin_amdgcn_rcpf(1.f + __expf(-x)); }
__device__ __forceinline__ float tanh_(float z) { return 1.f - 2.f * __builtin_amdgcn_rcpf(1.f + __expf(2.f * z)); }
__device__ __forceinline__ float gelu_tanh(float x) { return 0.5f * x * (1.f + tanh_(0.7978845608028654f * (x + 0.044715f * x * x * x))); }
__device__ __forceinline__ float softplus_(float x) { return fmaxf(x, 0.f) + log1pf(__expf(-fabsf(x))); }
#define LDS_WAIT() asm volatile("s_waitcnt lgkmcnt(0)" ::: "memory")

struct Args { const float* in[32]; float* out; unsigned char* ws; };
typedef const __attribute__((address_space(4))) Args* CA;

struct EpiSwiGLU {
    static constexpr bool PERM = true, AFTER_DRAIN = false; bf16* O; int ldc;
    __device__ __forceinline__ void operator()(const pg8::f32x4 (&acc)[2][2][4][2], const pg8::Unit& u, int wr, int wc, int fr, int fq) const {
        const int row0 = u.pm * 256 + wr * 64 + fr, col0 = u.pn * 128 + wc * 32 + 8 * fq;
#pragma unroll
        for (int ai = 0; ai < 2; ++ai)
#pragma unroll
            for (int m = 0; m < 4; ++m) {
                bf16* rowp = O + (size_t)(row0 + ai * 128 + m * 16) * ldc + col0; float o[8];
#pragma unroll
                for (int n = 0; n < 2; ++n)
#pragma unroll
                    for (int i = 0; i < 4; ++i) { const float uu = acc[ai][0][m][n][i], gg = acc[ai][1][m][n][i]; o[n * 4 + i] = uu * sigm(uu) * gg; }
                v4u w; w.x = pk2(o[0], o[1]); w.y = pk2(o[2], o[3]); w.z = pk2(o[4], o[5]); w.w = pk2(o[6], o[7]); *(v4u*)rowp = w; }
    }
};
struct EpiGateF32 {
    static constexpr bool PERM = false, AFTER_DRAIN = false; float* Y; const float* gate; float mul;
    __device__ __forceinline__ void operator()(const pg8::f32x4 (&acc)[2][2][4][2], const pg8::Unit& u, int wr, int wc, int fr, int fq) const {
        const int row0 = u.pm * 256 + wr * 64 + fr, col0 = u.pn * 256 + wc * 32 + 4 * fq;
#pragma unroll
        for (int bj = 0; bj < 2; ++bj)
#pragma unroll
            for (int n = 0; n < 2; ++n) { const int c = col0 + bj * 128 + n * 16; const f32x4 gv = *(const f32x4*)(gate + c) * mul;
#pragma unroll
                for (int ai = 0; ai < 2; ++ai)
#pragma unroll
                    for (int m = 0; m < 4; ++m) *(f32x4*)(Y + (size_t)(row0 + ai * 128 + m * 16) * D + c) = acc[ai][bj][m][n] * gv; }
    }
};
struct EpiIn {
    static constexpr bool PERM = true, AFTER_DRAIN = false; bf16* Z;
    __device__ __forceinline__ void operator()(const pg8::f32x4 (&acc)[2][2][4][2], const pg8::Unit& u, int wr, int wc, int fr, int fq) const {
        const int row0 = u.pm * 256 + wr * 64 + fr, col0 = u.pn * 256 + wc * 32 + 8 * fq;
        const int mode = (u.pn < 2) ? 1 : ((u.pn >= 21 && u.pn < 33) ? 2 : 0);
#pragma unroll
        for (int ai = 0; ai < 2; ++ai)
#pragma unroll
            for (int m = 0; m < 4; ++m) { bf16* rowp = Z + (size_t)(row0 + ai * 128 + m * 16) * ZP + col0;
#pragma unroll
                for (int bj = 0; bj < 2; ++bj) { float o[8];
#pragma unroll
                    for (int n = 0; n < 2; ++n)
#pragma unroll
                        for (int i = 0; i < 4; ++i) { float v = acc[ai][bj][m][n][i]; if (mode == 1) v *= attn_body::C2; else if (mode == 2) v = sigm(v); o[n * 4 + i] = v; }
                    v4u w; w.x = pk2(o[0], o[1]); w.y = pk2(o[2], o[3]); w.z = pk2(o[4], o[5]); w.w = pk2(o[6], o[7]); *(v4u*)(rowp + bj * 128) = w; } }
    }
};
struct EpiPlain {
    static constexpr bool PERM = true, AFTER_DRAIN = false; bf16* O; int ldc;
    __device__ __forceinline__ void operator()(const pg8::f32x4 (&acc)[2][2][4][2], const pg8::Unit& u, int wr, int wc, int fr, int fq) const {
        const int row0 = u.pm * 256 + wr * 64 + fr, col0 = u.pn * 256 + wc * 32 + 8 * fq;
#pragma unroll
        for (int ai = 0; ai < 2; ++ai)
#pragma unroll
            for (int m = 0; m < 4; ++m) { bf16* rowp = O + (size_t)(row0 + ai * 128 + m * 16) * ldc + col0;
#pragma unroll
                for (int bj = 0; bj < 2; ++bj) { const pg8::f32x4 v0 = acc[ai][bj][m][0], v1 = acc[ai][bj][m][1];
                    v4u w; w.x = pk2(v0[0], v0[1]); w.y = pk2(v0[2], v0[3]); w.z = pk2(v1[0], v1[1]); w.w = pk2(v1[2], v1[3]); *(v4u*)(rowp + bj * 128) = w; } }
    }
};
template <int PASS> struct EpiProj {
    static constexpr bool PERM = false, AFTER_DRAIN = false; float* Y; const bf16* Z; bf16* MIX;
    __device__ __forceinline__ void operator()(const pg8::f32x4 (&acc)[2][2][4][2], const pg8::Unit& u, int wr, int wc, int fr, int fq) const {
        const int row0 = u.pm * 256 + wr * 64 + fr, col0 = u.pn * 256 + wc * 32 + 4 * fq;
#pragma unroll
        for (int ai = 0; ai < 2; ++ai)
#pragma unroll
            for (int m = 0; m < 4; ++m) { const size_t row = (size_t)(row0 + ai * 128 + m * 16);
#pragma unroll
                for (int bj = 0; bj < 2; ++bj)
#pragma unroll
                    for (int n = 0; n < 2; ++n) { const int c = col0 + bj * 128 + n * 16;
                        const v2u gw = *(const v2u*)(Z + row * ZP + ZGT + PASS * 1024 + c);
                        f32x4 gv; gv.x = bflo(gw.x); gv.y = bfhi(gw.x); gv.z = bflo(gw.y); gv.w = bfhi(gw.y);
                        f32x4 v = acc[ai][bj][m][n] * gv; float* yp = Y + row * D + c;
                        if (PASS > 0) v += *(const f32x4*)yp;
                        if (PASS < 2) *(f32x4*)yp = v; else { v2u w; w.x = pk2(v.x, v.y); w.y = pk2(v.z, v.w); *(v2u*)(MIX + row * D + c) = w; } } }
    }
};

__device__ __forceinline__ void cvt_item(const float* W, int ldw, int sk0, int sn0, int nvalid, bf16* WT, int ldo, int orow0, int dk0, LAS float* scr, int lane) {
    const int n_ = lane & 31;
#pragma unroll 8
    for (int i = 0; i < 32; ++i) { const int kk = 2 * i + (lane >> 5); scr[kk * 33 + n_] = (n_ < nvalid) ? W[(size_t)(sk0 + kk) * ldw + sn0 + n_] : 0.f; }
    LDS_WAIT(); asm volatile("" ::: "memory");
    const int c = lane & 7;
#pragma unroll
    for (int j = 0; j < 4; ++j) { const int n = (lane >> 3) + 8 * j; const LAS float* s = scr + (8 * c) * 33 + n;
        v4u o; o.x = pk2(s[0 * 33], s[1 * 33]); o.y = pk2(s[2 * 33], s[3 * 33]); o.z = pk2(s[4 * 33], s[5 * 33]); o.w = pk2(s[6 * 33], s[7 * 33]);
        *(v4u*)(WT + (size_t)(orow0 + n) * ldo + dk0 + 8 * c) = o; }
    LDS_WAIT(); asm volatile("" ::: "memory");
}
__device__ __forceinline__ void convert_layer(CA a, int l, LAS unsigned char* lds, int gw, int NGW, int wave, int lane) {
    LAS float* scr = (LAS float*)(lds + wave * 16384);
    unsigned char* ws = a->ws;
    constexpr int I_UP = 16 * 176, I_DN = 44 * 32, I_IN = 16 * 272, I_PA = 8 * 32, I_PB = 16 * 32, I_LO = 4 * 48;
    constexpr int NITEMS = 2 * I_UP + 2 * I_DN + I_IN + 2 * I_PA + 2 * I_PB + I_LO;
    for (int it = gw; it < NITEMS; it += NGW) {
        int r = it;
        if (r < 2 * I_UP) { const int s = r / I_UP; r -= s * I_UP; const int kb = r / 176, ob = r % 176, orow0 = 32 * ob, pn = orow0 >> 8, wi = orow0 & 255;
            const int sn0 = (wi < 128) ? (128 * pn + wi) : (DFF + 128 * pn + wi - 128);
            cvt_item(a->in[6] + (size_t)(l * 2 + s) * D * 2 * DFF, 2 * DFF, 64 * kb, sn0, 32, (bf16*)(ws + (s ? W_UP1 : W_UP0)), D, orow0, 64 * kb, scr, lane); continue; }
        r -= 2 * I_UP;
        if (r < 2 * I_DN) { const int s = r / I_DN; r -= s * I_DN; const int kb = r / 32, ob = r % 32;
            cvt_item(a->in[7] + (size_t)(l * 2 + s) * DFF * D, D, 64 * kb, 32 * ob, 32, (bf16*)(ws + (s ? W_DN1 : W_DN0)), DFF, 32 * ob, 64 * kb, scr, lane); continue; }
        r -= 2 * I_DN;
        if (r < I_IN) { const int kb = r / 272, ob = r % 272, orow0 = 32 * ob; int sn0, nv;
            if (orow0 < 1536) { sn0 = orow0; nv = 32; } else if (orow0 < ZFL) { sn0 = orow0 + 8; nv = 32; } else if (orow0 == ZFL) { sn0 = 1536; nv = 8; } else { sn0 = 0; nv = 0; }
            cvt_item(a->in[8] + (size_t)l * D * 8456, 8456, 64 * kb, sn0, nv, (bf16*)(ws + W_IN), D, orow0, 64 * kb, scr, lane); continue; }
        r -= I_IN;
        if (r < I_PA) { const int kb = r / 32, ob = r % 32; cvt_item(a->in[28] + (size_t)l * 512 * D, D, 64 * kb, 32 * ob, 32, (bf16*)(ws + W_PA), 512, 32 * ob, 64 * kb, scr, lane); continue; }
        r -= I_PA;
        if (r < I_PB) { const int kb = r / 32, ob = r % 32; cvt_item(a->in[29] + (size_t)l * D * D, D, 64 * kb, 32 * ob, 32, (bf16*)(ws + W_PB), D, 32 * ob, 64 * kb, scr, lane); continue; }
        r -= I_PB;
        if (r < I_PA) { const int kb = r / 32, ob = r % 32; cvt_item(a->in[30] + (size_t)l * 512 * D, D, 64 * kb, 32 * ob, 32, (bf16*)(ws + W_PC), 512, 32 * ob, 64 * kb, scr, lane); continue; }
        r -= I_PA;
        if (r < I_PB) { const int kb = r / 32, ob = r % 32; cvt_item(a->in[31] + (size_t)l * D * D, D, 64 * kb, 32 * ob, 32, (bf16*)(ws + W_OUT), D, 32 * ob, 64 * kb, scr, lane); continue; }
        r -= I_PB;
        {
            const int kb = r / 48, ob = r % 48, reg = ob / 16, nb = ob % 16; const float* W = a->in[19]; int sk0 = 0, nv = 0;
            if (reg == 0 && kb == 0) { W = a->in[19] + (size_t)l * 64 * 512; nv = 32; }
            else if (reg == 1 && kb == 1) { W = a->in[21] + (size_t)l * 64 * 512; nv = 32; }
            else if (reg == 2 && kb >= 2) { W = a->in[22] + (size_t)l * 128 * 512; sk0 = 64 * (kb - 2); nv = 32; }
            cvt_item(W, 512, sk0, 32 * nb, nv, (bf16*)(ws + W_LORA), 256, 32 * ob, 64 * kb, scr, lane); }
    }
}

__device__ __forceinline__ void row_stats(const f32x4 (&v)[4], float& mean, float& rstd) {
    float s = 0.f;
#pragma unroll
    for (int j = 0; j < 4; ++j) s += (v[j].x + v[j].y) + (v[j].z + v[j].w);
    mean = wave_sum(s) * (1.f / D); float s2 = 0.f;
#pragma unroll
    for (int j = 0; j < 4; ++j) { const f32x4 d = v[j] - mean; s2 += (d.x * d.x + d.y * d.y) + (d.z * d.z + d.w * d.w); }
    rstd = 1.f / sqrtf(wave_sum(s2) * (1.f / D) + LN_EPS);
}
__device__ __forceinline__ void store_mod(const f32x4 (&v)[4], float mean, float rstd, const float* sh, const float* sc, bf16* hrow, int lane) {
#pragma unroll
    for (int j = 0; j < 4; ++j) { const int c = 4 * lane + 256 * j; const f32x4 s1 = *(const f32x4*)(sc + c) + 1.f, s0 = *(const f32x4*)(sh + c);
        const f32x4 h = (v[j] - mean) * rstd * s1 + s0; v2u w; w.x = pk2(h.x, h.y); w.y = pk2(h.z, h.w); *(v2u*)(hrow + c) = w; }
}
__device__ __forceinline__ void ln_phase(const float* xsrc, const float* Y, float* xout, bf16* H, const float* lng, const float* lnb, const float* sh, const float* sc, bool do_mod, int gw, int NGW, int lane) {
    for (int m = gw; m < M; m += NGW) {
        f32x4 v[4];
#pragma unroll
        for (int j = 0; j < 4; ++j) { const size_t o = (size_t)m * D + 4 * lane + 256 * j; v[j] = *(const f32x4*)(xsrc + o) * ALPHA + *(const f32x4*)(Y + o); }
        float mean, rstd; row_stats(v, mean, rstd);
#pragma unroll
        for (int j = 0; j < 4; ++j) { const int c = 4 * lane + 256 * j; v[j] = (v[j] - mean) * rstd * *(const f32x4*)(lng + c) + *(const f32x4*)(lnb + c); *(f32x4*)(xout + (size_t)m * D + c) = v[j]; }
        if (do_mod) { row_stats(v, mean, rstd); store_mod(v, mean, rstd, sh, sc, H + (size_t)m * D, lane); }
    }
}
__device__ __forceinline__ void mod_phase(const float* x, bf16* H, const float* sh, const float* sc, int gw, int NGW, int lane) {
    for (int m = gw; m < M; m += NGW) {
        f32x4 v[4];
#pragma unroll
        for (int j = 0; j < 4; ++j) v[j] = *(const f32x4*)(x + (size_t)m * D + 4 * lane + 256 * j);
        float mean, rstd; row_stats(v, mean, rstd); store_mod(v, mean, rstd, sh, sc, H + (size_t)m * D, lane);
    }
}
__device__ __forceinline__ void ada_phase(CA a, LAS unsigned char* lds, int tid, int lane, int wave) {
    LAS float* cact = (LAS float*)lds; LAS float* part = cact + 1024;
    for (int i = tid; i < D; i += NTHR) { const float c = a->in[1][i]; cact[i] = c * sigm(c); }
    __syncthreads();
    float* ADA = (float*)(a->ws + WS_ADA);
    for (int task = blockIdx.x; task < NL * 144; task += gridDim.x) {
        const int l = task / 144, col = (task % 144) * 64 + lane; const float* W = a->in[2] + (size_t)l * D * 9216 + col; float s = 0.f;
#pragma unroll 16
        for (int k = wave * 128; k < wave * 128 + 128; ++k) s += cact[k] * W[(size_t)k * 9216];
        part[wave * 64 + lane] = s; __syncthreads();
        if (wave == 0) { float t = 0.f;
#pragma unroll
            for (int w = 0; w < 8; ++w) t += part[w * 64 + lane];
            ADA[l * 9216 + col] = t + a->in[3][l * 9216 + col]; }
        __syncthreads();
    }
}

__device__ __forceinline__ void fscan_head(const bf16* Z, const float* fbias, float* FL2, int h, LAS unsigned char* lds, int tid, int lane, int wave) {
    LAS float* wt = (LAS float*)lds; const float fb = fbias[h]; float lf[32]; float run = 0.f;
#pragma unroll
    for (int i = 0; i < 32; ++i) { const float x = bf1(Z[(size_t)(tid * 32 + i) * ZP + ZFL + h]) + fb; run += -softplus_(-x); lf[i] = run; }
    float inc = run;
#pragma unroll
    for (int o = 1; o < 64; o <<= 1) { const float t = __shfl_up(inc, o); if (lane >= o) inc += t; }
    if (lane == 63) wt[wave] = inc;
    __syncthreads();
    float base = inc - run;
    for (int w = 0; w < wave; ++w) base += wt[w];
#pragma unroll
    for (int i = 0; i < 32; ++i) FL2[(size_t)h * M + tid * 32 + i] = (base + lf[i]) * LOG2E;
    __syncthreads();
}
__device__ __forceinline__ void codes_phase(const bf16* Z, const float* mu, bf16* CODES, int gtid, int NGT) {
    for (int it = gtid; it < M * 32; it += NGT) { const int t = it >> 5, j0 = (it & 31) * 8;
        const v4u z = *(const v4u*)(Z + (size_t)t * ZP + ZRW + 1536 + j0); v4u zp = (v4u){0u, 0u, 0u, 0u};
        if (t > 0) zp = *(const v4u*)(Z + (size_t)(t - 1) * ZP + ZRW + 1536 + j0);
        float o[8];
#pragma unroll
        for (int q = 0; q < 4; ++q) { const float a0 = bflo(z[q]), a1 = bfhi(z[q]), p0 = bflo(zp[q]), p1 = bfhi(zp[q]); const float m0 = mu[1536 + j0 + 2 * q], m1 = mu[1536 + j0 + 2 * q + 1];
            o[2 * q] = a0 + (p0 - a0) * m0; o[2 * q + 1] = a1 + (p1 - a1) * m1; }
#pragma unroll
        for (int q = 0; q < 8; ++q) { if (j0 < 64) o[q] = tanh_(o[q]); else if (j0 >= 128) o[q] = sigm(o[q]); }
        v4u w; w.x = pk2(o[0], o[1]); w.y = pk2(o[2], o[3]); w.z = pk2(o[4], o[5]); w.w = pk2(o[6], o[7]); *(v4u*)(CODES + (size_t)t * 256 + j0) = w; }
}
__device__ __forceinline__ void lru_l1(CA a, int l, const bf16* Z, bf16* HLOC, bf16* ACUM, float* AEND, float* HEND, LAS unsigned char* lds, int tid, int lane, int wave) {
    LAS float* xcf = (LAS float*)lds; LAS bf16* xcb = (LAS bf16*)(lds + 16640); LAS bf16* wga = (LAS bf16*)(lds + 25856); LAS bf16* wgx = (LAS bf16*)(lds + 35072);
    LAS float* la = (LAS float*)(lds + 44288); LAS float* lu = (LAS float*)(lds + 60928); LAS float* agg = (LAS float*)(lds + 77568);
    const float* cw = a->in[10] + (size_t)l * 4 * D; const float* cb = a->in[11] + (size_t)l * D;
    const float* gaw = a->in[12] + (size_t)l * 16 * 4096; const float* gab = a->in[13] + (size_t)l * D;
    const float* gxw = a->in[14] + (size_t)l * 16 * 4096; const float* gxb = a->in[15] + (size_t)l * D; const float* lam = a->in[16] + (size_t)l * D;
    int nprev = -1;
    for (int task = blockIdx.x; task < NCH * 16; task += gridDim.x) {
        const int c = task >> 4, n = task & 15, t0 = c * LC;
        {
            const int tok = tid >> 3, cg8 = (tid & 7) * 8, ch0 = n * 64 + cg8; float acc[8];
#pragma unroll
            for (int q = 0; q < 8; ++q) acc[q] = cb[ch0 + q];
#pragma unroll
            for (int j = 0; j < 4; ++j) { const int tt = t0 + tok - 3 + j;
                if (tt >= 0) { const v4u x = *(const v4u*)(Z + (size_t)tt * ZP + ZXB + ch0);
#pragma unroll
                    for (int q = 0; q < 4; ++q) { acc[2 * q] += cw[j * D + ch0 + 2 * q] * bflo(x[q]); acc[2 * q + 1] += cw[j * D + ch0 + 2 * q + 1] * bfhi(x[q]); } } }
#pragma unroll
            for (int q = 0; q < 8; ++q) xcf[tok * 65 + cg8 + q] = acc[q];
            v4u w; w.x = pk2(acc[0], acc[1]); w.y = pk2(acc[2], acc[3]); w.z = pk2(acc[4], acc[5]); w.w = pk2(acc[6], acc[7]); *(LAS v4u*)(xcb + tok * 72 + cg8) = w;
        }
        if (n != nprev) {
            const int i = tid >> 3, j0 = (tid & 7) * 8;
#pragma unroll
            for (int q = 0; q < 8; ++q) { wga[(j0 + q) * 72 + i] = (bf16)f2bf(gaw[(size_t)n * 4096 + i * 64 + j0 + q]); wgx[(j0 + q) * 72 + i] = (bf16)f2bf(gxw[(size_t)n * 4096 + i * 64 + j0 + q]); }
            nprev = n;
        }
        __syncthreads();
        {
            const int tb = wave & 3, cbp = wave >> 2, fr = lane & 15, fq = lane >> 4;
            bf16x8 af[2];
#pragma unroll
            for (int kk = 0; kk < 2; ++kk) af[kk] = *(const LAS bf16x8*)(xcb + (tb * 16 + fr) * 72 + kk * 32 + fq * 8);
#pragma unroll
            for (int c2 = 0; c2 < 2; ++c2) { const int cbk = 2 * cbp + c2; f32x4 ar = (f32x4){0.f, 0.f, 0.f, 0.f}, ai = ar;
#pragma unroll
                for (int kk = 0; kk < 2; ++kk) { const bf16x8 b0 = *(const LAS bf16x8*)(wga + (cbk * 16 + fr) * 72 + kk * 32 + fq * 8), b1 = *(const LAS bf16x8*)(wgx + (cbk * 16 + fr) * 72 + kk * 32 + fq * 8);
                    ar = __builtin_amdgcn_mfma_f32_16x16x32_bf16(af[kk], b0, ar, 0, 0, 0); ai = __builtin_amdgcn_mfma_f32_16x16x32_bf16(af[kk], b1, ai, 0, 0, 0); }
                const int ch = cbk * 16 + fr, gch = n * 64 + ch; const float bga = gab[gch], bgx = gxb[gch], sp = log1pf(__expf(-lam[gch]));
#pragma unroll
                for (int rg = 0; rg < 4; ++rg) { const int tok = tb * 16 + fq * 4 + rg; const float r = sigm(ar[rg] + bga), ig = sigm(ai[rg] + bgx);
                    const float log_a = -8.f * r * sp, av = __expf(log_a), uv = sqrtf(-expm1f(2.f * log_a)) * (ig * xcf[tok * 65 + ch]);
                    la[tok * 65 + ch] = av; lu[tok * 65 + ch] = uv; } }
        }
        __syncthreads();
        {
            float hl[8], al[8]; float A = 1.f, h = 0.f;
#pragma unroll
            for (int s = 0; s < 8; ++s) { const float av = la[(wave * 8 + s) * 65 + lane], uv = lu[(wave * 8 + s) * 65 + lane]; h = av * h + uv; A *= av; hl[s] = h; al[s] = A; }
            agg[(wave * 2 + 0) * 64 + lane] = A; agg[(wave * 2 + 1) * 64 + lane] = h;
            __syncthreads();
            float cA = 1.f, cH = 0.f;
            for (int w = 0; w < wave; ++w) { const float A2 = agg[(w * 2 + 0) * 64 + lane], h2 = agg[(w * 2 + 1) * 64 + lane]; cH = A2 * cH + h2; cA *= A2; }
            float hf = 0.f, Af = 1.f;
#pragma unroll
            for (int s = 0; s < 8; ++s) { hf = hl[s] + al[s] * cH; Af = al[s] * cA; const size_t o = (size_t)(t0 + wave * 8 + s) * D + n * 64 + lane; HLOC[o] = (bf16)f2bf(hf); ACUM[o] = (bf16)f2bf(Af); }
            if (wave == 7) { AEND[c * D + n * 64 + lane] = Af; HEND[c * D + n * 64 + lane] = hf; }
        }
        __syncthreads();
    }
}
__device__ __forceinline__ void lru_l2(const float* AEND, const float* HEND, float* CAR, int gw, int lane) {
    if (gw < 16) { const int ch = gw * 64 + lane; float carry = 0.f;
#pragma unroll 8
        for (int c = 0; c < NCH; ++c) { CAR[c * D + ch] = carry; carry = AEND[c * D + ch] * carry + HEND[c * D + ch]; } }
}
__device__ __forceinline__ void lru_l3(bf16* Z, const bf16* HLOC, const bf16* ACUM, const float* CAR, int gtid, int NGT) {
    for (int it = gtid; it < M * 128; it += NGT) { const int t = it >> 7, ch0 = (it & 127) * 8; const size_t o = (size_t)t * D + ch0;
        const v4u hl = *(const v4u*)(HLOC + o), ac = *(const v4u*)(ACUM + o), yb = *(const v4u*)(Z + (size_t)t * ZP + ZYB + ch0);
        const f32x4 c0 = *(const f32x4*)(CAR + (t >> 6) * D + ch0), c1 = *(const f32x4*)(CAR + (t >> 6) * D + ch0 + 4); float o8[8];
#pragma unroll
        for (int q = 0; q < 4; ++q) { const float ca = (q < 2) ? c0[2 * q] : c1[2 * q - 4], cb_ = (q < 2) ? c0[2 * q + 1] : c1[2 * q - 3];
            o8[2 * q] = (bflo(hl[q]) + bflo(ac[q]) * ca) * gelu_tanh(bflo(yb[q])); o8[2 * q + 1] = (bfhi(hl[q]) + bfhi(ac[q]) * cb_) * gelu_tanh(bfhi(yb[q])); }
        v4u w; w.x = pk2(o8[0], o8[1]); w.y = pk2(o8[2], o8[3]); w.z = pk2(o8[4], o8[5]); w.w = pk2(o8[6], o8[7]); *(v4u*)(Z + (size_t)t * ZP + ZYB + ch0) = w; }
}
__device__ __forceinline__ void rw_prep(CA a, int l, const bf16* Z, const bf16* LORA, float* Wd, bf16* R, bf16* KF, bf16* V, bf16* KK, bf16* Bv, bf16* GB, float* BON, int gw, int NGW, int lane) {
    const float* mu = a->in[17] + (size_t)l * 1792; const float* w0 = a->in[18] + (size_t)l * 512; const float* a0 = a->in[20] + (size_t)l * 512;
    const float* k_k = a->in[23] + (size_t)l * 512; const float* k_a = a->in[24] + (size_t)l * 512; const float* r_k = a->in[25] + (size_t)l * 512;
    for (int it = gw; it < M * 8; it += NGW) { const int t = it >> 3, h = it & 7, col = h * 64 + lane; const bf16* zr = Z + (size_t)t * ZP + ZRW + col;
        float r = bf1(zr[0]), k = bf1(zr[512]), v = bf1(zr[1024]); float rp = 0.f, kp = 0.f, vp = 0.f;
        if (t > 0) { rp = bf1(zr[-ZP]); kp = bf1(zr[512 - ZP]); vp = bf1(zr[1024 - ZP]); }
        r += (rp - r) * mu[col]; k += (kp - k) * mu[512 + col]; v += (vp - v) * mu[1024 + col];
        const bf16* lo = LORA + (size_t)t * 1536 + col; const float lw = bf1(lo[0]), lav = bf1(lo[512]);
        const float wv = -softplus_(-(w0[col] + lw)) - 0.5f, decay = __expf(-__expf(wv)); const float av = sigm(a0[col] + lav);
        float kk = k * k_k[col]; const float nrm = sqrtf(wave_sum(kk * kk)); kk = kk / fmaxf(nrm, 1e-12f);
        const float kf = k * (1.f + (av - 1.f) * k_a[col]); const float bon = wave_sum(r * kf * r_k[col]);
        const size_t o = (size_t)t * 512 + col;
        Wd[o] = decay; R[o] = (bf16)f2bf(r); KF[o] = (bf16)f2bf(kf); V[o] = (bf16)f2bf(v); KK[o] = (bf16)f2bf(kk); Bv[o] = (bf16)f2bf(kk * av); GB[o] = lo[1024];
        if (lane == 0) BON[t * 8 + h] = bon; }
}
template <bool WITH_V> __device__ __forceinline__ void rw_step(float (&st)[64], cu32p pk, cu32p pb, cu32p pf, cf32p pw, float vv) {
    float s0 = 0.f, s1 = 0.f, s2 = 0.f, s3 = 0.f;
#pragma unroll
    for (int k2 = 0; k2 < 32; k2 += 2) { const unsigned u0 = pk[k2], u1 = pk[k2 + 1]; s0 += st[2 * k2] * bflo(u0); s1 += st[2 * k2 + 1] * bfhi(u0); s2 += st[2 * k2 + 2] * bflo(u1); s3 += st[2 * k2 + 3] * bfhi(u1); }
    const float sa = -((s0 + s1) + (s2 + s3));
#pragma unroll
    for (int k2 = 0; k2 < 32; ++k2) { const unsigned ub = pb[k2]; float t0 = sa * bflo(ub), t1 = sa * bfhi(ub);
        if (WITH_V) { const unsigned uf = pf[k2]; t0 += vv * bflo(uf); t1 += vv * bfhi(uf); }
        st[2 * k2] = st[2 * k2] * pw[2 * k2] + t0; st[2 * k2 + 1] = st[2 * k2 + 1] * pw[2 * k2 + 1] + t1; }
}
__device__ __forceinline__ void rw_touch(const unsigned char* ws, const RwSet rs, int h, int c, bool with_r, int lane) {
    const size_t o = ((size_t)(c * LC + lane) * 512 + h * 64); unsigned acc = 0u;
    const unsigned char* p16[4] = {ws + rs.kk + o * 2, ws + rs.b + o * 2, ws + rs.kf + o * 2, ws + rs.r + o * 2};
#pragma unroll
    for (int q = 0; q < 4; ++q) if (q < 3 || with_r) { acc ^= *(const unsigned*)(p16[q]); acc ^= *(const unsigned*)(p16[q] + 64); }
    const unsigned char* pw = ws + rs.w + o * 4;
#pragma unroll
    for (int q = 0; q < 4; ++q) acc ^= *(const unsigned*)(pw + 64 * q);
    asm volatile("" :: "v"(acc));
}
__device__ __forceinline__ void rw_step2(float (&sp)[64], float (&sg)[64], cu32p pk, cu32p pb, cu32p pf, cf32p pw, float vv) {
    float p0 = 0.f, p1 = 0.f, g0 = 0.f, g1 = 0.f;
#pragma unroll
    for (int k2 = 0; k2 < 32; ++k2) { const unsigned u0 = pk[k2]; const float lo = bflo(u0), hi = bfhi(u0); p0 += sp[2 * k2] * lo; p1 += sp[2 * k2 + 1] * hi; g0 += sg[2 * k2] * lo; g1 += sg[2 * k2 + 1] * hi; }
    const float sap = -(p0 + p1), sag = -(g0 + g1);
#pragma unroll
    for (int k2 = 0; k2 < 32; ++k2) { const unsigned ub = pb[k2], uf = pf[k2]; const float bl = bflo(ub), bh = bfhi(ub), w0 = pw[2 * k2], w1 = pw[2 * k2 + 1];
        sp[2 * k2] = sp[2 * k2] * w0 + sap * bl; sp[2 * k2 + 1] = sp[2 * k2 + 1] * w1 + sap * bh;
        sg[2 * k2] = sg[2 * k2] * w0 + (sag * bl + vv * bflo(uf)); sg[2 * k2 + 1] = sg[2 * k2 + 1] * w1 + (sag * bh + vv * bfhi(uf)); }
}
__device__ __forceinline__ void rw_r1(const unsigned char* ws, const RwSet rs, float* P, float* G, int gw, int NGW, int lane) {
    for (int T = gw; T < NCH * 8; T += NGW) { const int h = T & 7, c = T >> 3; float sp[64], sg[64];
        rw_touch(ws, rs, h, c, false, lane);
#pragma unroll
        for (int k = 0; k < 64; ++k) { sp[k] = (k == lane) ? 1.f : 0.f; sg[k] = 0.f; }
        const bf16* Vb = (const bf16*)(ws + WS_RW_V);
        for (int t = c * LC; t < c * LC + LC; ++t) { const size_t o = (size_t)t * 512 + h * 64;
            cu32p pk = (cu32p)(uintptr_t)(ws + rs.kk + o * 2), pb = (cu32p)(uintptr_t)(ws + rs.b + o * 2), pf = (cu32p)(uintptr_t)(ws + rs.kf + o * 2); cf32p pw = (cf32p)(uintptr_t)(ws + rs.w + o * 4);
            rw_step2(sp, sg, pk, pb, pf, pw, bf1(Vb[o + lane])); }
        float* dp = P + ((size_t)(h * NCH + c) * 64 + lane) * 64; float* dg = G + ((size_t)(h * NCH + c) * 64 + lane) * 64;
#pragma unroll
        for (int k = 0; k < 64; k += 4) { *(f32x4*)(dp + k) = (f32x4){sp[k], sp[k + 1], sp[k + 2], sp[k + 3]}; *(f32x4*)(dg + k) = (f32x4){sg[k], sg[k + 1], sg[k + 2], sg[k + 3]}; } }
}
__device__ __forceinline__ void rw_r2(const float* P, const float* G, float* S0, LAS unsigned char* lds, int lane, int wave) {
    LAS float* red = (LAS float*)lds;
    for (int rp = blockIdx.x; rp < 256; rp += gridDim.x) { const int h = rp >> 5, v0 = (rp & 31) * 2; float s0 = 0.f, s1 = 0.f;
        const float* Ph = P + (size_t)h * NCH * 4096 + (size_t)(8 * wave) * 64 + lane; const float* Gh = G + (size_t)h * NCH * 4096 + (size_t)v0 * 64 + lane; float* Sh = S0 + (size_t)h * NCH * 4096 + (size_t)v0 * 64 + lane;
        float pq[8][8], gq[8][2];
#pragma unroll
        for (int d = 0; d < 8; ++d) {
#pragma unroll
            for (int jj = 0; jj < 8; ++jj) pq[d][jj] = Ph[(size_t)d * 4096 + jj * 64];
            gq[d][0] = Gh[(size_t)d * 4096]; gq[d][1] = Gh[(size_t)d * 4096 + 64]; }
        for (int c0 = 0; c0 < NCH; c0 += 8) {
#pragma unroll
            for (int d = 0; d < 8; ++d) { const int c = c0 + d;
                if (wave == 0) { Sh[(size_t)c * 4096] = s0; Sh[(size_t)c * 4096 + 64] = s1; }
                float p0 = 0.f, p1 = 0.f;
#pragma unroll
                for (int jj = 0; jj < 8; ++jj) { const float a0 = __builtin_bit_cast(float, __builtin_amdgcn_readlane(__builtin_bit_cast(int, s0), 8 * wave + jj)), a1 = __builtin_bit_cast(float, __builtin_amdgcn_readlane(__builtin_bit_cast(int, s1), 8 * wave + jj));
                    p0 += a0 * pq[d][jj]; p1 += a1 * pq[d][jj]; }
                LAS float* rd = red + (c & 1) * 1024;
                rd[(wave * 2 + 0) * 64 + lane] = p0; rd[(wave * 2 + 1) * 64 + lane] = p1;
                const float g0 = gq[d][0], g1 = gq[d][1];
                if (c + 8 < NCH) {
#pragma unroll
                    for (int jj = 0; jj < 8; ++jj) pq[d][jj] = Ph[(size_t)(c + 8) * 4096 + jj * 64];
                    gq[d][0] = Gh[(size_t)(c + 8) * 4096]; gq[d][1] = Gh[(size_t)(c + 8) * 4096 + 64]; }
                asm volatile("s_waitcnt lgkmcnt(0)\n\ts_barrier" ::: "memory");
                float n0 = g0, n1 = g1;
#pragma unroll
                for (int w = 0; w < 8; ++w) { n0 += rd[(w * 2 + 0) * 64 + lane]; n1 += rd[(w * 2 + 1) * 64 + lane]; }
                s0 = n0; s1 = n1; }
        }
        __syncthreads();
    }
}
__device__ __forceinline__ void rw_r3(CA a, int l, const unsigned char* ws, const RwSet rs, const float* S0, const float* BON, bf16* RWO, LAS unsigned char* lds, int gw, int NGW, int lane, int wave) {
    LAS float* yl = (LAS float*)(lds + wave * 16640);
    const float* gnw = a->in[26] + (size_t)l * 512; const float* gnb = a->in[27] + (size_t)l * 512;
    const bf16* Vb = (const bf16*)(ws + WS_RW_V); const bf16* GB = (const bf16*)(ws + WS_GB);
    for (int T = gw; T < NCH * 8; T += NGW) { const int h = T & 7, c = T >> 3; float st[64];
        rw_touch(ws, rs, h, c, true, lane);
        const float* src = S0 + ((size_t)(h * NCH + c) * 64 + lane) * 64;
#pragma unroll
        for (int k = 0; k < 64; k += 4) { const f32x4 v4 = *(const f32x4*)(src + k); st[k] = v4.x; st[k + 1] = v4.y; st[k + 2] = v4.z; st[k + 3] = v4.w; }
        for (int tt = 0; tt < LC; ++tt) { const size_t o = (size_t)(c * LC + tt) * 512 + h * 64;
            cu32p pk = (cu32p)(uintptr_t)(ws + rs.kk + o * 2), pb = (cu32p)(uintptr_t)(ws + rs.b + o * 2), pf = (cu32p)(uintptr_t)(ws + rs.kf + o * 2), pr = (cu32p)(uintptr_t)(ws + rs.r + o * 2); cf32p pw = (cf32p)(uintptr_t)(ws + rs.w + o * 4);
            rw_step<true>(st, pk, pb, pf, pw, bf1(Vb[o + lane]));
            float y0 = 0.f, y1 = 0.f, y2 = 0.f, y3 = 0.f;
#pragma unroll
            for (int k2 = 0; k2 < 32; k2 += 2) { const unsigned u0 = pr[k2], u1 = pr[k2 + 1]; y0 += st[2 * k2] * bflo(u0); y1 += st[2 * k2 + 1] * bfhi(u0); y2 += st[2 * k2 + 2] * bflo(u1); y3 += st[2 * k2 + 3] * bfhi(u1); }
            yl[tt * 65 + lane] = (y0 + y1) + (y2 + y3); }
        LDS_WAIT(); asm volatile("" ::: "memory");
        {
            const int t = c * LC + lane; float y[64]; float s = 0.f;
#pragma unroll
            for (int v = 0; v < 64; ++v) { y[v] = yl[lane * 65 + v]; s += y[v]; }
            const float mean = s * (1.f / 64.f); float q = 0.f;
#pragma unroll
            for (int v = 0; v < 64; ++v) { const float d = y[v] - mean; q += d * d; }
            const float rstd = 1.f / sqrtf(q * (1.f / 64.f) + GN_EPS); const float bon = BON[t * 8 + h];
            const size_t o = (size_t)t * 512 + h * 64;
#pragma unroll
            for (int v8 = 0; v8 < 64; v8 += 8) { const v4u vv = *(const v4u*)(Vb + o + v8), gg = *(const v4u*)(GB + o + v8); float ov[8];
#pragma unroll
                for (int q2 = 0; q2 < 4; ++q2) { const int v = v8 + 2 * q2;
                    ov[2 * q2] = ((y[v] - mean) * rstd * gnw[h * 64 + v] + gnb[h * 64 + v] + bon * bflo(vv[q2])) * bflo(gg[q2]);
                    ov[2 * q2 + 1] = ((y[v + 1] - mean) * rstd * gnw[h * 64 + v + 1] + gnb[h * 64 + v + 1] + bon * bfhi(vv[q2])) * bfhi(gg[q2]); }
                v4u w; w.x = pk2(ov[0], ov[1]); w.y = pk2(ov[2], ov[3]); w.z = pk2(ov[4], ov[5]); w.w = pk2(ov[6], ov[7]); *(v4u*)(RWO + o + v8) = w; }
        }
        LDS_WAIT(); asm volatile("" ::: "memory");
    }
}

#define XB_TMO      128
#define XB_XCNT(j)  (256  + 64 * (j))
#define XB_XSUB(j)  (1280 + 64 * (j))
#define XB_XGEN(j)  (2304 + 64 * (j))
#define XB_TOP      3328
#define XB_TOPGEN   3392
#define XCD_BAR_WORDS 3456
#define XB_SPIN_CAP (1u << 18)

__device__ __forceinline__ unsigned xb_ld(unsigned* p)              { return __hip_atomic_load(p, __ATOMIC_RELAXED, __HIP_MEMORY_SCOPE_AGENT); }
__device__ __forceinline__ unsigned xb_add(unsigned* p, unsigned v) { return __hip_atomic_fetch_add(p, v, __ATOMIC_RELAXED, __HIP_MEMORY_SCOPE_AGENT); }
__device__ __forceinline__ unsigned xb_xcc_id() { return (unsigned)__builtin_amdgcn_s_getreg((3 << 11) | 20) & 0xFu; }
#define XB_SPIN(cond, bar) do { unsigned _sp = 0; while (cond) { __builtin_amdgcn_s_sleep(1); \
    if ((++_sp & 255u) == 0u) { if (xb_ld(&(bar)[XB_TMO])) break; if (_sp > XB_SPIN_CAP) { atomicAdd(&(bar)[XB_TMO], 1u); break; } } } } while (0)

struct XcdBarrier {
    unsigned* bar; unsigned x;
    volatile LAS unsigned* st;
};

__device__ __forceinline__ XcdBarrier xcd_barrier_post(unsigned* bar, volatile LAS unsigned* st) {
    XcdBarrier b; b.bar = bar; b.x = xb_xcc_id(); b.st = st;
    if (threadIdx.x == 0) (void)xb_add(&bar[XB_XCNT(b.x)], 1u);
    return b;
}
__device__ __forceinline__ void xcd_barrier_complete(unsigned* bar, unsigned x, unsigned& nloc, unsigned& nx) {
    const unsigned G = gridDim.x * gridDim.y * gridDim.z;
    unsigned sum, cnt, mine, sp = 0u;
    for (;;) {
        sum = 0u; cnt = 0u; mine = 0u;
#pragma unroll
        for (unsigned j = 0; j < 16; ++j) { const unsigned c = xb_ld(&bar[XB_XCNT(j)]); sum += c; cnt += (c > 0u) ? 1u : 0u; mine = (j == x) ? c : mine; }
        if (sum == G) break;
        __builtin_amdgcn_s_sleep(1);
        if ((++sp & 255u) == 0u) { if (xb_ld(&bar[XB_TMO])) break; if (sp > XB_SPIN_CAP) { atomicAdd(&bar[XB_TMO], 1u); break; } }
    }
    nloc = mine > 0u ? mine : 1u; nx = cnt > 0u ? cnt : 1u;
}

__device__ __forceinline__ void xcd_barrier(const XcdBarrier& b) {
    asm volatile("s_waitcnt vmcnt(0)" ::: "memory");
    __syncthreads();
    if (threadIdx.x == 0) {
        unsigned* bar = b.bar;
        __builtin_amdgcn_s_waitcnt(0);
        unsigned nloc = b.st[0], nx = b.st[1];
        if (nloc == 0u) { xcd_barrier_complete(bar, b.x, nloc, nx); b.st[0] = nloc; b.st[1] = nx; }
        const unsigned old = xb_add(&bar[XB_XSUB(b.x)], 1u);
        const unsigned gen = old / nloc;
        if (old + 1u == (gen + 1u) * nloc) {
            __builtin_amdgcn_fence(__ATOMIC_RELEASE, "agent");
            asm volatile("s_waitcnt vmcnt(0)" ::: "memory");
            const unsigned og = xb_add(&bar[XB_TOP], 1u);
            const unsigned tg = og / nx;
            if (og + 1u == (tg + 1u) * nx) xb_add(&bar[XB_TOPGEN], 1u);
            else XB_SPIN(xb_ld(&bar[XB_TOPGEN]) == tg, bar);
            __builtin_amdgcn_fence(__ATOMIC_ACQUIRE, "agent");
            xb_add(&bar[XB_XGEN(b.x)], 1u);
            asm volatile("s_waitcnt vmcnt(0)" ::: "memory");
        } else {
            XB_SPIN(xb_ld(&bar[XB_XGEN(b.x)]) == gen, bar);
            __builtin_amdgcn_fence(__ATOMIC_ACQUIRE, "agent");
            asm volatile("s_waitcnt vmcnt(0)" ::: "memory");
        }
    }
    __syncthreads();
}

__device__ __forceinline__ unsigned char* args_ws_ptr() { CA a = (CA)__builtin_amdgcn_kernarg_segment_ptr(); return a->ws; }
__global__ void __launch_bounds__(NTHR, 2) fwd_mega(Args args_unused) {
    extern __shared__ __attribute__((aligned(16))) unsigned char lds_raw[];
    LAS unsigned char* lds = (LAS unsigned char*)lds_raw;
    cg::grid_group grid = cg::this_grid();
    if (threadIdx.x < 16) ((LAS unsigned*)(lds + MISC_OFF))[threadIdx.x] = 0u;
    __syncthreads();
    (void)xcd_barrier_post((unsigned*)args_ws_ptr(), (volatile LAS unsigned*)(lds + MISC_OFF));
    const int wave = __builtin_amdgcn_readfirstlane((int)threadIdx.x >> 6);
    const int G = gridDim.x, gw = blockIdx.x * NWAVES + wave, NGW = G * NWAVES, NGT = G * NTHR;
#define SYNC() do { XcdBarrier b_; { CA a_ = (CA)__builtin_amdgcn_kernarg_segment_ptr(); asm volatile("" : "+s"(a_)); b_.bar = (unsigned*)a_->ws; } b_.x = xb_xcc_id(); b_.st = (volatile LAS unsigned*)(lds + MISC_OFF); xcd_barrier(b_); } while (0)
#define PH_BEGIN { CA a = (CA)__builtin_amdgcn_kernarg_segment_ptr(); asm volatile("" : "+s"(a)); unsigned char* ws = a->ws; (void)ws; \
        int tid_l = threadIdx.x; asm volatile("" : "+v"(tid_l)); const int tid = tid_l, lane = tid & 63, gtid = blockIdx.x * NTHR + tid; (void)lane; (void)gtid;
#define PH_END }
#define WSP(T, off) ((T*)(ws + (off)))
#define ADA_L (WSP(float, WS_ADA) + l * 9216)
#define GEMM(EPI, Aptr, LDA, Bptr, N_, K_, ...) do { int kk_ = (K_); asm volatile("" : "+s"(kk_));   pg8::Gemm g_{(const pg8::bf16_t*)(Aptr), (const pg8::bf16_t*)(Bptr), M, (N_), kk_, (LDA)}; pg8::StaticOrder S_; S_.init(M, (N_), G, (int)blockIdx.x); \
        EPI E_{__VA_ARGS__}; pg8::gemm_phase<EPI, pg8::StaticOrder, PG8_ALIGN, PG8_SP2>(lds, g_, S_, E_); } while (0)

    PH_BEGIN ada_phase(a, lds, tid, lane, wave); PH_END
    grid.sync();
    PH_BEGIN mod_phase(a->in[0], WSP(bf16, WS_HB), WSP(float, WS_ADA), WSP(float, WS_ADA) + D, gw, NGW, lane); convert_layer(a, 0, lds, gw, NGW, wave, lane); PH_END
    SYNC();

    for (int l = 0; l < NL; ++l) {
        PH_BEGIN GEMM(EpiSwiGLU, WSP(bf16, WS_HB), D, ws + W_UP0, 2 * DFF, D, WSP(bf16, WS_ACT), DFF); PH_END
        SYNC();
        PH_BEGIN GEMM(EpiGateF32, WSP(bf16, WS_ACT), DFF, ws + W_DN0, D, DFF, WSP(float, WS_Y), ADA_L + 2 * D, 0.5f); PH_END
        SYNC();
        PH_BEGIN ln_phase(l == 0 ? a->in[0] : a->out, WSP(float, WS_Y), a->out, WSP(bf16, WS_HB), a->in[4] + (size_t)l * 3 * D, a->in[5] + (size_t)l * 3 * D, ADA_L + 3 * D, ADA_L + 4 * D, true, gw, NGW, lane); PH_END
        SYNC();
        PH_BEGIN GEMM(EpiIn, WSP(bf16, WS_HB), D, ws + W_IN, ZP, D, WSP(bf16, WS_Z)); PH_END
        SYNC();
        PH_BEGIN if (blockIdx.x < 8) fscan_head(WSP(bf16, WS_Z), a->in[9] + l * 8, WSP(float, WS_FL2), blockIdx.x, lds, tid, lane, wave); PH_END
        PH_BEGIN codes_phase(WSP(bf16, WS_Z), a->in[17] + (size_t)l * 1792, WSP(bf16, WS_CODES), gtid, NGT); PH_END
        PH_BEGIN lru_l1(a, l, WSP(bf16, WS_Z), WSP(bf16, WS_HLOC), WSP(bf16, WS_ACUM), WSP(float, WS_LAEND), WSP(float, WS_LHEND), lds, tid, lane, wave); PH_END
        SYNC();
        PH_BEGIN GEMM(EpiPlain, ws + WS_CODES, 256, ws + W_LORA, 1536, 256, WSP(bf16, WS_LORA), 1536); PH_END
        PH_BEGIN lru_l2(WSP(const float, WS_LAEND), WSP(const float, WS_LHEND), WSP(float, WS_LCAR), gw, lane); PH_END
        SYNC();
        PH_BEGIN const RwSet rs = rw_set(l); rw_prep(a, l, WSP(bf16, WS_Z), WSP(const bf16, WS_LORA), WSP(float, rs.w), WSP(bf16, rs.r), WSP(bf16, rs.kf), WSP(bf16, WS_RW_V), WSP(bf16, rs.kk), WSP(bf16, rs.b), WSP(bf16, WS_GB), WSP(float, WS_BON), gw, NGW, lane); PH_END
        PH_BEGIN lru_l3(WSP(bf16, WS_Z), WSP(const bf16, WS_HLOC), WSP(const bf16, WS_ACUM), WSP(const float, WS_LCAR), gtid, NGT); PH_END
        SYNC();
        PH_BEGIN rw_r1(ws, rw_set(l), WSP(float, WS_P), WSP(float, WS_G), gw, NGW, lane); PH_END
        SYNC();
        PH_BEGIN rw_r2(WSP(const float, WS_P), WSP(const float, WS_G), WSP(float, WS_S0), lds, lane, wave); PH_END
        SYNC();
        PH_BEGIN rw_r3(a, l, ws, rw_set(l), WSP(const float, WS_S0), WSP(const float, WS_BON), WSP(bf16, WS_RWO), lds, gw, NGW, lane, wave); PH_END
        __syncthreads();
        PH_BEGIN
            bf16* Zb = WSP(bf16, WS_Z);
            const attn_body::AttnTensors AT{(const attn_body::bf16*)(Zb + ZQ), (const attn_body::bf16*)(Zb + ZK), (const attn_body::bf16*)(Zb + ZV), (attn_body::bf16*)(Zb + ZXB), WSP(const float, WS_FL2)};
            const attn_body::StaticOrder S((int)G, (int)blockIdx.x);
            attn_body::attn_phase<attn_body::StaticOrder>((char*)lds_raw, AT, S);
        PH_END
        SYNC();
        PH_BEGIN GEMM(EpiProj<0>, WSP(bf16, WS_Z) + ZXB, ZP, ws + W_PA, D, 512, WSP(float, WS_Y), WSP(bf16, WS_Z), WSP(bf16, WS_HB)); PH_END
        __builtin_amdgcn_fence(__ATOMIC_SEQ_CST, "agent");
        PH_BEGIN GEMM(EpiProj<1>, WSP(bf16, WS_Z) + ZYB, ZP, ws + W_PB, D, D, WSP(float, WS_Y), WSP(bf16, WS_Z), WSP(bf16, WS_HB)); PH_END
        __builtin_amdgcn_fence(__ATOMIC_SEQ_CST, "agent");
        PH_BEGIN GEMM(EpiProj<2>, ws + WS_RWO, 512, ws + W_PC, D, 512, WSP(float, WS_Y), WSP(bf16, WS_Z), WSP(bf16, WS_HB)); PH_END
        SYNC();
        PH_BEGIN GEMM(EpiGateF32, WSP(bf16, WS_HB), D, ws + W_OUT, D, D, WSP(float, WS_Y), ADA_L + 5 * D, 1.0f); PH_END
        SYNC();
        PH_BEGIN ln_phase(a->out, WSP(float, WS_Y), a->out, WSP(bf16, WS_HB), a->in[4] + (size_t)(l * 3 + 1) * D, a->in[5] + (size_t)(l * 3 + 1) * D, ADA_L + 6 * D, ADA_L + 7 * D, true, gw, NGW, lane); PH_END
        SYNC();
        PH_BEGIN GEMM(EpiSwiGLU, WSP(bf16, WS_HB), D, ws + W_UP1, 2 * DFF, D, WSP(bf16, WS_ACT), DFF); PH_END
        SYNC();
        PH_BEGIN GEMM(EpiGateF32, WSP(bf16, WS_ACT), DFF, ws + W_DN1, D, DFF, WSP(float, WS_Y), ADA_L + 8 * D, 0.5f); PH_END
        SYNC();
        PH_BEGIN ln_phase(a->out, WSP(float, WS_Y), a->out, WSP(bf16, WS_HB), a->in[4] + (size_t)(l * 3 + 2) * D, a->in[5] + (size_t)(l * 3 + 2) * D, ADA_L + 9216, ADA_L + 9216 + D, l + 1 < NL, gw, NGW, lane); PH_END
        if (l + 1 < NL) { PH_BEGIN convert_layer(a, l + 1, lds, gw, NGW, wave, lane); PH_END SYNC(); }
    }
#undef SYNC
#undef GEMM
}

extern "C" void kernel_launch(void* const* d_in, const int* in_sizes, int n_in, void* d_out, int out_size, void* d_ws, size_t ws_size, hipStream_t stream) {
    static int grid = 0;
    if (grid == 0) {
        if (n_in != 32 || out_size != M * D || ws_size < WS_END) { fprintf(stderr, "kernel_launch: unexpected shapes (n_in %d, out %d, ws %zu)\n", n_in, out_size, ws_size); grid = -1; return; }
        int dev = 0, cus = 0, per_cu = 0;
        hipGetDevice(&dev); hipDeviceGetAttribute(&cus, hipDeviceAttributeMultiprocessorCount, dev);
        hipFuncSetAttribute((const void*)fwd_mega, hipFuncAttributeMaxDynamicSharedMemorySize, LDS_BYTES);
        if (hipOccupancyMaxActiveBlocksPerMultiprocessor(&per_cu, (const void*)fwd_mega, NTHR, LDS_BYTES) != hipSuccess || per_cu < 1) { fprintf(stderr, "kernel_launch: occupancy query says %d blocks per CU\n", per_cu); per_cu = 1; }
        (void)hipGetLastError();
        grid = cus * per_cu;
        fprintf(stderr, "kernel_launch: grid %d (cus %d x %d), lds %d\n", grid, cus, per_cu, LDS_BYTES);
    }
    if (grid < 0) return;
    Args a{};
    for (int i = 0; i < 32; ++i) a.in[i] = (const float*)d_in[i];
    a.out = (float*)d_out; a.ws = (unsigned char*)d_ws;
    if (hipMemsetAsync(d_ws, 0, CTL_ZERO_BYTES, stream) != hipSuccess) { fprintf(stderr, "kernel_launch: memset of the barrier words failed\n"); return; }
    void* kargs[] = {&a};
    hipError_t e = hipLaunchCooperativeKernel((const void*)fwd_mega, dim3(grid), dim3(NTHR), kargs, LDS_BYTES, stream);
    if (e != hipSuccess) fprintf(stderr, "kernel_launch: cooperative launch failed: %s (grid %d)\n", hipGetErrorString(e), grid);
}
```

```cpp
#include <hip/hip_runtime.h>
#include <hip/hip_cooperative_groups.h>
#include <cstdio>
#include <cstdint>
namespace cg = cooperative_groups;
namespace pg8 {
#define PG8_LAS __attribute__((address_space(3)))
typedef unsigned short bf16_t;
typedef short bf16x8 __attribute__((ext_vector_type(8)));
typedef float f32x4 __attribute__((ext_vector_type(4)));
typedef unsigned u32x4 __attribute__((ext_vector_type(4)));
constexpr int BM = 256, BK = 64, HALF = 128, HTB = HALF * BK * 2  , STAGE_BYTES = 8 * HTB, NXCD = 8, WGM = 8;

__host__ __device__ __forceinline__ int lds_byte(int r, int c) { const int st = (r >> 4) * 2 + (c >> 5), rr = r & 15, cc = c & 31, ob = rr * 64 + cc * 2; return st * 1024 + (ob ^ (((ob >> 9) & 1) << 5)); }
__host__ __device__ __forceinline__ void stage_rc(int b, int& R, int& C) { const int st = b / 1024, sb = b % 1024, swz = sb ^ (((sb >> 9) & 1) << 5); R = (st >> 1) * 16 + swz / 64; C = (st & 1) * 32 + (swz % 64) / 2; }
__host__ __device__ __forceinline__ int perm32(int rho) { const int n = rho >> 4, i = rho & 15; return 8 * (i >> 2) + 4 * n + (i & 3); }

struct Unit { int pm, pn; };
struct Gemm { const bf16_t* A; const bf16_t* Bt; int M, N, K, lda; };

struct StaticOrder {
    int nM, nN, nwg, G, c;
    __host__ __device__ void init(int M, int N, int G_, int c_) { nM = M / BM; nN = N / BM; nwg = nM * nN; G = G_; c = c_; }
    __host__ __device__ bool next(int i, Unit& u) const {
        const long L = (long)i * G + c; if (L >= nwg) return false;
        int wgid = (int)L; { const int q = nwg / NXCD, r = nwg % NXCD, xcd = wgid % NXCD, off = wgid / NXCD; wgid = (xcd < r ? xcd * (q + 1) : r * (q + 1) + (xcd - r) * q) + off; }
        const int nig = WGM * nN, gid = wgid / nig, fm = gid * WGM, gsz = (nM - fm) < WGM ? (nM - fm) : WGM;
        u.pm = fm + ((wgid % nig) % gsz); u.pn = (wgid % nig) / gsz; return true;
    }
    __device__ __forceinline__ void a_ready(const Unit&) const {}
    __device__ __forceinline__ void done(const Unit&) const {}
};

__device__ __forceinline__ unsigned cvt_pk_bf16(float lo, float hi) { unsigned r; asm volatile("v_cvt_pk_bf16_f32 %0, %1, %2" : "=v"(r) : "v"(lo), "v"(hi)); return r; }
typedef float f32x2 __attribute__((ext_vector_type(2)));
__device__ __forceinline__ f32x2 gelu_pk(f32x2 v) {
    const f32x2 av = __builtin_elementwise_abs(v), d = av * 0.2316418882f + 1.0f;
    f32x2 t; t.x = __builtin_amdgcn_rcpf(d.x); t.y = __builtin_amdgcn_rcpf(d.y);
    f32x2 q = t * 0.5307027145f + (-0.7265760135f); q = q * t + 0.7107068705f; q = q * t + (-0.142248368f); q = q * t + 0.127414796f; q = q * t;
    const f32x2 s = (v * v) * (-0.72134752044f);
    f32x2 e; e.x = __builtin_amdgcn_exp2f(s.x); e.y = __builtin_amdgcn_exp2f(s.y);
    const f32x2 m = v * (q * e), r = v - m;
    f32x2 o; o.x = v.x < 0.f ? m.x : r.x; o.y = v.y < 0.f ? m.y : r.y; return o;
}

template <int ACT  > struct EpiBf16 {
    static constexpr bool PERM = true, AFTER_DRAIN = false; static_assert(ACT == 0 || ACT == 1, "EpiBf16: ACT is 0 (none) or 1 (gelu_pk)");
    bf16_t* O; int ldc; const float* bias; int split_cols; size_t split_stride; float scale0;
    __device__ __forceinline__ void operator()(const f32x4 (&acc)[2][2][4][2], const Unit& u, int wr, int wc, int fr, int fq) const {
        const int row0 = u.pm * BM + wr * 64 + fr; int colt = u.pn * BM; bf16_t* base = O;
        float sc = 1.f; if (split_cols) { const int t = colt / split_cols; base += (size_t)t * split_stride; colt -= t * split_cols; if (t == 0) sc = scale0; }
        const int col0 = colt + wc * 32 + 8 * fq, bcol0 = u.pn * BM + wc * 32 + 8 * fq;
        f32x4 bv[2][2];
#pragma unroll
        for (int bj = 0; bj < 2; ++bj)
#pragma unroll
            for (int n = 0; n < 2; ++n) bv[bj][n] = bias ? *(const f32x4*)(bias + bcol0 + bj * HALF + 4 * n) : (f32x4){0.f, 0.f, 0.f, 0.f};
#pragma unroll
        for (int ai = 0; ai < 2; ++ai)
#pragma unroll
            for (int m = 0; m < 4; ++m) { bf16_t* rowp = base + (size_t)(row0 + ai * HALF + m * 16) * ldc + col0;
#pragma unroll
                for (int bj = 0; bj < 2; ++bj) { f32x4 v0 = acc[ai][bj][m][0] + bv[bj][0], v1 = acc[ai][bj][m][1] + bv[bj][1];
                    if (ACT == 1) { f32x2 a = gelu_pk((f32x2){v0[0], v0[1]}), b = gelu_pk((f32x2){v0[2], v0[3]}), c = gelu_pk((f32x2){v1[0], v1[1]}), d = gelu_pk((f32x2){v1[2], v1[3]});
                        v0 = (f32x4){a.x, a.y, b.x, b.y}; v1 = (f32x4){c.x, c.y, d.x, d.y}; }
                    v0 = v0 * sc; v1 = v1 * sc; u32x4 w; w.x = cvt_pk_bf16(v0[0], v0[1]); w.y = cvt_pk_bf16(v0[2], v0[3]); w.z = cvt_pk_bf16(v1[0], v1[1]); w.w = cvt_pk_bf16(v1[2], v1[3]);
                    *(u32x4*)(rowp + bj * HALF) = w; } }
    }
};

struct PanelStats {
    unsigned* xbuf;
    unsigned* cnt;
    unsigned* tmo;
    int ntn; float eps;
    unsigned code;
    __device__ __forceinline__ bool run(const f32x4 (&v)[2][2][4][2], const Unit& u, int wr, int wc, int fr, int fq, PG8_LAS unsigned char* lds, int wid, int lane) const {
        typedef float f32x2v __attribute__((ext_vector_type(2)));
        PG8_LAS f32x2v* P = (PG8_LAS f32x2v*)lds;
        PG8_LAS f32x2v* S = (PG8_LAS f32x2v*)(lds + 8192);
        PG8_LAS unsigned* flag = (PG8_LAS unsigned*)(lds + 8192 + 2048);
#pragma unroll
        for (int ai = 0; ai < 2; ++ai)
#pragma unroll
            for (int m = 0; m < 4; ++m) {
                float s = 0.f;
#pragma unroll
                for (int bj = 0; bj < 2; ++bj)
#pragma unroll
                    for (int n = 0; n < 2; ++n) { const f32x4 x = v[ai][bj][m][n]; s += (x[0] + x[1]) + (x[2] + x[3]); }
                s += __shfl_xor(s, 16); s += __shfl_xor(s, 32);
                const float mw = s * (1.0f / 64.0f); float q = 0.f;
#pragma unroll
                for (int bj = 0; bj < 2; ++bj)
#pragma unroll
                    for (int n = 0; n < 2; ++n) { const f32x4 d = v[ai][bj][m][n] - mw; q += (d[0] * d[0] + d[1] * d[1]) + (d[2] * d[2] + d[3] * d[3]); }
                q += __shfl_xor(q, 16); q += __shfl_xor(q, 32);
                if (fq == 0) P[(ai * HALF + wr * 64 + m * 16 + fr) * 4 + wc] = (f32x2v){mw, q};
            }
        asm volatile("s_waitcnt lgkmcnt(0)" ::: "memory"); __builtin_amdgcn_s_barrier(); asm volatile("" ::: "memory");
#if defined(BROKEN_EXCHANGE_NO_WAIT)
#warning BROKEN CONTROL BUILD: the row-statistics exchange does not wait; results are wrong by design
        if (blockIdx.x >= 64) { const long long t0_ = clock64(); while (clock64() - t0_ < 60000) __builtin_amdgcn_s_sleep(8); }
#endif
        const int row = wid * 32 + (lane & 31);
        if (lane < 32) {
            const f32x2v a = P[row * 4 + 0], b = P[row * 4 + 1], c = P[row * 4 + 2], d = P[row * 4 + 3];
            const float mt = (a.x + b.x + c.x + d.x) * 0.25f;
            const float da = a.x - mt, db = b.x - mt, dc = c.x - mt, dd = d.x - mt;
            const float m2 = (a.y + b.y) + (c.y + d.y) + 64.0f * ((da * da + db * db) + (dc * dc + dd * dd));
            unsigned long long* slot = (unsigned long long*)xbuf + ((size_t)(u.pm * BM + row) * 4 + u.pn);
            __hip_atomic_store(slot, ((unsigned long long)__float_as_uint(m2) << 32) | __float_as_uint(mt), __ATOMIC_RELAXED, __HIP_MEMORY_SCOPE_AGENT);
        }
        asm volatile("s_waitcnt vmcnt(0)" ::: "memory");
        if (lane == 0) __hip_atomic_fetch_add(cnt + 64 * u.pm, 1u, __ATOMIC_RELAXED, __HIP_MEMORY_SCOPE_AGENT);
        if (wid == 0) {
            bool dead = false; const unsigned long long t0 = __builtin_amdgcn_s_memrealtime(); const unsigned want = 8u * (unsigned)ntn;
            for (;;) {
#if defined(BROKEN_EXCHANGE_NO_WAIT)
                break;
#endif
                if ((unsigned)__builtin_amdgcn_readfirstlane(__hip_atomic_load(cnt + 64 * u.pm, __ATOMIC_RELAXED, __HIP_MEMORY_SCOPE_AGENT)) >= want) break;
                if (__builtin_amdgcn_s_memrealtime() - t0 > 2000000ull) {
                    if (lane == 0) { unsigned expect = 0u; __hip_atomic_compare_exchange_strong(tmo + 1, &expect, code | (unsigned)(u.pm & 0xff), __ATOMIC_RELAXED, __ATOMIC_RELAXED, __HIP_MEMORY_SCOPE_AGENT);
                                     __hip_atomic_store(tmo, 1u, __ATOMIC_RELAXED, __HIP_MEMORY_SCOPE_AGENT); }
                    dead = true; break; }
                __builtin_amdgcn_s_sleep(2);
            }
            __builtin_amdgcn_fence(__ATOMIC_ACQUIRE, "agent");
            if (lane == 0) flag[0] = dead ? 1u : 0u;
        }
        asm volatile("s_waitcnt vmcnt(0) lgkmcnt(0)" ::: "memory"); __builtin_amdgcn_s_barrier(); asm volatile("" ::: "memory");
        const bool bad = flag[0] != 0u;
        if (lane < 32) {
            const unsigned long long* slot = (const unsigned long long*)xbuf + (size_t)(u.pm * BM + row) * 4; float mt[4], m2[4]; float ms = 0.f;
#pragma unroll
            for (int t = 0; t < 4; ++t) { if (t < ntn) { const unsigned long long w = __hip_atomic_load(slot + t, __ATOMIC_RELAXED, __HIP_MEMORY_SCOPE_AGENT); mt[t] = __uint_as_float((unsigned)w); m2[t] = __uint_as_float((unsigned)(w >> 32)); } else { mt[t] = 0.f; m2[t] = 0.f; } ms += mt[t]; }
            const float mean = ms / (float)ntn; float q = 0.f;
#pragma unroll
            for (int t = 0; t < 4; ++t) if (t < ntn) { const float dm = mt[t] - mean; q += m2[t] + 256.0f * dm * dm; }
            S[row] = (f32x2v){mean, 1.0f / sqrtf(q / (256.0f * (float)ntn) + eps)};
        }
        asm volatile("s_waitcnt lgkmcnt(0)" ::: "memory"); __builtin_amdgcn_s_barrier(); asm volatile("" ::: "memory");
        return bad;
    }
};
struct EpiLnRes {
    static constexpr bool PERM = false, AFTER_DRAIN = true;
    const float* base; float* out; int ldc; const float* bias; PanelStats st; unsigned poison;
    __device__ __forceinline__ void fused(f32x4 (&acc)[2][2][4][2], const Unit& u, int wr, int wc, int fr, int fq, PG8_LAS unsigned char* lds, int wid, int lane) const {
        typedef float f32x2v __attribute__((ext_vector_type(2)));
        const PG8_LAS f32x2v* S = (const PG8_LAS f32x2v*)(lds + 8192);
        const int col0 = u.pn * BM + wc * 32 + 4 * fq;
#pragma unroll
        for (int bj = 0; bj < 2; ++bj)
#pragma unroll
            for (int n = 0; n < 2; ++n) { const f32x4 bv = bias ? *(const f32x4*)(bias + col0 + bj * HALF + n * 16) : (f32x4){0.f, 0.f, 0.f, 0.f};
#pragma unroll
                for (int ai = 0; ai < 2; ++ai)
#pragma unroll
                    for (int m = 0; m < 4; ++m) acc[ai][bj][m][n] += bv; }
        f32x4 pre[4][2][2];
#pragma unroll
        for (int m = 0; m < 4; ++m) { const size_t off = (size_t)(u.pm * BM + wr * 64 + m * 16 + fr) * ldc + col0;
#pragma unroll
            for (int bj = 0; bj < 2; ++bj)
#pragma unroll
                for (int n = 0; n < 2; ++n) pre[m][bj][n] = *(const f32x4*)(base + off + bj * HALF + n * 16); }
        const bool bad = st.run(acc, u, wr, wc, fr, fq, lds, wid, lane) || poison != 0u;
        const float qnan = __builtin_nanf("");
#pragma unroll
        for (int ai = 0; ai < 2; ++ai)
#pragma unroll
            for (int m = 0; m < 4; ++m) { const int r = ai * HALF + wr * 64 + m * 16 + fr; const f32x2v sr = S[r]; const size_t off = (size_t)(u.pm * BM + r) * ldc + col0;
#pragma unroll
                for (int bj = 0; bj < 2; ++bj)
#pragma unroll
                    for (int n = 0; n < 2; ++n) { const f32x4 bs = ai == 0 ? pre[m][bj][n] : *(const f32x4*)(base + off + bj * HALF + n * 16); f32x4 o = bs + (acc[ai][bj][m][n] - sr.x) * sr.y;
                        if (bad) o = (f32x4){qnan, qnan, qnan, qnan}; *(f32x4*)(out + off + bj * HALF + n * 16) = o; }
                if (m & 1) asm volatile("" ::: "memory"); }
    }
};
struct EpiLnResLn {
    static constexpr bool PERM = false, AFTER_DRAIN = true;
    const float* base; float* out; bf16_t* xn; int ldc; const float* bias; PanelStats st1, st2; unsigned poison;
    __device__ __forceinline__ void fused(f32x4 (&acc)[2][2][4][2], const Unit& u, int wr, int wc, int fr, int fq, PG8_LAS unsigned char* lds, int wid, int lane) const {
        typedef float f32x2v __attribute__((ext_vector_type(2))); typedef unsigned u32x2v __attribute__((ext_vector_type(2)));
        const PG8_LAS f32x2v* S = (const PG8_LAS f32x2v*)(lds + 8192);
        const int col0 = u.pn * BM + wc * 32 + 4 * fq;
#pragma unroll
        for (int bj = 0; bj < 2; ++bj)
#pragma unroll
            for (int n = 0; n < 2; ++n) { const f32x4 bv = bias ? *(const f32x4*)(bias + col0 + bj * HALF + n * 16) : (f32x4){0.f, 0.f, 0.f, 0.f};
#pragma unroll
                for (int ai = 0; ai < 2; ++ai)
#pragma unroll
                    for (int m = 0; m < 4; ++m) acc[ai][bj][m][n] += bv; }
        bool bad = st1.run(acc, u, wr, wc, fr, fq, lds, wid, lane) || poison != 0u;
        const float qnan = __builtin_nanf("");
#pragma unroll
        for (int ai = 0; ai < 2; ++ai)
#pragma unroll
            for (int m = 0; m < 4; ++m) { const int r = ai * HALF + wr * 64 + m * 16 + fr; const f32x2v sr = S[r]; const size_t off = (size_t)(u.pm * BM + r) * ldc + col0;
#pragma unroll
                for (int bj = 0; bj < 2; ++bj)
#pragma unroll
                    for (int n = 0; n < 2; ++n) { const f32x4 bs = *(const f32x4*)(base + off + bj * HALF + n * 16); acc[ai][bj][m][n] = bs + (acc[ai][bj][m][n] - sr.x) * sr.y; }
                asm volatile("" : "+v"(acc[ai][0][m][0]), "+v"(acc[ai][0][m][1]), "+v"(acc[ai][1][m][0]), "+v"(acc[ai][1][m][1]));
                if (m & 1) asm volatile("" ::: "memory"); }
        const bool bad1 = bad;
        bad = st2.run(acc, u, wr, wc, fr, fq, lds, wid, lane) || bad;
#pragma unroll
        for (int ai = 0; ai < 2; ++ai)
#pragma unroll
            for (int m = 0; m < 4; ++m) { const int r = ai * HALF + wr * 64 + m * 16 + fr; const f32x2v sr = S[r]; const size_t off = (size_t)(u.pm * BM + r) * ldc + col0;
#pragma unroll
                for (int bj = 0; bj < 2; ++bj)
#pragma unroll
                    for (int n = 0; n < 2; ++n) { const f32x4 x1 = acc[ai][bj][m][n]; *(f32x4*)(out + off + bj * HALF + n * 16) = bad1 ? (f32x4){qnan, qnan, qnan, qnan} : x1;
                        const f32x4 o = (x1 - sr.x) * sr.y; u32x2v w; w.x = cvt_pk_bf16(o[0], o[1]); w.y = cvt_pk_bf16(o[2], o[3]);
                        if (bad) { w.x = 0x7fc07fc0u; w.y = 0x7fc07fc0u; } *(u32x2v*)(xn + off + bj * HALF + n * 16) = w; }
                asm volatile("" ::: "memory"); }
    }
};

template <class Epi, class Sched, bool ALIGN_EPI = false, bool SP2 = false>
__device__ __forceinline__ void gemm_phase(PG8_LAS unsigned char* lds, const Gemm g, const Sched& S, const Epi& E) {
    int tid_l = threadIdx.x; asm volatile("" : "+v"(tid_l));
    const int tid = tid_l, wid = __builtin_amdgcn_readfirstlane(tid >> 6), lane = tid & 63, wr = wid >> 2, wc = wid & 3, fr = lane & 15, fq = lane >> 4;
    const int K = g.K, nt = K / BK;
    unsigned voffA[2], voffB[2];
#pragma unroll
    for (int i = 0; i < 2; ++i) { int R, C; stage_rc(tid * 16 + i * 8192, R, C); const int Rb = Epi::PERM ? ((R & ~31) + perm32(R & 31)) : R;
        voffA[i] = (unsigned)(R * g.lda + C) * 2u; voffB[i] = (unsigned)(Rb * K + C) * 2u; }
    const size_t kstep = (size_t)(BK * 2);
    const size_t hstep = (size_t)HALF * K * 2;
    const size_t tstep = 2 * hstep; const size_t hstepA = (size_t)HALF * g.lda * 2, tstepA = 2 * hstepA;
    const unsigned ldsw = (unsigned)wid * 1024u;
    const int aoff = lds_byte(wr * 64 + fr, fq * 8), boff = lds_byte(wc * 32 + fr, fq * 8);
#define PG8_SA(b, h) (((b) * 2 + (h)) * HTB)
#define PG8_SB(b, h) ((4 + (b) * 2 + (h)) * HTB)
#define PG8_STAGE(bufoff, gbase, voff) do { _Pragma("unroll") for (int _i = 0; _i < 2; ++_i) \
        __builtin_amdgcn_global_load_lds((const unsigned*)((const char*)(gbase) + (voff)[_i]), (PG8_LAS unsigned*)(lds + (bufoff) + ldsw + _i * 8192), 16, 0, 0); } while (0)
#define PG8_LDA(dst, b, h) do { _Pragma("unroll") for (int m = 0; m < 4; ++m) _Pragma("unroll") for (int k = 0; k < 2; ++k) dst[m][k] = *(const PG8_LAS bf16x8*)(lds + PG8_SA(b, h) + aoff + m * 2048 + k * 1024); } while (0)
#define PG8_LDB(dst, b, h) do { _Pragma("unroll") for (int n = 0; n < 2; ++n) _Pragma("unroll") for (int k = 0; k < 2; ++k) dst[n][k] = *(const PG8_LAS bf16x8*)(lds + PG8_SB(b, h) + boff + n * 2048 + k * 1024); } while (0)
#define PG8_MMA(ai, bj, At, Bt) do { __builtin_amdgcn_s_setprio(1); _Pragma("unroll") for (int m = 0; m < 4; ++m) _Pragma("unroll") for (int n = 0; n < 2; ++n) _Pragma("unroll") for (int k = 0; k < 2; ++k) \
        acc[ai][bj][m][n] = __builtin_amdgcn_mfma_f32_16x16x32_bf16(Bt[n][k], At[m][k], acc[ai][bj][m][n], 0, 0, 0); __builtin_amdgcn_s_setprio(0); } while (0)
#define PG8_WAIT_V(n) asm volatile("s_waitcnt vmcnt(" #n ")" ::: "memory")
#define PG8_WAIT_L(n) asm volatile("s_waitcnt lgkmcnt(" #n ")" ::: "memory")
#define PG8_BAR __builtin_amdgcn_s_barrier()
#define PG8_SCHED __builtin_amdgcn_sched_barrier(0)
    Unit cur, nxt; int ui = 0;
    if (!S.next(0, cur)) return;
    f32x4 acc[2][2][4][2];
#pragma unroll
    for (int a = 0; a < 2; ++a)
#pragma unroll
        for (int b = 0; b < 2; ++b)
#pragma unroll
            for (int m = 0; m < 4; ++m)
#pragma unroll
                for (int n = 0; n < 2; ++n) acc[a][b][m][n] = (f32x4){0.f, 0.f, 0.f, 0.f};
    bf16x8 At[4][2], B0[2][2], B1[2][2];
    const char* cA = (const char*)g.A + (size_t)cur.pm * tstepA; const char* cB = (const char*)g.Bt + (size_t)cur.pn * tstep;
    S.a_ready(cur);
    if constexpr (SP2) {
        PG8_STAGE(PG8_SB(0, 0), cB, voffB); PG8_STAGE(PG8_SB(0, 1), cB + hstep, voffB); PG8_STAGE(PG8_SA(0, 0), cA, voffA); PG8_STAGE(PG8_SA(0, 1), cA + hstepA, voffA);
        if (wr == 1) PG8_BAR;
        PG8_WAIT_V(2); PG8_BAR;
        PG8_STAGE(PG8_SB(1, 0), cB + kstep, voffB); PG8_STAGE(PG8_SA(1, 0), cA + kstep, voffA); PG8_STAGE(PG8_SB(1, 1), cB + hstep + kstep, voffB);
        PG8_WAIT_V(6); PG8_BAR;
    } else {
        PG8_STAGE(PG8_SB(0, 0), cB, voffB); PG8_STAGE(PG8_SA(0, 0), cA, voffA); PG8_STAGE(PG8_SB(0, 1), cB + hstep, voffB); PG8_STAGE(PG8_SA(0, 1), cA + hstepA, voffA);
        if (wr == 1) PG8_BAR;
        PG8_WAIT_V(4); PG8_BAR;
        PG8_STAGE(PG8_SB(1, 0), cB + kstep, voffB); PG8_STAGE(PG8_SA(1, 0), cA + kstep, voffA); PG8_STAGE(PG8_SB(1, 1), cB + hstep + kstep, voffB);
        PG8_WAIT_V(6); PG8_BAR;
    }
    for (;;) {
        const bool has_next = S.next(ui + 1, nxt);
        const char* nA = has_next ? (const char*)g.A + (size_t)nxt.pm * tstepA : cA; const char* nB = has_next ? (const char*)g.Bt + (size_t)nxt.pn * tstep : cB;
        for (int t = 0; t < nt; t += 2) {
            const bool last = (t == nt - 2);
            const char* a1 = cA + (size_t)(t + 1) * kstep;
            const char* a2 = last ? nA : cA + (size_t)(t + 2) * kstep; const char* b2 = last ? nB : cB + (size_t)(t + 2) * kstep;
            const char* a3 = a2 + kstep; const char* b3 = b2 + kstep;
            if (last && has_next) S.a_ready(nxt);
            if constexpr (SP2) {
            PG8_LDB(B0, 0, 0); PG8_LDB(B1, 0, 1); PG8_SCHED; PG8_LDA(At, 0, 0); PG8_STAGE(PG8_SA(1, 1), a1 + hstepA, voffA);
            PG8_WAIT_V(8); PG8_WAIT_L(0); PG8_BAR; PG8_MMA(0, 0, At, B0); PG8_MMA(0, 1, At, B1); PG8_BAR; PG8_SCHED;
            PG8_LDA(At, 0, 1); PG8_STAGE(PG8_SB(0, 0), b2, voffB); PG8_STAGE(PG8_SB(0, 1), b2 + hstep, voffB); PG8_STAGE(PG8_SA(0, 0), a2, voffA);
            PG8_WAIT_V(8); PG8_WAIT_L(0); PG8_BAR; PG8_MMA(1, 0, At, B0); PG8_MMA(1, 1, At, B1); PG8_BAR; PG8_SCHED;
            PG8_LDB(B0, 1, 0); PG8_LDB(B1, 1, 1); PG8_SCHED; PG8_LDA(At, 1, 0); PG8_STAGE(PG8_SA(0, 1), a2 + hstepA, voffA);
            PG8_WAIT_V(8); PG8_WAIT_L(0); PG8_BAR; PG8_MMA(0, 0, At, B0); PG8_MMA(0, 1, At, B1); PG8_BAR; PG8_SCHED;
            PG8_LDA(At, 1, 1); PG8_STAGE(PG8_SB(1, 0), b3, voffB); PG8_STAGE(PG8_SB(1, 1), b3 + hstep, voffB); PG8_STAGE(PG8_SA(1, 0), a3, voffA);
            PG8_WAIT_V(8); PG8_WAIT_L(0); PG8_BAR; PG8_MMA(1, 0, At, B0); PG8_MMA(1, 1, At, B1); PG8_BAR; PG8_SCHED;
            } else {
            PG8_LDB(B0, 0, 0); PG8_SCHED; PG8_LDA(At, 0, 0); PG8_STAGE(PG8_SA(1, 1), a1 + hstepA, voffA);
            PG8_WAIT_L(8); PG8_BAR; PG8_WAIT_L(0); PG8_MMA(0, 0, At, B0); PG8_BAR; PG8_SCHED;
            PG8_LDB(B1, 0, 1); PG8_STAGE(PG8_SB(0, 0), b2, voffB);
            PG8_BAR; PG8_WAIT_L(0); PG8_MMA(0, 1, At, B1); PG8_BAR;
            PG8_LDA(At, 0, 1); PG8_STAGE(PG8_SA(0, 0), a2, voffA);
            PG8_BAR; PG8_WAIT_L(0); PG8_MMA(1, 0, At, B0); PG8_BAR; PG8_SCHED;
            PG8_STAGE(PG8_SB(0, 1), b2 + hstep, voffB);
            PG8_WAIT_V(6); PG8_BAR; PG8_MMA(1, 1, At, B1); PG8_BAR;
            PG8_LDB(B0, 1, 0); PG8_SCHED; PG8_LDA(At, 1, 0); PG8_STAGE(PG8_SA(0, 1), a2 + hstepA, voffA);
            PG8_WAIT_L(8); PG8_BAR; PG8_WAIT_L(0); PG8_MMA(0, 0, At, B0); PG8_BAR; PG8_SCHED;
            PG8_LDB(B1, 1, 1); PG8_STAGE(PG8_SB(1, 0), b3, voffB);
            PG8_BAR; PG8_WAIT_L(0); PG8_MMA(0, 1, At, B1); PG8_BAR;
            PG8_LDA(At, 1, 1); PG8_STAGE(PG8_SA(1, 0), a3, voffA);
            PG8_BAR; PG8_WAIT_L(0); PG8_MMA(1, 0, At, B0); PG8_BAR; PG8_SCHED;
            PG8_STAGE(PG8_SB(1, 1), b3 + hstep, voffB);
            PG8_WAIT_V(6); PG8_BAR; PG8_MMA(1, 1, At, B1); PG8_BAR;
            }
        }
        if constexpr (ALIGN_EPI) { if (wr == 0) PG8_BAR; }
        if constexpr (!Epi::AFTER_DRAIN) { E(acc, cur, wr, wc, fr, fq); S.done(cur); }
        if (!has_next) break;
#pragma unroll
        for (int a = 0; a < 2; ++a)
#pragma unroll
            for (int b = 0; b < 2; ++b)
#pragma unroll
                for (int m = 0; m < 4; ++m)
#pragma unroll
                    for (int n = 0; n < 2; ++n) acc[a][b][m][n] = (f32x4){0.f, 0.f, 0.f, 0.f};
        cur = nxt; cA = nA; cB = nB; ++ui;
        if constexpr (ALIGN_EPI) { if (wr == 1) PG8_BAR; }
    }
    PG8_WAIT_V(0);
    if constexpr (!ALIGN_EPI) { if (wr == 0) PG8_BAR; }
    PG8_BAR;
    if constexpr (Epi::AFTER_DRAIN) { E.fused(acc, cur, wr, wc, fr, fq, lds, wid, lane); S.done(cur); }
#undef PG8_SA
#undef PG8_SB
#undef PG8_STAGE
#undef PG8_LDA
#undef PG8_LDB
#undef PG8_MMA
#undef PG8_WAIT_V
#undef PG8_WAIT_L
#undef PG8_BAR
#undef PG8_SCHED
}
}

#ifndef PG8_SP2
#define PG8_SP2 true
#endif
#ifndef PG8_ALIGN
#define PG8_ALIGN true
#endif
#include <hip/hip_bf16.h>
#include <cmath>
namespace attn_body {
using bf16=__hip_bfloat16;
using bf16x8=__attribute__((ext_vector_type(8)))short;
using s16x4=__attribute__((ext_vector_type(4)))short;
using f32x16=__attribute__((ext_vector_type(16)))float;
using u32x4=__attribute__((ext_vector_type(4)))unsigned;
using f32x4v=__attribute__((ext_vector_type(4)))float;
constexpr int BATCH=1,NHEAD=8,SEQ=16384,D=64,DM=8704;
constexpr int NW=8,QBLK=32,QB=QBLK*NW,KVBLK=64,NQB=SEQ/QB;
constexpr int ATTN_PITCH=DM, ATTN_UNIT_ROWS=QB;
__device__ __forceinline__ int crow(int r,int hi){return (r&3)+8*(r>>2)+4*hi;}
#define SBAR() __builtin_amdgcn_sched_barrier(0)
__device__ __forceinline__ void cmask(f32x16&p0,f32x16&p1,int jb,int qrel,int hi){
  const float NEG=-INFINITY; int kb=64*jb+4*hi;
  #pragma unroll
  for(int r=0;r<16;++r){int kv=kb+(r&3)+8*(r>>2); if(kv>qrel)p0[r]=NEG; if(kv+32>qrel)p1[r]=NEG;}
}

constexpr int NSLOT=3, SLOTB=8192;
constexpr int LDS_K=0, LDS_V=NSLOT*SLOTB, LDS_WS=2*NSLOT*SLOTB, LDS_OST=LDS_WS+NW*64*4, LDS_F=LDS_OST+NW*4096, LDS_BYTES=LDS_F+SEQ*4;
constexpr float C2=0.125f*1.4426950408889634f;
__device__ __forceinline__ void glds16(const void*gsrc,unsigned lds_dst){unsigned keep;
  asm volatile("s_mov_b32 %0, m0\n\ts_mov_b32 m0, %2\n\ts_nop 0\n\tglobal_load_lds_dwordx4 %1, off\n\ts_mov_b32 m0, %0":"=&s"(keep):"v"(gsrc),"s"(lds_dst):"memory");}
__device__ __forceinline__ float max3f(float a,float b,float c){float r;asm("v_max3_f32 %0, %1, %2, %3":"=v"(r):"v"(a),"v"(b),"v"(c));return r;}
__device__ __forceinline__ float max2f(float a,float b){float r;asm("v_max_f32_e32 %0, %1, %2":"=v"(r):"v"(a),"v"(b));return r;}
__device__ __forceinline__ float fadd_s(float a,float b){float r;asm("v_add_f32_e32 %0, %1, %2":"=v"(r):"v"(a),"v"(b));return r;}
__device__ __forceinline__ float fsub_s(float a,float b){float r;asm("v_sub_f32_e32 %0, %1, %2":"=v"(r):"v"(a),"v"(b));return r;}
typedef float f32x2_t __attribute__((ext_vector_type(2))); typedef __bf16 bf16x2_t __attribute__((ext_vector_type(2)));
__device__ __forceinline__ unsigned cvtpk_s(float lo,float hi){f32x2_t v={lo,hi};bf16x2_t b=__builtin_convertvector(v,bf16x2_t);return __builtin_bit_cast(unsigned,b);}
#define WAIT_BAR(N) asm volatile("s_waitcnt vmcnt(" #N ") lgkmcnt(0)\n\ts_barrier":::"memory")


__device__ __forceinline__ bf16x8 mkbias(float x,int hi){
  const unsigned xb=__float_as_uint(x); const unsigned hb=xb&0xffff0000u; const float r1=x-__uint_as_float(hb);
  const unsigned mb=__float_as_uint(r1)&0xffff0000u; const float r2=r1-__uint_as_float(mb); const unsigned lb=__float_as_uint(r2)&0xffff0000u;
  u32x4 w; w.x=(hb>>16)|mb; w.y=(lb>>16)|0x3f800000u; w.z=0x3f803f80u; w.w=0u; if(hi){w.x=0u;w.y=0u;w.z=0u;}
  return __builtin_bit_cast(bf16x8,w);
}
__device__ __forceinline__ bf16x8 mkq(float x,int hi){
  const unsigned xb=__float_as_uint(x); const unsigned hb=xb&0xffff0000u; const float r1=x-__uint_as_float(hb);
  const unsigned mb=__float_as_uint(r1)&0xffff0000u; const float r2=r1-__uint_as_float(mb); const unsigned lb=__float_as_uint(r2)&0xffff0000u;
  u32x4 w; w.x=0x3f803f80u; w.y=0x3f80u|hb; w.z=(mb>>16)|lb; w.w=0u; if(hi){w.x=0u;w.y=0u;w.z=0u;}
  return __builtin_bit_cast(bf16x8,w);
}
__device__ __forceinline__ void qkt(f32x16&p0,f32x16&p1,const char*Kslot,const bf16x8*qr,int r32,int hi,bf16x8 kb0,bf16x8 kb1,bf16x8 qone){ const f32x16 negm=f32x16{};
  const char*kb=Kslot+hi*1024+r32*16;
  #pragma unroll
  for(int d0=0;d0<4;++d0){
    const bf16x8 b0=*reinterpret_cast<const bf16x8*>(kb+d0*2048);
    const bf16x8 b1=*reinterpret_cast<const bf16x8*>(kb+d0*2048+512);
    if(d0==0){p0=__builtin_amdgcn_mfma_f32_32x32x16_bf16(b0,qr[0],negm,0,0,0);p1=__builtin_amdgcn_mfma_f32_32x32x16_bf16(b1,qr[0],negm,0,0,0);}
    else{p0=__builtin_amdgcn_mfma_f32_32x32x16_bf16(b0,qr[d0],p0,0,0,0);p1=__builtin_amdgcn_mfma_f32_32x32x16_bf16(b1,qr[d0],p1,0,0,0);}}
  p0=__builtin_amdgcn_mfma_f32_32x32x16_bf16(kb0,qone,p0,0,0,0);p1=__builtin_amdgcn_mfma_f32_32x32x16_bf16(kb1,qone,p1,0,0,0);
}
typedef __attribute__((address_space(3))) const char* lds_cptr;
typedef short v4i16_t __attribute__((ext_vector_type(4)));
__device__ __forceinline__ void kload8(bf16x8*kf,lds_cptr kp){
  kf[0]=*(const __attribute__((address_space(3))) bf16x8*)(kp);      kf[1]=*(const __attribute__((address_space(3))) bf16x8*)(kp+512);
  kf[2]=*(const __attribute__((address_space(3))) bf16x8*)(kp+2048); kf[3]=*(const __attribute__((address_space(3))) bf16x8*)(kp+2560);
  kf[4]=*(const __attribute__((address_space(3))) bf16x8*)(kp+4096); kf[5]=*(const __attribute__((address_space(3))) bf16x8*)(kp+4608);
  kf[6]=*(const __attribute__((address_space(3))) bf16x8*)(kp+6144); kf[7]=*(const __attribute__((address_space(3))) bf16x8*)(kp+6656);
}
__device__ __forceinline__ void kload2(bf16x8*kf,lds_cptr kp,int j){ kf[2*j]=*(const __attribute__((address_space(3))) bf16x8*)(kp+j*2048); kf[2*j+1]=*(const __attribute__((address_space(3))) bf16x8*)(kp+j*2048+512); }
__device__ __forceinline__ s16x4 vtr(lds_cptr p){ return __builtin_bit_cast(s16x4,__builtin_amdgcn_ds_read_tr16_b64_v4i16((__attribute__((address_space(3))) v4i16_t*)p)); }
__device__ __forceinline__ float rowmax(const f32x16&p0,const f32x16&p1){
  float a=max3f(p0[0],p0[1],p1[0]),b=max3f(p0[2],p0[3],p1[1]);a=max3f(a,p1[2],p1[3]);
  #pragma unroll
  for(int r=4;r<16;r+=4){a=max3f(a,p0[r],p0[r+1]);b=max3f(b,p0[r+2],p0[r+3]);a=max3f(a,p1[r],p1[r+1]);b=max3f(b,p1[r+2],p1[r+3]);}
  const float m=max2f(a,b);
  auto rr=__builtin_amdgcn_permlane32_swap(__float_as_uint(m),__float_as_uint(m),false,false);
  return max2f(__uint_as_float(rr[0]),__uint_as_float(rr[1]));
}
__device__ __forceinline__ void pv(f32x16*o,int vb,bf16x8 pa0,bf16x8 pa1,bf16x8 pa2,bf16x8 pa3){
  #pragma unroll
  for(int d0=0;d0<2;++d0){s16x4 lo[4],hi[4];
    #pragma unroll
    for(int ks=0;ks<4;++ks){
      asm volatile("ds_read_b64_tr_b16 %0,%1 offset:%c2":"=&v"(lo[ks]):"v"(vb),"i"(d0*4096+ks*1024):"memory");
      asm volatile("ds_read_b64_tr_b16 %0,%1 offset:%c2":"=&v"(hi[ks]):"v"(vb),"i"(d0*4096+ks*1024+512):"memory");}
    asm volatile("s_waitcnt lgkmcnt(0)":::"memory");SBAR();
    #define PK(k) (bf16x8){lo[k][0],lo[k][1],lo[k][2],lo[k][3],hi[k][0],hi[k][1],hi[k][2],hi[k][3]}
    o[d0]=__builtin_amdgcn_mfma_f32_32x32x16_bf16(pa0,PK(0),o[d0],0,0,0);
    o[d0]=__builtin_amdgcn_mfma_f32_32x32x16_bf16(pa1,PK(1),o[d0],0,0,0);
    o[d0]=__builtin_amdgcn_mfma_f32_32x32x16_bf16(pa2,PK(2),o[d0],0,0,0);
    o[d0]=__builtin_amdgcn_mfma_f32_32x32x16_bf16(pa3,PK(3),o[d0],0,0,0);
    #undef PK
  }
}

#ifndef ATTN_STORE16
#define ATTN_STORE16(p,v) (*(u32x4*)(p)=(v))
#endif
template<int THRL> __device__ __forceinline__ void attn_unit(int b,int h,int qb,const bf16*Q,const bf16*__restrict__ K,const bf16*__restrict__ V,bf16*O,const float*FL2,char*shm){
  int tid_l=threadIdx.x; asm volatile("":"+v"(tid_l));
  const int tid=tid_l,lane=tid&63,r32=lane&31,hi=lane>>5; const int wid=__builtin_amdgcn_readfirstlane(tid>>6);
  const long rowbase=(long)b*SEQ; const int q0=qb*QB;
  const bf16*Qw=Q+(rowbase+q0+wid*QBLK)*DM+h*D;
  const bf16*Kh=K+rowbase*DM+h*D,*Vh=V+rowbase*DM+h*D;
  const lds_cptr shm3=(lds_cptr)shm;
  const unsigned lds0=(unsigned)(uintptr_t)shm;
  float*wsf=(float*)(shm+LDS_WS)+wid*64;
  const bf16*ksrc=Kh+(long)lane*DM+wid*8;
  const bf16*vsrc=Vh+(long)(16*(wid&3)+(lane>>2))*DM+(wid>>2)*32+(lane&3)*8;
  const unsigned kdst=lds0+LDS_K+wid*1024, vdst=lds0+LDS_V+wid*1024;
  #define DMA_K(t,slot) glds16(ksrc+(long)(t)*KVBLK*DM,(unsigned)__builtin_amdgcn_readfirstlane(kdst+(slot)))
  #define DMA_V(t,slot) glds16(vsrc+(long)(t)*KVBLK*DM,(unsigned)__builtin_amdgcn_readfirstlane(vdst+(slot)))
  const int vb0=(int)(lds0+LDS_V)+((lane>>4)&1)*32+(lane&3)*8+(4*hi+((lane&15)>>2))*64;
  const char*Kbase=shm+LDS_K; bf16x8 kf[8];
  const lds_cptr kp0=shm3+LDS_K+hi*1024+r32*16; const lds_cptr vp0=shm3+LDS_V+((lane>>4)&1)*32+(lane&3)*8+(4*hi+((lane&15)>>2))*64;
  const int NT=(q0+QB)/KVBLK;
  const __attribute__((address_space(3))) float* Fl=(const __attribute__((address_space(3))) float*)(shm3+LDS_F);
  float fref;
  { const float*Fg=FL2+(long)h*SEQ; const int nF=q0+QB;
    for(int i=tid*4;i<nF;i+=NW*64*4){ const f32x4v v4=*reinterpret_cast<const f32x4v*>(Fg+i); *(__attribute__((address_space(3))) f32x4v*)(shm3+LDS_F+i*4)=v4; }
    fref=Fg[nF-1]; }
  asm volatile("s_waitcnt vmcnt(0) lgkmcnt(0)":::"memory");
  bf16x8 qone=mkq(0.f,hi);
  #define MKB(t,off) mkbias(fref-Fl[(t)*KVBLK+(off)+r32],hi)
  DMA_K(0,0);DMA_V(0,0);DMA_K(1,SLOTB);
  bf16x8 qr[4];
  #pragma unroll
  for(int d0=0;d0<4;++d0)qr[d0]=*reinterpret_cast<const bf16x8*>(&Qw[(long)r32*DM+d0*16+hi*8]);
  float mhat=0.f,l_reg=0.f;f32x16 o[2];o[0]=f32x16{};o[1]=f32x16{};
  const int qrel=wid*QBLK+r32;
  #define CMASK(P0,P1,t) do{int jb_=(t)-(NT-4); if(jb_>=0)cmask(P0,P1,jb_,qrel,hi);}while(0)
  bool resc=false;
  #define START(P0,P1) do{ const float rm=rowmax(P0,P1); resc=false; \
    { const float dl=rm; mhat=fadd_s(mhat,dl); \
      _Pragma("unroll") for(int r=0;r<16;++r){P0[r]=fsub_s(P0[r],dl);P1[r]=fsub_s(P1[r],dl);} \
      qone=mkq(-mhat,hi); } \
    _Pragma("unroll") for(int r=0;r<16;++r)P0[r]=__builtin_amdgcn_exp2f(P0[r]); }while(0)
  #define RESC() do{ if(resc){ asm volatile("s_waitcnt lgkmcnt(0)":::"memory"); \
      _Pragma("unroll") for(int d_=0;d_<2;++d_) _Pragma("unroll") for(int r=0;r<16;++r)o[d_][r]*=wsf[crow(r,hi)]; } }while(0)
  f32x16 pA0,pA1,pB0,pB1;
  int sl_prev=0,sl_cur=0,sl_next=SLOTB;
  #define ROT() do{sl_prev=sl_cur;sl_cur=sl_next;sl_next=(sl_next==(NSLOT-1)*SLOTB)?0:sl_next+SLOTB;}while(0)
  DMA_K(2,2*SLOTB);
  WAIT_BAR(3);
  qkt(pA0,pA1,Kbase,qr,r32,hi,MKB(0,0),MKB(0,32),qone);asm volatile("s_nop 15\n\ts_nop 7":"+v"(pA0),"+v"(pA1));CMASK(pA0,pA1,0);
  START(pA0,pA1);
  _Pragma("unroll") for(int r=0;r<16;++r)pA1[r]=__builtin_amdgcn_exp2f(pA1[r]);
  WAIT_BAR(0);
  DMA_K(3,0);DMA_V(1,SLOTB);
  ROT();
  kload8(kf,kp0+sl_cur);
  WAIT_BAR(2);
  s16x4 vlo[8],vhi[8]; u32x4 pw0,pw1,pw2,pw3;
  #define PKW(P,B) cvtpk_s(P[B],P[B+1])
  #define PAF(k) __builtin_bit_cast(bf16x8,pw##k)
  #define VFR(i) (bf16x8){vlo[i][0],vlo[i][1],vlo[i][2],vlo[i][3],vhi[i][0],vhi[i][1],vhi[i][2],vhi[i][3]}
  #define PIN(x) asm volatile("":"+v"(x))
  #define MX3(a,b,c) __builtin_fmaxf(__builtin_fmaxf((a),(b)),(c))
  #define GAPA(MF,A0,A1,A2,A3,W0,W1,PW) do{ MF; sacc+=A0; sacc+=A1; sacc+=A2; sacc+=A3; PIN(sacc); W0; W1; PIN(PW); SBAR(); }while(0)
  #define EX(v) __builtin_amdgcn_exp2f(v)
  #define GAPB(MF,X,B) do{ MF; X[B]=EX(X[B]); X[B+1]=EX(X[B+1]); X[B+2]=EX(X[B+2]); X[B+3]=EX(X[B+3]); PIN(X); SBAR(); }while(0)
  #define VRD(i) do{ vlo[i]=vtr(vp_+(((i)>>2)*4096+((i)&3)*1024)); vhi[i]=vtr(vp_+(((i)>>2)*4096+((i)&3)*1024+512)); }while(0)
  #define KRD(G,j) do{ if(G){ kload2(kf,kp0+sl_next,j); SBAR(); } }while(0)
  #define STEP(C0,C1,P0,P1,t,GK,GV,GL) do{ SBAR(); \
    const bf16x8 kbA_=MKB(t,0), kbB_=MKB(t,32); \
    const lds_cptr vp_=vp0+sl_prev; \
    VRD(0); SBAR(); float sacc=(P0[0]+P0[1]); \
    GAPA(C0=__builtin_amdgcn_mfma_f32_32x32x16_bf16(kf[0],qr[0],f32x16{},0,0,0), P0[2],P0[3],P0[4],P0[5],     pw0[0]=PKW(P0,0), pw0[1]=PKW(P0,2), pw0); \
    VRD(4); SBAR(); GAPA(C1=__builtin_amdgcn_mfma_f32_32x32x16_bf16(kf[1],qr[0],f32x16{},0,0,0), P0[6],P0[7],P0[8],P0[9],     pw0[2]=PKW(P0,4), pw0[3]=PKW(P0,6), pw0); \
    VRD(1); SBAR(); GAPA(C0=__builtin_amdgcn_mfma_f32_32x32x16_bf16(kf[2],qr[1],C0,0,0,0),   P0[10],P0[11],P0[12],P0[13], pw1[0]=PKW(P0,8), pw1[1]=PKW(P0,10), pw1); \
    VRD(5); SBAR(); GAPA(C1=__builtin_amdgcn_mfma_f32_32x32x16_bf16(kf[3],qr[1],C1,0,0,0),   P0[14],P0[15],P1[0],P1[1],   pw1[2]=PKW(P0,12),pw1[3]=PKW(P0,14), pw1); \
    VRD(2); SBAR(); GAPA(C0=__builtin_amdgcn_mfma_f32_32x32x16_bf16(kf[4],qr[2],C0,0,0,0),   P1[2],P1[3],P1[4],P1[5],     pw2[0]=PKW(P1,0), pw2[1]=PKW(P1,2), pw2); \
    VRD(6); SBAR(); GAPA(C1=__builtin_amdgcn_mfma_f32_32x32x16_bf16(kf[5],qr[2],C1,0,0,0),   P1[6],P1[7],P1[8],P1[9],     pw2[2]=PKW(P1,4), pw2[3]=PKW(P1,6), pw2); \
    VRD(3); SBAR(); GAPA(C0=__builtin_amdgcn_mfma_f32_32x32x16_bf16(kf[6],qr[3],C0,0,0,0),   P1[10],P1[11],P1[12],P1[13], pw3[0]=PKW(P1,8), pw3[1]=PKW(P1,10), pw3); \
    VRD(7); SBAR(); GAPA(C1=__builtin_amdgcn_mfma_f32_32x32x16_bf16(kf[7],qr[3],C1,0,0,0),   P1[14],P1[15],0.f,0.f,       pw3[2]=PKW(P1,12),pw3[3]=PKW(P1,14), pw3); \
    C0=__builtin_amdgcn_mfma_f32_32x32x16_bf16(kbA_,qone,C0,0,0,0); C1=__builtin_amdgcn_mfma_f32_32x32x16_bf16(kbB_,qone,C1,0,0,0); \
    l_reg+=sacc; \
    if(GK){DMA_K((t)+3,sl_cur);} if(GV){DMA_V((t)+1,sl_next);} \
    CMASK(C0,C1,t); \
    { float a=MX3(C0[0],C0[1],C1[0]),b=MX3(C0[2],C0[3],C1[1]); a=MX3(a,C1[2],C1[3]); \
      _Pragma("unroll") for(int r=4;r<16;r+=4){a=MX3(a,C0[r],C0[r+1]);b=MX3(b,C0[r+2],C0[r+3]);a=MX3(a,C1[r],C1[r+1]);b=MX3(b,C1[r+2],C1[r+3]);} \
      float rm=__builtin_fmaxf(a,b); { auto rr=__builtin_amdgcn_permlane32_swap(__float_as_uint(rm),__float_as_uint(rm),false,false); rm=__builtin_fmaxf(__uint_as_float(rr[0]),__uint_as_float(rr[1])); } \
      resc=false; \
      if(__builtin_expect(__any(rm>(float)THRL),0)){ const float dl=__builtin_fmaxf(rm,0.f); mhat+=dl; \
        _Pragma("unroll") for(int r=0;r<16;++r){C0[r]-=dl;C1[r]-=dl;} \
        qone=mkq(-mhat,hi); \
        const float f=__builtin_amdgcn_exp2f(-dl); l_reg*=f; if(hi==0)wsf[r32]=f; resc=true; } } \
    SBAR(); \
    GAPB(o[0]=__builtin_amdgcn_mfma_f32_32x32x16_bf16(PAF(0),VFR(0),o[0],0,0,0), C0,0); \
    GAPB(o[1]=__builtin_amdgcn_mfma_f32_32x32x16_bf16(PAF(0),VFR(4),o[1],0,0,0), C0,4); \
    KRD(GL,0); GAPB(o[0]=__builtin_amdgcn_mfma_f32_32x32x16_bf16(PAF(1),VFR(1),o[0],0,0,0), C0,8); \
    KRD(GL,1); GAPB(o[1]=__builtin_amdgcn_mfma_f32_32x32x16_bf16(PAF(1),VFR(5),o[1],0,0,0), C0,12); \
    KRD(GL,2); GAPB(o[0]=__builtin_amdgcn_mfma_f32_32x32x16_bf16(PAF(2),VFR(2),o[0],0,0,0), C1,0); \
    KRD(GL,3); GAPB(o[1]=__builtin_amdgcn_mfma_f32_32x32x16_bf16(PAF(2),VFR(6),o[1],0,0,0), C1,4); \
    GAPB(o[0]=__builtin_amdgcn_mfma_f32_32x32x16_bf16(PAF(3),VFR(3),o[0],0,0,0), C1,8); \
    GAPB(o[1]=__builtin_amdgcn_mfma_f32_32x32x16_bf16(PAF(3),VFR(7),o[1],0,0,0), C1,12); \
    }while(0)
  int t=1;
  #undef CMASK
  #define CMASK(P0,P1,t) do{}while(0)
  for(;t+5<NT;t+=2){
    STEP(pB0,pB1,pA0,pA1,t,true,true,true);     WAIT_BAR(2); RESC(); ROT();
    STEP(pA0,pA1,pB0,pB1,t+1,true,true,true);   WAIT_BAR(2); RESC(); ROT();
  }
  #undef CMASK
  #define CMASK(P0,P1,t) do{int jb_=(t)-(NT-4); if(jb_>=0)cmask(P0,P1,jb_,qrel,hi);}while(0)
  #define ENDW(tt) do{ if((tt)+3<NT){WAIT_BAR(2);} else if((tt)+2<NT){WAIT_BAR(1);} else {WAIT_BAR(0);} }while(0)
  for(;t+1<NT;t+=2){
    STEP(pB0,pB1,pA0,pA1,t,(t+3<NT),(t+1<NT),(t+1<NT));       ENDW(t);   RESC(); ROT();
    STEP(pA0,pA1,pB0,pB1,t+1,(t+4<NT),(t+2<NT),(t+2<NT));     ENDW(t+1); RESC(); ROT();
  }
  STEP(pB0,pB1,pA0,pA1,NT-1,false,false,false); RESC();
  { float sacc=pB0[0]+pB0[1]; _Pragma("unroll") for(int r=2;r<16;++r)sacc+=pB0[r]; _Pragma("unroll") for(int r=0;r<16;++r)sacc+=pB1[r]; l_reg+=sacc;
    pw0=(u32x4){PKW(pB0,0),PKW(pB0,2),PKW(pB0,4),PKW(pB0,6)};pw1=(u32x4){PKW(pB0,8),PKW(pB0,10),PKW(pB0,12),PKW(pB0,14)};pw2=(u32x4){PKW(pB1,0),PKW(pB1,2),PKW(pB1,4),PKW(pB1,6)};pw3=(u32x4){PKW(pB1,8),PKW(pB1,10),PKW(pB1,12),PKW(pB1,14)};
    SBAR(); pv(o,vb0+sl_cur,PAF(0),PAF(1),PAF(2),PAF(3)); }
  #undef PKW
  #undef PAF
  #undef VFR
  #undef PIN
  #undef MX3
  #undef GAPA
  #undef GAPB
  #undef EX
  #undef VRD
  #undef KRD
  #undef STEP
  #undef ENDW
  {auto rr=__builtin_amdgcn_permlane32_swap(__float_as_uint(l_reg),__float_as_uint(l_reg),false,false);l_reg=__uint_as_float(rr[0])+__uint_as_float(rr[1]);}
  if(hi==0)wsf[32+r32]=l_reg;asm volatile("s_waitcnt lgkmcnt(0)":::"memory");
  float rli[16];
  #pragma unroll
  for(int r=0;r<16;++r)rli[r]=__builtin_amdgcn_rcpf(wsf[32+crow(r,hi)]);
  bf16*Ow=O+(rowbase+q0+wid*QBLK)*DM+h*D;
  { bf16*stg=(bf16*)(shm+LDS_OST)+wid*2048;
    #pragma unroll
    for(int r=0;r<16;++r){const int orow=crow(r,hi);
      #pragma unroll
      for(int d0=0;d0<2;++d0)stg[orow*64+d0*32+r32]=__float2bfloat16(o[d0][r]*rli[r]);}
    asm volatile("s_waitcnt lgkmcnt(0)":::"memory");
    #pragma unroll
    for(int i=0;i<4;++i){const int row=i*8+(lane>>3),ch=lane&7; const u32x4 v=*(const u32x4*)(stg+row*64+ch*8); ATTN_STORE16(Ow+(long)row*DM+ch*8,v);} }
  asm volatile("s_waitcnt lgkmcnt(0)\n\ts_barrier":::"memory");
  #undef DMA_K
  #undef DMA_V
  #undef MKB
  #undef CMASK
  #undef START
  #undef RESC
  #undef ROT
}
constexpr int ATTN_LDS_BYTES=LDS_BYTES;
struct AttnTensors { const bf16* Q; const bf16* K; const bf16* V; bf16* O; const float* FL2; };
struct AttnUnit { int bh; int qb; };
struct StaticOrder {
  int vcu;
  __device__ __forceinline__ explicit StaticOrder(int grid,int block):vcu((block%8)*(grid/8)+block/8){}
  __device__ __forceinline__ bool next(int i,AttnUnit&u)const{ if(i>=2)return false; const int s=vcu&31; u.bh=vcu>>5; u.qb=(i==0)?s:63-s; return true; }
  __device__ __forceinline__ void a_ready(const AttnUnit&)const{}
  __device__ __forceinline__ void done(const AttnUnit&)const{}
};
template<class Sched,int THRL=8> __device__ __forceinline__ void attn_phase(char*lds,const AttnTensors&T,const Sched&S){
  AttnUnit u;
  for(int i=0;S.next(i,u);++i){ S.a_ready(u); attn_unit<THRL>(u.bh/NHEAD,u.bh%NHEAD,u.qb,T.Q,T.K,T.V,T.O,T.FL2,lds); S.done(u); }
}
#undef SBAR
#undef WAIT_BAR
}
#define LAS __attribute__((address_space(3)))
typedef unsigned short bf16;
typedef unsigned v4u __attribute__((ext_vector_type(4)));
typedef unsigned v2u __attribute__((ext_vector_type(2)));
typedef float f32x4 __attribute__((ext_vector_type(4)));
typedef short bf16x8 __attribute__((ext_vector_type(8)));
typedef const __attribute__((address_space(4))) unsigned* cu32p;
typedef const __attribute__((address_space(4))) float* cf32p;

constexpr int M = 16384, D = 1024, DFF = 2816, ZP = 8704, NL = 4, NWAVES = 8, NTHR = 512;
constexpr int ZQ = 0, ZK = 512, ZV = 1024, ZXB = 1536, ZYB = 2560, ZRW = 3584, ZGT = 5376, ZFL = 8448;
constexpr float ALPHA = 1.6817928305074292f, LN_EPS = 1e-5f, GN_EPS = 64e-5f, LOG2E = 1.4426950408889634f;
constexpr int NCH = 256, LC = 64;

constexpr size_t MiB = 1u << 20;
constexpr size_t WS_ADA = 1 * MiB, WS_FL2 = 2 * MiB, WS_LAEND = 3 * MiB, WS_LHEND = 4 * MiB, WS_LCAR = 5 * MiB, WS_BON = 6 * MiB;
constexpr size_t WS_W = 8 * MiB;
constexpr size_t W_UP0 = WS_W, W_UP1 = WS_W + 11 * MiB, W_DN0 = WS_W + 22 * MiB, W_DN1 = WS_W + 22 * MiB + 5632 * 1024, W_IN = WS_W + 33 * MiB,
                 W_PA = WS_W + 50 * MiB, W_PB = WS_W + 51 * MiB, W_PC = WS_W + 53 * MiB, W_OUT = WS_W + 54 * MiB, W_LORA = WS_W + 56 * MiB;
constexpr size_t WS_HB = 65 * MiB, WS_Y = 97 * MiB, WS_HLOC = 97 * MiB, WS_ACUM = 129 * MiB, WS_P = 97 * MiB, WS_G = 129 * MiB;
constexpr size_t WS_RWO = 161 * MiB, WS_CODES = 177 * MiB, WS_LORA = 185 * MiB, WS_S0 = 185 * MiB;
constexpr size_t WS_RW_W = 233 * MiB, WS_RW_R = 265 * MiB, WS_RW_KF = 281 * MiB, WS_RW_V = 297 * MiB, WS_RW_KK = 313 * MiB, WS_RW_B = 329 * MiB, WS_GB = 345 * MiB;
constexpr size_t WS_Z = 361 * MiB, WS_ACT = 361 * MiB, WS_END = 697 * MiB;
struct RwSet { size_t w, r, kf, kk, b; };
__device__ __forceinline__ RwSet rw_set(int l) { return (l & 1) ? RwSet{WS_HB, 633 * MiB, 649 * MiB, 665 * MiB, 681 * MiB} : RwSet{WS_RW_W, WS_RW_R, WS_RW_KF, WS_RW_KK, WS_RW_B}; }
constexpr int MISC_OFF = attn_body::ATTN_LDS_BYTES, LDS_BYTES = attn_body::ATTN_LDS_BYTES + 64;
constexpr size_t CTL_ZERO_BYTES = 16384;
constexpr int LDS_PHASE_BYTES = attn_body::ATTN_LDS_BYTES;
static_assert(LDS_BYTES >= pg8::STAGE_BYTES && LDS_BYTES <= 160 * 1024, "LDS map");

__device__ __forceinline__ unsigned f2bf(float f) { unsigned u = __builtin_bit_cast(unsigned, f); return (u + 0x7fffu + ((u >> 16) & 1u)) >> 16; }
__device__ __forceinline__ unsigned pk2(float lo, float hi) { return f2bf(lo) | (f2bf(hi) << 16); }
__device__ __forceinline__ float bflo(unsigned u) { return __uint_as_float(u << 16); }
__device__ __forceinline__ float bfhi(unsigned u) { return __uint_as_float(u & 0xffff0000u); }
__device__ __forceinline__ float bf1(bf16 b) { return __uint_as_float(((unsigned)b) << 16); }
__device__ __forceinline__ float wave_sum(float v) {
#pragma unroll
    for (int o = 1; o < 64; o <<= 1) v += __shfl_xor(v, o);
    return v;
}
__device__ __forceinline__ float sigm(float x) { return __builtin_amdgcn_rcpf(1.f + __expf(-x)); }
__device__ __forceinline__ float tanh_(float z) { return 1.f - 2.f * __builtin_amdgcn_rcpf(1.f + __expf(2.f * z)); }
__device__ __forceinline__ float gelu_tanh(float x) { return 0.5f * x * (1.f + tanh_(0.7978845608028654f * (x + 0.044715f * x * x * x))); }
__device__ __forceinline__ float softplus_(float x) { return fmaxf(x, 0.f) + log1pf(__expf(-fabsf(x))); }
#define LDS_WAIT() asm volatile("s_waitcnt lgkmcnt(0)" ::: "memory")

struct Args { const float* in[32]; float* out; unsigned char* ws; };
typedef const __attribute__((address_space(4))) Args* CA;

struct EpiSwiGLU {
    static constexpr bool PERM = true, AFTER_DRAIN = false; bf16* O; int ldc;
    __device__ __forceinline__ void operator()(const pg8::f32x4 (&acc)[2][2][4][2], const pg8::Unit& u, int wr, int wc, int fr, int fq) const {
        const int row0 = u.pm * 256 + wr * 64 + fr, col0 = u.pn * 128 + wc * 32 + 8 * fq;
#pragma unroll
        for (int ai = 0; ai < 2; ++ai)
#pragma unroll
            for (int m = 0; m < 4; ++m) {
                bf16* rowp = O + (size_t)(row0 + ai * 128 + m * 16) * ldc + col0; float o[8];
#pragma unroll
                for (int n = 0; n < 2; ++n)
#pragma unroll
                    for (int i = 0; i < 4; ++i) { const float uu = acc[ai][0][m][n][i], gg = acc[ai][1][m][n][i]; o[n * 4 + i] = uu * sigm(uu) * gg; }
                v4u w; w.x = pk2(o[0], o[1]); w.y = pk2(o[2], o[3]); w.z = pk2(o[4], o[5]); w.w = pk2(o[6], o[7]); *(v4u*)rowp = w; }
    }
};
struct EpiGateF32 {
    static constexpr bool PERM = false, AFTER_DRAIN = false; float* Y; const float* gate; float mul;
    __device__ __forceinline__ void operator()(const pg8::f32x4 (&acc)[2][2][4][2], const pg8::Unit& u, int wr, int wc, int fr, int fq) const {
        const int row0 = u.pm * 256 + wr * 64 + fr, col0 = u.pn * 256 + wc * 32 + 4 * fq;
#pragma unroll
        for (int bj = 0; bj < 2; ++bj)
#pragma unroll
            for (int n = 0; n < 2; ++n) { const int c = col0 + bj * 128 + n * 16; const f32x4 gv = *(const f32x4*)(gate + c) * mul;
#pragma unroll
                for (int ai = 0; ai < 2; ++ai)
#pragma unroll
                    for (int m = 0; m < 4; ++m) *(f32x4*)(Y + (size_t)(row0 + ai * 128 + m * 16) * D + c) = acc[ai][bj][m][n] * gv; }
    }
};
struct EpiIn {
    static constexpr bool PERM = true, AFTER_DRAIN = false; bf16* Z;
    __device__ __forceinline__ void operator()(const pg8::f32x4 (&acc)[2][2][4][2], const pg8::Unit& u, int wr, int wc, int fr, int fq) const {
        const int row0 = u.pm * 256 + wr * 64 + fr, col0 = u.pn * 256 + wc * 32 + 8 * fq;
        const int mode = (u.pn < 2) ? 1 : ((u.pn >= 21 && u.pn < 33) ? 2 : 0);
#pragma unroll
        for (int ai = 0; ai < 2; ++ai)
#pragma unroll
            for (int m = 0; m < 4; ++m) { bf16* rowp = Z + (size_t)(row0 + ai * 128 + m * 16) * ZP + col0;
#pragma unroll
                for (int bj = 0; bj < 2; ++bj) { float o[8];
#pragma unroll
                    for (int n = 0; n < 2; ++n)
#pragma unroll
                        for (int i = 0; i < 4; ++i) { float v = acc[ai][bj][m][n][i]; if (mode == 1) v *= attn_body::C2; else if (mode == 2) v = sigm(v); o[n * 4 + i] = v; }
                    v4u w; w.x = pk2(o[0], o[1]); w.y = pk2(o[2], o[3]); w.z = pk2(o[4], o[5]); w.w = pk2(o[6], o[7]); *(v4u*)(rowp + bj * 128) = w; } }
    }
};
struct EpiPlain {
    static constexpr bool PERM = true, AFTER_DRAIN = false; bf16* O; int ldc;
    __device__ __forceinline__ void operator()(const pg8::f32x4 (&acc)[2][2][4][2], const pg8::Unit& u, int wr, int wc, int fr, int fq) const {
        const int row0 = u.pm * 256 + wr * 64 + fr, col0 = u.pn * 256 + wc * 32 + 8 * fq;
#pragma unroll
        for (int ai = 0; ai < 2; ++ai)
#pragma unroll
            for (int m = 0; m < 4; ++m) { bf16* rowp = O + (size_t)(row0 + ai * 128 + m * 16) * ldc + col0;
#pragma unroll
                for (int bj = 0; bj < 2; ++bj) { const pg8::f32x4 v0 = acc[ai][bj][m][0], v1 = acc[ai][bj][m][1];
                    v4u w; w.x = pk2(v0[0], v0[1]); w.y = pk2(v0[2], v0[3]); w.z = pk2(v1[0], v1[1]); w.w = pk2(v1[2], v1[3]); *(v4u*)(rowp + bj * 128) = w; } }
    }
};
template <int PASS> struct EpiProj {
    static constexpr bool PERM = false, AFTER_DRAIN = false; float* Y; const bf16* Z; bf16* MIX;
    __device__ __forceinline__ void operator()(const pg8::f32x4 (&acc)[2][2][4][2], const pg8::Unit& u, int wr, int wc, int fr, int fq) const {
        const int row0 = u.pm * 256 + wr * 64 + fr, col0 = u.pn * 256 + wc * 32 + 4 * fq;
#pragma unroll
        for (int ai = 0; ai < 2; ++ai)
#pragma unroll
            for (int m = 0; m < 4; ++m) { const size_t row = (size_t)(row0 + ai * 128 + m * 16);
#pragma unroll
                for (int bj = 0; bj < 2; ++bj)
#pragma unroll
                    for (int n = 0; n < 2; ++n) { const int c = col0 + bj * 128 + n * 16;
                        const v2u gw = *(const v2u*)(Z + row * ZP + ZGT + PASS * 1024 + c);
                        f32x4 gv; gv.x = bflo(gw.x); gv.y = bfhi(gw.x); gv.z = bflo(gw.y); gv.w = bfhi(gw.y);
                        f32x4 v = acc[ai][bj][m][n] * gv; float* yp = Y + row * D + c;
                        if (PASS > 0) v += *(const f32x4*)yp;
                        if (PASS < 2) *(f32x4*)yp = v; else { v2u w; w.x = pk2(v.x, v.y); w.y = pk2(v.z, v.w); *(v2u*)(MIX + row * D + c) = w; } } }
    }
};

__device__ __forceinline__ void cvt_item(const float* W, int ldw, int sk0, int sn0, int nvalid, bf16* WT, int ldo, int orow0, int dk0, LAS float* scr, int lane) {
    const int n_ = lane & 31;
#pragma unroll 8
    for (int i = 0; i < 32; ++i) { const int kk = 2 * i + (lane >> 5); scr[kk * 33 + n_] = (n_ < nvalid) ? W[(size_t)(sk0 + kk) * ldw + sn0 + n_] : 0.f; }
    LDS_WAIT(); asm volatile("" ::: "memory");
    const int c = lane & 7;
#pragma unroll
    for (int j = 0; j < 4; ++j) { const int n = (lane >> 3) + 8 * j; const LAS float* s = scr + (8 * c) * 33 + n;
        v4u o; o.x = pk2(s[0 * 33], s[1 * 33]); o.y = pk2(s[2 * 33], s[3 * 33]); o.z = pk2(s[4 * 33], s[5 * 33]); o.w = pk2(s[6 * 33], s[7 * 33]);
        *(v4u*)(WT + (size_t)(orow0 + n) * ldo + dk0 + 8 * c) = o; }
    LDS_WAIT(); asm volatile("" ::: "memory");
}
__device__ __forceinline__ void convert_layer(CA a, int l, LAS unsigned char* lds, int gw, int NGW, int wave, int lane) {
    LAS float* scr = (LAS float*)(lds + wave * 16384);
    unsigned char* ws = a->ws;
    constexpr int I_UP = 16 * 176, I_DN = 44 * 32, I_IN = 16 * 272, I_PA = 8 * 32, I_PB = 16 * 32, I_LO = 4 * 48;
    constexpr int NITEMS = 2 * I_UP + 2 * I_DN + I_IN + 2 * I_PA + 2 * I_PB + I_LO;
    for (int it = gw; it < NITEMS; it += NGW) {
        int r = it;
        if (r < 2 * I_UP) { const int s = r / I_UP; r -= s * I_UP; const int kb = r / 176, ob = r % 176, orow0 = 32 * ob, pn = orow0 >> 8, wi = orow0 & 255;
            const int sn0 = (wi < 128) ? (128 * pn + wi) : (DFF + 128 * pn + wi - 128);
            cvt_item(a->in[6] + (size_t)(l * 2 + s) * D * 2 * DFF, 2 * DFF, 64 * kb, sn0, 32, (bf16*)(ws + (s ? W_UP1 : W_UP0)), D, orow0, 64 * kb, scr, lane); continue; }
        r -= 2 * I_UP;
        if (r < 2 * I_DN) { const int s = r / I_DN; r -= s * I_DN; const int kb = r / 32, ob = r % 32;
            cvt_item(a->in[7] + (size_t)(l * 2 + s) * DFF * D, D, 64 * kb, 32 * ob, 32, (bf16*)(ws + (s ? W_DN1 : W_DN0)), DFF, 32 * ob, 64 * kb, scr, lane); continue; }
        r -= 2 * I_DN;
        if (r < I_IN) { const int kb = r / 272, ob = r % 272, orow0 = 32 * ob; int sn0, nv;
            if (orow0 < 1536) { sn0 = orow0; nv = 32; } else if (orow0 < ZFL) { sn0 = orow0 + 8; nv = 32; } else if (orow0 == ZFL) { sn0 = 1536; nv = 8; } else { sn0 = 0; nv = 0; }
            cvt_item(a->in[8] + (size_t)l * D * 8456, 8456, 64 * kb, sn0, nv, (bf16*)(ws + W_IN), D, orow0, 64 * kb, scr, lane); continue; }
        r -= I_IN;
        if (r < I_PA) { const int kb = r / 32, ob = r % 32; cvt_item(a->in[28] + (size_t)l * 512 * D, D, 64 * kb, 32 * ob, 32, (bf16*)(ws + W_PA), 512, 32 * ob, 64 * kb, scr, lane); continue; }
        r -= I_PA;
        if (r < I_PB) { const int kb = r / 32, ob = r % 32; cvt_item(a->in[29] + (size_t)l * D * D, D, 64 * kb, 32 * ob, 32, (bf16*)(ws + W_PB), D, 32 * ob, 64 * kb, scr, lane); continue; }
        r -= I_PB;
        if (r < I_PA) { const int kb = r / 32, ob = r % 32; cvt_item(a->in[30] + (size_t)l * 512 * D, D, 64 * kb, 32 * ob, 32, (bf16*)(ws + W_PC), 512, 32 * ob, 64 * kb, scr, lane); continue; }
        r -= I_PA;
        if (r < I_PB) { const int kb = r / 32, ob = r % 32; cvt_item(a->in[31] + (size_t)l * D * D, D, 64 * kb, 32 * ob, 32, (bf16*)(ws + W_OUT), D, 32 * ob, 64 * kb, scr, lane); continue; }
        r -= I_PB;
        {
            const int kb = r / 48, ob = r % 48, reg = ob / 16, nb = ob % 16; const float* W = a->in[19]; int sk0 = 0, nv = 0;
            if (reg == 0 && kb == 0) { W = a->in[19] + (size_t)l * 64 * 512; nv = 32; }
            else if (reg == 1 && kb == 1) { W = a->in[21] + (size_t)l * 64 * 512; nv = 32; }
            else if (reg == 2 && kb >= 2) { W = a->in[22] + (size_t)l * 128 * 512; sk0 = 64 * (kb - 2); nv = 32; }
            cvt_item(W, 512, sk0, 32 * nb, nv, (bf16*)(ws + W_LORA), 256, 32 * ob, 64 * kb, scr, lane); }
    }
}

__device__ __forceinline__ void row_stats(const f32x4 (&v)[4], float& mean, float& rstd) {
    float s = 0.f;
#pragma unroll
    for (int j = 0; j < 4; ++j) s += (v[j].x + v[j].y) + (v[j].z + v[j].w);
    mean = wave_sum(s) * (1.f / D); float s2 = 0.f;
#pragma unroll
    for (int j = 0; j < 4; ++j) { const f32x4 d = v[j] - mean; s2 += (d.x * d.x + d.y * d.y) + (d.z * d.z + d.w * d.w); }
    rstd = 1.f / sqrtf(wave_sum(s2) * (1.f / D) + LN_EPS);
}
__device__ __forceinline__ void store_mod(const f32x4 (&v)[4], float mean, float rstd, const float* sh, const float* sc, bf16* hrow, int lane) {
#pragma unroll
    for (int j = 0; j < 4; ++j) { const int c = 4 * lane + 256 * j; const f32x4 s1 = *(const f32x4*)(sc + c) + 1.f, s0 = *(const f32x4*)(sh + c);
        const f32x4 h = (v[j] - mean) * rstd * s1 + s0; v2u w; w.x = pk2(h.x, h.y); w.y = pk2(h.z, h.w); *(v2u*)(hrow + c) = w; }
}
__device__ __forceinline__ void ln_phase(const float* xsrc, const float* Y, float* xout, bf16* H, const float* lng, const float* lnb, const float* sh, const float* sc, bool do_mod, int gw, int NGW, int lane) {
    for (int m = gw; m < M; m += NGW) {
        f32x4 v[4];
#pragma unroll
        for (int j = 0; j < 4; ++j) { const size_t o = (size_t)m * D + 4 * lane + 256 * j; v[j] = *(const f32x4*)(xsrc + o) * ALPHA + *(const f32x4*)(Y + o); }
        float mean, rstd; row_stats(v, mean, rstd);
#pragma unroll
        for (int j = 0; j < 4; ++j) { const int c = 4 * lane + 256 * j; v[j] = (v[j] - mean) * rstd * *(const f32x4*)(lng + c) + *(const f32x4*)(lnb + c); *(f32x4*)(xout + (size_t)m * D + c) = v[j]; }
        if (do_mod) { row_stats(v, mean, rstd); store_mod(v, mean, rstd, sh, sc, H + (size_t)m * D, lane); }
    }
}
__device__ __forceinline__ void mod_phase(const float* x, bf16* H, const float* sh, const float* sc, int gw, int NGW, int lane) {
    for (int m = gw; m < M; m += NGW) {
        f32x4 v[4];
#pragma unroll
        for (int j = 0; j < 4; ++j) v[j] = *(const f32x4*)(x + (size_t)m * D + 4 * lane + 256 * j);
        float mean, rstd; row_stats(v, mean, rstd); store_mod(v, mean, rstd, sh, sc, H + (size_t)m * D, lane);
    }
}
__device__ __forceinline__ void ada_phase(CA a, LAS unsigned char* lds, int tid, int lane, int wave, int bid) {
    LAS float* cact = (LAS float*)lds; LAS float* part = cact + 1024;
    for (int i = tid; i < D; i += NTHR) { const float c = a->in[1][i]; cact[i] = c * sigm(c); }
    __syncthreads();
    float* ADA = (float*)(a->ws + WS_ADA);
    for (int task = bid; task < NL * 144; task += gridDim.x) {
        const int l = task / 144, col = (task % 144) * 64 + lane; const float* W = a->in[2] + (size_t)l * D * 9216 + col; float s = 0.f;
#pragma unroll 16
        for (int k = wave * 128; k < wave * 128 + 128; ++k) s += cact[k] * W[(size_t)k * 9216];
        part[wave * 64 + lane] = s; __syncthreads();
        if (wave == 0) { float t = 0.f;
#pragma unroll
            for (int w = 0; w < 8; ++w) t += part[w * 64 + lane];
            ADA[l * 9216 + col] = t + a->in[3][l * 9216 + col]; }
        __syncthreads();
    }
}

__device__ __forceinline__ void fscan_head(const bf16* Z, const float* fbias, float* FL2, int h, LAS unsigned char* lds, int tid, int lane, int wave) {
    LAS float* wt = (LAS float*)lds; const float fb = fbias[h]; float lf[32]; float run = 0.f;
#pragma unroll
    for (int i = 0; i < 32; ++i) { const float x = bf1(Z[(size_t)(tid * 32 + i) * ZP + ZFL + h]) + fb; run += -softplus_(-x); lf[i] = run; }
    float inc = run;
#pragma unroll
    for (int o = 1; o < 64; o <<= 1) { const float t = __shfl_up(inc, o); if (lane >= o) inc += t; }
    if (lane == 63) wt[wave] = inc;
    __syncthreads();
    float base = inc - run;
    for (int w = 0; w < wave; ++w) base += wt[w];
#pragma unroll
    for (int i = 0; i < 32; ++i) FL2[(size_t)h * M + tid * 32 + i] = (base + lf[i]) * LOG2E;
    __syncthreads();
}
__device__ __forceinline__ void codes_phase(const bf16* Z, const float* mu, bf16* CODES, int gtid, int NGT) {
    for (int it = gtid; it < M * 32; it += NGT) { const int t = it >> 5, j0 = (it & 31) * 8;
        const v4u z = *(const v4u*)(Z + (size_t)t * ZP + ZRW + 1536 + j0); v4u zp = (v4u){0u, 0u, 0u, 0u};
        if (t > 0) zp = *(const v4u*)(Z + (size_t)(t - 1) * ZP + ZRW + 1536 + j0);
        float o[8];
#pragma unroll
        for (int q = 0; q < 4; ++q) { const float a0 = bflo(z[q]), a1 = bfhi(z[q]), p0 = bflo(zp[q]), p1 = bfhi(zp[q]); const float m0 = mu[1536 + j0 + 2 * q], m1 = mu[1536 + j0 + 2 * q + 1];
            o[2 * q] = a0 + (p0 - a0) * m0; o[2 * q + 1] = a1 + (p1 - a1) * m1; }
#pragma unroll
        for (int q = 0; q < 8; ++q) { if (j0 < 64) o[q] = tanh_(o[q]); else if (j0 >= 128) o[q] = sigm(o[q]); }
        v4u w; w.x = pk2(o[0], o[1]); w.y = pk2(o[2], o[3]); w.z = pk2(o[4], o[5]); w.w = pk2(o[6], o[7]); *(v4u*)(CODES + (size_t)t * 256 + j0) = w; }
}
__device__ __forceinline__ void lru_l1(CA a, int l, const bf16* Z, bf16* HLOC, bf16* ACUM, float* AEND, float* HEND, LAS unsigned char* lds, int tid, int lane, int wave, int bid) {
    LAS float* xcf = (LAS float*)lds; LAS bf16* xcb = (LAS bf16*)(lds + 16640); LAS bf16* wga = (LAS bf16*)(lds + 25856); LAS bf16* wgx = (LAS bf16*)(lds + 35072);
    LAS float* la = (LAS float*)(lds + 44288); LAS float* lu = (LAS float*)(lds + 60928); LAS float* agg = (LAS float*)(lds + 77568);
    const float* cw = a->in[10] + (size_t)l * 4 * D; const float* cb = a->in[11] + (size_t)l * D;
    const float* gaw = a->in[12] + (size_t)l * 16 * 4096; const float* gab = a->in[13] + (size_t)l * D;
    const float* gxw = a->in[14] + (size_t)l * 16 * 4096; const float* gxb = a->in[15] + (size_t)l * D; const float* lam = a->in[16] + (size_t)l * D;
    int nprev = -1;
    for (int task = bid; task < NCH * 16; task += gridDim.x) {
        const int c = task >> 4, n = task & 15, t0 = c * LC;
        {
            const int tok = tid >> 3, cg8 = (tid & 7) * 8, ch0 = n * 64 + cg8; float acc[8];
#pragma unroll
            for (int q = 0; q < 8; ++q) acc[q] = cb[ch0 + q];
#pragma unroll
            for (int j = 0; j < 4; ++j) { const int tt = t0 + tok - 3 + j;
                if (tt >= 0) { const v4u x = *(const v4u*)(Z + (size_t)tt * ZP + ZXB + ch0);
#pragma unroll
                    for (int q = 0; q < 4; ++q) { acc[2 * q] += cw[j * D + ch0 + 2 * q] * bflo(x[q]); acc[2 * q + 1] += cw[j * D + ch0 + 2 * q + 1] * bfhi(x[q]); } } }
#pragma unroll
            for (int q = 0; q < 8; ++q) xcf[tok * 65 + cg8 + q] = acc[q];
            v4u w; w.x = pk2(acc[0], acc[1]); w.y = pk2(acc[2], acc[3]); w.z = pk2(acc[4], acc[5]); w.w = pk2(acc[6], acc[7]); *(LAS v4u*)(xcb + tok * 72 + cg8) = w;
        }
        if (n != nprev) {
            const int i = tid >> 3, j0 = (tid & 7) * 8;
#pragma unroll
            for (int q = 0; q < 8; ++q) { wga[(j0 + q) * 72 + i] = (bf16)f2bf(gaw[(size_t)n * 4096 + i * 64 + j0 + q]); wgx[(j0 + q) * 72 + i] = (bf16)f2bf(gxw[(size_t)n * 4096 + i * 64 + j0 + q]); }
            nprev = n;
        }
        __syncthreads();
        {
            const int tb = wave & 3, cbp = wave >> 2, fr = lane & 15, fq = lane >> 4;
            bf16x8 af[2];
#pragma unroll
            for (int kk = 0; kk < 2; ++kk) af[kk] = *(const LAS bf16x8*)(xcb + (tb * 16 + fr) * 72 + kk * 32 + fq * 8);
#pragma unroll
            for (int c2 = 0; c2 < 2; ++c2) { const int cbk = 2 * cbp + c2; f32x4 ar = (f32x4){0.f, 0.f, 0.f, 0.f}, ai = ar;
#pragma unroll
                for (int kk = 0; kk < 2; ++kk) { const bf16x8 b0 = *(const LAS bf16x8*)(wga + (cbk * 16 + fr) * 72 + kk * 32 + fq * 8), b1 = *(const LAS bf16x8*)(wgx + (cbk * 16 + fr) * 72 + kk * 32 + fq * 8);
                    ar = __builtin_amdgcn_mfma_f32_16x16x32_bf16(af[kk], b0, ar, 0, 0, 0); ai = __builtin_amdgcn_mfma_f32_16x16x32_bf16(af[kk], b1, ai, 0, 0, 0); }
                const int ch = cbk * 16 + fr, gch = n * 64 + ch; const float bga = gab[gch], bgx = gxb[gch], sp = log1pf(__expf(-lam[gch]));
#pragma unroll
                for (int rg = 0; rg < 4; ++rg) { const int tok = tb * 16 + fq * 4 + rg; const float r = sigm(ar[rg] + bga), ig = sigm(ai[rg] + bgx);
                    const float log_a = -8.f * r * sp, av = __expf(log_a), uv = sqrtf(-expm1f(2.f * log_a)) * (ig * xcf[tok * 65 + ch]);
                    la[tok * 65 + ch] = av; lu[tok * 65 + ch] = uv; } }
        }
        __syncthreads();
        {
            float hl[8], al[8]; float A = 1.f, h = 0.f;
#pragma unroll
            for (int s = 0; s < 8; ++s) { const float av = la[(wave * 8 + s) * 65 + lane], uv = lu[(wave * 8 + s) * 65 + lane]; h = av * h + uv; A *= av; hl[s] = h; al[s] = A; }
            agg[(wave * 2 + 0) * 64 + lane] = A; agg[(wave * 2 + 1) * 64 + lane] = h;
            __syncthreads();
            float cA = 1.f, cH = 0.f;
            for (int w = 0; w < wave; ++w) { const float A2 = agg[(w * 2 + 0) * 64 + lane], h2 = agg[(w * 2 + 1) * 64 + lane]; cH = A2 * cH + h2; cA *= A2; }
            float hf = 0.f, Af = 1.f;
#pragma unroll
            for (int s = 0; s < 8; ++s) { hf = hl[s] + al[s] * cH; Af = al[s] * cA; const size_t o = (size_t)(t0 + wave * 8 + s) * D + n * 64 + lane; HLOC[o] = (bf16)f2bf(hf); ACUM[o] = (bf16)f2bf(Af); }
            if (wave == 7) { AEND[c * D + n * 64 + lane] = Af; HEND[c * D + n * 64 + lane] = hf; }
        }
        __syncthreads();
    }
}
__device__ __forceinline__ void lru_l2(const float* AEND, const float* HEND, float* CAR, int gw, int lane) {
    if (gw < 16) { const int ch = gw * 64 + lane; float carry = 0.f;
#pragma unroll 8
        for (int c = 0; c < NCH; ++c) { CAR[c * D + ch] = carry; carry = AEND[c * D + ch] * carry + HEND[c * D + ch]; } }
}
__device__ __forceinline__ void lru_l3(bf16* Z, const bf16* HLOC, const bf16* ACUM, const float* CAR, int gtid, int NGT) {
    for (int it = gtid; it < M * 128; it += NGT) { const int t = it >> 7, ch0 = (it & 127) * 8; const size_t o = (size_t)t * D + ch0;
        const v4u hl = *(const v4u*)(HLOC + o), ac = *(const v4u*)(ACUM + o), yb = *(const v4u*)(Z + (size_t)t * ZP + ZYB + ch0);
        const f32x4 c0 = *(const f32x4*)(CAR + (t >> 6) * D + ch0), c1 = *(const f32x4*)(CAR + (t >> 6) * D + ch0 + 4); float o8[8];
#pragma unroll
        for (int q = 0; q < 4; ++q) { const float ca = (q < 2) ? c0[2 * q] : c1[2 * q - 4], cb_ = (q < 2) ? c0[2 * q + 1] : c1[2 * q - 3];
            o8[2 * q] = (bflo(hl[q]) + bflo(ac[q]) * ca) * gelu_tanh(bflo(yb[q])); o8[2 * q + 1] = (bfhi(hl[q]) + bfhi(ac[q]) * cb_) * gelu_tanh(bfhi(yb[q])); }
        v4u w; w.x = pk2(o8[0], o8[1]); w.y = pk2(o8[2], o8[3]); w.z = pk2(o8[4], o8[5]); w.w = pk2(o8[6], o8[7]); *(v4u*)(Z + (size_t)t * ZP + ZYB + ch0) = w; }
}
__device__ __forceinline__ void ld8bf(const bf16* p, float (&o)[8]) { const v4u u = *(const v4u*)p;
#pragma unroll
    for (int q = 0; q < 4; ++q) { o[2 * q] = bflo(u[q]); o[2 * q + 1] = bfhi(u[q]); } }
__device__ __forceinline__ void ld8f(const float* p, float (&o)[8]) { const f32x4 a = *(const f32x4*)p, b = *(const f32x4*)(p + 4); o[0] = a.x; o[1] = a.y; o[2] = a.z; o[3] = a.w; o[4] = b.x; o[5] = b.y; o[6] = b.z; o[7] = b.w; }
__device__ __forceinline__ void st8bf(bf16* p, const float (&v)[8]) { v4u w; w.x = pk2(v[0], v[1]); w.y = pk2(v[2], v[3]); w.z = pk2(v[4], v[5]); w.w = pk2(v[6], v[7]); *(v4u*)p = w; }
__device__ __forceinline__ float sum8lanes(float v) { v += __shfl_xor(v, 1); v += __shfl_xor(v, 2); v += __shfl_xor(v, 4); return v; }
__device__ __forceinline__ void rw_prep(CA a, int l, const bf16* Z, const bf16* LORA, float* Wd, bf16* R, bf16* KF, bf16* V, bf16* KK, bf16* Bv, bf16* GB, float* BON, int gw, int NGW, int lane) {
    const int c0 = 8 * lane;
    float mur[8], muk[8], muv[8], w0[8], a0[8], kk_[8], ka_[8], rk_[8];
    ld8f(a->in[17] + (size_t)l * 1792 + c0, mur); ld8f(a->in[17] + (size_t)l * 1792 + 512 + c0, muk); ld8f(a->in[17] + (size_t)l * 1792 + 1024 + c0, muv);
    ld8f(a->in[18] + (size_t)l * 512 + c0, w0); ld8f(a->in[20] + (size_t)l * 512 + c0, a0); ld8f(a->in[23] + (size_t)l * 512 + c0, kk_); ld8f(a->in[24] + (size_t)l * 512 + c0, ka_); ld8f(a->in[25] + (size_t)l * 512 + c0, rk_);
    for (int tb = gw * 8; tb < M; tb += NGW * 8) {
        float rp[8], kp[8], vp[8];
        if (tb > 0) { const bf16* zp = Z + (size_t)(tb - 1) * ZP + ZRW + c0; ld8bf(zp, rp); ld8bf(zp + 512, kp); ld8bf(zp + 1024, vp); }
        else {
#pragma unroll
            for (int q = 0; q < 8; ++q) { rp[q] = 0.f; kp[q] = 0.f; vp[q] = 0.f; } }
#pragma unroll 2
        for (int tt = 0; tt < 8; ++tt) { const int t = tb + tt; const bf16* zc = Z + (size_t)t * ZP + ZRW + c0; float rc[8], kc[8], vc[8], lw[8], la[8];
            ld8bf(zc, rc); ld8bf(zc + 512, kc); ld8bf(zc + 1024, vc);
            const bf16* lo = LORA + (size_t)t * 1536 + c0; ld8bf(lo, lw); ld8bf(lo + 512, la); const v4u lg = *(const v4u*)(lo + 1024);
            float r[8], k[8], v[8], dec[8], av[8], kk[8], kf[8], bb[8]; float n2 = 0.f, bs = 0.f;
#pragma unroll
            for (int q = 0; q < 8; ++q) { r[q] = rc[q] + (rp[q] - rc[q]) * mur[q]; k[q] = kc[q] + (kp[q] - kc[q]) * muk[q]; v[q] = vc[q] + (vp[q] - vc[q]) * muv[q];
                const float wv = -softplus_(-(w0[q] + lw[q])) - 0.5f; dec[q] = __expf(-__expf(wv)); av[q] = sigm(a0[q] + la[q]);
                kk[q] = k[q] * kk_[q]; n2 += kk[q] * kk[q]; kf[q] = k[q] * (1.f + (av[q] - 1.f) * ka_[q]); bs += r[q] * kf[q] * rk_[q];
                rp[q] = rc[q]; kp[q] = kc[q]; vp[q] = vc[q]; }
            n2 = sum8lanes(n2); bs = sum8lanes(bs); const float inv = 1.f / fmaxf(sqrtf(n2), 1e-12f);
#pragma unroll
            for (int q = 0; q < 8; ++q) { kk[q] *= inv; bb[q] = kk[q] * av[q]; }
            const size_t o = (size_t)t * 512 + c0;
            *(f32x4*)(Wd + o) = (f32x4){dec[0], dec[1], dec[2], dec[3]}; *(f32x4*)(Wd + o + 4) = (f32x4){dec[4], dec[5], dec[6], dec[7]};
            st8bf(R + o, r); st8bf(KF + o, kf); st8bf(V + o, v); st8bf(KK + o, kk); st8bf(Bv + o, bb); *(v4u*)(GB + o) = lg;
            if ((lane & 7) == 0) BON[t * 8 + (lane >> 3)] = bs; }
    }
}
constexpr int RW_PF = 4;
struct RwOps { unsigned kb, fr, w, v; };
__device__ __forceinline__ RwOps rw_load(const unsigned char* ws, const RwSet rs, size_t o  , int lane) {
    RwOps x; const int l5 = lane & 31;
    x.kb = *(const unsigned*)(ws + ((lane < 32) ? rs.kk : rs.b) + o * 2 + l5 * 4);
    x.fr = *(const unsigned*)(ws + ((lane < 32) ? rs.kf : rs.r) + o * 2 + l5 * 4);
    x.w = *(const unsigned*)(ws + rs.w + o * 4 + lane * 4);
    x.v = *(const bf16*)(ws + WS_RW_V + o * 2 + lane * 2);
    return x;
}
#define RL(x, i) ((unsigned)__builtin_amdgcn_readlane((int)(x), (i)))
#define RLF(x, i) __uint_as_float(RL(x, i))
template <bool WITH_V> __device__ __forceinline__ void rw_step1(float (&st)[64], const RwOps x) {
    float s0 = 0.f, s1 = 0.f;
#pragma unroll
    for (int k2 = 0; k2 < 32; ++k2) { const unsigned u0 = RL(x.kb, k2); s0 += st[2 * k2] * bflo(u0); s1 += st[2 * k2 + 1] * bfhi(u0); if ((k2 & 3) == 3) { asm volatile("" : "+v"(s0), "+v"(s1)); __builtin_amdgcn_sched_barrier(0); } }
    const float sa = -(s0 + s1), vv = __uint_as_float(x.v << 16);
#pragma unroll
    for (int k2 = 0; k2 < 32; ++k2) { const unsigned ub = RL(x.kb, 32 + k2); const float w0 = RLF(x.w, 2 * k2), w1 = RLF(x.w, 2 * k2 + 1); float t0 = sa * bflo(ub), t1 = sa * bfhi(ub);
        if (WITH_V) { const unsigned uf = RL(x.fr, k2); t0 += vv * bflo(uf); t1 += vv * bfhi(uf); }
        st[2 * k2] = st[2 * k2] * w0 + t0; st[2 * k2 + 1] = st[2 * k2 + 1] * w1 + t1; if ((k2 & 3) == 3) __builtin_amdgcn_sched_barrier(0); }
}
__device__ __forceinline__ void rw_r1(const unsigned char* ws, const RwSet rs, float* P, float* G, int gw, int NGW, int lane) {
    for (int T = gw; T < NCH * 8 * 2; T += NGW) { const int kind = T & 1, h = (T >> 1) & 7, c = T >> 4; float st[64];
        int ln_ = lane; asm volatile("" : "+v"(ln_));
#pragma unroll
        for (int k = 0; k < 64; ++k) st[k] = (kind == 0 && k == ln_) ? 1.f : 0.f;
        const size_t o0 = (size_t)(c * LC) * 512 + h * 64; RwOps q[RW_PF];
#pragma unroll
        for (int d = 0; d < RW_PF; ++d) q[d] = rw_load(ws, rs, o0 + (size_t)d * 512, ln_);
        for (int tb = 0; tb < LC; tb += RW_PF) {
#pragma unroll
            for (int d = 0; d < RW_PF; ++d) { const RwOps x = q[d]; if (tb + d + RW_PF < LC) q[d] = rw_load(ws, rs, o0 + (size_t)(tb + d + RW_PF) * 512, ln_);
                if (kind == 0) rw_step1<false>(st, x); else rw_step1<true>(st, x); } }
        float* dst = (kind == 0 ? P : G) + ((size_t)(h * NCH + c) * 64 + ln_) * 64;
#pragma unroll
        for (int k = 0; k < 64; k += 4) *(f32x4*)(dst + k) = (f32x4){st[k], st[k + 1], st[k + 2], st[k + 3]}; }
}
__device__ __forceinline__ float rw_step3(float (&st)[64], const RwOps x) {
    float s0 = 0.f, s1 = 0.f;
#pragma unroll
    for (int k2 = 0; k2 < 32; ++k2) { const unsigned u0 = RL(x.kb, k2); s0 += st[2 * k2] * bflo(u0); s1 += st[2 * k2 + 1] * bfhi(u0); if ((k2 & 3) == 3) { asm volatile("" : "+v"(s0), "+v"(s1)); __builtin_amdgcn_sched_barrier(0); } }
    const float sa = -(s0 + s1), vv = __uint_as_float(x.v << 16); float y0 = 0.f, y1 = 0.f;
#pragma unroll
    for (int k2 = 0; k2 < 32; ++k2) { const unsigned ub = RL(x.kb, 32 + k2), uf = RL(x.fr, k2), ur = RL(x.fr, 32 + k2); const float w0 = RLF(x.w, 2 * k2), w1 = RLF(x.w, 2 * k2 + 1);
        st[2 * k2] = st[2 * k2] * w0 + (sa * bflo(ub) + vv * bflo(uf)); st[2 * k2 + 1] = st[2 * k2 + 1] * w1 + (sa * bfhi(ub) + vv * bfhi(uf));
        y0 += st[2 * k2] * bflo(ur); y1 += st[2 * k2 + 1] * bfhi(ur); if ((k2 & 3) == 3) { asm volatile("" : "+v"(y0), "+v"(y1)); __builtin_amdgcn_sched_barrier(0); } }
    return y0 + y1;
}
__device__ __forceinline__ void rw_r2(const float* P, const float* G, float* S0, LAS unsigned char* lds, int lane, int wave, int bid) {
    LAS float* red = (LAS float*)lds;
    for (int rp = bid; rp < 256; rp += gridDim.x) { const int h = rp >> 5, v0 = (rp & 31) * 2; float s0 = 0.f, s1 = 0.f;
        const float* Ph = P + (size_t)h * NCH * 4096 + (size_t)(8 * wave) * 64 + lane; const float* Gh = G + (size_t)h * NCH * 4096 + (size_t)v0 * 64 + lane; float* Sh = S0 + (size_t)h * NCH * 4096 + (size_t)v0 * 64 + lane;
        float pq[8][8], gq[8][2];
#pragma unroll
        for (int d = 0; d < 8; ++d) {
#pragma unroll
            for (int jj = 0; jj < 8; ++jj) pq[d][jj] = Ph[(size_t)d * 4096 + jj * 64];
            gq[d][0] = Gh[(size_t)d * 4096]; gq[d][1] = Gh[(size_t)d * 4096 + 64]; }
        for (int c0 = 0; c0 < NCH; c0 += 8) {
#pragma unroll
            for (int d = 0; d < 8; ++d) { const int c = c0 + d;
                if (wave == 0) { Sh[(size_t)c * 4096] = s0; Sh[(size_t)c * 4096 + 64] = s1; }
                float p0 = 0.f, p1 = 0.f;
#pragma unroll
                for (int jj = 0; jj < 8; ++jj) { const float a0 = __builtin_bit_cast(float, __builtin_amdgcn_readlane(__builtin_bit_cast(int, s0), 8 * wave + jj)), a1 = __builtin_bit_cast(float, __builtin_amdgcn_readlane(__builtin_bit_cast(int, s1), 8 * wave + jj));
                    p0 += a0 * pq[d][jj]; p1 += a1 * pq[d][jj]; }
                LAS float* rd = red + (c & 1) * 1024;
                rd[(wave * 2 + 0) * 64 + lane] = p0; rd[(wave * 2 + 1) * 64 + lane] = p1;
                const float g0 = gq[d][0], g1 = gq[d][1];
                if (c + 8 < NCH) {
#pragma unroll
                    for (int jj = 0; jj < 8; ++jj) pq[d][jj] = Ph[(size_t)(c + 8) * 4096 + jj * 64];
                    gq[d][0] = Gh[(size_t)(c + 8) * 4096]; gq[d][1] = Gh[(size_t)(c + 8) * 4096 + 64]; }
                asm volatile("s_waitcnt lgkmcnt(0)\n\ts_barrier" ::: "memory");
                float n0 = g0, n1 = g1;
#pragma unroll
                for (int w = 0; w < 8; ++w) { n0 += rd[(w * 2 + 0) * 64 + lane]; n1 += rd[(w * 2 + 1) * 64 + lane]; }
                s0 = n0; s1 = n1; }
        }
        __syncthreads();
    }
}
__device__ __forceinline__ void rw_r3(CA a, int l, const unsigned char* ws, const RwSet rs, const float* S0, const float* BON, bf16* RWO, LAS unsigned char* lds, int gw, int NGW, int lane, int wave) {
    LAS float* yl = (LAS float*)(lds + wave * 16640);
    const float* gnw = a->in[26] + (size_t)l * 512; const float* gnb = a->in[27] + (size_t)l * 512;
    const bf16* Vb = (const bf16*)(ws + WS_RW_V); const bf16* GB = (const bf16*)(ws + WS_GB);
    for (int T = gw; T < NCH * 8; T += NGW) { const int h = T & 7, c = T >> 3; float st[64];
        const float* src = S0 + ((size_t)(h * NCH + c) * 64 + lane) * 64;
#pragma unroll
        for (int k = 0; k < 64; k += 4) { const f32x4 v4 = *(const f32x4*)(src + k); st[k] = v4.x; st[k + 1] = v4.y; st[k + 2] = v4.z; st[k + 3] = v4.w; }
        {   const size_t o0 = (size_t)(c * LC) * 512 + h * 64; RwOps q[RW_PF];
#pragma unroll
            for (int d = 0; d < RW_PF; ++d) q[d] = rw_load(ws, rs, o0 + (size_t)d * 512, lane);
            for (int tb = 0; tb < LC; tb += RW_PF) {
#pragma unroll
                for (int d = 0; d < RW_PF; ++d) { const RwOps x = q[d]; if (tb + d + RW_PF < LC) q[d] = rw_load(ws, rs, o0 + (size_t)(tb + d + RW_PF) * 512, lane); yl[(tb + d) * 65 + lane] = rw_step3(st, x); } } }
        LDS_WAIT(); asm volatile("" ::: "memory");
        {
            const int t = c * LC + lane; float y[64]; float s = 0.f;
#pragma unroll
            for (int v = 0; v < 64; ++v) { y[v] = yl[lane * 65 + v]; s += y[v]; }
            const float mean = s * (1.f / 64.f); float q = 0.f;
#pragma unroll
            for (int v = 0; v < 64; ++v) { const float d = y[v] - mean; q += d * d; }
            const float rstd = 1.f / sqrtf(q * (1.f / 64.f) + GN_EPS); const float bon = BON[t * 8 + h];
            const size_t o = (size_t)t * 512 + h * 64;
#pragma unroll
            for (int v8 = 0; v8 < 64; v8 += 8) { const v4u vv = *(const v4u*)(Vb + o + v8), gg = *(const v4u*)(GB + o + v8); float ov[8];
#pragma unroll
                for (int q2 = 0; q2 < 4; ++q2) { const int v = v8 + 2 * q2;
                    ov[2 * q2] = ((y[v] - mean) * rstd * gnw[h * 64 + v] + gnb[h * 64 + v] + bon * bflo(vv[q2])) * bflo(gg[q2]);
                    ov[2 * q2 + 1] = ((y[v + 1] - mean) * rstd * gnw[h * 64 + v + 1] + gnb[h * 64 + v + 1] + bon * bfhi(vv[q2])) * bfhi(gg[q2]); }
                v4u w; w.x = pk2(ov[0], ov[1]); w.y = pk2(ov[2], ov[3]); w.z = pk2(ov[4], ov[5]); w.w = pk2(ov[6], ov[7]); *(v4u*)(RWO + o + v8) = w; }
        }
        LDS_WAIT(); asm volatile("" ::: "memory");
    }
}

#define XB_TMO      128
#define XB_XCNT(j)  (256  + 64 * (j))
#define XB_XSUB(j)  (1280 + 64 * (j))
#define XB_XGEN(j)  (2304 + 64 * (j))
#define XB_TOP      3328
#define XB_TOPGEN   3392
#define XCD_BAR_WORDS 3456
#define XB_SPIN_CAP (1u << 18)

__device__ __forceinline__ unsigned xb_ld(unsigned* p)              { return __hip_atomic_load(p, __ATOMIC_RELAXED, __HIP_MEMORY_SCOPE_AGENT); }
__device__ __forceinline__ unsigned xb_add(unsigned* p, unsigned v) { return __hip_atomic_fetch_add(p, v, __ATOMIC_RELAXED, __HIP_MEMORY_SCOPE_AGENT); }
__device__ __forceinline__ unsigned xb_xcc_id() { return (unsigned)__builtin_amdgcn_s_getreg((3 << 11) | 20) & 0xFu; }
#define XB_SPIN(cond, bar) do { unsigned _sp = 0; while (cond) { __builtin_amdgcn_s_sleep(1); \
    if ((++_sp & 255u) == 0u) { if (xb_ld(&(bar)[XB_TMO])) break; if (_sp > XB_SPIN_CAP) { atomicAdd(&(bar)[XB_TMO], 1u); break; } } } } while (0)

struct XcdBarrier {
    unsigned* bar; unsigned x;
    volatile LAS unsigned* st;
};

__device__ __forceinline__ XcdBarrier xcd_barrier_post(unsigned* bar, volatile LAS unsigned* st) {
    XcdBarrier b; b.bar = bar; b.x = xb_xcc_id(); b.st = st;
    if (threadIdx.x == 0) (void)xb_add(&bar[XB_XCNT(b.x)], 1u);
    return b;
}
__device__ __forceinline__ void xcd_barrier_complete(unsigned* bar, unsigned x, unsigned& nloc, unsigned& nx) {
    const unsigned G = gridDim.x * gridDim.y * gridDim.z;
    unsigned sum, cnt, mine, sp = 0u;
    for (;;) {
        sum = 0u; cnt = 0u; mine = 0u;
#pragma unroll
        for (unsigned j = 0; j < 16; ++j) { const unsigned c = xb_ld(&bar[XB_XCNT(j)]); sum += c; cnt += (c > 0u) ? 1u : 0u; mine = (j == x) ? c : mine; }
        if (sum == G) break;
        __builtin_amdgcn_s_sleep(1);
        if ((++sp & 255u) == 0u) { if (xb_ld(&bar[XB_TMO])) break; if (sp > XB_SPIN_CAP) { atomicAdd(&bar[XB_TMO], 1u); break; } }
    }
    nloc = mine > 0u ? mine : 1u; nx = cnt > 0u ? cnt : 1u;
}

__device__ __forceinline__ void xcd_barrier(const XcdBarrier& b) {
    asm volatile("s_waitcnt vmcnt(0)" ::: "memory");
    __syncthreads();
    if (threadIdx.x == 0) {
        unsigned* bar = b.bar;
        __builtin_amdgcn_s_waitcnt(0);
        unsigned nloc = b.st[0], nx = b.st[1];
        if (nloc == 0u) { xcd_barrier_complete(bar, b.x, nloc, nx); b.st[0] = nloc; b.st[1] = nx; }
        const unsigned old = xb_add(&bar[XB_XSUB(b.x)], 1u);
        const unsigned gen = old / nloc;
        if (old + 1u == (gen + 1u) * nloc) {
            __builtin_amdgcn_fence(__ATOMIC_RELEASE, "agent");
            asm volatile("s_waitcnt vmcnt(0)" ::: "memory");
            const unsigned og = xb_add(&bar[XB_TOP], 1u);
            const unsigned tg = og / nx;
            if (og + 1u == (tg + 1u) * nx) xb_add(&bar[XB_TOPGEN], 1u);
            else XB_SPIN(xb_ld(&bar[XB_TOPGEN]) == tg, bar);
            __builtin_amdgcn_fence(__ATOMIC_ACQUIRE, "agent");
            xb_add(&bar[XB_XGEN(b.x)], 1u);
            asm volatile("s_waitcnt vmcnt(0)" ::: "memory");
        } else {
            XB_SPIN(xb_ld(&bar[XB_XGEN(b.x)]) == gen, bar);
            __builtin_amdgcn_fence(__ATOMIC_ACQUIRE, "agent");
            asm volatile("s_waitcnt vmcnt(0)" ::: "memory");
        }
    }
    __syncthreads();
}

__device__ __forceinline__ unsigned char* args_ws_ptr() { CA a = (CA)__builtin_amdgcn_kernarg_segment_ptr(); return a->ws; }
__global__ void __launch_bounds__(NTHR, 2) fwd_mega(Args args_unused) {
    extern __shared__ __attribute__((aligned(16))) unsigned char lds_raw[];
    LAS unsigned char* lds = (LAS unsigned char*)lds_raw;
    cg::grid_group grid = cg::this_grid();
    if (threadIdx.x < 16) ((LAS unsigned*)(lds + MISC_OFF))[threadIdx.x] = 0u;
    __syncthreads();
    (void)xcd_barrier_post((unsigned*)args_ws_ptr(), (volatile LAS unsigned*)(lds + MISC_OFF));
    const int G = gridDim.x, NGW = G * NWAVES, NGT = G * NTHR;
#define SYNC() do { XcdBarrier b_; { CA a_ = (CA)__builtin_amdgcn_kernarg_segment_ptr(); asm volatile("" : "+s"(a_)); b_.bar = (unsigned*)a_->ws; } b_.x = xb_xcc_id(); b_.st = (volatile LAS unsigned*)(lds + MISC_OFF); xcd_barrier(b_); } while (0)
#define PH_BEGIN { CA a = (CA)__builtin_amdgcn_kernarg_segment_ptr(); asm volatile("" : "+s"(a)); unsigned char* ws = a->ws; (void)ws; \
        int tid_l = threadIdx.x; asm volatile("" : "+v"(tid_l)); int bid_l = blockIdx.x; asm volatile("" : "+s"(bid_l)); \
        const int tid = tid_l, lane = tid & 63, bid = bid_l, wave = __builtin_amdgcn_readfirstlane(tid >> 6), gw = bid * NWAVES + wave, gtid = bid * NTHR + tid; (void)lane; (void)gtid; (void)gw; (void)wave;
#define PH_END }
#define WSP(T, off) ((T*)(ws + (off)))
#define ADA_L (WSP(float, WS_ADA) + l * 9216)
#define GEMM(EPI, Aptr, LDA, Bptr, N_, K_, ...) do { int kk_ = (K_); asm volatile("" : "+s"(kk_));   pg8::Gemm g_{(const pg8::bf16_t*)(Aptr), (const pg8::bf16_t*)(Bptr), M, (N_), kk_, (LDA)}; pg8::StaticOrder S_; S_.init(M, (N_), G, bid); \
        EPI E_{__VA_ARGS__}; pg8::gemm_phase<EPI, pg8::StaticOrder, PG8_ALIGN, PG8_SP2>(lds, g_, S_, E_); } while (0)

    PH_BEGIN ada_phase(a, lds, tid, lane, wave, bid); PH_END
    grid.sync();
    PH_BEGIN mod_phase(a->in[0], WSP(bf16, WS_HB), WSP(float, WS_ADA), WSP(float, WS_ADA) + D, gw, NGW, lane); convert_layer(a, 0, lds, gw, NGW, wave, lane); PH_END
    SYNC();

    for (int l = 0; l < NL; ++l) {
        PH_BEGIN GEMM(EpiSwiGLU, WSP(bf16, WS_HB), D, ws + W_UP0, 2 * DFF, D, WSP(bf16, WS_ACT), DFF); PH_END
        SYNC();
        PH_BEGIN GEMM(EpiGateF32, WSP(bf16, WS_ACT), DFF, ws + W_DN0, D, DFF, WSP(float, WS_Y), ADA_L + 2 * D, 0.5f); PH_END
        SYNC();
        PH_BEGIN ln_phase(l == 0 ? a->in[0] : a->out, WSP(float, WS_Y), a->out, WSP(bf16, WS_HB), a->in[4] + (size_t)l * 3 * D, a->in[5] + (size_t)l * 3 * D, ADA_L + 3 * D, ADA_L + 4 * D, true, gw, NGW, lane); PH_END
        SYNC();
        PH_BEGIN GEMM(EpiIn, WSP(bf16, WS_HB), D, ws + W_IN, ZP, D, WSP(bf16, WS_Z)); PH_END
        SYNC();
        PH_BEGIN if (bid < 8) fscan_head(WSP(bf16, WS_Z), a->in[9] + l * 8, WSP(float, WS_FL2), bid, lds, tid, lane, wave); PH_END
        PH_BEGIN codes_phase(WSP(bf16, WS_Z), a->in[17] + (size_t)l * 1792, WSP(bf16, WS_CODES), gtid, NGT); PH_END
        PH_BEGIN lru_l1(a, l, WSP(bf16, WS_Z), WSP(bf16, WS_HLOC), WSP(bf16, WS_ACUM), WSP(float, WS_LAEND), WSP(float, WS_LHEND), lds, tid, lane, wave, bid); PH_END
        SYNC();
        PH_BEGIN GEMM(EpiPlain, ws + WS_CODES, 256, ws + W_LORA, 1536, 256, WSP(bf16, WS_LORA), 1536); PH_END
        PH_BEGIN lru_l2(WSP(const float, WS_LAEND), WSP(const float, WS_LHEND), WSP(float, WS_LCAR), gw, lane); PH_END
        SYNC();
        PH_BEGIN const RwSet rs = rw_set(l); rw_prep(a, l, WSP(bf16, WS_Z), WSP(const bf16, WS_LORA), WSP(float, rs.w), WSP(bf16, rs.r), WSP(bf16, rs.kf), WSP(bf16, WS_RW_V), WSP(bf16, rs.kk), WSP(bf16, rs.b), WSP(bf16, WS_GB), WSP(float, WS_BON), gw, NGW, lane); PH_END
        PH_BEGIN lru_l3(WSP(bf16, WS_Z), WSP(const bf16, WS_HLOC), WSP(const bf16, WS_ACUM), WSP(const float, WS_LCAR), gtid, NGT); PH_END
        SYNC();
        PH_BEGIN rw_r1(ws, rw_set(l), WSP(float, WS_P), WSP(float, WS_G), gw, NGW, lane); PH_END
        SYNC();
        PH_BEGIN rw_r2(WSP(const float, WS_P), WSP(const float, WS_G), WSP(float, WS_S0), lds, lane, wave, bid); PH_END
        SYNC();
        PH_BEGIN rw_r3(a, l, ws, rw_set(l), WSP(const float, WS_S0), WSP(const float, WS_BON), WSP(bf16, WS_RWO), lds, gw, NGW, lane, wave); PH_END
        __syncthreads();
        PH_BEGIN
            bf16* Zb = WSP(bf16, WS_Z);
            const attn_body::AttnTensors AT{(const attn_body::bf16*)(Zb + ZQ), (const attn_body::bf16*)(Zb + ZK), (const attn_body::bf16*)(Zb + ZV), (attn_body::bf16*)(Zb + ZXB), WSP(const float, WS_FL2)};
            const attn_body::StaticOrder S((int)G, bid);
            attn_body::attn_phase<attn_body::StaticOrder>((char*)lds_raw, AT, S);
        PH_END
        SYNC();
        PH_BEGIN GEMM(EpiProj<0>, WSP(bf16, WS_Z) + ZXB, ZP, ws + W_PA, D, 512, WSP(float, WS_Y), WSP(bf16, WS_Z), WSP(bf16, WS_HB)); PH_END
        __builtin_amdgcn_fence(__ATOMIC_SEQ_CST, "agent");
        PH_BEGIN GEMM(EpiProj<1>, WSP(bf16, WS_Z) + ZYB, ZP, ws + W_PB, D, D, WSP(float, WS_Y), WSP(bf16, WS_Z), WSP(bf16, WS_HB)); PH_END
        __builtin_amdgcn_fence(__ATOMIC_SEQ_CST, "agent");
        PH_BEGIN GEMM(EpiProj<2>, ws + WS_RWO, 512, ws + W_PC, D, 512, WSP(float, WS_Y), WSP(bf16, WS_Z), WSP(bf16, WS_HB)); PH_END
        SYNC();
        PH_BEGIN GEMM(EpiGateF32, WSP(bf16, WS_HB), D, ws + W_OUT, D, D, WSP(float, WS_Y), ADA_L + 5 * D, 1.0f); PH_END
        SYNC();
        PH_BEGIN ln_phase(a->out, WSP(float, WS_Y), a->out, WSP(bf16, WS_HB), a->in[4] + (size_t)(l * 3 + 1) * D, a->in[5] + (size_t)(l * 3 + 1) * D, ADA_L + 6 * D, ADA_L + 7 * D, true, gw, NGW, lane); PH_END
        SYNC();
        PH_BEGIN GEMM(EpiSwiGLU, WSP(bf16, WS_HB), D, ws + W_UP1, 2 * DFF, D, WSP(bf16, WS_ACT), DFF); PH_END
        SYNC();
        PH_BEGIN GEMM(EpiGateF32, WSP(bf16, WS_ACT), DFF, ws + W_DN1, D, DFF, WSP(float, WS_Y), ADA_L + 8 * D, 0.5f); PH_END
        SYNC();
        PH_BEGIN ln_phase(a->out, WSP(float, WS_Y), a->out, WSP(bf16, WS_HB), a->in[4] + (size_t)(l * 3 + 2) * D, a->in[5] + (size_t)(l * 3 + 2) * D, ADA_L + 9216, ADA_L + 9216 + D, l + 1 < NL, gw, NGW, lane); PH_END
        if (l + 1 < NL) { PH_BEGIN convert_layer(a, l + 1, lds, gw, NGW, wave, lane); PH_END SYNC(); }
    }
#undef SYNC
#undef GEMM
}

extern "C" void kernel_launch(void* const* d_in, const int* in_sizes, int n_in, void* d_out, int out_size, void* d_ws, size_t ws_size, hipStream_t stream) {
    static int grid = 0;
    if (grid == 0) {
        if (n_in != 32 || out_size != M * D || ws_size < WS_END) { fprintf(stderr, "kernel_launch: unexpected shapes (n_in %d, out %d, ws %zu)\n", n_in, out_size, ws_size); grid = -1; return; }
        int dev = 0, cus = 0, per_cu = 0;
        hipGetDevice(&dev); hipDeviceGetAttribute(&cus, hipDeviceAttributeMultiprocessorCount, dev);
        hipFuncSetAttribute((const void*)fwd_mega, hipFuncAttributeMaxDynamicSharedMemorySize, LDS_BYTES);
        if (hipOccupancyMaxActiveBlocksPerMultiprocessor(&per_cu, (const void*)fwd_mega, NTHR, LDS_BYTES) != hipSuccess || per_cu < 1) { fprintf(stderr, "kernel_launch: occupancy query says %d blocks per CU\n", per_cu); per_cu = 1; }
        (void)hipGetLastError();
        grid = cus * per_cu;
        fprintf(stderr, "kernel_launch: grid %d (cus %d x %d), lds %d\n", grid, cus, per_cu, LDS_BYTES);
    }
    if (grid < 0) return;
    Args a{};
    for (int i = 0; i < 32; ++i) a.in[i] = (const float*)d_in[i];
    a.out = (float*)d_out; a.ws = (unsigned char*)d_ws;
    if (hipMemsetAsync(d_ws, 0, CTL_ZERO_BYTES, stream) != hipSuccess) { fprintf(stderr, "kernel_launch: memset of the barrier words failed\n"); return; }
    void* kargs[] = {&a};
    hipError_t e = hipLaunchCooperativeKernel((const void*)fwd_mega, dim3(grid), dim3(NTHR), kargs, LDS_BYTES, stream);
    if (e != hipSuccess) fprintf(stderr, "kernel_launch: cooperative launch failed: %s (grid %d)\n", hipGetErrorString(e), grid);
}
```

```cpp
#include <hip/hip_runtime.h>
#include <hip/hip_cooperative_groups.h>
#include <cstdio>
#include <cstdint>
namespace cg = cooperative_groups;
namespace pg8 {
#define PG8_LAS __attribute__((address_space(3)))
typedef unsigned short bf16_t;
typedef short bf16x8 __attribute__((ext_vector_type(8)));
typedef float f32x4 __attribute__((ext_vector_type(4)));
typedef unsigned u32x4 __attribute__((ext_vector_type(4)));
constexpr int BM = 256, BK = 64, HALF = 128, HTB = HALF * BK * 2  , STAGE_BYTES = 8 * HTB, NXCD = 8, WGM = 8;

__host__ __device__ __forceinline__ int lds_byte(int r, int c) { const int st = (r >> 4) * 2 + (c >> 5), rr = r & 15, cc = c & 31, ob = rr * 64 + cc * 2; return st * 1024 + (ob ^ (((ob >> 9) & 1) << 5)); }
__host__ __device__ __forceinline__ void stage_rc(int b, int& R, int& C) { const int st = b / 1024, sb = b % 1024, swz = sb ^ (((sb >> 9) & 1) << 5); R = (st >> 1) * 16 + swz / 64; C = (st & 1) * 32 + (swz % 64) / 2; }
__host__ __device__ __forceinline__ int perm32(int rho) { const int n = rho >> 4, i = rho & 15; return 8 * (i >> 2) + 4 * n + (i & 3); }

struct Unit { int pm, pn; };
struct Gemm { const bf16_t* A; const bf16_t* Bt; int M, N, K, lda; };

struct StaticOrder {
    int nM, nN, nwg, G, c;
    __host__ __device__ void init(int M, int N, int G_, int c_) { nM = M / BM; nN = N / BM; nwg = nM * nN; G = G_; c = c_; }
    __host__ __device__ bool next(int i, Unit& u) const {
        const long L = (long)i * G + c; if (L >= nwg) return false;
        int wgid = (int)L; { const int q = nwg / NXCD, r = nwg % NXCD, xcd = wgid % NXCD, off = wgid / NXCD; wgid = (xcd < r ? xcd * (q + 1) : r * (q + 1) + (xcd - r) * q) + off; }
        const int nig = WGM * nN, gid = wgid / nig, fm = gid * WGM, gsz = (nM - fm) < WGM ? (nM - fm) : WGM;
        u.pm = fm + ((wgid % nig) % gsz); u.pn = (wgid % nig) / gsz; return true;
    }
    __device__ __forceinline__ void a_ready(const Unit&) const {}
    __device__ __forceinline__ void done(const Unit&) const {}
};

__device__ __forceinline__ unsigned cvt_pk_bf16(float lo, float hi) { unsigned r; asm volatile("v_cvt_pk_bf16_f32 %0, %1, %2" : "=v"(r) : "v"(lo), "v"(hi)); return r; }
typedef float f32x2 __attribute__((ext_vector_type(2)));
__device__ __forceinline__ f32x2 gelu_pk(f32x2 v) {
    const f32x2 av = __builtin_elementwise_abs(v), d = av * 0.2316418882f + 1.0f;
    f32x2 t; t.x = __builtin_amdgcn_rcpf(d.x); t.y = __builtin_amdgcn_rcpf(d.y);
    f32x2 q = t * 0.5307027145f + (-0.7265760135f); q = q * t + 0.7107068705f; q = q * t + (-0.142248368f); q = q * t + 0.127414796f; q = q * t;
    const f32x2 s = (v * v) * (-0.72134752044f);
    f32x2 e; e.x = __builtin_amdgcn_exp2f(s.x); e.y = __builtin_amdgcn_exp2f(s.y);
    const f32x2 m = v * (q * e), r = v - m;
    f32x2 o; o.x = v.x < 0.f ? m.x : r.x; o.y = v.y < 0.f ? m.y : r.y; return o;
}

template <int ACT  > struct EpiBf16 {
    static constexpr bool PERM = true, AFTER_DRAIN = false; static_assert(ACT == 0 || ACT == 1, "EpiBf16: ACT is 0 (none) or 1 (gelu_pk)");
    bf16_t* O; int ldc; const float* bias; int split_cols; size_t split_stride; float scale0;
    __device__ __forceinline__ void operator()(const f32x4 (&acc)[2][2][4][2], const Unit& u, int wr, int wc, int fr, int fq) const {
        const int row0 = u.pm * BM + wr * 64 + fr; int colt = u.pn * BM; bf16_t* base = O;
        float sc = 1.f; if (split_cols) { const int t = colt / split_cols; base += (size_t)t * split_stride; colt -= t * split_cols; if (t == 0) sc = scale0; }
        const int col0 = colt + wc * 32 + 8 * fq, bcol0 = u.pn * BM + wc * 32 + 8 * fq;
        f32x4 bv[2][2];
#pragma unroll
        for (int bj = 0; bj < 2; ++bj)
#pragma unroll
            for (int n = 0; n < 2; ++n) bv[bj][n] = bias ? *(const f32x4*)(bias + bcol0 + bj * HALF + 4 * n) : (f32x4){0.f, 0.f, 0.f, 0.f};
#pragma unroll
        for (int ai = 0; ai < 2; ++ai)
#pragma unroll
            for (int m = 0; m < 4; ++m) { bf16_t* rowp = base + (size_t)(row0 + ai * HALF + m * 16) * ldc + col0;
#pragma unroll
                for (int bj = 0; bj < 2; ++bj) { f32x4 v0 = acc[ai][bj][m][0] + bv[bj][0], v1 = acc[ai][bj][m][1] + bv[bj][1];
                    if (ACT == 1) { f32x2 a = gelu_pk((f32x2){v0[0], v0[1]}), b = gelu_pk((f32x2){v0[2], v0[3]}), c = gelu_pk((f32x2){v1[0], v1[1]}), d = gelu_pk((f32x2){v1[2], v1[3]});
                        v0 = (f32x4){a.x, a.y, b.x, b.y}; v1 = (f32x4){c.x, c.y, d.x, d.y}; }
                    v0 = v0 * sc; v1 = v1 * sc; u32x4 w; w.x = cvt_pk_bf16(v0[0], v0[1]); w.y = cvt_pk_bf16(v0[2], v0[3]); w.z = cvt_pk_bf16(v1[0], v1[1]); w.w = cvt_pk_bf16(v1[2], v1[3]);
                    *(u32x4*)(rowp + bj * HALF) = w; } }
    }
};

struct PanelStats {
    unsigned* xbuf;
    unsigned* cnt;
    unsigned* tmo;
    int ntn; float eps;
    unsigned code;
    __device__ __forceinline__ bool run(const f32x4 (&v)[2][2][4][2], const Unit& u, int wr, int wc, int fr, int fq, PG8_LAS unsigned char* lds, int wid, int lane) const {
        typedef float f32x2v __attribute__((ext_vector_type(2)));
        PG8_LAS f32x2v* P = (PG8_LAS f32x2v*)lds;
        PG8_LAS f32x2v* S = (PG8_LAS f32x2v*)(lds + 8192);
        PG8_LAS unsigned* flag = (PG8_LAS unsigned*)(lds + 8192 + 2048);
#pragma unroll
        for (int ai = 0; ai < 2; ++ai)
#pragma unroll
            for (int m = 0; m < 4; ++m) {
                float s = 0.f;
#pragma unroll
                for (int bj = 0; bj < 2; ++bj)
#pragma unroll
                    for (int n = 0; n < 2; ++n) { const f32x4 x = v[ai][bj][m][n]; s += (x[0] + x[1]) + (x[2] + x[3]); }
                s += __shfl_xor(s, 16); s += __shfl_xor(s, 32);
                const float mw = s * (1.0f / 64.0f); float q = 0.f;
#pragma unroll
                for (int bj = 0; bj < 2; ++bj)
#pragma unroll
                    for (int n = 0; n < 2; ++n) { const f32x4 d = v[ai][bj][m][n] - mw; q += (d[0] * d[0] + d[1] * d[1]) + (d[2] * d[2] + d[3] * d[3]); }
                q += __shfl_xor(q, 16); q += __shfl_xor(q, 32);
                if (fq == 0) P[(ai * HALF + wr * 64 + m * 16 + fr) * 4 + wc] = (f32x2v){mw, q};
            }
        asm volatile("s_waitcnt lgkmcnt(0)" ::: "memory"); __builtin_amdgcn_s_barrier(); asm volatile("" ::: "memory");
#if defined(BROKEN_EXCHANGE_NO_WAIT)
#warning BROKEN CONTROL BUILD: the row-statistics exchange does not wait; results are wrong by design
        if (blockIdx.x >= 64) { const long long t0_ = clock64(); while (clock64() - t0_ < 60000) __builtin_amdgcn_s_sleep(8); }
#endif
        const int row = wid * 32 + (lane & 31);
        if (lane < 32) {
            const f32x2v a = P[row * 4 + 0], b = P[row * 4 + 1], c = P[row * 4 + 2], d = P[row * 4 + 3];
            const float mt = (a.x + b.x + c.x + d.x) * 0.25f;
            const float da = a.x - mt, db = b.x - mt, dc = c.x - mt, dd = d.x - mt;
            const float m2 = (a.y + b.y) + (c.y + d.y) + 64.0f * ((da * da + db * db) + (dc * dc + dd * dd));
            unsigned long long* slot = (unsigned long long*)xbuf + ((size_t)(u.pm * BM + row) * 4 + u.pn);
            __hip_atomic_store(slot, ((unsigned long long)__float_as_uint(m2) << 32) | __float_as_uint(mt), __ATOMIC_RELAXED, __HIP_MEMORY_SCOPE_AGENT);
        }
        asm volatile("s_waitcnt vmcnt(0)" ::: "memory");
        if (lane == 0) __hip_atomic_fetch_add(cnt + 64 * u.pm, 1u, __ATOMIC_RELAXED, __HIP_MEMORY_SCOPE_AGENT);
        if (wid == 0) {
            bool dead = false; const unsigned long long t0 = __builtin_amdgcn_s_memrealtime(); const unsigned want = 8u * (unsigned)ntn;
            for (;;) {
#if defined(BROKEN_EXCHANGE_NO_WAIT)
                break;
#endif
                if ((unsigned)__builtin_amdgcn_readfirstlane(__hip_atomic_load(cnt + 64 * u.pm, __ATOMIC_RELAXED, __HIP_MEMORY_SCOPE_AGENT)) >= want) break;
                if (__builtin_amdgcn_s_memrealtime() - t0 > 2000000ull) {
                    if (lane == 0) { unsigned expect = 0u; __hip_atomic_compare_exchange_strong(tmo + 1, &expect, code | (unsigned)(u.pm & 0xff), __ATOMIC_RELAXED, __ATOMIC_RELAXED, __HIP_MEMORY_SCOPE_AGENT);
                                     __hip_atomic_store(tmo, 1u, __ATOMIC_RELAXED, __HIP_MEMORY_SCOPE_AGENT); }
                    dead = true; break; }
                __builtin_amdgcn_s_sleep(2);
            }
            __builtin_amdgcn_fence(__ATOMIC_ACQUIRE, "agent");
            if (lane == 0) flag[0] = dead ? 1u : 0u;
        }
        asm volatile("s_waitcnt vmcnt(0) lgkmcnt(0)" ::: "memory"); __builtin_amdgcn_s_barrier(); asm volatile("" ::: "memory");
        const bool bad = flag[0] != 0u;
        if (lane < 32) {
            const unsigned long long* slot = (const unsigned long long*)xbuf + (size_t)(u.pm * BM + row) * 4; float mt[4], m2[4]; float ms = 0.f;
#pragma unroll
            for (int t = 0; t < 4; ++t) { if (t < ntn) { const unsigned long long w = __hip_atomic_load(slot + t, __ATOMIC_RELAXED, __HIP_MEMORY_SCOPE_AGENT); mt[t] = __uint_as_float((unsigned)w); m2[t] = __uint_as_float((unsigned)(w >> 32)); } else { mt[t] = 0.f; m2[t] = 0.f; } ms += mt[t]; }
            const float mean = ms / (float)ntn; float q = 0.f;
#pragma unroll
            for (int t = 0; t < 4; ++t) if (t < ntn) { const float dm = mt[t] - mean; q += m2[t] + 256.0f * dm * dm; }
            S[row] = (f32x2v){mean, 1.0f / sqrtf(q / (256.0f * (float)ntn) + eps)};
        }
        asm volatile("s_waitcnt lgkmcnt(0)" ::: "memory"); __builtin_amdgcn_s_barrier(); asm volatile("" ::: "memory");
        return bad;
    }
};
struct EpiLnRes {
    static constexpr bool PERM = false, AFTER_DRAIN = true;
    const float* base; float* out; int ldc; const float* bias; PanelStats st; unsigned poison;
    __device__ __forceinline__ void fused(f32x4 (&acc)[2][2][4][2], const Unit& u, int wr, int wc, int fr, int fq, PG8_LAS unsigned char* lds, int wid, int lane) const {
        typedef float f32x2v __attribute__((ext_vector_type(2)));
        const PG8_LAS f32x2v* S = (const PG8_LAS f32x2v*)(lds + 8192);
        const int col0 = u.pn * BM + wc * 32 + 4 * fq;
#pragma unroll
        for (int bj = 0; bj < 2; ++bj)
#pragma unroll
            for (int n = 0; n < 2; ++n) { const f32x4 bv = bias ? *(const f32x4*)(bias + col0 + bj * HALF + n * 16) : (f32x4){0.f, 0.f, 0.f, 0.f};
#pragma unroll
                for (int ai = 0; ai < 2; ++ai)
#pragma unroll
                    for (int m = 0; m < 4; ++m) acc[ai][bj][m][n] += bv; }
        f32x4 pre[4][2][2];
#pragma unroll
        for (int m = 0; m < 4; ++m) { const size_t off = (size_t)(u.pm * BM + wr * 64 + m * 16 + fr) * ldc + col0;
#pragma unroll
            for (int bj = 0; bj < 2; ++bj)
#pragma unroll
                for (int n = 0; n < 2; ++n) pre[m][bj][n] = *(const f32x4*)(base + off + bj * HALF + n * 16); }
        const bool bad = st.run(acc, u, wr, wc, fr, fq, lds, wid, lane) || poison != 0u;
        const float qnan = __builtin_nanf("");
#pragma unroll
        for (int ai = 0; ai < 2; ++ai)
#pragma unroll
            for (int m = 0; m < 4; ++m) { const int r = ai * HALF + wr * 64 + m * 16 + fr; const f32x2v sr = S[r]; const size_t off = (size_t)(u.pm * BM + r) * ldc + col0;
#pragma unroll
                for (int bj = 0; bj < 2; ++bj)
#pragma unroll
                    for (int n = 0; n < 2; ++n) { const f32x4 bs = ai == 0 ? pre[m][bj][n] : *(const f32x4*)(base + off + bj * HALF + n * 16); f32x4 o = bs + (acc[ai][bj][m][n] - sr.x) * sr.y;
                        if (bad) o = (f32x4){qnan, qnan, qnan, qnan}; *(f32x4*)(out + off + bj * HALF + n * 16) = o; }
                if (m & 1) asm volatile("" ::: "memory"); }
    }
};
struct EpiLnResLn {
    static constexpr bool PERM = false, AFTER_DRAIN = true;
    const float* base; float* out; bf16_t* xn; int ldc; const float* bias; PanelStats st1, st2; unsigned poison;
    __device__ __forceinline__ void fused(f32x4 (&acc)[2][2][4][2], const Unit& u, int wr, int wc, int fr, int fq, PG8_LAS unsigned char* lds, int wid, int lane) const {
        typedef float f32x2v __attribute__((ext_vector_type(2))); typedef unsigned u32x2v __attribute__((ext_vector_type(2)));
        const PG8_LAS f32x2v* S = (const PG8_LAS f32x2v*)(lds + 8192);
        const int col0 = u.pn * BM + wc * 32 + 4 * fq;
#pragma unroll
        for (int bj = 0; bj < 2; ++bj)
#pragma unroll
            for (int n = 0; n < 2; ++n) { const f32x4 bv = bias ? *(const f32x4*)(bias + col0 + bj * HALF + n * 16) : (f32x4){0.f, 0.f, 0.f, 0.f};
#pragma unroll
                for (int ai = 0; ai < 2; ++ai)
#pragma unroll
                    for (int m = 0; m < 4; ++m) acc[ai][bj][m][n] += bv; }
        bool bad = st1.run(acc, u, wr, wc, fr, fq, lds, wid, lane) || poison != 0u;
        const float qnan = __builtin_nanf("");
#pragma unroll
        for (int ai = 0; ai < 2; ++ai)
#pragma unroll
            for (int m = 0; m < 4; ++m) { const int r = ai * HALF + wr * 64 + m * 16 + fr; const f32x2v sr = S[r]; const size_t off = (size_t)(u.pm * BM + r) * ldc + col0;
#pragma unroll
                for (int bj = 0; bj < 2; ++bj)
#pragma unroll
                    for (int n = 0; n < 2; ++n) { const f32x4 bs = *(const f32x4*)(base + off + bj * HALF + n * 16); acc[ai][bj][m][n] = bs + (acc[ai][bj][m][n] - sr.x) * sr.y; }
                asm volatile("" : "+v"(acc[ai][0][m][0]), "+v"(acc[ai][0][m][1]), "+v"(acc[ai][1][m][0]), "+v"(acc[ai][1][m][1]));
                if (m & 1) asm volatile("" ::: "memory"); }
        const bool bad1 = bad;
        bad = st2.run(acc, u, wr, wc, fr, fq, lds, wid, lane) || bad;
#pragma unroll
        for (int ai = 0; ai < 2; ++ai)
#pragma unroll
            for (int m = 0; m < 4; ++m) { const int r = ai * HALF + wr * 64 + m * 16 + fr; const f32x2v sr = S[r]; const size_t off = (size_t)(u.pm * BM + r) * ldc + col0;
#pragma unroll
                for (int bj = 0; bj < 2; ++bj)
#pragma unroll
                    for (int n = 0; n < 2; ++n) { const f32x4 x1 = acc[ai][bj][m][n]; *(f32x4*)(out + off + bj * HALF + n * 16) = bad1 ? (f32x4){qnan, qnan, qnan, qnan} : x1;
                        const f32x4 o = (x1 - sr.x) * sr.y; u32x2v w; w.x = cvt_pk_bf16(o[0], o[1]); w.y = cvt_pk_bf16(o[2], o[3]);
                        if (bad) { w.x = 0x7fc07fc0u; w.y = 0x7fc07fc0u; } *(u32x2v*)(xn + off + bj * HALF + n * 16) = w; }
                asm volatile("" ::: "memory"); }
    }
};

template <class Epi, class Sched, bool ALIGN_EPI = false, bool SP2 = false>
__device__ __forceinline__ void gemm_phase(PG8_LAS unsigned char* lds, const Gemm g, const Sched& S, const Epi& E, int tid_in) {
    int tid_l = tid_in; asm volatile("" : "+v"(tid_l));
    const int tid = tid_l, wid = __builtin_amdgcn_readfirstlane(tid >> 6), lane = tid & 63, wr = wid >> 2, wc = wid & 3, fr = lane & 15, fq = lane >> 4;
    const int K = g.K, nt = K / BK;
    unsigned voffA[2], voffB[2];
#pragma unroll
    for (int i = 0; i < 2; ++i) { int R, C; stage_rc(tid * 16 + i * 8192, R, C); const int Rb = Epi::PERM ? ((R & ~31) + perm32(R & 31)) : R;
        voffA[i] = (unsigned)(R * g.lda + C) * 2u; voffB[i] = (unsigned)(Rb * K + C) * 2u; }
    const size_t kstep = (size_t)(BK * 2);
    const size_t hstep = (size_t)HALF * K * 2;
    const size_t tstep = 2 * hstep; const size_t hstepA = (size_t)HALF * g.lda * 2, tstepA = 2 * hstepA;
    const unsigned ldsw = (unsigned)wid * 1024u;
    const int aoff = lds_byte(wr * 64 + fr, fq * 8), boff = lds_byte(wc * 32 + fr, fq * 8);
#define PG8_SA(b, h) (((b) * 2 + (h)) * HTB)
#define PG8_SB(b, h) ((4 + (b) * 2 + (h)) * HTB)
#define PG8_STAGE(bufoff, gbase, voff) do { _Pragma("unroll") for (int _i = 0; _i < 2; ++_i) \
        __builtin_amdgcn_global_load_lds((const unsigned*)((const char*)(gbase) + (voff)[_i]), (PG8_LAS unsigned*)(lds + (bufoff) + ldsw + _i * 8192), 16, 0, 0); } while (0)
#define PG8_LDA(dst, b, h) do { _Pragma("unroll") for (int m = 0; m < 4; ++m) _Pragma("unroll") for (int k = 0; k < 2; ++k) dst[m][k] = *(const PG8_LAS bf16x8*)(lds + PG8_SA(b, h) + aoff + m * 2048 + k * 1024); } while (0)
#define PG8_LDB(dst, b, h) do { _Pragma("unroll") for (int n = 0; n < 2; ++n) _Pragma("unroll") for (int k = 0; k < 2; ++k) dst[n][k] = *(const PG8_LAS bf16x8*)(lds + PG8_SB(b, h) + boff + n * 2048 + k * 1024); } while (0)
#define PG8_MMA(ai, bj, At, Bt) do { __builtin_amdgcn_s_setprio(1); _Pragma("unroll") for (int m = 0; m < 4; ++m) _Pragma("unroll") for (int n = 0; n < 2; ++n) _Pragma("unroll") for (int k = 0; k < 2; ++k) \
        acc[ai][bj][m][n] = __builtin_amdgcn_mfma_f32_16x16x32_bf16(Bt[n][k], At[m][k], acc[ai][bj][m][n], 0, 0, 0); __builtin_amdgcn_s_setprio(0); } while (0)
#define PG8_WAIT_V(n) asm volatile("s_waitcnt vmcnt(" #n ")" ::: "memory")
#define PG8_WAIT_L(n) asm volatile("s_waitcnt lgkmcnt(" #n ")" ::: "memory")
#define PG8_BAR __builtin_amdgcn_s_barrier()
#define PG8_SCHED __builtin_amdgcn_sched_barrier(0)
    Unit cur, nxt; int ui = 0;
    if (!S.next(0, cur)) return;
    f32x4 acc[2][2][4][2];
#pragma unroll
    for (int a = 0; a < 2; ++a)
#pragma unroll
        for (int b = 0; b < 2; ++b)
#pragma unroll
            for (int m = 0; m < 4; ++m)
#pragma unroll
                for (int n = 0; n < 2; ++n) acc[a][b][m][n] = (f32x4){0.f, 0.f, 0.f, 0.f};
    bf16x8 At[4][2], B0[2][2], B1[2][2];
    const char* cA = (const char*)g.A + (size_t)cur.pm * tstepA; const char* cB = (const char*)g.Bt + (size_t)cur.pn * tstep;
    S.a_ready(cur);
    if constexpr (SP2) {
        PG8_STAGE(PG8_SB(0, 0), cB, voffB); PG8_STAGE(PG8_SB(0, 1), cB + hstep, voffB); PG8_STAGE(PG8_SA(0, 0), cA, voffA); PG8_STAGE(PG8_SA(0, 1), cA + hstepA, voffA);
        if (wr == 1) PG8_BAR;
        PG8_WAIT_V(2); PG8_BAR;
        PG8_STAGE(PG8_SB(1, 0), cB + kstep, voffB); PG8_STAGE(PG8_SA(1, 0), cA + kstep, voffA); PG8_STAGE(PG8_SB(1, 1), cB + hstep + kstep, voffB);
        PG8_WAIT_V(6); PG8_BAR;
    } else {
        PG8_STAGE(PG8_SB(0, 0), cB, voffB); PG8_STAGE(PG8_SA(0, 0), cA, voffA); PG8_STAGE(PG8_SB(0, 1), cB + hstep, voffB); PG8_STAGE(PG8_SA(0, 1), cA + hstepA, voffA);
        if (wr == 1) PG8_BAR;
        PG8_WAIT_V(4); PG8_BAR;
        PG8_STAGE(PG8_SB(1, 0), cB + kstep, voffB); PG8_STAGE(PG8_SA(1, 0), cA + kstep, voffA); PG8_STAGE(PG8_SB(1, 1), cB + hstep + kstep, voffB);
        PG8_WAIT_V(6); PG8_BAR;
    }
    for (;;) {
        const bool has_next = S.next(ui + 1, nxt);
        const char* nA = has_next ? (const char*)g.A + (size_t)nxt.pm * tstepA : cA; const char* nB = has_next ? (const char*)g.Bt + (size_t)nxt.pn * tstep : cB;
        for (int t = 0; t < nt; t += 2) {
            const bool last = (t == nt - 2);
            const char* a1 = cA + (size_t)(t + 1) * kstep;
            const char* a2 = last ? nA : cA + (size_t)(t + 2) * kstep; const char* b2 = last ? nB : cB + (size_t)(t + 2) * kstep;
            const char* a3 = a2 + kstep; const char* b3 = b2 + kstep;
            if (last && has_next) S.a_ready(nxt);
            if constexpr (SP2) {
            PG8_LDB(B0, 0, 0); PG8_LDB(B1, 0, 1); PG8_SCHED; PG8_LDA(At, 0, 0); PG8_STAGE(PG8_SA(1, 1), a1 + hstepA, voffA);
            PG8_WAIT_V(8); PG8_WAIT_L(0); PG8_BAR; PG8_MMA(0, 0, At, B0); PG8_MMA(0, 1, At, B1); PG8_BAR; PG8_SCHED;
            PG8_LDA(At, 0, 1); PG8_STAGE(PG8_SB(0, 0), b2, voffB); PG8_STAGE(PG8_SB(0, 1), b2 + hstep, voffB); PG8_STAGE(PG8_SA(0, 0), a2, voffA);
            PG8_WAIT_V(8); PG8_WAIT_L(0); PG8_BAR; PG8_MMA(1, 0, At, B0); PG8_MMA(1, 1, At, B1); PG8_BAR; PG8_SCHED;
            PG8_LDB(B0, 1, 0); PG8_LDB(B1, 1, 1); PG8_SCHED; PG8_LDA(At, 1, 0); PG8_STAGE(PG8_SA(0, 1), a2 + hstepA, voffA);
            PG8_WAIT_V(8); PG8_WAIT_L(0); PG8_BAR; PG8_MMA(0, 0, At, B0); PG8_MMA(0, 1, At, B1); PG8_BAR; PG8_SCHED;
            PG8_LDA(At, 1, 1); PG8_STAGE(PG8_SB(1, 0), b3, voffB); PG8_STAGE(PG8_SB(1, 1), b3 + hstep, voffB); PG8_STAGE(PG8_SA(1, 0), a3, voffA);
            PG8_WAIT_V(8); PG8_WAIT_L(0); PG8_BAR; PG8_MMA(1, 0, At, B0); PG8_MMA(1, 1, At, B1); PG8_BAR; PG8_SCHED;
            } else {
            PG8_LDB(B0, 0, 0); PG8_SCHED; PG8_LDA(At, 0, 0); PG8_STAGE(PG8_SA(1, 1), a1 + hstepA, voffA);
            PG8_WAIT_L(8); PG8_BAR; PG8_WAIT_L(0); PG8_MMA(0, 0, At, B0); PG8_BAR; PG8_SCHED;
            PG8_LDB(B1, 0, 1); PG8_STAGE(PG8_SB(0, 0), b2, voffB);
            PG8_BAR; PG8_WAIT_L(0); PG8_MMA(0, 1, At, B1); PG8_BAR;
            PG8_LDA(At, 0, 1); PG8_STAGE(PG8_SA(0, 0), a2, voffA);
            PG8_BAR; PG8_WAIT_L(0); PG8_MMA(1, 0, At, B0); PG8_BAR; PG8_SCHED;
            PG8_STAGE(PG8_SB(0, 1), b2 + hstep, voffB);
            PG8_WAIT_V(6); PG8_BAR; PG8_MMA(1, 1, At, B1); PG8_BAR;
            PG8_LDB(B0, 1, 0); PG8_SCHED; PG8_LDA(At, 1, 0); PG8_STAGE(PG8_SA(0, 1), a2 + hstepA, voffA);
            PG8_WAIT_L(8); PG8_BAR; PG8_WAIT_L(0); PG8_MMA(0, 0, At, B0); PG8_BAR; PG8_SCHED;
            PG8_LDB(B1, 1, 1); PG8_STAGE(PG8_SB(1, 0), b3, voffB);
            PG8_BAR; PG8_WAIT_L(0); PG8_MMA(0, 1, At, B1); PG8_BAR;
            PG8_LDA(At, 1, 1); PG8_STAGE(PG8_SA(1, 0), a3, voffA);
            PG8_BAR; PG8_WAIT_L(0); PG8_MMA(1, 0, At, B0); PG8_BAR; PG8_SCHED;
            PG8_STAGE(PG8_SB(1, 1), b3 + hstep, voffB);
            PG8_WAIT_V(6); PG8_BAR; PG8_MMA(1, 1, At, B1); PG8_BAR;
            }
        }
        if constexpr (ALIGN_EPI) { if (wr == 0) PG8_BAR; }
        if constexpr (!Epi::AFTER_DRAIN) { E(acc, cur, wr, wc, fr, fq); S.done(cur); }
        if (!has_next) break;
#pragma unroll
        for (int a = 0; a < 2; ++a)
#pragma unroll
            for (int b = 0; b < 2; ++b)
#pragma unroll
                for (int m = 0; m < 4; ++m)
#pragma unroll
                    for (int n = 0; n < 2; ++n) acc[a][b][m][n] = (f32x4){0.f, 0.f, 0.f, 0.f};
        cur = nxt; cA = nA; cB = nB; ++ui;
        if constexpr (ALIGN_EPI) { if (wr == 1) PG8_BAR; }
    }
    PG8_WAIT_V(0);
    if constexpr (!ALIGN_EPI) { if (wr == 0) PG8_BAR; }
    PG8_BAR;
    if constexpr (Epi::AFTER_DRAIN) { E.fused(acc, cur, wr, wc, fr, fq, lds, wid, lane); S.done(cur); }
#undef PG8_SA
#undef PG8_SB
#undef PG8_STAGE
#undef PG8_LDA
#undef PG8_LDB
#undef PG8_MMA
#undef PG8_WAIT_V
#undef PG8_WAIT_L
#undef PG8_BAR
#undef PG8_SCHED
}
}

#ifndef PG8_SP2
#define PG8_SP2 true
#endif
#ifndef PG8_ALIGN
#define PG8_ALIGN true
#endif
#include <hip/hip_bf16.h>
#include <cmath>
namespace attn_body {
using bf16=__hip_bfloat16;
using bf16x8=__attribute__((ext_vector_type(8)))short;
using s16x4=__attribute__((ext_vector_type(4)))short;
using f32x16=__attribute__((ext_vector_type(16)))float;
using u32x4=__attribute__((ext_vector_type(4)))unsigned;
using f32x4v=__attribute__((ext_vector_type(4)))float;
constexpr int BATCH=1,NHEAD=8,SEQ=16384,D=64,DM=8704;
constexpr int NW=8,QBLK=32,QB=QBLK*NW,KVBLK=64,NQB=SEQ/QB;
constexpr int ATTN_PITCH=DM, ATTN_UNIT_ROWS=QB;
__device__ __forceinline__ int crow(int r,int hi){return (r&3)+8*(r>>2)+4*hi;}
#define SBAR() __builtin_amdgcn_sched_barrier(0)
__device__ __forceinline__ void cmask(f32x16&p0,f32x16&p1,int jb,int qrel,int hi){
  const float NEG=-INFINITY; int kb=64*jb+4*hi;
  #pragma unroll
  for(int r=0;r<16;++r){int kv=kb+(r&3)+8*(r>>2); if(kv>qrel)p0[r]=NEG; if(kv+32>qrel)p1[r]=NEG;}
}

constexpr int NSLOT=3, SLOTB=8192;
constexpr int LDS_K=0, LDS_V=NSLOT*SLOTB, LDS_WS=2*NSLOT*SLOTB, LDS_OST=LDS_WS+NW*64*4, LDS_F=LDS_OST+NW*4096, LDS_BYTES=LDS_F+SEQ*4;
constexpr float C2=0.125f*1.4426950408889634f;
__device__ __forceinline__ void glds16(const void*gsrc,unsigned lds_dst){unsigned keep;
  asm volatile("s_mov_b32 %0, m0\n\ts_mov_b32 m0, %2\n\ts_nop 0\n\tglobal_load_lds_dwordx4 %1, off\n\ts_mov_b32 m0, %0":"=&s"(keep):"v"(gsrc),"s"(lds_dst):"memory");}
__device__ __forceinline__ float max3f(float a,float b,float c){float r;asm("v_max3_f32 %0, %1, %2, %3":"=v"(r):"v"(a),"v"(b),"v"(c));return r;}
__device__ __forceinline__ float max2f(float a,float b){float r;asm("v_max_f32_e32 %0, %1, %2":"=v"(r):"v"(a),"v"(b));return r;}
__device__ __forceinline__ float fadd_s(float a,float b){float r;asm("v_add_f32_e32 %0, %1, %2":"=v"(r):"v"(a),"v"(b));return r;}
__device__ __forceinline__ float fsub_s(float a,float b){float r;asm("v_sub_f32_e32 %0, %1, %2":"=v"(r):"v"(a),"v"(b));return r;}
typedef float f32x2_t __attribute__((ext_vector_type(2))); typedef __bf16 bf16x2_t __attribute__((ext_vector_type(2)));
__device__ __forceinline__ unsigned cvtpk_s(float lo,float hi){f32x2_t v={lo,hi};bf16x2_t b=__builtin_convertvector(v,bf16x2_t);return __builtin_bit_cast(unsigned,b);}
#define WAIT_BAR(N) asm volatile("s_waitcnt vmcnt(" #N ") lgkmcnt(0)\n\ts_barrier":::"memory")


__device__ __forceinline__ bf16x8 mkbias(float x,int hi){
  const unsigned xb=__float_as_uint(x); const unsigned hb=xb&0xffff0000u; const float r1=x-__uint_as_float(hb);
  const unsigned mb=__float_as_uint(r1)&0xffff0000u; const float r2=r1-__uint_as_float(mb); const unsigned lb=__float_as_uint(r2)&0xffff0000u;
  u32x4 w; w.x=(hb>>16)|mb; w.y=(lb>>16)|0x3f800000u; w.z=0x3f803f80u; w.w=0u; if(hi){w.x=0u;w.y=0u;w.z=0u;}
  return __builtin_bit_cast(bf16x8,w);
}
__device__ __forceinline__ bf16x8 mkq(float x,int hi){
  const unsigned xb=__float_as_uint(x); const unsigned hb=xb&0xffff0000u; const float r1=x-__uint_as_float(hb);
  const unsigned mb=__float_as_uint(r1)&0xffff0000u; const float r2=r1-__uint_as_float(mb); const unsigned lb=__float_as_uint(r2)&0xffff0000u;
  u32x4 w; w.x=0x3f803f80u; w.y=0x3f80u|hb; w.z=(mb>>16)|lb; w.w=0u; if(hi){w.x=0u;w.y=0u;w.z=0u;}
  return __builtin_bit_cast(bf16x8,w);
}
__device__ __forceinline__ void qkt(f32x16&p0,f32x16&p1,const char*Kslot,const bf16x8*qr,int r32,int hi,bf16x8 kb0,bf16x8 kb1,bf16x8 qone){ const f32x16 negm=f32x16{};
  const char*kb=Kslot+hi*1024+r32*16;
  #pragma unroll
  for(int d0=0;d0<4;++d0){
    const bf16x8 b0=*reinterpret_cast<const bf16x8*>(kb+d0*2048);
    const bf16x8 b1=*reinterpret_cast<const bf16x8*>(kb+d0*2048+512);
    if(d0==0){p0=__builtin_amdgcn_mfma_f32_32x32x16_bf16(b0,qr[0],negm,0,0,0);p1=__builtin_amdgcn_mfma_f32_32x32x16_bf16(b1,qr[0],negm,0,0,0);}
    else{p0=__builtin_amdgcn_mfma_f32_32x32x16_bf16(b0,qr[d0],p0,0,0,0);p1=__builtin_amdgcn_mfma_f32_32x32x16_bf16(b1,qr[d0],p1,0,0,0);}}
  p0=__builtin_amdgcn_mfma_f32_32x32x16_bf16(kb0,qone,p0,0,0,0);p1=__builtin_amdgcn_mfma_f32_32x32x16_bf16(kb1,qone,p1,0,0,0);
}
typedef __attribute__((address_space(3))) const char* lds_cptr;
typedef short v4i16_t __attribute__((ext_vector_type(4)));
__device__ __forceinline__ void kload8(bf16x8*kf,lds_cptr kp){
  kf[0]=*(const __attribute__((address_space(3))) bf16x8*)(kp);      kf[1]=*(const __attribute__((address_space(3))) bf16x8*)(kp+512);
  kf[2]=*(const __attribute__((address_space(3))) bf16x8*)(kp+2048); kf[3]=*(const __attribute__((address_space(3))) bf16x8*)(kp+2560);
  kf[4]=*(const __attribute__((address_space(3))) bf16x8*)(kp+4096); kf[5]=*(const __attribute__((address_space(3))) bf16x8*)(kp+4608);
  kf[6]=*(const __attribute__((address_space(3))) bf16x8*)(kp+6144); kf[7]=*(const __attribute__((address_space(3))) bf16x8*)(kp+6656);
}
__device__ __forceinline__ void kload2(bf16x8*kf,lds_cptr kp,int j){ kf[2*j]=*(const __attribute__((address_space(3))) bf16x8*)(kp+j*2048); kf[2*j+1]=*(const __attribute__((address_space(3))) bf16x8*)(kp+j*2048+512); }
__device__ __forceinline__ s16x4 vtr(lds_cptr p){ return __builtin_bit_cast(s16x4,__builtin_amdgcn_ds_read_tr16_b64_v4i16((__attribute__((address_space(3))) v4i16_t*)p)); }
__device__ __forceinline__ float rowmax(const f32x16&p0,const f32x16&p1){
  float a=max3f(p0[0],p0[1],p1[0]),b=max3f(p0[2],p0[3],p1[1]);a=max3f(a,p1[2],p1[3]);
  #pragma unroll
  for(int r=4;r<16;r+=4){a=max3f(a,p0[r],p0[r+1]);b=max3f(b,p0[r+2],p0[r+3]);a=max3f(a,p1[r],p1[r+1]);b=max3f(b,p1[r+2],p1[r+3]);}
  const float m=max2f(a,b);
  auto rr=__builtin_amdgcn_permlane32_swap(__float_as_uint(m),__float_as_uint(m),false,false);
  return max2f(__uint_as_float(rr[0]),__uint_as_float(rr[1]));
}
__device__ __forceinline__ void pv(f32x16*o,int vb,bf16x8 pa0,bf16x8 pa1,bf16x8 pa2,bf16x8 pa3){
  #pragma unroll
  for(int d0=0;d0<2;++d0){s16x4 lo[4],hi[4];
    #pragma unroll
    for(int ks=0;ks<4;++ks){
      asm volatile("ds_read_b64_tr_b16 %0,%1 offset:%c2":"=&v"(lo[ks]):"v"(vb),"i"(d0*4096+ks*1024):"memory");
      asm volatile("ds_read_b64_tr_b16 %0,%1 offset:%c2":"=&v"(hi[ks]):"v"(vb),"i"(d0*4096+ks*1024+512):"memory");}
    asm volatile("s_waitcnt lgkmcnt(0)":::"memory");SBAR();
    #define PK(k) (bf16x8){lo[k][0],lo[k][1],lo[k][2],lo[k][3],hi[k][0],hi[k][1],hi[k][2],hi[k][3]}
    o[d0]=__builtin_amdgcn_mfma_f32_32x32x16_bf16(pa0,PK(0),o[d0],0,0,0);
    o[d0]=__builtin_amdgcn_mfma_f32_32x32x16_bf16(pa1,PK(1),o[d0],0,0,0);
    o[d0]=__builtin_amdgcn_mfma_f32_32x32x16_bf16(pa2,PK(2),o[d0],0,0,0);
    o[d0]=__builtin_amdgcn_mfma_f32_32x32x16_bf16(pa3,PK(3),o[d0],0,0,0);
    #undef PK
  }
}

#ifndef ATTN_STORE16
#define ATTN_STORE16(p,v) (*(u32x4*)(p)=(v))
#endif
template<int THRL> __device__ __forceinline__ void attn_unit(int b,int h,int qb,const bf16*Q,const bf16*__restrict__ K,const bf16*__restrict__ V,bf16*O,const float*FL2,char*shm,int tid_in){
  int tid_l=tid_in; asm volatile("":"+v"(tid_l));
  const int tid=tid_l,lane=tid&63,r32=lane&31,hi=lane>>5; const int wid=__builtin_amdgcn_readfirstlane(tid>>6);
  const long rowbase=(long)b*SEQ; const int q0=qb*QB;
  const bf16*Qw=Q+(rowbase+q0+wid*QBLK)*DM+h*D;
  const bf16*Kh=K+rowbase*DM+h*D,*Vh=V+rowbase*DM+h*D;
  const lds_cptr shm3=(lds_cptr)shm;
  const unsigned lds0=(unsigned)(uintptr_t)shm;
  float*wsf=(float*)(shm+LDS_WS)+wid*64;
  const bf16*ksrc=Kh+(long)lane*DM+wid*8;
  const bf16*vsrc=Vh+(long)(16*(wid&3)+(lane>>2))*DM+(wid>>2)*32+(lane&3)*8;
  const unsigned kdst=lds0+LDS_K+wid*1024, vdst=lds0+LDS_V+wid*1024;
  #define DMA_K(t,slot) glds16(ksrc+(long)(t)*KVBLK*DM,(unsigned)__builtin_amdgcn_readfirstlane(kdst+(slot)))
  #define DMA_V(t,slot) glds16(vsrc+(long)(t)*KVBLK*DM,(unsigned)__builtin_amdgcn_readfirstlane(vdst+(slot)))
  const int vb0=(int)(lds0+LDS_V)+((lane>>4)&1)*32+(lane&3)*8+(4*hi+((lane&15)>>2))*64;
  const char*Kbase=shm+LDS_K; bf16x8 kf[8];
  const lds_cptr kp0=shm3+LDS_K+hi*1024+r32*16; const lds_cptr vp0=shm3+LDS_V+((lane>>4)&1)*32+(lane&3)*8+(4*hi+((lane&15)>>2))*64;
  const int NT=(q0+QB)/KVBLK;
  const __attribute__((address_space(3))) float* Fl=(const __attribute__((address_space(3))) float*)(shm3+LDS_F);
  float fref;
  { const float*Fg=FL2+(long)h*SEQ; const int nF=q0+QB;
    for(int i=tid*4;i<nF;i+=NW*64*4){ const f32x4v v4=*reinterpret_cast<const f32x4v*>(Fg+i); *(__attribute__((address_space(3))) f32x4v*)(shm3+LDS_F+i*4)=v4; }
    fref=Fg[nF-1]; }
  asm volatile("s_waitcnt vmcnt(0) lgkmcnt(0)":::"memory");
  bf16x8 qone=mkq(0.f,hi);
  #define MKB(t,off) mkbias(fref-Fl[(t)*KVBLK+(off)+r32],hi)
  DMA_K(0,0);DMA_V(0,0);DMA_K(1,SLOTB);
  bf16x8 qr[4];
  #pragma unroll
  for(int d0=0;d0<4;++d0)qr[d0]=*reinterpret_cast<const bf16x8*>(&Qw[(long)r32*DM+d0*16+hi*8]);
  float mhat=0.f,l_reg=0.f;f32x16 o[2];o[0]=f32x16{};o[1]=f32x16{};
  const int qrel=wid*QBLK+r32;
  #define CMASK(P0,P1,t) do{int jb_=(t)-(NT-4); if(jb_>=0)cmask(P0,P1,jb_,qrel,hi);}while(0)
  bool resc=false;
  #define START(P0,P1) do{ const float rm=rowmax(P0,P1); resc=false; \
    { const float dl=rm; mhat=fadd_s(mhat,dl); \
      _Pragma("unroll") for(int r=0;r<16;++r){P0[r]=fsub_s(P0[r],dl);P1[r]=fsub_s(P1[r],dl);} \
      qone=mkq(-mhat,hi); } \
    _Pragma("unroll") for(int r=0;r<16;++r)P0[r]=__builtin_amdgcn_exp2f(P0[r]); }while(0)
  #define RESC() do{ if(resc){ asm volatile("s_waitcnt lgkmcnt(0)":::"memory"); \
      _Pragma("unroll") for(int d_=0;d_<2;++d_) _Pragma("unroll") for(int r=0;r<16;++r)o[d_][r]*=wsf[crow(r,hi)]; } }while(0)
  f32x16 pA0,pA1,pB0,pB1;
  int sl_prev=0,sl_cur=0,sl_next=SLOTB;
  #define ROT() do{sl_prev=sl_cur;sl_cur=sl_next;sl_next=(sl_next==(NSLOT-1)*SLOTB)?0:sl_next+SLOTB;}while(0)
  DMA_K(2,2*SLOTB);
  WAIT_BAR(3);
  qkt(pA0,pA1,Kbase,qr,r32,hi,MKB(0,0),MKB(0,32),qone);asm volatile("s_nop 15\n\ts_nop 7":"+v"(pA0),"+v"(pA1));CMASK(pA0,pA1,0);
  START(pA0,pA1);
  _Pragma("unroll") for(int r=0;r<16;++r)pA1[r]=__builtin_amdgcn_exp2f(pA1[r]);
  WAIT_BAR(0);
  DMA_K(3,0);DMA_V(1,SLOTB);
  ROT();
  kload8(kf,kp0+sl_cur);
  WAIT_BAR(2);
  s16x4 vlo[8],vhi[8]; u32x4 pw0,pw1,pw2,pw3;
  #define PKW(P,B) cvtpk_s(P[B],P[B+1])
  #define PAF(k) __builtin_bit_cast(bf16x8,pw##k)
  #define VFR(i) (bf16x8){vlo[i][0],vlo[i][1],vlo[i][2],vlo[i][3],vhi[i][0],vhi[i][1],vhi[i][2],vhi[i][3]}
  #define PIN(x) asm volatile("":"+v"(x))
  #define MX3(a,b,c) __builtin_fmaxf(__builtin_fmaxf((a),(b)),(c))
  #define GAPA(MF,A0,A1,A2,A3,W0,W1,PW) do{ MF; sacc+=A0; sacc+=A1; sacc+=A2; sacc+=A3; PIN(sacc); W0; W1; PIN(PW); SBAR(); }while(0)
  #define EX(v) __builtin_amdgcn_exp2f(v)
  #define GAPB(MF,X,B) do{ MF; X[B]=EX(X[B]); X[B+1]=EX(X[B+1]); X[B+2]=EX(X[B+2]); X[B+3]=EX(X[B+3]); PIN(X); SBAR(); }while(0)
  #define VRD(i) do{ vlo[i]=vtr(vp_+(((i)>>2)*4096+((i)&3)*1024)); vhi[i]=vtr(vp_+(((i)>>2)*4096+((i)&3)*1024+512)); }while(0)
  #define KRD(G,j) do{ if(G){ kload2(kf,kp0+sl_next,j); SBAR(); } }while(0)
  #define STEP(C0,C1,P0,P1,t,GK,GV,GL) do{ SBAR(); \
    const bf16x8 kbA_=MKB(t,0), kbB_=MKB(t,32); \
    const lds_cptr vp_=vp0+sl_prev; \
    VRD(0); SBAR(); float sacc=(P0[0]+P0[1]); \
    GAPA(C0=__builtin_amdgcn_mfma_f32_32x32x16_bf16(kf[0],qr[0],f32x16{},0,0,0), P0[2],P0[3],P0[4],P0[5],     pw0[0]=PKW(P0,0), pw0[1]=PKW(P0,2), pw0); \
    VRD(4); SBAR(); GAPA(C1=__builtin_amdgcn_mfma_f32_32x32x16_bf16(kf[1],qr[0],f32x16{},0,0,0), P0[6],P0[7],P0[8],P0[9],     pw0[2]=PKW(P0,4), pw0[3]=PKW(P0,6), pw0); \
    VRD(1); SBAR(); GAPA(C0=__builtin_amdgcn_mfma_f32_32x32x16_bf16(kf[2],qr[1],C0,0,0,0),   P0[10],P0[11],P0[12],P0[13], pw1[0]=PKW(P0,8), pw1[1]=PKW(P0,10), pw1); \
    VRD(5); SBAR(); GAPA(C1=__builtin_amdgcn_mfma_f32_32x32x16_bf16(kf[3],qr[1],C1,0,0,0),   P0[14],P0[15],P1[0],P1[1],   pw1[2]=PKW(P0,12),pw1[3]=PKW(P0,14), pw1); \
    VRD(2); SBAR(); GAPA(C0=__builtin_amdgcn_mfma_f32_32x32x16_bf16(kf[4],qr[2],C0,0,0,0),   P1[2],P1[3],P1[4],P1[5],     pw2[0]=PKW(P1,0), pw2[1]=PKW(P1,2), pw2); \
    VRD(6); SBAR(); GAPA(C1=__builtin_amdgcn_mfma_f32_32x32x16_bf16(kf[5],qr[2],C1,0,0,0),   P1[6],P1[7],P1[8],P1[9],     pw2[2]=PKW(P1,4), pw2[3]=PKW(P1,6), pw2); \
    VRD(3); SBAR(); GAPA(C0=__builtin_amdgcn_mfma_f32_32x32x16_bf16(kf[6],qr[3],C0,0,0,0),   P1[10],P1[11],P1[12],P1[13], pw3[0]=PKW(P1,8), pw3[1]=PKW(P1,10), pw3); \
    VRD(7); SBAR(); GAPA(C1=__builtin_amdgcn_mfma_f32_32x32x16_bf16(kf[7],qr[3],C1,0,0,0),   P1[14],P1[15],0.f,0.f,       pw3[2]=PKW(P1,12),pw3[3]=PKW(P1,14), pw3); \
    C0=__builtin_amdgcn_mfma_f32_32x32x16_bf16(kbA_,qone,C0,0,0,0); C1=__builtin_amdgcn_mfma_f32_32x32x16_bf16(kbB_,qone,C1,0,0,0); \
    l_reg+=sacc; \
    if(GK){DMA_K((t)+3,sl_cur);} if(GV){DMA_V((t)+1,sl_next);} \
    CMASK(C0,C1,t); \
    { float a=MX3(C0[0],C0[1],C1[0]),b=MX3(C0[2],C0[3],C1[1]); a=MX3(a,C1[2],C1[3]); \
      _Pragma("unroll") for(int r=4;r<16;r+=4){a=MX3(a,C0[r],C0[r+1]);b=MX3(b,C0[r+2],C0[r+3]);a=MX3(a,C1[r],C1[r+1]);b=MX3(b,C1[r+2],C1[r+3]);} \
      float rm=__builtin_fmaxf(a,b); { auto rr=__builtin_amdgcn_permlane32_swap(__float_as_uint(rm),__float_as_uint(rm),false,false); rm=__builtin_fmaxf(__uint_as_float(rr[0]),__uint_as_float(rr[1])); } \
      resc=false; \
      if(__builtin_expect(__any(rm>(float)THRL),0)){ const float dl=__builtin_fmaxf(rm,0.f); mhat+=dl; \
        _Pragma("unroll") for(int r=0;r<16;++r){C0[r]-=dl;C1[r]-=dl;} \
        qone=mkq(-mhat,hi); \
        const float f=__builtin_amdgcn_exp2f(-dl); l_reg*=f; if(hi==0)wsf[r32]=f; resc=true; } } \
    SBAR(); \
    GAPB(o[0]=__builtin_amdgcn_mfma_f32_32x32x16_bf16(PAF(0),VFR(0),o[0],0,0,0), C0,0); \
    GAPB(o[1]=__builtin_amdgcn_mfma_f32_32x32x16_bf16(PAF(0),VFR(4),o[1],0,0,0), C0,4); \
    KRD(GL,0); GAPB(o[0]=__builtin_amdgcn_mfma_f32_32x32x16_bf16(PAF(1),VFR(1),o[0],0,0,0), C0,8); \
    KRD(GL,1); GAPB(o[1]=__builtin_amdgcn_mfma_f32_32x32x16_bf16(PAF(1),VFR(5),o[1],0,0,0), C0,12); \
    KRD(GL,2); GAPB(o[0]=__builtin_amdgcn_mfma_f32_32x32x16_bf16(PAF(2),VFR(2),o[0],0,0,0), C1,0); \
    KRD(GL,3); GAPB(o[1]=__builtin_amdgcn_mfma_f32_32x32x16_bf16(PAF(2),VFR(6),o[1],0,0,0), C1,4); \
    GAPB(o[0]=__builtin_amdgcn_mfma_f32_32x32x16_bf16(PAF(3),VFR(3),o[0],0,0,0), C1,8); \
    GAPB(o[1]=__builtin_amdgcn_mfma_f32_32x32x16_bf16(PAF(3),VFR(7),o[1],0,0,0), C1,12); \
    }while(0)
  int t=1;
  #undef CMASK
  #define CMASK(P0,P1,t) do{}while(0)
  for(;t+5<NT;t+=2){
    STEP(pB0,pB1,pA0,pA1,t,true,true,true);     WAIT_BAR(2); RESC(); ROT();
    STEP(pA0,pA1,pB0,pB1,t+1,true,true,true);   WAIT_BAR(2); RESC(); ROT();
  }
  #undef CMASK
  #define CMASK(P0,P1,t) do{int jb_=(t)-(NT-4); if(jb_>=0)cmask(P0,P1,jb_,qrel,hi);}while(0)
  #define ENDW(tt) do{ if((tt)+3<NT){WAIT_BAR(2);} else if((tt)+2<NT){WAIT_BAR(1);} else {WAIT_BAR(0);} }while(0)
  for(;t+1<NT;t+=2){
    STEP(pB0,pB1,pA0,pA1,t,(t+3<NT),(t+1<NT),(t+1<NT));       ENDW(t);   RESC(); ROT();
    STEP(pA0,pA1,pB0,pB1,t+1,(t+4<NT),(t+2<NT),(t+2<NT));     ENDW(t+1); RESC(); ROT();
  }
  STEP(pB0,pB1,pA0,pA1,NT-1,false,false,false); RESC();
  { float sacc=pB0[0]+pB0[1]; _Pragma("unroll") for(int r=2;r<16;++r)sacc+=pB0[r]; _Pragma("unroll") for(int r=0;r<16;++r)sacc+=pB1[r]; l_reg+=sacc;
    pw0=(u32x4){PKW(pB0,0),PKW(pB0,2),PKW(pB0,4),PKW(pB0,6)};pw1=(u32x4){PKW(pB0,8),PKW(pB0,10),PKW(pB0,12),PKW(pB0,14)};pw2=(u32x4){PKW(pB1,0),PKW(pB1,2),PKW(pB1,4),PKW(pB1,6)};pw3=(u32x4){PKW(pB1,8),PKW(pB1,10),PKW(pB1,12),PKW(pB1,14)};
    SBAR(); pv(o,vb0+sl_cur,PAF(0),PAF(1),PAF(2),PAF(3)); }
  #undef PKW
  #undef PAF
  #undef VFR
  #undef PIN
  #undef MX3
  #undef GAPA
  #undef GAPB
  #undef EX
  #undef VRD
  #undef KRD
  #undef STEP
  #undef ENDW
  {auto rr=__builtin_amdgcn_permlane32_swap(__float_as_uint(l_reg),__float_as_uint(l_reg),false,false);l_reg=__uint_as_float(rr[0])+__uint_as_float(rr[1]);}
  if(hi==0)wsf[32+r32]=l_reg;asm volatile("s_waitcnt lgkmcnt(0)":::"memory");
  float rli[16];
  #pragma unroll
  for(int r=0;r<16;++r)rli[r]=__builtin_amdgcn_rcpf(wsf[32+crow(r,hi)]);
  bf16*Ow=O+(rowbase+q0+wid*QBLK)*DM+h*D;
  { bf16*stg=(bf16*)(shm+LDS_OST)+wid*2048;
    #pragma unroll
    for(int r=0;r<16;++r){const int orow=crow(r,hi);
      #pragma unroll
      for(int d0=0;d0<2;++d0)stg[orow*64+d0*32+r32]=__float2bfloat16(o[d0][r]*rli[r]);}
    asm volatile("s_waitcnt lgkmcnt(0)":::"memory");
    #pragma unroll
    for(int i=0;i<4;++i){const int row=i*8+(lane>>3),ch=lane&7; const u32x4 v=*(const u32x4*)(stg+row*64+ch*8); ATTN_STORE16(Ow+(long)row*DM+ch*8,v);} }
  asm volatile("s_waitcnt lgkmcnt(0)\n\ts_barrier":::"memory");
  #undef DMA_K
  #undef DMA_V
  #undef MKB
  #undef CMASK
  #undef START
  #undef RESC
  #undef ROT
}
constexpr int ATTN_LDS_BYTES=LDS_BYTES;
struct AttnTensors { const bf16* Q; const bf16* K; const bf16* V; bf16* O; const float* FL2; };
struct AttnUnit { int bh; int qb; };
struct StaticOrder {
  int vcu;
  __device__ __forceinline__ explicit StaticOrder(int grid,int block):vcu((block%8)*(grid/8)+block/8){}
  __device__ __forceinline__ bool next(int i,AttnUnit&u)const{ if(i>=2)return false; const int s=vcu&31; u.bh=vcu>>5; u.qb=(i==0)?s:63-s; return true; }
  __device__ __forceinline__ void a_ready(const AttnUnit&)const{}
  __device__ __forceinline__ void done(const AttnUnit&)const{}
};
template<class Sched,int THRL=8> __device__ __forceinline__ void attn_phase(char*lds,const AttnTensors&T,const Sched&S,int tid_in){
  AttnUnit u;
  for(int i=0;S.next(i,u);++i){ S.a_ready(u); attn_unit<THRL>(u.bh/NHEAD,u.bh%NHEAD,u.qb,T.Q,T.K,T.V,T.O,T.FL2,lds,tid_in); S.done(u); }
}
#undef SBAR
#undef WAIT_BAR
}
#define LAS __attribute__((address_space(3)))
typedef unsigned short bf16;
typedef unsigned v4u __attribute__((ext_vector_type(4)));
typedef unsigned v2u __attribute__((ext_vector_type(2)));
typedef float f32x4 __attribute__((ext_vector_type(4)));
typedef short bf16x8 __attribute__((ext_vector_type(8)));
typedef const __attribute__((address_space(4))) unsigned* cu32p;
typedef const __attribute__((address_space(4))) float* cf32p;

constexpr int M = 16384, D = 1024, DFF = 2816, ZP = 8704, NL = 4, NWAVES = 8, NTHR = 512;
constexpr int ZQ = 0, ZK = 512, ZV = 1024, ZXB = 1536, ZYB = 2560, ZRW = 3584, ZGT = 5376, ZFL = 8448;
constexpr float ALPHA = 1.6817928305074292f, LN_EPS = 1e-5f, GN_EPS = 64e-5f, LOG2E = 1.4426950408889634f;
constexpr int NCH = 256, LC = 64;

constexpr size_t MiB = 1u << 20;
constexpr size_t WS_ADA = 1 * MiB, WS_FL2 = 2 * MiB, WS_LAEND = 3 * MiB, WS_LHEND = 4 * MiB, WS_LCAR = 5 * MiB, WS_BON = 6 * MiB;
constexpr size_t WS_W = 8 * MiB;
constexpr size_t W_UP0 = WS_W, W_UP1 = WS_W + 11 * MiB, W_DN0 = WS_W + 22 * MiB, W_DN1 = WS_W + 22 * MiB + 5632 * 1024, W_IN = WS_W + 33 * MiB,
                 W_PA = WS_W + 50 * MiB, W_PB = WS_W + 51 * MiB, W_PC = WS_W + 53 * MiB, W_OUT = WS_W + 54 * MiB, W_LORA = WS_W + 56 * MiB;
constexpr size_t WS_HB = 65 * MiB, WS_Y = 97 * MiB, WS_HLOC = 97 * MiB, WS_ACUM = 129 * MiB, WS_P = 97 * MiB, WS_G = 129 * MiB;
constexpr size_t WS_RWO = 161 * MiB, WS_CODES = 177 * MiB, WS_LORA = 185 * MiB, WS_S0 = 185 * MiB;
constexpr size_t WS_RW_W = 233 * MiB, WS_RW_R = 265 * MiB, WS_RW_KF = 281 * MiB, WS_RW_V = 297 * MiB, WS_RW_KK = 313 * MiB, WS_RW_B = 329 * MiB, WS_GB = 345 * MiB;
constexpr size_t WS_Z = 361 * MiB, WS_ACT = 361 * MiB, WS_END = 697 * MiB;
struct RwSet { size_t w, r, kf, kk, b; };
__device__ __forceinline__ RwSet rw_set(int l) { return (l & 1) ? RwSet{WS_HB, 633 * MiB, 649 * MiB, 665 * MiB, 681 * MiB} : RwSet{WS_RW_W, WS_RW_R, WS_RW_KF, WS_RW_KK, WS_RW_B}; }
constexpr int MISC_OFF = attn_body::ATTN_LDS_BYTES, LDS_BYTES = attn_body::ATTN_LDS_BYTES + 64;
constexpr size_t CTL_ZERO_BYTES = 16384;
constexpr int LDS_PHASE_BYTES = attn_body::ATTN_LDS_BYTES;
static_assert(LDS_BYTES >= pg8::STAGE_BYTES && LDS_BYTES <= 160 * 1024, "LDS map");

__device__ __forceinline__ unsigned f2bf(float f) { unsigned u = __builtin_bit_cast(unsigned, f); return (u + 0x7fffu + ((u >> 16) & 1u)) >> 16; }
__device__ __forceinline__ unsigned pk2(float lo, float hi) { return f2bf(lo) | (f2bf(hi) << 16); }
__device__ __forceinline__ float bflo(unsigned u) { return __uint_as_float(u << 16); }
__device__ __forceinline__ float bfhi(unsigned u) { return __uint_as_float(u & 0xffff0000u); }
__device__ __forceinline__ float bf1(bf16 b) { return __uint_as_float(((unsigned)b) << 16); }
__device__ __forceinline__ float shx(float v, int o, int lane) { return __builtin_bit_cast(float, __builtin_amdgcn_ds_bpermute((lane ^ o) << 2, __builtin_bit_cast(int, v))); }
__device__ __forceinline__ float wave_sum(float v, int lane) {
#pragma unroll
    for (int o = 1; o < 64; o <<= 1) v += shx(v, o, lane);
    return v;
}
__device__ __forceinline__ float sigm(float x) { return __builtin_amdgcn_rcpf(1.f + __expf(-x)); }
__device__ __forceinline__ float tanh_(float z) { return 1.f - 2.f * __builtin_amdgcn_rcpf(1.f + __expf(2.f * z)); }
__device__ __forceinline__ float gelu_tanh(float x) { return 0.5f * x * (1.f + tanh_(0.7978845608028654f * (x + 0.044715f * x * x * x))); }
__device__ __forceinline__ float softplus_(float x) { return fmaxf(x, 0.f) + log1pf(__expf(-fabsf(x))); }
#define LDS_WAIT() asm volatile("s_waitcnt lgkmcnt(0)" ::: "memory")

struct Args { const float* in[32]; float* out; unsigned char* ws; };
typedef const __attribute__((address_space(4))) Args* CA;

struct EpiSwiGLU {
    static constexpr bool PERM = true, AFTER_DRAIN = false; bf16* O; int ldc;
    __device__ __forceinline__ void operator()(const pg8::f32x4 (&acc)[2][2][4][2], const pg8::Unit& u, int wr, int wc, int fr, int fq) const {
        const int row0 = u.pm * 256 + wr * 64 + fr, col0 = u.pn * 128 + wc * 32 + 8 * fq;
#pragma unroll
        for (int ai = 0; ai < 2; ++ai)
#pragma unroll
            for (int m = 0; m < 4; ++m) {
                bf16* rowp = O + (size_t)(row0 + ai * 128 + m * 16) * ldc + col0; float o[8];
#pragma unroll
                for (int n = 0; n < 2; ++n)
#pragma unroll
                    for (int i = 0; i < 4; ++i) { const float uu = acc[ai][0][m][n][i], gg = acc[ai][1][m][n][i]; o[n * 4 + i] = uu * sigm(uu) * gg; }
                v4u w; w.x = pk2(o[0], o[1]); w.y = pk2(o[2], o[3]); w.z = pk2(o[4], o[5]); w.w = pk2(o[6], o[7]); *(v4u*)rowp = w; }
    }
};
struct EpiGateF32 {
    static constexpr bool PERM = false, AFTER_DRAIN = false; float* Y; const float* gate; float mul;
    __device__ __forceinline__ void operator()(const pg8::f32x4 (&acc)[2][2][4][2], const pg8::Unit& u, int wr, int wc, int fr, int fq) const {
        const int row0 = u.pm * 256 + wr * 64 + fr, col0 = u.pn * 256 + wc * 32 + 4 * fq;
#pragma unroll
        for (int bj = 0; bj < 2; ++bj)
#pragma unroll
            for (int n = 0; n < 2; ++n) { const int c = col0 + bj * 128 + n * 16; const f32x4 gv = *(const f32x4*)(gate + c) * mul;
#pragma unroll
                for (int ai = 0; ai < 2; ++ai)
#pragma unroll
                    for (int m = 0; m < 4; ++m) *(f32x4*)(Y + (size_t)(row0 + ai * 128 + m * 16) * D + c) = acc[ai][bj][m][n] * gv; }
    }
};
struct EpiIn {
    static constexpr bool PERM = true, AFTER_DRAIN = false; bf16* Z;
    __device__ __forceinline__ void operator()(const pg8::f32x4 (&acc)[2][2][4][2], const pg8::Unit& u, int wr, int wc, int fr, int fq) const {
        const int row0 = u.pm * 256 + wr * 64 + fr, col0 = u.pn * 256 + wc * 32 + 8 * fq;
        const int mode = (u.pn < 2) ? 1 : ((u.pn >= 21 && u.pn < 33) ? 2 : 0);
#pragma unroll
        for (int ai = 0; ai < 2; ++ai)
#pragma unroll
            for (int m = 0; m < 4; ++m) { bf16* rowp = Z + (size_t)(row0 + ai * 128 + m * 16) * ZP + col0;
#pragma unroll
                for (int bj = 0; bj < 2; ++bj) { float o[8];
#pragma unroll
                    for (int n = 0; n < 2; ++n)
#pragma unroll
                        for (int i = 0; i < 4; ++i) { float v = acc[ai][bj][m][n][i]; if (mode == 1) v *= attn_body::C2; else if (mode == 2) v = sigm(v); o[n * 4 + i] = v; }
                    v4u w; w.x = pk2(o[0], o[1]); w.y = pk2(o[2], o[3]); w.z = pk2(o[4], o[5]); w.w = pk2(o[6], o[7]); *(v4u*)(rowp + bj * 128) = w; } }
    }
};
struct EpiPlain {
    static constexpr bool PERM = true, AFTER_DRAIN = false; bf16* O; int ldc;
    __device__ __forceinline__ void operator()(const pg8::f32x4 (&acc)[2][2][4][2], const pg8::Unit& u, int wr, int wc, int fr, int fq) const {
        const int row0 = u.pm * 256 + wr * 64 + fr, col0 = u.pn * 256 + wc * 32 + 8 * fq;
#pragma unroll
        for (int ai = 0; ai < 2; ++ai)
#pragma unroll
            for (int m = 0; m < 4; ++m) { bf16* rowp = O + (size_t)(row0 + ai * 128 + m * 16) * ldc + col0;
#pragma unroll
                for (int bj = 0; bj < 2; ++bj) { const pg8::f32x4 v0 = acc[ai][bj][m][0], v1 = acc[ai][bj][m][1];
                    v4u w; w.x = pk2(v0[0], v0[1]); w.y = pk2(v0[2], v0[3]); w.z = pk2(v1[0], v1[1]); w.w = pk2(v1[2], v1[3]); *(v4u*)(rowp + bj * 128) = w; } }
    }
};
template <int PASS> struct EpiProj {
    static constexpr bool PERM = false, AFTER_DRAIN = false; float* Y; const bf16* Z; bf16* MIX;
    __device__ __forceinline__ void operator()(const pg8::f32x4 (&acc)[2][2][4][2], const pg8::Unit& u, int wr, int wc, int fr, int fq) const {
        const int row0 = u.pm * 256 + wr * 64 + fr, col0 = u.pn * 256 + wc * 32 + 4 * fq;
#pragma unroll
        for (int ai = 0; ai < 2; ++ai)
#pragma unroll
            for (int m = 0; m < 4; ++m) { const size_t row = (size_t)(row0 + ai * 128 + m * 16);
#pragma unroll
                for (int bj = 0; bj < 2; ++bj)
#pragma unroll
                    for (int n = 0; n < 2; ++n) { const int c = col0 + bj * 128 + n * 16;
                        const v2u gw = *(const v2u*)(Z + row * ZP + ZGT + PASS * 1024 + c);
                        f32x4 gv; gv.x = bflo(gw.x); gv.y = bfhi(gw.x); gv.z = bflo(gw.y); gv.w = bfhi(gw.y);
                        f32x4 v = acc[ai][bj][m][n] * gv; float* yp = Y + row * D + c;
                        if (PASS > 0) v += *(const f32x4*)yp;
                        if (PASS < 2) *(f32x4*)yp = v; else { v2u w; w.x = pk2(v.x, v.y); w.y = pk2(v.z, v.w); *(v2u*)(MIX + row * D + c) = w; } } }
    }
};

__device__ __forceinline__ void cvt_item(const float* W, int ldw, int sk0, int sn0, int nvalid, bf16* WT, int ldo, int orow0, int dk0, LAS float* scr, int lane) {
    const int n_ = lane & 31;
#pragma unroll 8
    for (int i = 0; i < 32; ++i) { const int kk = 2 * i + (lane >> 5); scr[kk * 33 + n_] = (n_ < nvalid) ? W[(size_t)(sk0 + kk) * ldw + sn0 + n_] : 0.f; }
    LDS_WAIT(); asm volatile("" ::: "memory");
    const int c = lane & 7;
#pragma unroll
    for (int j = 0; j < 4; ++j) { const int n = (lane >> 3) + 8 * j; const LAS float* s = scr + (8 * c) * 33 + n;
        v4u o; o.x = pk2(s[0 * 33], s[1 * 33]); o.y = pk2(s[2 * 33], s[3 * 33]); o.z = pk2(s[4 * 33], s[5 * 33]); o.w = pk2(s[6 * 33], s[7 * 33]);
        *(v4u*)(WT + (size_t)(orow0 + n) * ldo + dk0 + 8 * c) = o; }
    LDS_WAIT(); asm volatile("" ::: "memory");
}
__device__ __forceinline__ void convert_layer(CA a, int l, LAS unsigned char* lds, int gw, int NGW, int wave, int lane) {
    LAS float* scr = (LAS float*)(lds + wave * 16384);
    unsigned char* ws = a->ws;
    constexpr int I_UP = 16 * 176, I_DN = 44 * 32, I_IN = 16 * 272, I_PA = 8 * 32, I_PB = 16 * 32, I_LO = 4 * 48;
    constexpr int NITEMS = 2 * I_UP + 2 * I_DN + I_IN + 2 * I_PA + 2 * I_PB + I_LO;
    for (int it = gw; it < NITEMS; it += NGW) {
        int r = it;
        if (r < 2 * I_UP) { const int s = r / I_UP; r -= s * I_UP; const int kb = r / 176, ob = r % 176, orow0 = 32 * ob, pn = orow0 >> 8, wi = orow0 & 255;
            const int sn0 = (wi < 128) ? (128 * pn + wi) : (DFF + 128 * pn + wi - 128);
            cvt_item(a->in[6] + (size_t)(l * 2 + s) * D * 2 * DFF, 2 * DFF, 64 * kb, sn0, 32, (bf16*)(ws + (s ? W_UP1 : W_UP0)), D, orow0, 64 * kb, scr, lane); continue; }
        r -= 2 * I_UP;
        if (r < 2 * I_DN) { const int s = r / I_DN; r -= s * I_DN; const int kb = r / 32, ob = r % 32;
            cvt_item(a->in[7] + (size_t)(l * 2 + s) * DFF * D, D, 64 * kb, 32 * ob, 32, (bf16*)(ws + (s ? W_DN1 : W_DN0)), DFF, 32 * ob, 64 * kb, scr, lane); continue; }
        r -= 2 * I_DN;
        if (r < I_IN) { const int kb = r / 272, ob = r % 272, orow0 = 32 * ob; int sn0, nv;
            if (orow0 < 1536) { sn0 = orow0; nv = 32; } else if (orow0 < ZFL) { sn0 = orow0 + 8; nv = 32; } else if (orow0 == ZFL) { sn0 = 1536; nv = 8; } else { sn0 = 0; nv = 0; }
            cvt_item(a->in[8] + (size_t)l * D * 8456, 8456, 64 * kb, sn0, nv, (bf16*)(ws + W_IN), D, orow0, 64 * kb, scr, lane); continue; }
        r -= I_IN;
        if (r < I_PA) { const int kb = r / 32, ob = r % 32; cvt_item(a->in[28] + (size_t)l * 512 * D, D, 64 * kb, 32 * ob, 32, (bf16*)(ws + W_PA), 512, 32 * ob, 64 * kb, scr, lane); continue; }
        r -= I_PA;
        if (r < I_PB) { const int kb = r / 32, ob = r % 32; cvt_item(a->in[29] + (size_t)l * D * D, D, 64 * kb, 32 * ob, 32, (bf16*)(ws + W_PB), D, 32 * ob, 64 * kb, scr, lane); continue; }
        r -= I_PB;
        if (r < I_PA) { const int kb = r / 32, ob = r % 32; cvt_item(a->in[30] + (size_t)l * 512 * D, D, 64 * kb, 32 * ob, 32, (bf16*)(ws + W_PC), 512, 32 * ob, 64 * kb, scr, lane); continue; }
        r -= I_PA;
        if (r < I_PB) { const int kb = r / 32, ob = r % 32; cvt_item(a->in[31] + (size_t)l * D * D, D, 64 * kb, 32 * ob, 32, (bf16*)(ws + W_OUT), D, 32 * ob, 64 * kb, scr, lane); continue; }
        r -= I_PB;
        {
            const int kb = r / 48, ob = r % 48, reg = ob / 16, nb = ob % 16; const float* W = a->in[19]; int sk0 = 0, nv = 0;
            if (reg == 0 && kb == 0) { W = a->in[19] + (size_t)l * 64 * 512; nv = 32; }
            else if (reg == 1 && kb == 1) { W = a->in[21] + (size_t)l * 64 * 512; nv = 32; }
            else if (reg == 2 && kb >= 2) { W = a->in[22] + (size_t)l * 128 * 512; sk0 = 64 * (kb - 2); nv = 32; }
            cvt_item(W, 512, sk0, 32 * nb, nv, (bf16*)(ws + W_LORA), 256, 32 * ob, 64 * kb, scr, lane); }
    }
}

__device__ __forceinline__ void row_stats(const f32x4 (&v)[4], float& mean, float& rstd, int lane) {
    float s = 0.f;
#pragma unroll
    for (int j = 0; j < 4; ++j) s += (v[j].x + v[j].y) + (v[j].z + v[j].w);
    mean = wave_sum(s, lane) * (1.f / D); float s2 = 0.f;
#pragma unroll
    for (int j = 0; j < 4; ++j) { const f32x4 d = v[j] - mean; s2 += (d.x * d.x + d.y * d.y) + (d.z * d.z + d.w * d.w); }
    rstd = 1.f / sqrtf(wave_sum(s2, lane) * (1.f / D) + LN_EPS);
}
__device__ __forceinline__ void store_mod(const f32x4 (&v)[4], float mean, float rstd, const float* sh, const float* sc, bf16* hrow, int lane) {
#pragma unroll
    for (int j = 0; j < 4; ++j) { const int c = 4 * lane + 256 * j; const f32x4 s1 = *(const f32x4*)(sc + c) + 1.f, s0 = *(const f32x4*)(sh + c);
        const f32x4 h = (v[j] - mean) * rstd * s1 + s0; v2u w; w.x = pk2(h.x, h.y); w.y = pk2(h.z, h.w); *(v2u*)(hrow + c) = w; }
}
__device__ __forceinline__ void ln_phase(const float* xsrc, const float* Y, float* xout, bf16* H, const float* lng, const float* lnb, const float* sh, const float* sc, bool do_mod, int gw, int NGW, int lane) {
    for (int m = gw; m < M; m += NGW) {
        f32x4 v[4];
#pragma unroll
        for (int j = 0; j < 4; ++j) { const size_t o = (size_t)m * D + 4 * lane + 256 * j; v[j] = *(const f32x4*)(xsrc + o) * ALPHA + *(const f32x4*)(Y + o); }
        float mean, rstd; row_stats(v, mean, rstd, lane);
#pragma unroll
        for (int j = 0; j < 4; ++j) { const int c = 4 * lane + 256 * j; v[j] = (v[j] - mean) * rstd * *(const f32x4*)(lng + c) + *(const f32x4*)(lnb + c); *(f32x4*)(xout + (size_t)m * D + c) = v[j]; }
        if (do_mod) { row_stats(v, mean, rstd, lane); store_mod(v, mean, rstd, sh, sc, H + (size_t)m * D, lane); }
    }
}
__device__ __forceinline__ void mod_phase(const float* x, bf16* H, const float* sh, const float* sc, int gw, int NGW, int lane) {
    for (int m = gw; m < M; m += NGW) {
        f32x4 v[4];
#pragma unroll
        for (int j = 0; j < 4; ++j) v[j] = *(const f32x4*)(x + (size_t)m * D + 4 * lane + 256 * j);
        float mean, rstd; row_stats(v, mean, rstd, lane); store_mod(v, mean, rstd, sh, sc, H + (size_t)m * D, lane);
    }
}
__device__ __forceinline__ void ada_phase(CA a, LAS unsigned char* lds, int tid, int lane, int wave, int bid) {
    LAS float* cact = (LAS float*)lds; LAS float* part = cact + 1024;
    for (int i = tid; i < D; i += NTHR) { const float c = a->in[1][i]; cact[i] = c * sigm(c); }
    __syncthreads();
    float* ADA = (float*)(a->ws + WS_ADA);
    for (int task = bid; task < NL * 144; task += gridDim.x) {
        const int l = task / 144, col = (task % 144) * 64 + lane; const float* W = a->in[2] + (size_t)l * D * 9216 + col; float s = 0.f;
#pragma unroll 16
        for (int k = wave * 128; k < wave * 128 + 128; ++k) s += cact[k] * W[(size_t)k * 9216];
        part[wave * 64 + lane] = s; __syncthreads();
        if (wave == 0) { float t = 0.f;
#pragma unroll
            for (int w = 0; w < 8; ++w) t += part[w * 64 + lane];
            ADA[l * 9216 + col] = t + a->in[3][l * 9216 + col]; }
        __syncthreads();
    }
}

__device__ __forceinline__ void fscan_head(const bf16* Z, const float* fbias, float* FL2, int h, LAS unsigned char* lds, int tid, int lane, int wave) {
    LAS float* wt = (LAS float*)lds; const float fb = fbias[h]; float lf[32]; float run = 0.f;
#pragma unroll
    for (int i = 0; i < 32; ++i) { const float x = bf1(Z[(size_t)(tid * 32 + i) * ZP + ZFL + h]) + fb; run += -softplus_(-x); lf[i] = run; }
    float inc = run;
#pragma unroll
    for (int o = 1; o < 64; o <<= 1) { const float t = __builtin_bit_cast(float, __builtin_amdgcn_ds_bpermute(((lane - o) & 63) << 2, __builtin_bit_cast(int, inc))); if (lane >= o) inc += t; }
    if (lane == 63) wt[wave] = inc;
    __syncthreads();
    float base = inc - run;
    for (int w = 0; w < wave; ++w) base += wt[w];
#pragma unroll
    for (int i = 0; i < 32; ++i) FL2[(size_t)h * M + tid * 32 + i] = (base + lf[i]) * LOG2E;
    __syncthreads();
}
__device__ __forceinline__ void codes_phase(const bf16* Z, const float* mu, bf16* CODES, int gtid, int NGT) {
    for (int it = gtid; it < M * 32; it += NGT) { const int t = it >> 5, j0 = (it & 31) * 8;
        const v4u z = *(const v4u*)(Z + (size_t)t * ZP + ZRW + 1536 + j0); v4u zp = (v4u){0u, 0u, 0u, 0u};
        if (t > 0) zp = *(const v4u*)(Z + (size_t)(t - 1) * ZP + ZRW + 1536 + j0);
        float o[8];
#pragma unroll
        for (int q = 0; q < 4; ++q) { const float a0 = bflo(z[q]), a1 = bfhi(z[q]), p0 = bflo(zp[q]), p1 = bfhi(zp[q]); const float m0 = mu[1536 + j0 + 2 * q], m1 = mu[1536 + j0 + 2 * q + 1];
            o[2 * q] = a0 + (p0 - a0) * m0; o[2 * q + 1] = a1 + (p1 - a1) * m1; }
#pragma unroll
        for (int q = 0; q < 8; ++q) { if (j0 < 64) o[q] = tanh_(o[q]); else if (j0 >= 128) o[q] = sigm(o[q]); }
        v4u w; w.x = pk2(o[0], o[1]); w.y = pk2(o[2], o[3]); w.z = pk2(o[4], o[5]); w.w = pk2(o[6], o[7]); *(v4u*)(CODES + (size_t)t * 256 + j0) = w; }
}
__device__ __forceinline__ void lru_l1(CA a, int l, const bf16* Z, bf16* HLOC, bf16* ACUM, float* AEND, float* HEND, LAS unsigned char* lds, int tid, int lane, int wave, int bid) {
    LAS float* xcf = (LAS float*)lds; LAS bf16* xcb = (LAS bf16*)(lds + 16640); LAS bf16* wga = (LAS bf16*)(lds + 25856); LAS bf16* wgx = (LAS bf16*)(lds + 35072);
    LAS float* la = (LAS float*)(lds + 44288); LAS float* lu = (LAS float*)(lds + 60928); LAS float* agg = (LAS float*)(lds + 77568);
    const float* cw = a->in[10] + (size_t)l * 4 * D; const float* cb = a->in[11] + (size_t)l * D;
    const float* gaw = a->in[12] + (size_t)l * 16 * 4096; const float* gab = a->in[13] + (size_t)l * D;
    const float* gxw = a->in[14] + (size_t)l * 16 * 4096; const float* gxb = a->in[15] + (size_t)l * D; const float* lam = a->in[16] + (size_t)l * D;
    int nprev = -1;
    for (int task = bid; task < NCH * 16; task += gridDim.x) {
        const int c = task >> 4, n = task & 15, t0 = c * LC;
        {
            const int tok = tid >> 3, cg8 = (tid & 7) * 8, ch0 = n * 64 + cg8; float acc[8];
#pragma unroll
            for (int q = 0; q < 8; ++q) acc[q] = cb[ch0 + q];
#pragma unroll
            for (int j = 0; j < 4; ++j) { const int tt = t0 + tok - 3 + j;
                if (tt >= 0) { const v4u x = *(const v4u*)(Z + (size_t)tt * ZP + ZXB + ch0);
#pragma unroll
                    for (int q = 0; q < 4; ++q) { acc[2 * q] += cw[j * D + ch0 + 2 * q] * bflo(x[q]); acc[2 * q + 1] += cw[j * D + ch0 + 2 * q + 1] * bfhi(x[q]); } } }
#pragma unroll
            for (int q = 0; q < 8; ++q) xcf[tok * 65 + cg8 + q] = acc[q];
            v4u w; w.x = pk2(acc[0], acc[1]); w.y = pk2(acc[2], acc[3]); w.z = pk2(acc[4], acc[5]); w.w = pk2(acc[6], acc[7]); *(LAS v4u*)(xcb + tok * 72 + cg8) = w;
        }
        if (n != nprev) {
            const int i = tid >> 3, j0 = (tid & 7) * 8;
#pragma unroll
            for (int q = 0; q < 8; ++q) { wga[(j0 + q) * 72 + i] = (bf16)f2bf(gaw[(size_t)n * 4096 + i * 64 + j0 + q]); wgx[(j0 + q) * 72 + i] = (bf16)f2bf(gxw[(size_t)n * 4096 + i * 64 + j0 + q]); }
            nprev = n;
        }
        __syncthreads();
        {
            const int tb = wave & 3, cbp = wave >> 2, fr = lane & 15, fq = lane >> 4;
            bf16x8 af[2];
#pragma unroll
            for (int kk = 0; kk < 2; ++kk) af[kk] = *(const LAS bf16x8*)(xcb + (tb * 16 + fr) * 72 + kk * 32 + fq * 8);
#pragma unroll
            for (int c2 = 0; c2 < 2; ++c2) { const int cbk = 2 * cbp + c2; f32x4 ar = (f32x4){0.f, 0.f, 0.f, 0.f}, ai = ar;
#pragma unroll
                for (int kk = 0; kk < 2; ++kk) { const bf16x8 b0 = *(const LAS bf16x8*)(wga + (cbk * 16 + fr) * 72 + kk * 32 + fq * 8), b1 = *(const LAS bf16x8*)(wgx + (cbk * 16 + fr) * 72 + kk * 32 + fq * 8);
                    ar = __builtin_amdgcn_mfma_f32_16x16x32_bf16(af[kk], b0, ar, 0, 0, 0); ai = __builtin_amdgcn_mfma_f32_16x16x32_bf16(af[kk], b1, ai, 0, 0, 0); }
                const int ch = cbk * 16 + fr, gch = n * 64 + ch; const float bga = gab[gch], bgx = gxb[gch], sp = log1pf(__expf(-lam[gch]));
#pragma unroll
                for (int rg = 0; rg < 4; ++rg) { const int tok = tb * 16 + fq * 4 + rg; const float r = sigm(ar[rg] + bga), ig = sigm(ai[rg] + bgx);
                    const float log_a = -8.f * r * sp, av = __expf(log_a), uv = sqrtf(-expm1f(2.f * log_a)) * (ig * xcf[tok * 65 + ch]);
                    la[tok * 65 + ch] = av; lu[tok * 65 + ch] = uv; } }
        }
        __syncthreads();
        {
            float hl[8], al[8]; float A = 1.f, h = 0.f;
#pragma unroll
            for (int s = 0; s < 8; ++s) { const float av = la[(wave * 8 + s) * 65 + lane], uv = lu[(wave * 8 + s) * 65 + lane]; h = av * h + uv; A *= av; hl[s] = h; al[s] = A; }
            agg[(wave * 2 + 0) * 64 + lane] = A; agg[(wave * 2 + 1) * 64 + lane] = h;
            __syncthreads();
            float cA = 1.f, cH = 0.f;
            for (int w = 0; w < wave; ++w) { const float A2 = agg[(w * 2 + 0) * 64 + lane], h2 = agg[(w * 2 + 1) * 64 + lane]; cH = A2 * cH + h2; cA *= A2; }
            float hf = 0.f, Af = 1.f;
#pragma unroll
            for (int s = 0; s < 8; ++s) { hf = hl[s] + al[s] * cH; Af = al[s] * cA; const size_t o = (size_t)(t0 + wave * 8 + s) * D + n * 64 + lane; HLOC[o] = (bf16)f2bf(hf); ACUM[o] = (bf16)f2bf(Af); }
            if (wave == 7) { AEND[c * D + n * 64 + lane] = Af; HEND[c * D + n * 64 + lane] = hf; }
        }
        __syncthreads();
    }
}
__device__ __forceinline__ void lru_l2(const float* AEND, const float* HEND, float* CAR, int gw, int lane) {
    if (gw < 16) { const int ch = gw * 64 + lane; float carry = 0.f;
#pragma unroll 8
        for (int c = 0; c < NCH; ++c) { CAR[c * D + ch] = carry; carry = AEND[c * D + ch] * carry + HEND[c * D + ch]; } }
}
__device__ __forceinline__ void lru_l3(bf16* Z, const bf16* HLOC, const bf16* ACUM, const float* CAR, int gtid, int NGT) {
    for (int it = gtid; it < M * 128; it += NGT) { const int t = it >> 7, ch0 = (it & 127) * 8; const size_t o = (size_t)t * D + ch0;
        const v4u hl = *(const v4u*)(HLOC + o), ac = *(const v4u*)(ACUM + o), yb = *(const v4u*)(Z + (size_t)t * ZP + ZYB + ch0);
        const f32x4 c0 = *(const f32x4*)(CAR + (t >> 6) * D + ch0), c1 = *(const f32x4*)(CAR + (t >> 6) * D + ch0 + 4); float o8[8];
#pragma unroll
        for (int q = 0; q < 4; ++q) { const float ca = (q < 2) ? c0[2 * q] : c1[2 * q - 4], cb_ = (q < 2) ? c0[2 * q + 1] : c1[2 * q - 3];
            o8[2 * q] = (bflo(hl[q]) + bflo(ac[q]) * ca) * gelu_tanh(bflo(yb[q])); o8[2 * q + 1] = (bfhi(hl[q]) + bfhi(ac[q]) * cb_) * gelu_tanh(bfhi(yb[q])); }
        v4u w; w.x = pk2(o8[0], o8[1]); w.y = pk2(o8[2], o8[3]); w.z = pk2(o8[4], o8[5]); w.w = pk2(o8[6], o8[7]); *(v4u*)(Z + (size_t)t * ZP + ZYB + ch0) = w; }
}
__device__ __forceinline__ void ld8bf(const bf16* p, float (&o)[8]) { const v4u u = *(const v4u*)p;
#pragma unroll
    for (int q = 0; q < 4; ++q) { o[2 * q] = bflo(u[q]); o[2 * q + 1] = bfhi(u[q]); } }
__device__ __forceinline__ void ld8f(const float* p, float (&o)[8]) { const f32x4 a = *(const f32x4*)p, b = *(const f32x4*)(p + 4); o[0] = a.x; o[1] = a.y; o[2] = a.z; o[3] = a.w; o[4] = b.x; o[5] = b.y; o[6] = b.z; o[7] = b.w; }
__device__ __forceinline__ void st8bf(bf16* p, const float (&v)[8]) { v4u w; w.x = pk2(v[0], v[1]); w.y = pk2(v[2], v[3]); w.z = pk2(v[4], v[5]); w.w = pk2(v[6], v[7]); *(v4u*)p = w; }
__device__ __forceinline__ float sum8lanes(float v, int lane) { v += shx(v, 1, lane); v += shx(v, 2, lane); v += shx(v, 4, lane); return v; }
__device__ __forceinline__ void rw_prep(CA a, int l, const bf16* Z, const bf16* LORA, float* Wd, bf16* R, bf16* KF, bf16* V, bf16* KK, bf16* Bv, bf16* GB, float* BON, int gw, int NGW, int lane) {
    const int c0 = 8 * lane;
    float mur[8], muk[8], muv[8], w0[8], a0[8], kk_[8], ka_[8], rk_[8];
    ld8f(a->in[17] + (size_t)l * 1792 + c0, mur); ld8f(a->in[17] + (size_t)l * 1792 + 512 + c0, muk); ld8f(a->in[17] + (size_t)l * 1792 + 1024 + c0, muv);
    ld8f(a->in[18] + (size_t)l * 512 + c0, w0); ld8f(a->in[20] + (size_t)l * 512 + c0, a0); ld8f(a->in[23] + (size_t)l * 512 + c0, kk_); ld8f(a->in[24] + (size_t)l * 512 + c0, ka_); ld8f(a->in[25] + (size_t)l * 512 + c0, rk_);
    for (int tb = gw * 8; tb < M; tb += NGW * 8) {
        float rp[8], kp[8], vp[8];
        if (tb > 0) { const bf16* zp = Z + (size_t)(tb - 1) * ZP + ZRW + c0; ld8bf(zp, rp); ld8bf(zp + 512, kp); ld8bf(zp + 1024, vp); }
        else {
#pragma unroll
            for (int q = 0; q < 8; ++q) { rp[q] = 0.f; kp[q] = 0.f; vp[q] = 0.f; } }
#pragma unroll 2
        for (int tt = 0; tt < 8; ++tt) { const int t = tb + tt; const bf16* zc = Z + (size_t)t * ZP + ZRW + c0; float rc[8], kc[8], vc[8], lw[8], la[8];
            ld8bf(zc, rc); ld8bf(zc + 512, kc); ld8bf(zc + 1024, vc);
            const bf16* lo = LORA + (size_t)t * 1536 + c0; ld8bf(lo, lw); ld8bf(lo + 512, la); const v4u lg = *(const v4u*)(lo + 1024);
            float r[8], k[8], v[8], dec[8], av[8], kk[8], kf[8], bb[8]; float n2 = 0.f, bs = 0.f;
#pragma unroll
            for (int q = 0; q < 8; ++q) { r[q] = rc[q] + (rp[q] - rc[q]) * mur[q]; k[q] = kc[q] + (kp[q] - kc[q]) * muk[q]; v[q] = vc[q] + (vp[q] - vc[q]) * muv[q];
                const float wv = -softplus_(-(w0[q] + lw[q])) - 0.5f; dec[q] = __expf(-__expf(wv)); av[q] = sigm(a0[q] + la[q]);
                kk[q] = k[q] * kk_[q]; n2 += kk[q] * kk[q]; kf[q] = k[q] * (1.f + (av[q] - 1.f) * ka_[q]); bs += r[q] * kf[q] * rk_[q];
                rp[q] = rc[q]; kp[q] = kc[q]; vp[q] = vc[q]; }
            n2 = sum8lanes(n2, lane); bs = sum8lanes(bs, lane); const float inv = 1.f / fmaxf(sqrtf(n2), 1e-12f);
#pragma unroll
            for (int q = 0; q < 8; ++q) { kk[q] *= inv; bb[q] = kk[q] * av[q]; }
            const size_t o = (size_t)t * 512 + c0;
            *(f32x4*)(Wd + o) = (f32x4){dec[0], dec[1], dec[2], dec[3]}; *(f32x4*)(Wd + o + 4) = (f32x4){dec[4], dec[5], dec[6], dec[7]};
            st8bf(R + o, r); st8bf(KF + o, kf); st8bf(V + o, v); st8bf(KK + o, kk); st8bf(Bv + o, bb); *(v4u*)(GB + o) = lg;
            if ((lane & 7) == 0) BON[t * 8 + (lane >> 3)] = bs; }
    }
}
constexpr int RW_PF = 4;
struct RwOps { unsigned kk[2], b[2], kf[2], r[2]; float w[4]; unsigned v; };
template <bool WITH_R> __device__ __forceinline__ RwOps rw_load(const unsigned char* ws, const RwSet rs, size_t o  , int lane) {
    RwOps x; const int i4 = (lane & 15) * 4;
#pragma unroll
    for (int j = 0; j < 2; ++j) { x.kk[j] = *(const unsigned*)(ws + rs.kk + o * 2 + 64 * j + i4); x.b[j] = *(const unsigned*)(ws + rs.b + o * 2 + 64 * j + i4); x.kf[j] = *(const unsigned*)(ws + rs.kf + o * 2 + 64 * j + i4);
        x.r[j] = WITH_R ? *(const unsigned*)(ws + rs.r + o * 2 + 64 * j + i4) : 0u; }
#pragma unroll
    for (int j = 0; j < 4; ++j) x.w[j] = *(const float*)(ws + rs.w + o * 4 + 64 * j + i4);
    x.v = *(const bf16*)(ws + WS_RW_V + o * 2 + lane * 2);
    return x;
}
#define FMAC_BC(acc, opv, y, n) asm("v_fmac_f32_dpp %0, %1, %2 row_newbcast:" #n " row_mask:0xf bank_mask:0xf" : "+v"(acc) : "v"(opv), "v"(y))
#define MUL_BC(dst, opv, y, n) asm("v_mul_f32_dpp %0, %1, %2 row_newbcast:" #n " row_mask:0xf bank_mask:0xf" : "=v"(dst) : "v"(opv), "v"(y))
#define RW_UNPACK(A, src) float A##l0 = __uint_as_float((src)[0] << 16), A##h0 = __uint_as_float((src)[0] & 0xffff0000u), A##l1 = __uint_as_float((src)[1] << 16), A##h1 = __uint_as_float((src)[1] & 0xffff0000u); \
    asm volatile("s_nop 1" : "+v"(A##l0), "+v"(A##h0), "+v"(A##l1), "+v"(A##h1))
template <int MODE> __device__ __forceinline__ float rw_step(float (&st)[64], const RwOps x) {
    RW_UNPACK(kk, x.kk); RW_UNPACK(bb, x.b); RW_UNPACK(kf, x.kf); RW_UNPACK(rr, x.r);
    float w0 = x.w[0], w1 = x.w[1], w2 = x.w[2], w3 = x.w[3]; asm volatile("" : "+v"(w0), "+v"(w1), "+v"(w2), "+v"(w3));
    float s0 = 0.f, s1 = 0.f, y0 = 0.f, y1 = 0.f; const float vv = __uint_as_float(x.v << 16);
    FMAC_BC(s0, kkl0, st[0], 0);
    FMAC_BC(s1, kkh0, st[1], 0);
    FMAC_BC(s0, kkl0, st[2], 1);
    FMAC_BC(s1, kkh0, st[3], 1);
    FMAC_BC(s0, kkl0, st[4], 2);
    FMAC_BC(s1, kkh0, st[5], 2);
    FMAC_BC(s0, kkl0, st[6], 3);
    FMAC_BC(s1, kkh0, st[7], 3);
    FMAC_BC(s0, kkl0, st[8], 4);
    FMAC_BC(s1, kkh0, st[9], 4);
    FMAC_BC(s0, kkl0, st[10], 5);
    FMAC_BC(s1, kkh0, st[11], 5);
    FMAC_BC(s0, kkl0, st[12], 6);
    FMAC_BC(s1, kkh0, st[13], 6);
    FMAC_BC(s0, kkl0, st[14], 7);
    FMAC_BC(s1, kkh0, st[15], 7);
    FMAC_BC(s0, kkl0, st[16], 8);
    FMAC_BC(s1, kkh0, st[17], 8);
    FMAC_BC(s0, kkl0, st[18], 9);
    FMAC_BC(s1, kkh0, st[19], 9);
    FMAC_BC(s0, kkl0, st[20], 10);
    FMAC_BC(s1, kkh0, st[21], 10);
    FMAC_BC(s0, kkl0, st[22], 11);
    FMAC_BC(s1, kkh0, st[23], 11);
    FMAC_BC(s0, kkl0, st[24], 12);
    FMAC_BC(s1, kkh0, st[25], 12);
    FMAC_BC(s0, kkl0, st[26], 13);
    FMAC_BC(s1, kkh0, st[27], 13);
    FMAC_BC(s0, kkl0, st[28], 14);
    FMAC_BC(s1, kkh0, st[29], 14);
    FMAC_BC(s0, kkl0, st[30], 15);
    FMAC_BC(s1, kkh0, st[31], 15);
    FMAC_BC(s0, kkl1, st[32], 0);
    FMAC_BC(s1, kkh1, st[33], 0);
    FMAC_BC(s0, kkl1, st[34], 1);
    FMAC_BC(s1, kkh1, st[35], 1);
    FMAC_BC(s0, kkl1, st[36], 2);
    FMAC_BC(s1, kkh1, st[37], 2);
    FMAC_BC(s0, kkl1, st[38], 3);
    FMAC_BC(s1, kkh1, st[39], 3);
    FMAC_BC(s0, kkl1, st[40], 4);
    FMAC_BC(s1, kkh1, st[41], 4);
    FMAC_BC(s0, kkl1, st[42], 5);
    FMAC_BC(s1, kkh1, st[43], 5);
    FMAC_BC(s0, kkl1, st[44], 6);
    FMAC_BC(s1, kkh1, st[45], 6);
    FMAC_BC(s0, kkl1, st[46], 7);
    FMAC_BC(s1, kkh1, st[47], 7);
    FMAC_BC(s0, kkl1, st[48], 8);
    FMAC_BC(s1, kkh1, st[49], 8);
    FMAC_BC(s0, kkl1, st[50], 9);
    FMAC_BC(s1, kkh1, st[51], 9);
    FMAC_BC(s0, kkl1, st[52], 10);
    FMAC_BC(s1, kkh1, st[53], 10);
    FMAC_BC(s0, kkl1, st[54], 11);
    FMAC_BC(s1, kkh1, st[55], 11);
    FMAC_BC(s0, kkl1, st[56], 12);
    FMAC_BC(s1, kkh1, st[57], 12);
    FMAC_BC(s0, kkl1, st[58], 13);
    FMAC_BC(s1, kkh1, st[59], 13);
    FMAC_BC(s0, kkl1, st[60], 14);
    FMAC_BC(s1, kkh1, st[61], 14);
    FMAC_BC(s0, kkl1, st[62], 15);
    FMAC_BC(s1, kkh1, st[63], 15);
    const float sa = -(s0 + s1);
    float t;
    MUL_BC(t, bbl0, sa, 0); if (MODE != 0) FMAC_BC(t, kfl0, vv, 0); FMAC_BC(t, w0, st[0], 0); st[0] = t; if (MODE == 2) FMAC_BC(y0, rrl0, t, 0);
    MUL_BC(t, bbh0, sa, 0); if (MODE != 0) FMAC_BC(t, kfh0, vv, 0); FMAC_BC(t, w0, st[1], 1); st[1] = t; if (MODE == 2) FMAC_BC(y1, rrh0, t, 0);
    MUL_BC(t, bbl0, sa, 1); if (MODE != 0) FMAC_BC(t, kfl0, vv, 1); FMAC_BC(t, w0, st[2], 2); st[2] = t; if (MODE == 2) FMAC_BC(y0, rrl0, t, 1);
    MUL_BC(t, bbh0, sa, 1); if (MODE != 0) FMAC_BC(t, kfh0, vv, 1); FMAC_BC(t, w0, st[3], 3); st[3] = t; if (MODE == 2) FMAC_BC(y1, rrh0, t, 1);
    MUL_BC(t, bbl0, sa, 2); if (MODE != 0) FMAC_BC(t, kfl0, vv, 2); FMAC_BC(t, w0, st[4], 4); st[4] = t; if (MODE == 2) FMAC_BC(y0, rrl0, t, 2);
    MUL_BC(t, bbh0, sa, 2); if (MODE != 0) FMAC_BC(t, kfh0, vv, 2); FMAC_BC(t, w0, st[5], 5); st[5] = t; if (MODE == 2) FMAC_BC(y1, rrh0, t, 2);
    MUL_BC(t, bbl0, sa, 3); if (MODE != 0) FMAC_BC(t, kfl0, vv, 3); FMAC_BC(t, w0, st[6], 6); st[6] = t; if (MODE == 2) FMAC_BC(y0, rrl0, t, 3);
    MUL_BC(t, bbh0, sa, 3); if (MODE != 0) FMAC_BC(t, kfh0, vv, 3); FMAC_BC(t, w0, st[7], 7); st[7] = t; if (MODE == 2) FMAC_BC(y1, rrh0, t, 3);
    MUL_BC(t, bbl0, sa, 4); if (MODE != 0) FMAC_BC(t, kfl0, vv, 4); FMAC_BC(t, w0, st[8], 8); st[8] = t; if (MODE == 2) FMAC_BC(y0, rrl0, t, 4);
    MUL_BC(t, bbh0, sa, 4); if (MODE != 0) FMAC_BC(t, kfh0, vv, 4); FMAC_BC(t, w0, st[9], 9); st[9] = t; if (MODE == 2) FMAC_BC(y1, rrh0, t, 4);
    MUL_BC(t, bbl0, sa, 5); if (MODE != 0) FMAC_BC(t, kfl0, vv, 5); FMAC_BC(t, w0, st[10], 10); st[10] = t; if (MODE == 2) FMAC_BC(y0, rrl0, t, 5);
    MUL_BC(t, bbh0, sa, 5); if (MODE != 0) FMAC_BC(t, kfh0, vv, 5); FMAC_BC(t, w0, st[11], 11); st[11] = t; if (MODE == 2) FMAC_BC(y1, rrh0, t, 5);
    MUL_BC(t, bbl0, sa, 6); if (MODE != 0) FMAC_BC(t, kfl0, vv, 6); FMAC_BC(t, w0, st[12], 12); st[12] = t; if (MODE == 2) FMAC_BC(y0, rrl0, t, 6);
    MUL_BC(t, bbh0, sa, 6); if (MODE != 0) FMAC_BC(t, kfh0, vv, 6); FMAC_BC(t, w0, st[13], 13); st[13] = t; if (MODE == 2) FMAC_BC(y1, rrh0, t, 6);
    MUL_BC(t, bbl0, sa, 7); if (MODE != 0) FMAC_BC(t, kfl0, vv, 7); FMAC_BC(t, w0, st[14], 14); st[14] = t; if (MODE == 2) FMAC_BC(y0, rrl0, t, 7);
    MUL_BC(t, bbh0, sa, 7); if (MODE != 0) FMAC_BC(t, kfh0, vv, 7); FMAC_BC(t, w0, st[15], 15); st[15] = t; if (MODE == 2) FMAC_BC(y1, rrh0, t, 7);
    MUL_BC(t, bbl0, sa, 8); if (MODE != 0) FMAC_BC(t, kfl0, vv, 8); FMAC_BC(t, w1, st[16], 0); st[16] = t; if (MODE == 2) FMAC_BC(y0, rrl0, t, 8);
    MUL_BC(t, bbh0, sa, 8); if (MODE != 0) FMAC_BC(t, kfh0, vv, 8); FMAC_BC(t, w1, st[17], 1); st[17] = t; if (MODE == 2) FMAC_BC(y1, rrh0, t, 8);
    MUL_BC(t, bbl0, sa, 9); if (MODE != 0) FMAC_BC(t, kfl0, vv, 9); FMAC_BC(t, w1, st[18], 2); st[18] = t; if (MODE == 2) FMAC_BC(y0, rrl0, t, 9);
    MUL_BC(t, bbh0, sa, 9); if (MODE != 0) FMAC_BC(t, kfh0, vv, 9); FMAC_BC(t, w1, st[19], 3); st[19] = t; if (MODE == 2) FMAC_BC(y1, rrh0, t, 9);
    MUL_BC(t, bbl0, sa, 10); if (MODE != 0) FMAC_BC(t, kfl0, vv, 10); FMAC_BC(t, w1, st[20], 4); st[20] = t; if (MODE == 2) FMAC_BC(y0, rrl0, t, 10);
    MUL_BC(t, bbh0, sa, 10); if (MODE != 0) FMAC_BC(t, kfh0, vv, 10); FMAC_BC(t, w1, st[21], 5); st[21] = t; if (MODE == 2) FMAC_BC(y1, rrh0, t, 10);
    MUL_BC(t, bbl0, sa, 11); if (MODE != 0) FMAC_BC(t, kfl0, vv, 11); FMAC_BC(t, w1, st[22], 6); st[22] = t; if (MODE == 2) FMAC_BC(y0, rrl0, t, 11);
    MUL_BC(t, bbh0, sa, 11); if (MODE != 0) FMAC_BC(t, kfh0, vv, 11); FMAC_BC(t, w1, st[23], 7); st[23] = t; if (MODE == 2) FMAC_BC(y1, rrh0, t, 11);
    MUL_BC(t, bbl0, sa, 12); if (MODE != 0) FMAC_BC(t, kfl0, vv, 12); FMAC_BC(t, w1, st[24], 8); st[24] = t; if (MODE == 2) FMAC_BC(y0, rrl0, t, 12);
    MUL_BC(t, bbh0, sa, 12); if (MODE != 0) FMAC_BC(t, kfh0, vv, 12); FMAC_BC(t, w1, st[25], 9); st[25] = t; if (MODE == 2) FMAC_BC(y1, rrh0, t, 12);
    MUL_BC(t, bbl0, sa, 13); if (MODE != 0) FMAC_BC(t, kfl0, vv, 13); FMAC_BC(t, w1, st[26], 10); st[26] = t; if (MODE == 2) FMAC_BC(y0, rrl0, t, 13);
    MUL_BC(t, bbh0, sa, 13); if (MODE != 0) FMAC_BC(t, kfh0, vv, 13); FMAC_BC(t, w1, st[27], 11); st[27] = t; if (MODE == 2) FMAC_BC(y1, rrh0, t, 13);
    MUL_BC(t, bbl0, sa, 14); if (MODE != 0) FMAC_BC(t, kfl0, vv, 14); FMAC_BC(t, w1, st[28], 12); st[28] = t; if (MODE == 2) FMAC_BC(y0, rrl0, t, 14);
    MUL_BC(t, bbh0, sa, 14); if (MODE != 0) FMAC_BC(t, kfh0, vv, 14); FMAC_BC(t, w1, st[29], 13); st[29] = t; if (MODE == 2) FMAC_BC(y1, rrh0, t, 14);
    MUL_BC(t, bbl0, sa, 15); if (MODE != 0) FMAC_BC(t, kfl0, vv, 15); FMAC_BC(t, w1, st[30], 14); st[30] = t; if (MODE == 2) FMAC_BC(y0, rrl0, t, 15);
    MUL_BC(t, bbh0, sa, 15); if (MODE != 0) FMAC_BC(t, kfh0, vv, 15); FMAC_BC(t, w1, st[31], 15); st[31] = t; if (MODE == 2) FMAC_BC(y1, rrh0, t, 15);
    MUL_BC(t, bbl1, sa, 0); if (MODE != 0) FMAC_BC(t, kfl1, vv, 0); FMAC_BC(t, w2, st[32], 0); st[32] = t; if (MODE == 2) FMAC_BC(y0, rrl1, t, 0);
    MUL_BC(t, bbh1, sa, 0); if (MODE != 0) FMAC_BC(t, kfh1, vv, 0); FMAC_BC(t, w2, st[33], 1); st[33] = t; if (MODE == 2) FMAC_BC(y1, rrh1, t, 0);
    MUL_BC(t, bbl1, sa, 1); if (MODE != 0) FMAC_BC(t, kfl1, vv, 1); FMAC_BC(t, w2, st[34], 2); st[34] = t; if (MODE == 2) FMAC_BC(y0, rrl1, t, 1);
    MUL_BC(t, bbh1, sa, 1); if (MODE != 0) FMAC_BC(t, kfh1, vv, 1); FMAC_BC(t, w2, st[35], 3); st[35] = t; if (MODE == 2) FMAC_BC(y1, rrh1, t, 1);
    MUL_BC(t, bbl1, sa, 2); if (MODE != 0) FMAC_BC(t, kfl1, vv, 2); FMAC_BC(t, w2, st[36], 4); st[36] = t; if (MODE == 2) FMAC_BC(y0, rrl1, t, 2);
    MUL_BC(t, bbh1, sa, 2); if (MODE != 0) FMAC_BC(t, kfh1, vv, 2); FMAC_BC(t, w2, st[37], 5); st[37] = t; if (MODE == 2) FMAC_BC(y1, rrh1, t, 2);
    MUL_BC(t, bbl1, sa, 3); if (MODE != 0) FMAC_BC(t, kfl1, vv, 3); FMAC_BC(t, w2, st[38], 6); st[38] = t; if (MODE == 2) FMAC_BC(y0, rrl1, t, 3);
    MUL_BC(t, bbh1, sa, 3); if (MODE != 0) FMAC_BC(t, kfh1, vv, 3); FMAC_BC(t, w2, st[39], 7); st[39] = t; if (MODE == 2) FMAC_BC(y1, rrh1, t, 3);
    MUL_BC(t, bbl1, sa, 4); if (MODE != 0) FMAC_BC(t, kfl1, vv, 4); FMAC_BC(t, w2, st[40], 8); st[40] = t; if (MODE == 2) FMAC_BC(y0, rrl1, t, 4);
    MUL_BC(t, bbh1, sa, 4); if (MODE != 0) FMAC_BC(t, kfh1, vv, 4); FMAC_BC(t, w2, st[41], 9); st[41] = t; if (MODE == 2) FMAC_BC(y1, rrh1, t, 4);
    MUL_BC(t, bbl1, sa, 5); if (MODE != 0) FMAC_BC(t, kfl1, vv, 5); FMAC_BC(t, w2, st[42], 10); st[42] = t; if (MODE == 2) FMAC_BC(y0, rrl1, t, 5);
    MUL_BC(t, bbh1, sa, 5); if (MODE != 0) FMAC_BC(t, kfh1, vv, 5); FMAC_BC(t, w2, st[43], 11); st[43] = t; if (MODE == 2) FMAC_BC(y1, rrh1, t, 5);
    MUL_BC(t, bbl1, sa, 6); if (MODE != 0) FMAC_BC(t, kfl1, vv, 6); FMAC_BC(t, w2, st[44], 12); st[44] = t; if (MODE == 2) FMAC_BC(y0, rrl1, t, 6);
    MUL_BC(t, bbh1, sa, 6); if (MODE != 0) FMAC_BC(t, kfh1, vv, 6); FMAC_BC(t, w2, st[45], 13); st[45] = t; if (MODE == 2) FMAC_BC(y1, rrh1, t, 6);
    MUL_BC(t, bbl1, sa, 7); if (MODE != 0) FMAC_BC(t, kfl1, vv, 7); FMAC_BC(t, w2, st[46], 14); st[46] = t; if (MODE == 2) FMAC_BC(y0, rrl1, t, 7);
    MUL_BC(t, bbh1, sa, 7); if (MODE != 0) FMAC_BC(t, kfh1, vv, 7); FMAC_BC(t, w2, st[47], 15); st[47] = t; if (MODE == 2) FMAC_BC(y1, rrh1, t, 7);
    MUL_BC(t, bbl1, sa, 8); if (MODE != 0) FMAC_BC(t, kfl1, vv, 8); FMAC_BC(t, w3, st[48], 0); st[48] = t; if (MODE == 2) FMAC_BC(y0, rrl1, t, 8);
    MUL_BC(t, bbh1, sa, 8); if (MODE != 0) FMAC_BC(t, kfh1, vv, 8); FMAC_BC(t, w3, st[49], 1); st[49] = t; if (MODE == 2) FMAC_BC(y1, rrh1, t, 8);
    MUL_BC(t, bbl1, sa, 9); if (MODE != 0) FMAC_BC(t, kfl1, vv, 9); FMAC_BC(t, w3, st[50], 2); st[50] = t; if (MODE == 2) FMAC_BC(y0, rrl1, t, 9);
    MUL_BC(t, bbh1, sa, 9); if (MODE != 0) FMAC_BC(t, kfh1, vv, 9); FMAC_BC(t, w3, st[51], 3); st[51] = t; if (MODE == 2) FMAC_BC(y1, rrh1, t, 9);
    MUL_BC(t, bbl1, sa, 10); if (MODE != 0) FMAC_BC(t, kfl1, vv, 10); FMAC_BC(t, w3, st[52], 4); st[52] = t; if (MODE == 2) FMAC_BC(y0, rrl1, t, 10);
    MUL_BC(t, bbh1, sa, 10); if (MODE != 0) FMAC_BC(t, kfh1, vv, 10); FMAC_BC(t, w3, st[53], 5); st[53] = t; if (MODE == 2) FMAC_BC(y1, rrh1, t, 10);
    MUL_BC(t, bbl1, sa, 11); if (MODE != 0) FMAC_BC(t, kfl1, vv, 11); FMAC_BC(t, w3, st[54], 6); st[54] = t; if (MODE == 2) FMAC_BC(y0, rrl1, t, 11);
    MUL_BC(t, bbh1, sa, 11); if (MODE != 0) FMAC_BC(t, kfh1, vv, 11); FMAC_BC(t, w3, st[55], 7); st[55] = t; if (MODE == 2) FMAC_BC(y1, rrh1, t, 11);
    MUL_BC(t, bbl1, sa, 12); if (MODE != 0) FMAC_BC(t, kfl1, vv, 12); FMAC_BC(t, w3, st[56], 8); st[56] = t; if (MODE == 2) FMAC_BC(y0, rrl1, t, 12);
    MUL_BC(t, bbh1, sa, 12); if (MODE != 0) FMAC_BC(t, kfh1, vv, 12); FMAC_BC(t, w3, st[57], 9); st[57] = t; if (MODE == 2) FMAC_BC(y1, rrh1, t, 12);
    MUL_BC(t, bbl1, sa, 13); if (MODE != 0) FMAC_BC(t, kfl1, vv, 13); FMAC_BC(t, w3, st[58], 10); st[58] = t; if (MODE == 2) FMAC_BC(y0, rrl1, t, 13);
    MUL_BC(t, bbh1, sa, 13); if (MODE != 0) FMAC_BC(t, kfh1, vv, 13); FMAC_BC(t, w3, st[59], 11); st[59] = t; if (MODE == 2) FMAC_BC(y1, rrh1, t, 13);
    MUL_BC(t, bbl1, sa, 14); if (MODE != 0) FMAC_BC(t, kfl1, vv, 14); FMAC_BC(t, w3, st[60], 12); st[60] = t; if (MODE == 2) FMAC_BC(y0, rrl1, t, 14);
    MUL_BC(t, bbh1, sa, 14); if (MODE != 0) FMAC_BC(t, kfh1, vv, 14); FMAC_BC(t, w3, st[61], 13); st[61] = t; if (MODE == 2) FMAC_BC(y1, rrh1, t, 14);
    MUL_BC(t, bbl1, sa, 15); if (MODE != 0) FMAC_BC(t, kfl1, vv, 15); FMAC_BC(t, w3, st[62], 14); st[62] = t; if (MODE == 2) FMAC_BC(y0, rrl1, t, 15);
    MUL_BC(t, bbh1, sa, 15); if (MODE != 0) FMAC_BC(t, kfh1, vv, 15); FMAC_BC(t, w3, st[63], 15); st[63] = t; if (MODE == 2) FMAC_BC(y1, rrh1, t, 15);
    return y0 + y1;
}
__device__ __forceinline__ void rw_r1(const unsigned char* ws, const RwSet rs, float* P, float* G, int gw, int NGW, int lane) {
    for (int T = gw; T < NCH * 8 * 2; T += NGW) { const int kind = T & 1, h = (T >> 1) & 7, c = T >> 4; float st[64];
        int ln_ = lane; asm volatile("" : "+v"(ln_));
#pragma unroll
        for (int k = 0; k < 64; ++k) st[k] = (kind == 0 && k == ln_) ? 1.f : 0.f;
        const size_t o0 = (size_t)(c * LC) * 512 + h * 64; RwOps q[RW_PF];
#pragma unroll
        for (int d = 0; d < RW_PF; ++d) q[d] = rw_load<false>(ws, rs, o0 + (size_t)d * 512, ln_);
        for (int tb = 0; tb < LC; tb += RW_PF) {
#pragma unroll
            for (int d = 0; d < RW_PF; ++d) { const RwOps x = q[d]; if (tb + d + RW_PF < LC) q[d] = rw_load<false>(ws, rs, o0 + (size_t)(tb + d + RW_PF) * 512, ln_);
                if (kind == 0) (void)rw_step<0>(st, x); else (void)rw_step<1>(st, x); } }
        float* dst = (kind == 0 ? P : G) + ((size_t)(h * NCH + c) * 64 + ln_) * 64;
#pragma unroll
        for (int k = 0; k < 64; k += 4) *(f32x4*)(dst + k) = (f32x4){st[k], st[k + 1], st[k + 2], st[k + 3]}; }
}
__device__ __forceinline__ void rw_r2(const float* P, const float* G, float* S0, LAS unsigned char* lds, int lane, int wave, int bid) {
    LAS float* red = (LAS float*)lds;
    for (int rp = bid; rp < 256; rp += gridDim.x) { const int h = rp >> 5, v0 = (rp & 31) * 2; float s0 = 0.f, s1 = 0.f;
        const float* Ph = P + (size_t)h * NCH * 4096 + (size_t)(8 * wave) * 64 + lane; const float* Gh = G + (size_t)h * NCH * 4096 + (size_t)v0 * 64 + lane; float* Sh = S0 + (size_t)h * NCH * 4096 + (size_t)v0 * 64 + lane;
        float pq[8][8], gq[8][2];
#pragma unroll
        for (int d = 0; d < 8; ++d) {
#pragma unroll
            for (int jj = 0; jj < 8; ++jj) pq[d][jj] = Ph[(size_t)d * 4096 + jj * 64];
            gq[d][0] = Gh[(size_t)d * 4096]; gq[d][1] = Gh[(size_t)d * 4096 + 64]; }
        for (int c0 = 0; c0 < NCH; c0 += 8) {
#pragma unroll
            for (int d = 0; d < 8; ++d) { const int c = c0 + d;
                if (wave == 0) { Sh[(size_t)c * 4096] = s0; Sh[(size_t)c * 4096 + 64] = s1; }
                float p0 = 0.f, p1 = 0.f;
#pragma unroll
                for (int jj = 0; jj < 8; ++jj) { const float a0 = __builtin_bit_cast(float, __builtin_amdgcn_readlane(__builtin_bit_cast(int, s0), 8 * wave + jj)), a1 = __builtin_bit_cast(float, __builtin_amdgcn_readlane(__builtin_bit_cast(int, s1), 8 * wave + jj));
                    p0 += a0 * pq[d][jj]; p1 += a1 * pq[d][jj]; }
                LAS float* rd = red + (c & 1) * 1024;
                rd[(wave * 2 + 0) * 64 + lane] = p0; rd[(wave * 2 + 1) * 64 + lane] = p1;
                const float g0 = gq[d][0], g1 = gq[d][1];
                if (c + 8 < NCH) {
#pragma unroll
                    for (int jj = 0; jj < 8; ++jj) pq[d][jj] = Ph[(size_t)(c + 8) * 4096 + jj * 64];
                    gq[d][0] = Gh[(size_t)(c + 8) * 4096]; gq[d][1] = Gh[(size_t)(c + 8) * 4096 + 64]; }
                asm volatile("s_waitcnt lgkmcnt(0)\n\ts_barrier" ::: "memory");
                float n0 = g0, n1 = g1;
#pragma unroll
                for (int w = 0; w < 8; ++w) { n0 += rd[(w * 2 + 0) * 64 + lane]; n1 += rd[(w * 2 + 1) * 64 + lane]; }
                s0 = n0; s1 = n1; }
        }
        __syncthreads();
    }
}
__device__ __forceinline__ void rw_r3(CA a, int l, const unsigned char* ws, const RwSet rs, const float* S0, const float* BON, bf16* RWO, LAS unsigned char* lds, int gw, int NGW, int lane, int wave) {
    LAS float* yl = (LAS float*)(lds + wave * 16640);
    const float* gnw = a->in[26] + (size_t)l * 512; const float* gnb = a->in[27] + (size_t)l * 512;
    const bf16* Vb = (const bf16*)(ws + WS_RW_V); const bf16* GB = (const bf16*)(ws + WS_GB);
    for (int T = gw; T < NCH * 8; T += NGW) { const int h = T & 7, c = T >> 3; float st[64];
        const float* src = S0 + ((size_t)(h * NCH + c) * 64 + lane) * 64;
#pragma unroll
        for (int k = 0; k < 64; k += 4) { const f32x4 v4 = *(const f32x4*)(src + k); st[k] = v4.x; st[k + 1] = v4.y; st[k + 2] = v4.z; st[k + 3] = v4.w; }
        {   const size_t o0 = (size_t)(c * LC) * 512 + h * 64; RwOps q[RW_PF];
#pragma unroll
            for (int d = 0; d < RW_PF; ++d) q[d] = rw_load<true>(ws, rs, o0 + (size_t)d * 512, lane);
            for (int tb = 0; tb < LC; tb += RW_PF) {
#pragma unroll
                for (int d = 0; d < RW_PF; ++d) { const RwOps x = q[d]; if (tb + d + RW_PF < LC) q[d] = rw_load<true>(ws, rs, o0 + (size_t)(tb + d + RW_PF) * 512, lane); yl[(tb + d) * 65 + lane] = rw_step<2>(st, x); } } }
        LDS_WAIT(); asm volatile("" ::: "memory");
        {
            const int t = c * LC + lane; float y[64]; float s = 0.f;
#pragma unroll
            for (int v = 0; v < 64; ++v) { y[v] = yl[lane * 65 + v]; s += y[v]; }
            const float mean = s * (1.f / 64.f); float q = 0.f;
#pragma unroll
            for (int v = 0; v < 64; ++v) { const float d = y[v] - mean; q += d * d; }
            const float rstd = 1.f / sqrtf(q * (1.f / 64.f) + GN_EPS); const float bon = BON[t * 8 + h];
            const size_t o = (size_t)t * 512 + h * 64;
#pragma unroll
            for (int v8 = 0; v8 < 64; v8 += 8) { const v4u vv = *(const v4u*)(Vb + o + v8), gg = *(const v4u*)(GB + o + v8); float ov[8];
#pragma unroll
                for (int q2 = 0; q2 < 4; ++q2) { const int v = v8 + 2 * q2;
                    ov[2 * q2] = ((y[v] - mean) * rstd * gnw[h * 64 + v] + gnb[h * 64 + v] + bon * bflo(vv[q2])) * bflo(gg[q2]);
                    ov[2 * q2 + 1] = ((y[v + 1] - mean) * rstd * gnw[h * 64 + v + 1] + gnb[h * 64 + v + 1] + bon * bfhi(vv[q2])) * bfhi(gg[q2]); }
                v4u w; w.x = pk2(ov[0], ov[1]); w.y = pk2(ov[2], ov[3]); w.z = pk2(ov[4], ov[5]); w.w = pk2(ov[6], ov[7]); *(v4u*)(RWO + o + v8) = w; }
        }
        LDS_WAIT(); asm volatile("" ::: "memory");
    }
}

#define XB_TMO      128
#define XB_XCNT(j)  (256  + 64 * (j))
#define XB_XSUB(j)  (1280 + 64 * (j))
#define XB_XGEN(j)  (2304 + 64 * (j))
#define XB_TOP      3328
#define XB_TOPGEN   3392
#define XCD_BAR_WORDS 3456
#define XB_SPIN_CAP (1u << 18)

__device__ __forceinline__ unsigned xb_ld(unsigned* p)              { return __hip_atomic_load(p, __ATOMIC_RELAXED, __HIP_MEMORY_SCOPE_AGENT); }
__device__ __forceinline__ unsigned xb_add(unsigned* p, unsigned v) { return __hip_atomic_fetch_add(p, v, __ATOMIC_RELAXED, __HIP_MEMORY_SCOPE_AGENT); }
__device__ __forceinline__ unsigned xb_xcc_id() { return (unsigned)__builtin_amdgcn_s_getreg((3 << 11) | 20) & 0xFu; }
#define XB_SPIN(cond, bar) do { unsigned _sp = 0; while (cond) { __builtin_amdgcn_s_sleep(1); \
    if ((++_sp & 255u) == 0u) { if (xb_ld(&(bar)[XB_TMO])) break; if (_sp > XB_SPIN_CAP) { atomicAdd(&(bar)[XB_TMO], 1u); break; } } } } while (0)

struct XcdBarrier {
    unsigned* bar; unsigned x;
    volatile LAS unsigned* st;
};

__device__ __forceinline__ XcdBarrier xcd_barrier_post(unsigned* bar, volatile LAS unsigned* st, unsigned xb_tid) {
    XcdBarrier b; b.bar = bar; b.x = xb_xcc_id(); b.st = st;
    if (xb_tid == 0) (void)xb_add(&bar[XB_XCNT(b.x)], 1u);
    return b;
}
__device__ __forceinline__ void xcd_barrier_complete(unsigned* bar, unsigned x, unsigned& nloc, unsigned& nx) {
    const unsigned G = gridDim.x * gridDim.y * gridDim.z;
    unsigned sum, cnt, mine, sp = 0u;
    for (;;) {
        sum = 0u; cnt = 0u; mine = 0u;
#pragma unroll
        for (unsigned j = 0; j < 16; ++j) { const unsigned c = xb_ld(&bar[XB_XCNT(j)]); sum += c; cnt += (c > 0u) ? 1u : 0u; mine = (j == x) ? c : mine; }
        if (sum == G) break;
        __builtin_amdgcn_s_sleep(1);
        if ((++sp & 255u) == 0u) { if (xb_ld(&bar[XB_TMO])) break; if (sp > XB_SPIN_CAP) { atomicAdd(&bar[XB_TMO], 1u); break; } }
    }
    nloc = mine > 0u ? mine : 1u; nx = cnt > 0u ? cnt : 1u;
}

__device__ __forceinline__ void xcd_barrier(const XcdBarrier& b, unsigned xb_tid) {
    asm volatile("s_waitcnt vmcnt(0)" ::: "memory");
    __syncthreads();
    if (xb_tid == 0) {
        unsigned* bar = b.bar;
        __builtin_amdgcn_s_waitcnt(0);
        unsigned nloc = b.st[0], nx = b.st[1];
        if (nloc == 0u) { xcd_barrier_complete(bar, b.x, nloc, nx); b.st[0] = nloc; b.st[1] = nx; }
        const unsigned old = xb_add(&bar[XB_XSUB(b.x)], 1u);
        const unsigned gen = old / nloc;
        if (old + 1u == (gen + 1u) * nloc) {
            __builtin_amdgcn_fence(__ATOMIC_RELEASE, "agent");
            asm volatile("s_waitcnt vmcnt(0)" ::: "memory");
            const unsigned og = xb_add(&bar[XB_TOP], 1u);
            const unsigned tg = og / nx;
            if (og + 1u == (tg + 1u) * nx) xb_add(&bar[XB_TOPGEN], 1u);
            else XB_SPIN(xb_ld(&bar[XB_TOPGEN]) == tg, bar);
            __builtin_amdgcn_fence(__ATOMIC_ACQUIRE, "agent");
            xb_add(&bar[XB_XGEN(b.x)], 1u);
            asm volatile("s_waitcnt vmcnt(0)" ::: "memory");
        } else {
            XB_SPIN(xb_ld(&bar[XB_XGEN(b.x)]) == gen, bar);
            __builtin_amdgcn_fence(__ATOMIC_ACQUIRE, "agent");
            asm volatile("s_waitcnt vmcnt(0)" ::: "memory");
        }
    }
    __syncthreads();
}

__device__ __forceinline__ unsigned char* args_ws_ptr() { CA a = (CA)__builtin_amdgcn_kernarg_segment_ptr(); return a->ws; }
__global__ void __launch_bounds__(NTHR, 2) fwd_mega(Args args_unused) {
    extern __shared__ __attribute__((aligned(16))) unsigned char lds_raw[];
    LAS unsigned char* lds = (LAS unsigned char*)lds_raw;
    cg::grid_group grid = cg::this_grid();
    const int G = gridDim.x, NGW = G * NWAVES, NGT = G * NTHR;
    const int wave_s = __builtin_amdgcn_readfirstlane((int)threadIdx.x >> 6);
#define FRESH_LANE() ({ unsigned m_ = ~0u; asm volatile("" : "+s"(m_)); (int)__builtin_amdgcn_mbcnt_hi(m_, __builtin_amdgcn_mbcnt_lo(m_, 0u)); })
#define CUR_TID() (wave_s * 64 + FRESH_LANE())
    if (CUR_TID() < 16) ((LAS unsigned*)(lds + MISC_OFF))[CUR_TID()] = 0u;
    __syncthreads();
    (void)xcd_barrier_post((unsigned*)args_ws_ptr(), (volatile LAS unsigned*)(lds + MISC_OFF), (unsigned)CUR_TID());
#define SYNC() do { XcdBarrier b_; { CA a_ = (CA)__builtin_amdgcn_kernarg_segment_ptr(); asm volatile("" : "+s"(a_)); b_.bar = (unsigned*)a_->ws; } b_.x = xb_xcc_id(); b_.st = (volatile LAS unsigned*)(lds + MISC_OFF); xcd_barrier(b_, (unsigned)CUR_TID()); } while (0)
#define PH_BEGIN { CA a = (CA)__builtin_amdgcn_kernarg_segment_ptr(); asm volatile("" : "+s"(a)); unsigned char* ws = a->ws; (void)ws; \
        int lane_l = FRESH_LANE(); asm volatile("" : "+v"(lane_l)); int bid_l = blockIdx.x; asm volatile("" : "+s"(bid_l)); int wave_l = wave_s; asm volatile("" : "+s"(wave_l)); \
        const int lane = lane_l, wave = wave_l, tid = wave * 64 + lane, bid = bid_l, gw = bid * NWAVES + wave, gtid = bid * NTHR + tid; (void)lane; (void)gtid; (void)gw; (void)wave;
#define PH_END }
#define WSP(T, off) ((T*)(ws + (off)))
#define ADA_L (WSP(float, WS_ADA) + l * 9216)
#define GEMM(EPI, Aptr, LDA, Bptr, N_, K_, ...) do { int kk_ = (K_); asm volatile("" : "+s"(kk_));   pg8::Gemm g_{(const pg8::bf16_t*)(Aptr), (const pg8::bf16_t*)(Bptr), M, (N_), kk_, (LDA)}; pg8::StaticOrder S_; S_.init(M, (N_), G, bid); \
        EPI E_{__VA_ARGS__}; pg8::gemm_phase<EPI, pg8::StaticOrder, PG8_ALIGN, PG8_SP2>(lds, g_, S_, E_, tid); } while (0)

    PH_BEGIN ada_phase(a, lds, tid, lane, wave, bid); PH_END
    grid.sync();
    PH_BEGIN mod_phase(a->in[0], WSP(bf16, WS_HB), WSP(float, WS_ADA), WSP(float, WS_ADA) + D, gw, NGW, lane); convert_layer(a, 0, lds, gw, NGW, wave, lane); PH_END
    SYNC();

    for (int l = 0; l < NL; ++l) {
        PH_BEGIN GEMM(EpiSwiGLU, WSP(bf16, WS_HB), D, ws + W_UP0, 2 * DFF, D, WSP(bf16, WS_ACT), DFF); PH_END
        SYNC();
        PH_BEGIN GEMM(EpiGateF32, WSP(bf16, WS_ACT), DFF, ws + W_DN0, D, DFF, WSP(float, WS_Y), ADA_L + 2 * D, 0.5f); PH_END
        SYNC();
        PH_BEGIN ln_phase(l == 0 ? a->in[0] : a->out, WSP(float, WS_Y), a->out, WSP(bf16, WS_HB), a->in[4] + (size_t)l * 3 * D, a->in[5] + (size_t)l * 3 * D, ADA_L + 3 * D, ADA_L + 4 * D, true, gw, NGW, lane); PH_END
        SYNC();
        PH_BEGIN GEMM(EpiIn, WSP(bf16, WS_HB), D, ws + W_IN, ZP, D, WSP(bf16, WS_Z)); PH_END
        SYNC();
        PH_BEGIN if (bid < 8) fscan_head(WSP(bf16, WS_Z), a->in[9] + l * 8, WSP(float, WS_FL2), bid, lds, tid, lane, wave); PH_END
        PH_BEGIN codes_phase(WSP(bf16, WS_Z), a->in[17] + (size_t)l * 1792, WSP(bf16, WS_CODES), gtid, NGT); PH_END
        PH_BEGIN lru_l1(a, l, WSP(bf16, WS_Z), WSP(bf16, WS_HLOC), WSP(bf16, WS_ACUM), WSP(float, WS_LAEND), WSP(float, WS_LHEND), lds, tid, lane, wave, bid); PH_END
        SYNC();
        PH_BEGIN GEMM(EpiPlain, ws + WS_CODES, 256, ws + W_LORA, 1536, 256, WSP(bf16, WS_LORA), 1536); PH_END
        PH_BEGIN lru_l2(WSP(const float, WS_LAEND), WSP(const float, WS_LHEND), WSP(float, WS_LCAR), gw, lane); PH_END
        SYNC();
        PH_BEGIN const RwSet rs = rw_set(l); rw_prep(a, l, WSP(bf16, WS_Z), WSP(const bf16, WS_LORA), WSP(float, rs.w), WSP(bf16, rs.r), WSP(bf16, rs.kf), WSP(bf16, WS_RW_V), WSP(bf16, rs.kk), WSP(bf16, rs.b), WSP(bf16, WS_GB), WSP(float, WS_BON), gw, NGW, lane); PH_END
        PH_BEGIN lru_l3(WSP(bf16, WS_Z), WSP(const bf16, WS_HLOC), WSP(const bf16, WS_ACUM), WSP(const float, WS_LCAR), gtid, NGT); PH_END
        SYNC();
        PH_BEGIN rw_r1(ws, rw_set(l), WSP(float, WS_P), WSP(float, WS_G), gw, NGW, lane); PH_END
        SYNC();
        PH_BEGIN rw_r2(WSP(const float, WS_P), WSP(const float, WS_G), WSP(float, WS_S0), lds, lane, wave, bid); PH_END
        SYNC();
        PH_BEGIN rw_r3(a, l, ws, rw_set(l), WSP(const float, WS_S0), WSP(const float, WS_BON), WSP(bf16, WS_RWO), lds, gw, NGW, lane, wave); PH_END
        __syncthreads();
        PH_BEGIN
            bf16* Zb = WSP(bf16, WS_Z);
            const attn_body::AttnTensors AT{(const attn_body::bf16*)(Zb + ZQ), (const attn_body::bf16*)(Zb + ZK), (const attn_body::bf16*)(Zb + ZV), (attn_body::bf16*)(Zb + ZXB), WSP(const float, WS_FL2)};
            const attn_body::StaticOrder S((int)G, bid);
            attn_body::attn_phase<attn_body::StaticOrder>((char*)lds_raw, AT, S, tid);
        PH_END
        SYNC();
        PH_BEGIN GEMM(EpiProj<0>, WSP(bf16, WS_Z) + ZXB, ZP, ws + W_PA, D, 512, WSP(float, WS_Y), WSP(bf16, WS_Z), WSP(bf16, WS_HB)); PH_END
        __builtin_amdgcn_fence(__ATOMIC_SEQ_CST, "agent");
        PH_BEGIN GEMM(EpiProj<1>, WSP(bf16, WS_Z) + ZYB, ZP, ws + W_PB, D, D, WSP(float, WS_Y), WSP(bf16, WS_Z), WSP(bf16, WS_HB)); PH_END
        __builtin_amdgcn_fence(__ATOMIC_SEQ_CST, "agent");
        PH_BEGIN GEMM(EpiProj<2>, ws + WS_RWO, 512, ws + W_PC, D, 512, WSP(float, WS_Y), WSP(bf16, WS_Z), WSP(bf16, WS_HB)); PH_END
        SYNC();
        PH_BEGIN GEMM(EpiGateF32, WSP(bf16, WS_HB), D, ws + W_OUT, D, D, WSP(float, WS_Y), ADA_L + 5 * D, 1.0f); PH_END
        SYNC();
        PH_BEGIN ln_phase(a->out, WSP(float, WS_Y), a->out, WSP(bf16, WS_HB), a->in[4] + (size_t)(l * 3 + 1) * D, a->in[5] + (size_t)(l * 3 + 1) * D, ADA_L + 6 * D, ADA_L + 7 * D, true, gw, NGW, lane); PH_END
        SYNC();
        PH_BEGIN GEMM(EpiSwiGLU, WSP(bf16, WS_HB), D, ws + W_UP1, 2 * DFF, D, WSP(bf16, WS_ACT), DFF); PH_END
        SYNC();
        PH_BEGIN GEMM(EpiGateF32, WSP(bf16, WS_ACT), DFF, ws + W_DN1, D, DFF, WSP(float, WS_Y), ADA_L + 8 * D, 0.5f); PH_END
        SYNC();
        PH_BEGIN ln_phase(a->out, WSP(float, WS_Y), a->out, WSP(bf16, WS_HB), a->in[4] + (size_t)(l * 3 + 2) * D, a->in[5] + (size_t)(l * 3 + 2) * D, ADA_L + 9216, ADA_L + 9216 + D, l + 1 < NL, gw, NGW, lane); PH_END
        if (l + 1 < NL) { PH_BEGIN convert_layer(a, l + 1, lds, gw, NGW, wave, lane); PH_END SYNC(); }
    }
#undef SYNC
#undef GEMM
}

extern "C" void kernel_launch(void* const* d_in, const int* in_sizes, int n_in, void* d_out, int out_size, void* d_ws, size_t ws_size, hipStream_t stream) {
    static int grid = 0;
    if (grid == 0) {
        if (n_in != 32 || out_size != M * D || ws_size < WS_END) { fprintf(stderr, "kernel_launch: unexpected shapes (n_in %d, out %d, ws %zu)\n", n_in, out_size, ws_size); grid = -1; return; }
        int dev = 0, cus = 0, per_cu = 0;
        hipGetDevice(&dev); hipDeviceGetAttribute(&cus, hipDeviceAttributeMultiprocessorCount, dev);
        hipFuncSetAttribute((const void*)fwd_mega, hipFuncAttributeMaxDynamicSharedMemorySize, LDS_BYTES);
        if (hipOccupancyMaxActiveBlocksPerMultiprocessor(&per_cu, (const void*)fwd_mega, NTHR, LDS_BYTES) != hipSuccess || per_cu < 1) { fprintf(stderr, "kernel_launch: occupancy query says %d blocks per CU\n", per_cu); per_cu = 1; }
        (void)hipGetLastError();
        grid = cus * per_cu;
        fprintf(stderr, "kernel_launch: grid %d (cus %d x %d), lds %d\n", grid, cus, per_cu, LDS_BYTES);
    }
    if (grid < 0) return;
    Args a{};
    for (int i = 0; i < 32; ++i) a.in[i] = (const float*)d_in[i];
    a.out = (float*)d_out; a.ws = (unsigned char*)d_ws;
    if (hipMemsetAsync(d_ws, 0, CTL_ZERO_BYTES, stream) != hipSuccess) { fprintf(stderr, "kernel_launch: memset of the barrier words failed\n"); return; }
    void* kargs[] = {&a};
    hipError_t e = hipLaunchCooperativeKernel((const void*)fwd_mega, dim3(grid), dim3(NTHR), kargs, LDS_BYTES, stream);
    if (e != hipSuccess) fprintf(stderr, "kernel_launch: cooperative launch failed: %s (grid %d)\n", hipGetErrorString(e), grid);
}
```

```cpp
#include <hip/hip_runtime.h>
#include <hip/hip_cooperative_groups.h>
#include <cstdio>
#include <cstdint>
namespace cg = cooperative_groups;
namespace pg8 {
#define PG8_LAS __attribute__((address_space(3)))
typedef unsigned short bf16_t;
typedef short bf16x8 __attribute__((ext_vector_type(8)));
typedef float f32x4 __attribute__((ext_vector_type(4)));
typedef unsigned u32x4 __attribute__((ext_vector_type(4)));
constexpr int BM = 256, BK = 64, HALF = 128, HTB = HALF * BK * 2  , STAGE_BYTES = 8 * HTB, NXCD = 8, WGM = 8;

__host__ __device__ __forceinline__ int lds_byte(int r, int c) { const int st = (r >> 4) * 2 + (c >> 5), rr = r & 15, cc = c & 31, ob = rr * 64 + cc * 2; return st * 1024 + (ob ^ (((ob >> 9) & 1) << 5)); }
__host__ __device__ __forceinline__ void stage_rc(int b, int& R, int& C) { const int st = b / 1024, sb = b % 1024, swz = sb ^ (((sb >> 9) & 1) << 5); R = (st >> 1) * 16 + swz / 64; C = (st & 1) * 32 + (swz % 64) / 2; }
__host__ __device__ __forceinline__ int perm32(int rho) { const int n = rho >> 4, i = rho & 15; return 8 * (i >> 2) + 4 * n + (i & 3); }

struct Unit { int pm, pn; };
struct Gemm { const bf16_t* A; const bf16_t* Bt; int M, N, K, lda; };

struct StaticOrder {
    int nM, nN, nwg, G, c;
    __host__ __device__ void init(int M, int N, int G_, int c_) { nM = M / BM; nN = N / BM; nwg = nM * nN; G = G_; c = c_; }
    __host__ __device__ bool next(int i, Unit& u) const {
        const long L = (long)i * G + c; if (L >= nwg) return false;
        int wgid = (int)L; { const int q = nwg / NXCD, r = nwg % NXCD, xcd = wgid % NXCD, off = wgid / NXCD; wgid = (xcd < r ? xcd * (q + 1) : r * (q + 1) + (xcd - r) * q) + off; }
        const int nig = WGM * nN, gid = wgid / nig, fm = gid * WGM, gsz = (nM - fm) < WGM ? (nM - fm) : WGM;
        u.pm = fm + ((wgid % nig) % gsz); u.pn = (wgid % nig) / gsz; return true;
    }
    __device__ __forceinline__ void a_ready(const Unit&) const {}
    __device__ __forceinline__ void done(const Unit&) const {}
};

__device__ __forceinline__ unsigned cvt_pk_bf16(float lo, float hi) { unsigned r; asm volatile("v_cvt_pk_bf16_f32 %0, %1, %2" : "=v"(r) : "v"(lo), "v"(hi)); return r; }
typedef float f32x2 __attribute__((ext_vector_type(2)));
__device__ __forceinline__ f32x2 gelu_pk(f32x2 v) {
    const f32x2 av = __builtin_elementwise_abs(v), d = av * 0.2316418882f + 1.0f;
    f32x2 t; t.x = __builtin_amdgcn_rcpf(d.x); t.y = __builtin_amdgcn_rcpf(d.y);
    f32x2 q = t * 0.5307027145f + (-0.7265760135f); q = q * t + 0.7107068705f; q = q * t + (-0.142248368f); q = q * t + 0.127414796f; q = q * t;
    const f32x2 s = (v * v) * (-0.72134752044f);
    f32x2 e; e.x = __builtin_amdgcn_exp2f(s.x); e.y = __builtin_amdgcn_exp2f(s.y);
    const f32x2 m = v * (q * e), r = v - m;
    f32x2 o; o.x = v.x < 0.f ? m.x : r.x; o.y = v.y < 0.f ? m.y : r.y; return o;
}

template <int ACT  > struct EpiBf16 {
    static constexpr bool PERM = true, AFTER_DRAIN = false; static_assert(ACT == 0 || ACT == 1, "EpiBf16: ACT is 0 (none) or 1 (gelu_pk)");
    bf16_t* O; int ldc; const float* bias; int split_cols; size_t split_stride; float scale0;
    __device__ __forceinline__ void operator()(const f32x4 (&acc)[2][2][4][2], const Unit& u, int wr, int wc, int fr, int fq) const {
        const int row0 = u.pm * BM + wr * 64 + fr; int colt = u.pn * BM; bf16_t* base = O;
        float sc = 1.f; if (split_cols) { const int t = colt / split_cols; base += (size_t)t * split_stride; colt -= t * split_cols; if (t == 0) sc = scale0; }
        const int col0 = colt + wc * 32 + 8 * fq, bcol0 = u.pn * BM + wc * 32 + 8 * fq;
        f32x4 bv[2][2];
#pragma unroll
        for (int bj = 0; bj < 2; ++bj)
#pragma unroll
            for (int n = 0; n < 2; ++n) bv[bj][n] = bias ? *(const f32x4*)(bias + bcol0 + bj * HALF + 4 * n) : (f32x4){0.f, 0.f, 0.f, 0.f};
#pragma unroll
        for (int ai = 0; ai < 2; ++ai)
#pragma unroll
            for (int m = 0; m < 4; ++m) { bf16_t* rowp = base + (size_t)(row0 + ai * HALF + m * 16) * ldc + col0;
#pragma unroll
                for (int bj = 0; bj < 2; ++bj) { f32x4 v0 = acc[ai][bj][m][0] + bv[bj][0], v1 = acc[ai][bj][m][1] + bv[bj][1];
                    if (ACT == 1) { f32x2 a = gelu_pk((f32x2){v0[0], v0[1]}), b = gelu_pk((f32x2){v0[2], v0[3]}), c = gelu_pk((f32x2){v1[0], v1[1]}), d = gelu_pk((f32x2){v1[2], v1[3]});
                        v0 = (f32x4){a.x, a.y, b.x, b.y}; v1 = (f32x4){c.x, c.y, d.x, d.y}; }
                    v0 = v0 * sc; v1 = v1 * sc; u32x4 w; w.x = cvt_pk_bf16(v0[0], v0[1]); w.y = cvt_pk_bf16(v0[2], v0[3]); w.z = cvt_pk_bf16(v1[0], v1[1]); w.w = cvt_pk_bf16(v1[2], v1[3]);
                    *(u32x4*)(rowp + bj * HALF) = w; } }
    }
};

struct PanelStats {
    unsigned* xbuf;
    unsigned* cnt;
    unsigned* tmo;
    int ntn; float eps;
    unsigned code;
    __device__ __forceinline__ bool run(const f32x4 (&v)[2][2][4][2], const Unit& u, int wr, int wc, int fr, int fq, PG8_LAS unsigned char* lds, int wid, int lane) const {
        typedef float f32x2v __attribute__((ext_vector_type(2)));
        PG8_LAS f32x2v* P = (PG8_LAS f32x2v*)lds;
        PG8_LAS f32x2v* S = (PG8_LAS f32x2v*)(lds + 8192);
        PG8_LAS unsigned* flag = (PG8_LAS unsigned*)(lds + 8192 + 2048);
#pragma unroll
        for (int ai = 0; ai < 2; ++ai)
#pragma unroll
            for (int m = 0; m < 4; ++m) {
                float s = 0.f;
#pragma unroll
                for (int bj = 0; bj < 2; ++bj)
#pragma unroll
                    for (int n = 0; n < 2; ++n) { const f32x4 x = v[ai][bj][m][n]; s += (x[0] + x[1]) + (x[2] + x[3]); }
                s += __shfl_xor(s, 16); s += __shfl_xor(s, 32);
                const float mw = s * (1.0f / 64.0f); float q = 0.f;
#pragma unroll
                for (int bj = 0; bj < 2; ++bj)
#pragma unroll
                    for (int n = 0; n < 2; ++n) { const f32x4 d = v[ai][bj][m][n] - mw; q += (d[0] * d[0] + d[1] * d[1]) + (d[2] * d[2] + d[3] * d[3]); }
                q += __shfl_xor(q, 16); q += __shfl_xor(q, 32);
                if (fq == 0) P[(ai * HALF + wr * 64 + m * 16 + fr) * 4 + wc] = (f32x2v){mw, q};
            }
        asm volatile("s_waitcnt lgkmcnt(0)" ::: "memory"); __builtin_amdgcn_s_barrier(); asm volatile("" ::: "memory");
#if defined(BROKEN_EXCHANGE_NO_WAIT)
#warning BROKEN CONTROL BUILD: the row-statistics exchange does not wait; results are wrong by design
        if (blockIdx.x >= 64) { const long long t0_ = clock64(); while (clock64() - t0_ < 60000) __builtin_amdgcn_s_sleep(8); }
#endif
        const int row = wid * 32 + (lane & 31);
        if (lane < 32) {
            const f32x2v a = P[row * 4 + 0], b = P[row * 4 + 1], c = P[row * 4 + 2], d = P[row * 4 + 3];
            const float mt = (a.x + b.x + c.x + d.x) * 0.25f;
            const float da = a.x - mt, db = b.x - mt, dc = c.x - mt, dd = d.x - mt;
            const float m2 = (a.y + b.y) + (c.y + d.y) + 64.0f * ((da * da + db * db) + (dc * dc + dd * dd));
            unsigned long long* slot = (unsigned long long*)xbuf + ((size_t)(u.pm * BM + row) * 4 + u.pn);
            __hip_atomic_store(slot, ((unsigned long long)__float_as_uint(m2) << 32) | __float_as_uint(mt), __ATOMIC_RELAXED, __HIP_MEMORY_SCOPE_AGENT);
        }
        asm volatile("s_waitcnt vmcnt(0)" ::: "memory");
        if (lane == 0) __hip_atomic_fetch_add(cnt + 64 * u.pm, 1u, __ATOMIC_RELAXED, __HIP_MEMORY_SCOPE_AGENT);
        if (wid == 0) {
            bool dead = false; const unsigned long long t0 = __builtin_amdgcn_s_memrealtime(); const unsigned want = 8u * (unsigned)ntn;
            for (;;) {
#if defined(BROKEN_EXCHANGE_NO_WAIT)
                break;
#endif
                if ((unsigned)__builtin_amdgcn_readfirstlane(__hip_atomic_load(cnt + 64 * u.pm, __ATOMIC_RELAXED, __HIP_MEMORY_SCOPE_AGENT)) >= want) break;
                if (__builtin_amdgcn_s_memrealtime() - t0 > 2000000ull) {
                    if (lane == 0) { unsigned expect = 0u; __hip_atomic_compare_exchange_strong(tmo + 1, &expect, code | (unsigned)(u.pm & 0xff), __ATOMIC_RELAXED, __ATOMIC_RELAXED, __HIP_MEMORY_SCOPE_AGENT);
                                     __hip_atomic_store(tmo, 1u, __ATOMIC_RELAXED, __HIP_MEMORY_SCOPE_AGENT); }
                    dead = true; break; }
                __builtin_amdgcn_s_sleep(2);
            }
            __builtin_amdgcn_fence(__ATOMIC_ACQUIRE, "agent");
            if (lane == 0) flag[0] = dead ? 1u : 0u;
        }
        asm volatile("s_waitcnt vmcnt(0) lgkmcnt(0)" ::: "memory"); __builtin_amdgcn_s_barrier(); asm volatile("" ::: "memory");
        const bool bad = flag[0] != 0u;
        if (lane < 32) {
            const unsigned long long* slot = (const unsigned long long*)xbuf + (size_t)(u.pm * BM + row) * 4; float mt[4], m2[4]; float ms = 0.f;
#pragma unroll
            for (int t = 0; t < 4; ++t) { if (t < ntn) { const unsigned long long w = __hip_atomic_load(slot + t, __ATOMIC_RELAXED, __HIP_MEMORY_SCOPE_AGENT); mt[t] = __uint_as_float((unsigned)w); m2[t] = __uint_as_float((unsigned)(w >> 32)); } else { mt[t] = 0.f; m2[t] = 0.f; } ms += mt[t]; }
            const float mean = ms / (float)ntn; float q = 0.f;
#pragma unroll
            for (int t = 0; t < 4; ++t) if (t < ntn) { const float dm = mt[t] - mean; q += m2[t] + 256.0f * dm * dm; }
            S[row] = (f32x2v){mean, 1.0f / sqrtf(q / (256.0f * (float)ntn) + eps)};
        }
        asm volatile("s_waitcnt lgkmcnt(0)" ::: "memory"); __builtin_amdgcn_s_barrier(); asm volatile("" ::: "memory");
        return bad;
    }
};
struct EpiLnRes {
    static constexpr bool PERM = false, AFTER_DRAIN = true;
    const float* base; float* out; int ldc; const float* bias; PanelStats st; unsigned poison;
    __device__ __forceinline__ void fused(f32x4 (&acc)[2][2][4][2], const Unit& u, int wr, int wc, int fr, int fq, PG8_LAS unsigned char* lds, int wid, int lane) const {
        typedef float f32x2v __attribute__((ext_vector_type(2)));
        const PG8_LAS f32x2v* S = (const PG8_LAS f32x2v*)(lds + 8192);
        const int col0 = u.pn * BM + wc * 32 + 4 * fq;
#pragma unroll
        for (int bj = 0; bj < 2; ++bj)
#pragma unroll
            for (int n = 0; n < 2; ++n) { const f32x4 bv = bias ? *(const f32x4*)(bias + col0 + bj * HALF + n * 16) : (f32x4){0.f, 0.f, 0.f, 0.f};
#pragma unroll
                for (int ai = 0; ai < 2; ++ai)
#pragma unroll
                    for (int m = 0; m < 4; ++m) acc[ai][bj][m][n] += bv; }
        f32x4 pre[4][2][2];
#pragma unroll
        for (int m = 0; m < 4; ++m) { const size_t off = (size_t)(u.pm * BM + wr * 64 + m * 16 + fr) * ldc + col0;
#pragma unroll
            for (int bj = 0; bj < 2; ++bj)
#pragma unroll
                for (int n = 0; n < 2; ++n) pre[m][bj][n] = *(const f32x4*)(base + off + bj * HALF + n * 16); }
        const bool bad = st.run(acc, u, wr, wc, fr, fq, lds, wid, lane) || poison != 0u;
        const float qnan = __builtin_nanf("");
#pragma unroll
        for (int ai = 0; ai < 2; ++ai)
#pragma unroll
            for (int m = 0; m < 4; ++m) { const int r = ai * HALF + wr * 64 + m * 16 + fr; const f32x2v sr = S[r]; const size_t off = (size_t)(u.pm * BM + r) * ldc + col0;
#pragma unroll
                for (int bj = 0; bj < 2; ++bj)
#pragma unroll
                    for (int n = 0; n < 2; ++n) { const f32x4 bs = ai == 0 ? pre[m][bj][n] : *(const f32x4*)(base + off + bj * HALF + n * 16); f32x4 o = bs + (acc[ai][bj][m][n] - sr.x) * sr.y;
                        if (bad) o = (f32x4){qnan, qnan, qnan, qnan}; *(f32x4*)(out + off + bj * HALF + n * 16) = o; }
                if (m & 1) asm volatile("" ::: "memory"); }
    }
};
struct EpiLnResLn {
    static constexpr bool PERM = false, AFTER_DRAIN = true;
    const float* base; float* out; bf16_t* xn; int ldc; const float* bias; PanelStats st1, st2; unsigned poison;
    __device__ __forceinline__ void fused(f32x4 (&acc)[2][2][4][2], const Unit& u, int wr, int wc, int fr, int fq, PG8_LAS unsigned char* lds, int wid, int lane) const {
        typedef float f32x2v __attribute__((ext_vector_type(2))); typedef unsigned u32x2v __attribute__((ext_vector_type(2)));
        const PG8_LAS f32x2v* S = (const PG8_LAS f32x2v*)(lds + 8192);
        const int col0 = u.pn * BM + wc * 32 + 4 * fq;
#pragma unroll
        for (int bj = 0; bj < 2; ++bj)
#pragma unroll
            for (int n = 0; n < 2; ++n) { const f32x4 bv = bias ? *(const f32x4*)(bias + col0 + bj * HALF + n * 16) : (f32x4){0.f, 0.f, 0.f, 0.f};
#pragma unroll
                for (int ai = 0; ai < 2; ++ai)
#pragma unroll
                    for (int m = 0; m < 4; ++m) acc[ai][bj][m][n] += bv; }
        bool bad = st1.run(acc, u, wr, wc, fr, fq, lds, wid, lane) || poison != 0u;
        const float qnan = __builtin_nanf("");
#pragma unroll
        for (int ai = 0; ai < 2; ++ai)
#pragma unroll
            for (int m = 0; m < 4; ++m) { const int r = ai * HALF + wr * 64 + m * 16 + fr; const f32x2v sr = S[r]; const size_t off = (size_t)(u.pm * BM + r) * ldc + col0;
#pragma unroll
                for (int bj = 0; bj < 2; ++bj)
#pragma unroll
                    for (int n = 0; n < 2; ++n) { const f32x4 bs = *(const f32x4*)(base + off + bj * HALF + n * 16); acc[ai][bj][m][n] = bs + (acc[ai][bj][m][n] - sr.x) * sr.y; }
                asm volatile("" : "+v"(acc[ai][0][m][0]), "+v"(acc[ai][0][m][1]), "+v"(acc[ai][1][m][0]), "+v"(acc[ai][1][m][1]));
                if (m & 1) asm volatile("" ::: "memory"); }
        const bool bad1 = bad;
        bad = st2.run(acc, u, wr, wc, fr, fq, lds, wid, lane) || bad;
#pragma unroll
        for (int ai = 0; ai < 2; ++ai)
#pragma unroll
            for (int m = 0; m < 4; ++m) { const int r = ai * HALF + wr * 64 + m * 16 + fr; const f32x2v sr = S[r]; const size_t off = (size_t)(u.pm * BM + r) * ldc + col0;
#pragma unroll
                for (int bj = 0; bj < 2; ++bj)
#pragma unroll
                    for (int n = 0; n < 2; ++n) { const f32x4 x1 = acc[ai][bj][m][n]; *(f32x4*)(out + off + bj * HALF + n * 16) = bad1 ? (f32x4){qnan, qnan, qnan, qnan} : x1;
                        const f32x4 o = (x1 - sr.x) * sr.y; u32x2v w; w.x = cvt_pk_bf16(o[0], o[1]); w.y = cvt_pk_bf16(o[2], o[3]);
                        if (bad) { w.x = 0x7fc07fc0u; w.y = 0x7fc07fc0u; } *(u32x2v*)(xn + off + bj * HALF + n * 16) = w; }
                asm volatile("" ::: "memory"); }
    }
};

template <class Epi, class Sched, bool ALIGN_EPI = false, bool SP2 = false>
__device__ __forceinline__ void gemm_phase(PG8_LAS unsigned char* lds, const Gemm g, const Sched& S, const Epi& E, int tid_in) {
    int tid_l = tid_in; asm volatile("" : "+v"(tid_l));
    const int tid = tid_l, wid = __builtin_amdgcn_readfirstlane(tid >> 6), lane = tid & 63, wr = wid >> 2, wc = wid & 3, fr = lane & 15, fq = lane >> 4;
    const int K = g.K, nt = K / BK;
    unsigned voffA[2], voffB[2];
#pragma unroll
    for (int i = 0; i < 2; ++i) { int R, C; stage_rc(tid * 16 + i * 8192, R, C); const int Rb = Epi::PERM ? ((R & ~31) + perm32(R & 31)) : R;
        voffA[i] = (unsigned)(R * g.lda + C) * 2u; voffB[i] = (unsigned)(Rb * K + C) * 2u; }
    const size_t kstep = (size_t)(BK * 2);
    const size_t hstep = (size_t)HALF * K * 2;
    const size_t tstep = 2 * hstep; const size_t hstepA = (size_t)HALF * g.lda * 2, tstepA = 2 * hstepA;
    const unsigned ldsw = (unsigned)wid * 1024u;
    const int aoff = lds_byte(wr * 64 + fr, fq * 8), boff = lds_byte(wc * 32 + fr, fq * 8);
#define PG8_SA(b, h) (((b) * 2 + (h)) * HTB)
#define PG8_SB(b, h) ((4 + (b) * 2 + (h)) * HTB)
#define PG8_STAGE(bufoff, gbase, voff) do { _Pragma("unroll") for (int _i = 0; _i < 2; ++_i) \
        __builtin_amdgcn_global_load_lds((const unsigned*)((const char*)(gbase) + (voff)[_i]), (PG8_LAS unsigned*)(lds + (bufoff) + ldsw + _i * 8192), 16, 0, 0); } while (0)
#define PG8_LDA(dst, b, h) do { _Pragma("unroll") for (int m = 0; m < 4; ++m) _Pragma("unroll") for (int k = 0; k < 2; ++k) dst[m][k] = *(const PG8_LAS bf16x8*)(lds + PG8_SA(b, h) + aoff + m * 2048 + k * 1024); } while (0)
#define PG8_LDB(dst, b, h) do { _Pragma("unroll") for (int n = 0; n < 2; ++n) _Pragma("unroll") for (int k = 0; k < 2; ++k) dst[n][k] = *(const PG8_LAS bf16x8*)(lds + PG8_SB(b, h) + boff + n * 2048 + k * 1024); } while (0)
#define PG8_MMA(ai, bj, At, Bt) do { __builtin_amdgcn_s_setprio(1); _Pragma("unroll") for (int m = 0; m < 4; ++m) _Pragma("unroll") for (int n = 0; n < 2; ++n) _Pragma("unroll") for (int k = 0; k < 2; ++k) \
        acc[ai][bj][m][n] = __builtin_amdgcn_mfma_f32_16x16x32_bf16(Bt[n][k], At[m][k], acc[ai][bj][m][n], 0, 0, 0); __builtin_amdgcn_s_setprio(0); } while (0)
#define PG8_WAIT_V(n) asm volatile("s_waitcnt vmcnt(" #n ")" ::: "memory")
#define PG8_WAIT_L(n) asm volatile("s_waitcnt lgkmcnt(" #n ")" ::: "memory")
#define PG8_BAR __builtin_amdgcn_s_barrier()
#define PG8_SCHED __builtin_amdgcn_sched_barrier(0)
    Unit cur, nxt; int ui = 0;
    if (!S.next(0, cur)) return;
    f32x4 acc[2][2][4][2];
#pragma unroll
    for (int a = 0; a < 2; ++a)
#pragma unroll
        for (int b = 0; b < 2; ++b)
#pragma unroll
            for (int m = 0; m < 4; ++m)
#pragma unroll
                for (int n = 0; n < 2; ++n) acc[a][b][m][n] = (f32x4){0.f, 0.f, 0.f, 0.f};
    bf16x8 At[4][2], B0[2][2], B1[2][2];
    const char* cA = (const char*)g.A + (size_t)cur.pm * tstepA; const char* cB = (const char*)g.Bt + (size_t)cur.pn * tstep;
    S.a_ready(cur);
    if constexpr (SP2) {
        PG8_STAGE(PG8_SB(0, 0), cB, voffB); PG8_STAGE(PG8_SB(0, 1), cB + hstep, voffB); PG8_STAGE(PG8_SA(0, 0), cA, voffA); PG8_STAGE(PG8_SA(0, 1), cA + hstepA, voffA);
        if (wr == 1) PG8_BAR;
        PG8_WAIT_V(2); PG8_BAR;
        PG8_STAGE(PG8_SB(1, 0), cB + kstep, voffB); PG8_STAGE(PG8_SA(1, 0), cA + kstep, voffA); PG8_STAGE(PG8_SB(1, 1), cB + hstep + kstep, voffB);
        PG8_WAIT_V(6); PG8_BAR;
    } else {
        PG8_STAGE(PG8_SB(0, 0), cB, voffB); PG8_STAGE(PG8_SA(0, 0), cA, voffA); PG8_STAGE(PG8_SB(0, 1), cB + hstep, voffB); PG8_STAGE(PG8_SA(0, 1), cA + hstepA, voffA);
        if (wr == 1) PG8_BAR;
        PG8_WAIT_V(4); PG8_BAR;
        PG8_STAGE(PG8_SB(1, 0), cB + kstep, voffB); PG8_STAGE(PG8_SA(1, 0), cA + kstep, voffA); PG8_STAGE(PG8_SB(1, 1), cB + hstep + kstep, voffB);
        PG8_WAIT_V(6); PG8_BAR;
    }
    for (;;) {
        const bool has_next = S.next(ui + 1, nxt);
        const char* nA = has_next ? (const char*)g.A + (size_t)nxt.pm * tstepA : cA; const char* nB = has_next ? (const char*)g.Bt + (size_t)nxt.pn * tstep : cB;
        for (int t = 0; t < nt; t += 2) {
            const bool last = (t == nt - 2);
            const char* a1 = cA + (size_t)(t + 1) * kstep;
            const char* a2 = last ? nA : cA + (size_t)(t + 2) * kstep; const char* b2 = last ? nB : cB + (size_t)(t + 2) * kstep;
            const char* a3 = a2 + kstep; const char* b3 = b2 + kstep;
            if (last && has_next) S.a_ready(nxt);
            if constexpr (SP2) {
            PG8_LDB(B0, 0, 0); PG8_LDB(B1, 0, 1); PG8_SCHED; PG8_LDA(At, 0, 0); PG8_STAGE(PG8_SA(1, 1), a1 + hstepA, voffA);
            PG8_WAIT_V(8); PG8_WAIT_L(0); PG8_BAR; PG8_MMA(0, 0, At, B0); PG8_MMA(0, 1, At, B1); PG8_BAR; PG8_SCHED;
            PG8_LDA(At, 0, 1); PG8_STAGE(PG8_SB(0, 0), b2, voffB); PG8_STAGE(PG8_SB(0, 1), b2 + hstep, voffB); PG8_STAGE(PG8_SA(0, 0), a2, voffA);
            PG8_WAIT_V(8); PG8_WAIT_L(0); PG8_BAR; PG8_MMA(1, 0, At, B0); PG8_MMA(1, 1, At, B1); PG8_BAR; PG8_SCHED;
            PG8_LDB(B0, 1, 0); PG8_LDB(B1, 1, 1); PG8_SCHED; PG8_LDA(At, 1, 0); PG8_STAGE(PG8_SA(0, 1), a2 + hstepA, voffA);
            PG8_WAIT_V(8); PG8_WAIT_L(0); PG8_BAR; PG8_MMA(0, 0, At, B0); PG8_MMA(0, 1, At, B1); PG8_BAR; PG8_SCHED;
            PG8_LDA(At, 1, 1); PG8_STAGE(PG8_SB(1, 0), b3, voffB); PG8_STAGE(PG8_SB(1, 1), b3 + hstep, voffB); PG8_STAGE(PG8_SA(1, 0), a3, voffA);
            PG8_WAIT_V(8); PG8_WAIT_L(0); PG8_BAR; PG8_MMA(1, 0, At, B0); PG8_MMA(1, 1, At, B1); PG8_BAR; PG8_SCHED;
            } else {
            PG8_LDB(B0, 0, 0); PG8_SCHED; PG8_LDA(At, 0, 0); PG8_STAGE(PG8_SA(1, 1), a1 + hstepA, voffA);
            PG8_WAIT_L(8); PG8_BAR; PG8_WAIT_L(0); PG8_MMA(0, 0, At, B0); PG8_BAR; PG8_SCHED;
            PG8_LDB(B1, 0, 1); PG8_STAGE(PG8_SB(0, 0), b2, voffB);
            PG8_BAR; PG8_WAIT_L(0); PG8_MMA(0, 1, At, B1); PG8_BAR;
            PG8_LDA(At, 0, 1); PG8_STAGE(PG8_SA(0, 0), a2, voffA);
            PG8_BAR; PG8_WAIT_L(0); PG8_MMA(1, 0, At, B0); PG8_BAR; PG8_SCHED;
            PG8_STAGE(PG8_SB(0, 1), b2 + hstep, voffB);
            PG8_WAIT_V(6); PG8_BAR; PG8_MMA(1, 1, At, B1); PG8_BAR;
            PG8_LDB(B0, 1, 0); PG8_SCHED; PG8_LDA(At, 1, 0); PG8_STAGE(PG8_SA(0, 1), a2 + hstepA, voffA);
            PG8_WAIT_L(8); PG8_BAR; PG8_WAIT_L(0); PG8_MMA(0, 0, At, B0); PG8_BAR; PG8_SCHED;
            PG8_LDB(B1, 1, 1); PG8_STAGE(PG8_SB(1, 0), b3, voffB);
            PG8_BAR; PG8_WAIT_L(0); PG8_MMA(0, 1, At, B1); PG8_BAR;
            PG8_LDA(At, 1, 1); PG8_STAGE(PG8_SA(1, 0), a3, voffA);
            PG8_BAR; PG8_WAIT_L(0); PG8_MMA(1, 0, At, B0); PG8_BAR; PG8_SCHED;
            PG8_STAGE(PG8_SB(1, 1), b3 + hstep, voffB);
            PG8_WAIT_V(6); PG8_BAR; PG8_MMA(1, 1, At, B1); PG8_BAR;
            }
        }
        if constexpr (ALIGN_EPI) { if (wr == 0) PG8_BAR; }
        if constexpr (!Epi::AFTER_DRAIN) { E(acc, cur, wr, wc, fr, fq); S.done(cur); }
        if (!has_next) break;
#pragma unroll
        for (int a = 0; a < 2; ++a)
#pragma unroll
            for (int b = 0; b < 2; ++b)
#pragma unroll
                for (int m = 0; m < 4; ++m)
#pragma unroll
                    for (int n = 0; n < 2; ++n) acc[a][b][m][n] = (f32x4){0.f, 0.f, 0.f, 0.f};
        cur = nxt; cA = nA; cB = nB; ++ui;
        if constexpr (ALIGN_EPI) { if (wr == 1) PG8_BAR; }
    }
    PG8_WAIT_V(0);
    if constexpr (!ALIGN_EPI) { if (wr == 0) PG8_BAR; }
    PG8_BAR;
    if constexpr (Epi::AFTER_DRAIN) { E.fused(acc, cur, wr, wc, fr, fq, lds, wid, lane); S.done(cur); }
#undef PG8_SA
#undef PG8_SB
#undef PG8_STAGE
#undef PG8_LDA
#undef PG8_LDB
#undef PG8_MMA
#undef PG8_WAIT_V
#undef PG8_WAIT_L
#undef PG8_BAR
#undef PG8_SCHED
}
}

#ifndef PG8_SP2
#define PG8_SP2 true
#endif
#ifndef PG8_ALIGN
#define PG8_ALIGN true
#endif
#include <hip/hip_bf16.h>
#include <cmath>
namespace attn_body {
using bf16=__hip_bfloat16;
using bf16x8=__attribute__((ext_vector_type(8)))short;
using s16x4=__attribute__((ext_vector_type(4)))short;
using f32x16=__attribute__((ext_vector_type(16)))float;
using u32x4=__attribute__((ext_vector_type(4)))unsigned;
using f32x4v=__attribute__((ext_vector_type(4)))float;
constexpr int BATCH=1,NHEAD=8,SEQ=16384,D=64,DM=8704;
constexpr int NW=8,QBLK=32,QB=QBLK*NW,KVBLK=64,NQB=SEQ/QB;
constexpr int ATTN_PITCH=DM, ATTN_UNIT_ROWS=QB;
__device__ __forceinline__ int crow(int r,int hi){return (r&3)+8*(r>>2)+4*hi;}
#define SBAR() __builtin_amdgcn_sched_barrier(0)
__device__ __forceinline__ void cmask(f32x16&p0,f32x16&p1,int jb,int qrel,int hi){
  const float NEG=-INFINITY; int kb=64*jb+4*hi;
  #pragma unroll
  for(int r=0;r<16;++r){int kv=kb+(r&3)+8*(r>>2); if(kv>qrel)p0[r]=NEG; if(kv+32>qrel)p1[r]=NEG;}
}

constexpr int NSLOT=3, SLOTB=8192;
constexpr int LDS_K=0, LDS_V=NSLOT*SLOTB, LDS_WS=2*NSLOT*SLOTB, LDS_OST=LDS_WS+NW*64*4, LDS_F=LDS_OST+NW*4096, LDS_BYTES=LDS_F+SEQ*4;
constexpr float C2=0.125f*1.4426950408889634f;
__device__ __forceinline__ void glds16(const void*gsrc,unsigned lds_dst){unsigned keep;
  asm volatile("s_mov_b32 %0, m0\n\ts_mov_b32 m0, %2\n\ts_nop 0\n\tglobal_load_lds_dwordx4 %1, off\n\ts_mov_b32 m0, %0":"=&s"(keep):"v"(gsrc),"s"(lds_dst):"memory");}
__device__ __forceinline__ float max3f(float a,float b,float c){float r;asm("v_max3_f32 %0, %1, %2, %3":"=v"(r):"v"(a),"v"(b),"v"(c));return r;}
__device__ __forceinline__ float max2f(float a,float b){float r;asm("v_max_f32_e32 %0, %1, %2":"=v"(r):"v"(a),"v"(b));return r;}
__device__ __forceinline__ float fadd_s(float a,float b){float r;asm("v_add_f32_e32 %0, %1, %2":"=v"(r):"v"(a),"v"(b));return r;}
__device__ __forceinline__ float fsub_s(float a,float b){float r;asm("v_sub_f32_e32 %0, %1, %2":"=v"(r):"v"(a),"v"(b));return r;}
typedef float f32x2_t __attribute__((ext_vector_type(2))); typedef __bf16 bf16x2_t __attribute__((ext_vector_type(2)));
__device__ __forceinline__ unsigned cvtpk_s(float lo,float hi){f32x2_t v={lo,hi};bf16x2_t b=__builtin_convertvector(v,bf16x2_t);return __builtin_bit_cast(unsigned,b);}
#define WAIT_BAR(N) asm volatile("s_waitcnt vmcnt(" #N ") lgkmcnt(0)\n\ts_barrier":::"memory")


__device__ __forceinline__ bf16x8 mkbias(float x,int hi){
  const unsigned xb=__float_as_uint(x); const unsigned hb=xb&0xffff0000u; const float r1=x-__uint_as_float(hb);
  const unsigned mb=__float_as_uint(r1)&0xffff0000u; const float r2=r1-__uint_as_float(mb); const unsigned lb=__float_as_uint(r2)&0xffff0000u;
  u32x4 w; w.x=(hb>>16)|mb; w.y=(lb>>16)|0x3f800000u; w.z=0x3f803f80u; w.w=0u; if(hi){w.x=0u;w.y=0u;w.z=0u;}
  return __builtin_bit_cast(bf16x8,w);
}
__device__ __forceinline__ bf16x8 mkq(float x,int hi){
  const unsigned xb=__float_as_uint(x); const unsigned hb=xb&0xffff0000u; const float r1=x-__uint_as_float(hb);
  const unsigned mb=__float_as_uint(r1)&0xffff0000u; const float r2=r1-__uint_as_float(mb); const unsigned lb=__float_as_uint(r2)&0xffff0000u;
  u32x4 w; w.x=0x3f803f80u; w.y=0x3f80u|hb; w.z=(mb>>16)|lb; w.w=0u; if(hi){w.x=0u;w.y=0u;w.z=0u;}
  return __builtin_bit_cast(bf16x8,w);
}
__device__ __forceinline__ void qkt(f32x16&p0,f32x16&p1,const char*Kslot,const bf16x8*qr,int r32,int hi,bf16x8 kb0,bf16x8 kb1,bf16x8 qone){ const f32x16 negm=f32x16{};
  const char*kb=Kslot+hi*1024+r32*16;
  #pragma unroll
  for(int d0=0;d0<4;++d0){
    const bf16x8 b0=*reinterpret_cast<const bf16x8*>(kb+d0*2048);
    const bf16x8 b1=*reinterpret_cast<const bf16x8*>(kb+d0*2048+512);
    if(d0==0){p0=__builtin_amdgcn_mfma_f32_32x32x16_bf16(b0,qr[0],negm,0,0,0);p1=__builtin_amdgcn_mfma_f32_32x32x16_bf16(b1,qr[0],negm,0,0,0);}
    else{p0=__builtin_amdgcn_mfma_f32_32x32x16_bf16(b0,qr[d0],p0,0,0,0);p1=__builtin_amdgcn_mfma_f32_32x32x16_bf16(b1,qr[d0],p1,0,0,0);}}
  p0=__builtin_amdgcn_mfma_f32_32x32x16_bf16(kb0,qone,p0,0,0,0);p1=__builtin_amdgcn_mfma_f32_32x32x16_bf16(kb1,qone,p1,0,0,0);
}
typedef __attribute__((address_space(3))) const char* lds_cptr;
typedef short v4i16_t __attribute__((ext_vector_type(4)));
__device__ __forceinline__ void kload8(bf16x8*kf,lds_cptr kp){
  kf[0]=*(const __attribute__((address_space(3))) bf16x8*)(kp);      kf[1]=*(const __attribute__((address_space(3))) bf16x8*)(kp+512);
  kf[2]=*(const __attribute__((address_space(3))) bf16x8*)(kp+2048); kf[3]=*(const __attribute__((address_space(3))) bf16x8*)(kp+2560);
  kf[4]=*(const __attribute__((address_space(3))) bf16x8*)(kp+4096); kf[5]=*(const __attribute__((address_space(3))) bf16x8*)(kp+4608);
  kf[6]=*(const __attribute__((address_space(3))) bf16x8*)(kp+6144); kf[7]=*(const __attribute__((address_space(3))) bf16x8*)(kp+6656);
}
__device__ __forceinline__ void kload2(bf16x8*kf,lds_cptr kp,int j){ kf[2*j]=*(const __attribute__((address_space(3))) bf16x8*)(kp+j*2048); kf[2*j+1]=*(const __attribute__((address_space(3))) bf16x8*)(kp+j*2048+512); }
__device__ __forceinline__ s16x4 vtr(lds_cptr p){ return __builtin_bit_cast(s16x4,__builtin_amdgcn_ds_read_tr16_b64_v4i16((__attribute__((address_space(3))) v4i16_t*)p)); }
__device__ __forceinline__ float rowmax(const f32x16&p0,const f32x16&p1){
  float a=max3f(p0[0],p0[1],p1[0]),b=max3f(p0[2],p0[3],p1[1]);a=max3f(a,p1[2],p1[3]);
  #pragma unroll
  for(int r=4;r<16;r+=4){a=max3f(a,p0[r],p0[r+1]);b=max3f(b,p0[r+2],p0[r+3]);a=max3f(a,p1[r],p1[r+1]);b=max3f(b,p1[r+2],p1[r+3]);}
  const float m=max2f(a,b);
  auto rr=__builtin_amdgcn_permlane32_swap(__float_as_uint(m),__float_as_uint(m),false,false);
  return max2f(__uint_as_float(rr[0]),__uint_as_float(rr[1]));
}
__device__ __forceinline__ void pv(f32x16*o,int vb,bf16x8 pa0,bf16x8 pa1,bf16x8 pa2,bf16x8 pa3){
  #pragma unroll
  for(int d0=0;d0<2;++d0){s16x4 lo[4],hi[4];
    #pragma unroll
    for(int ks=0;ks<4;++ks){
      asm volatile("ds_read_b64_tr_b16 %0,%1 offset:%c2":"=&v"(lo[ks]):"v"(vb),"i"(d0*4096+ks*1024):"memory");
      asm volatile("ds_read_b64_tr_b16 %0,%1 offset:%c2":"=&v"(hi[ks]):"v"(vb),"i"(d0*4096+ks*1024+512):"memory");}
    asm volatile("s_waitcnt lgkmcnt(0)":::"memory");SBAR();
    #define PK(k) (bf16x8){lo[k][0],lo[k][1],lo[k][2],lo[k][3],hi[k][0],hi[k][1],hi[k][2],hi[k][3]}
    o[d0]=__builtin_amdgcn_mfma_f32_32x32x16_bf16(pa0,PK(0),o[d0],0,0,0);
    o[d0]=__builtin_amdgcn_mfma_f32_32x32x16_bf16(pa1,PK(1),o[d0],0,0,0);
    o[d0]=__builtin_amdgcn_mfma_f32_32x32x16_bf16(pa2,PK(2),o[d0],0,0,0);
    o[d0]=__builtin_amdgcn_mfma_f32_32x32x16_bf16(pa3,PK(3),o[d0],0,0,0);
    #undef PK
  }
}

#ifndef ATTN_STORE16
#define ATTN_STORE16(p,v) (*(u32x4*)(p)=(v))
#endif
template<int THRL> __device__ __forceinline__ void attn_unit(int b,int h,int qb,const bf16*Q,const bf16*__restrict__ K,const bf16*__restrict__ V,bf16*O,const float*FL2,char*shm,int tid_in){
  int tid_l=tid_in; asm volatile("":"+v"(tid_l));
  const int tid=tid_l,lane=tid&63,r32=lane&31,hi=lane>>5; const int wid=__builtin_amdgcn_readfirstlane(tid>>6);
  const long rowbase=(long)b*SEQ; const int q0=qb*QB;
  const bf16*Qw=Q+(rowbase+q0+wid*QBLK)*DM+h*D;
  const bf16*Kh=K+rowbase*DM+h*D,*Vh=V+rowbase*DM+h*D;
  const lds_cptr shm3=(lds_cptr)shm;
  const unsigned lds0=(unsigned)(uintptr_t)shm;
  float*wsf=(float*)(shm+LDS_WS)+wid*64;
  const bf16*ksrc=Kh+(long)lane*DM+wid*8;
  const bf16*vsrc=Vh+(long)(16*(wid&3)+(lane>>2))*DM+(wid>>2)*32+(lane&3)*8;
  const unsigned kdst=lds0+LDS_K+wid*1024, vdst=lds0+LDS_V+wid*1024;
  #define DMA_K(t,slot) glds16(ksrc+(long)(t)*KVBLK*DM,(unsigned)__builtin_amdgcn_readfirstlane(kdst+(slot)))
  #define DMA_V(t,slot) glds16(vsrc+(long)(t)*KVBLK*DM,(unsigned)__builtin_amdgcn_readfirstlane(vdst+(slot)))
  const int vb0=(int)(lds0+LDS_V)+((lane>>4)&1)*32+(lane&3)*8+(4*hi+((lane&15)>>2))*64;
  const char*Kbase=shm+LDS_K; bf16x8 kf[8];
  const lds_cptr kp0=shm3+LDS_K+hi*1024+r32*16; const lds_cptr vp0=shm3+LDS_V+((lane>>4)&1)*32+(lane&3)*8+(4*hi+((lane&15)>>2))*64;
  const int NT=(q0+QB)/KVBLK;
  const __attribute__((address_space(3))) float* Fl=(const __attribute__((address_space(3))) float*)(shm3+LDS_F);
  float fref;
  { const float*Fg=FL2+(long)h*SEQ; const int nF=q0+QB;
    for(int i=tid*4;i<nF;i+=NW*64*4){ const f32x4v v4=*reinterpret_cast<const f32x4v*>(Fg+i); *(__attribute__((address_space(3))) f32x4v*)(shm3+LDS_F+i*4)=v4; }
    fref=Fg[nF-1]; }
  asm volatile("s_waitcnt vmcnt(0) lgkmcnt(0)":::"memory");
  bf16x8 qone=mkq(0.f,hi);
  #define MKB(t,off) mkbias(fref-Fl[(t)*KVBLK+(off)+r32],hi)
  DMA_K(0,0);DMA_V(0,0);DMA_K(1,SLOTB);
  bf16x8 qr[4];
  #pragma unroll
  for(int d0=0;d0<4;++d0)qr[d0]=*reinterpret_cast<const bf16x8*>(&Qw[(long)r32*DM+d0*16+hi*8]);
  float mhat=0.f,l_reg=0.f;f32x16 o[2];o[0]=f32x16{};o[1]=f32x16{};
  const int qrel=wid*QBLK+r32;
  #define CMASK(P0,P1,t) do{int jb_=(t)-(NT-4); if(jb_>=0)cmask(P0,P1,jb_,qrel,hi);}while(0)
  bool resc=false;
  #define START(P0,P1) do{ const float rm=rowmax(P0,P1); resc=false; \
    { const float dl=rm; mhat=fadd_s(mhat,dl); \
      _Pragma("unroll") for(int r=0;r<16;++r){P0[r]=fsub_s(P0[r],dl);P1[r]=fsub_s(P1[r],dl);} \
      qone=mkq(-mhat,hi); } \
    _Pragma("unroll") for(int r=0;r<16;++r)P0[r]=__builtin_amdgcn_exp2f(P0[r]); }while(0)
  #define RESC() do{ if(resc){ asm volatile("s_waitcnt lgkmcnt(0)":::"memory"); \
      _Pragma("unroll") for(int d_=0;d_<2;++d_) _Pragma("unroll") for(int r=0;r<16;++r)o[d_][r]*=wsf[crow(r,hi)]; } }while(0)
  f32x16 pA0,pA1,pB0,pB1;
  int sl_prev=0,sl_cur=0,sl_next=SLOTB;
  #define ROT() do{sl_prev=sl_cur;sl_cur=sl_next;sl_next=(sl_next==(NSLOT-1)*SLOTB)?0:sl_next+SLOTB;}while(0)
  DMA_K(2,2*SLOTB);
  WAIT_BAR(3);
  qkt(pA0,pA1,Kbase,qr,r32,hi,MKB(0,0),MKB(0,32),qone);asm volatile("s_nop 15\n\ts_nop 7":"+v"(pA0),"+v"(pA1));CMASK(pA0,pA1,0);
  START(pA0,pA1);
  _Pragma("unroll") for(int r=0;r<16;++r)pA1[r]=__builtin_amdgcn_exp2f(pA1[r]);
  WAIT_BAR(0);
  DMA_K(3,0);DMA_V(1,SLOTB);
  ROT();
  kload8(kf,kp0+sl_cur);
  WAIT_BAR(2);
  s16x4 vlo[8],vhi[8]; u32x4 pw0,pw1,pw2,pw3;
  #define PKW(P,B) cvtpk_s(P[B],P[B+1])
  #define PAF(k) __builtin_bit_cast(bf16x8,pw##k)
  #define VFR(i) (bf16x8){vlo[i][0],vlo[i][1],vlo[i][2],vlo[i][3],vhi[i][0],vhi[i][1],vhi[i][2],vhi[i][3]}
  #define PIN(x) asm volatile("":"+v"(x))
  #define MX3(a,b,c) __builtin_fmaxf(__builtin_fmaxf((a),(b)),(c))
  #define GAPA(MF,A0,A1,A2,A3,W0,W1,PW) do{ MF; sacc+=A0; sacc+=A1; sacc+=A2; sacc+=A3; PIN(sacc); W0; W1; PIN(PW); SBAR(); }while(0)
  #define EX(v) __builtin_amdgcn_exp2f(v)
  #define GAPB(MF,X,B) do{ MF; X[B]=EX(X[B]); X[B+1]=EX(X[B+1]); X[B+2]=EX(X[B+2]); X[B+3]=EX(X[B+3]); PIN(X); SBAR(); }while(0)
  #define VRD(i) do{ vlo[i]=vtr(vp_+(((i)>>2)*4096+((i)&3)*1024)); vhi[i]=vtr(vp_+(((i)>>2)*4096+((i)&3)*1024+512)); }while(0)
  #define KRD(G,j) do{ if(G){ kload2(kf,kp0+sl_next,j); SBAR(); } }while(0)
  #define STEP(C0,C1,P0,P1,t,GK,GV,GL) do{ SBAR(); \
    const bf16x8 kbA_=MKB(t,0), kbB_=MKB(t,32); \
    const lds_cptr vp_=vp0+sl_prev; \
    VRD(0); SBAR(); float sacc=(P0[0]+P0[1]); \
    GAPA(C0=__builtin_amdgcn_mfma_f32_32x32x16_bf16(kf[0],qr[0],f32x16{},0,0,0), P0[2],P0[3],P0[4],P0[5],     pw0[0]=PKW(P0,0), pw0[1]=PKW(P0,2), pw0); \
    VRD(4); SBAR(); GAPA(C1=__builtin_amdgcn_mfma_f32_32x32x16_bf16(kf[1],qr[0],f32x16{},0,0,0), P0[6],P0[7],P0[8],P0[9],     pw0[2]=PKW(P0,4), pw0[3]=PKW(P0,6), pw0); \
    VRD(1); SBAR(); GAPA(C0=__builtin_amdgcn_mfma_f32_32x32x16_bf16(kf[2],qr[1],C0,0,0,0),   P0[10],P0[11],P0[12],P0[13], pw1[0]=PKW(P0,8), pw1[1]=PKW(P0,10), pw1); \
    VRD(5); SBAR(); GAPA(C1=__builtin_amdgcn_mfma_f32_32x32x16_bf16(kf[3],qr[1],C1,0,0,0),   P0[14],P0[15],P1[0],P1[1],   pw1[2]=PKW(P0,12),pw1[3]=PKW(P0,14), pw1); \
    VRD(2); SBAR(); GAPA(C0=__builtin_amdgcn_mfma_f32_32x32x16_bf16(kf[4],qr[2],C0,0,0,0),   P1[2],P1[3],P1[4],P1[5],     pw2[0]=PKW(P1,0), pw2[1]=PKW(P1,2), pw2); \
    VRD(6); SBAR(); GAPA(C1=__builtin_amdgcn_mfma_f32_32x32x16_bf16(kf[5],qr[2],C1,0,0,0),   P1[6],P1[7],P1[8],P1[9],     pw2[2]=PKW(P1,4), pw2[3]=PKW(P1,6), pw2); \
    VRD(3); SBAR(); GAPA(C0=__builtin_amdgcn_mfma_f32_32x32x16_bf16(kf[6],qr[3],C0,0,0,0),   P1[10],P1[11],P1[12],P1[13], pw3[0]=PKW(P1,8), pw3[1]=PKW(P1,10), pw3); \
    VRD(7); SBAR(); GAPA(C1=__builtin_amdgcn_mfma_f32_32x32x16_bf16(kf[7],qr[3],C1,0,0,0),   P1[14],P1[15],0.f,0.f,       pw3[2]=PKW(P1,12),pw3[3]=PKW(P1,14), pw3); \
    C0=__builtin_amdgcn_mfma_f32_32x32x16_bf16(kbA_,qone,C0,0,0,0); C1=__builtin_amdgcn_mfma_f32_32x32x16_bf16(kbB_,qone,C1,0,0,0); \
    l_reg+=sacc; \
    if(GK){DMA_K((t)+3,sl_cur);} if(GV){DMA_V((t)+1,sl_next);} \
    CMASK(C0,C1,t); \
    { float a=MX3(C0[0],C0[1],C1[0]),b=MX3(C0[2],C0[3],C1[1]); a=MX3(a,C1[2],C1[3]); \
      _Pragma("unroll") for(int r=4;r<16;r+=4){a=MX3(a,C0[r],C0[r+1]);b=MX3(b,C0[r+2],C0[r+3]);a=MX3(a,C1[r],C1[r+1]);b=MX3(b,C1[r+2],C1[r+3]);} \
      float rm=__builtin_fmaxf(a,b); { auto rr=__builtin_amdgcn_permlane32_swap(__float_as_uint(rm),__float_as_uint(rm),false,false); rm=__builtin_fmaxf(__uint_as_float(rr[0]),__uint_as_float(rr[1])); } \
      resc=false; \
      if(__builtin_expect(__any(rm>(float)THRL),0)){ const float dl=__builtin_fmaxf(rm,0.f); mhat+=dl; \
        _Pragma("unroll") for(int r=0;r<16;++r){C0[r]-=dl;C1[r]-=dl;} \
        qone=mkq(-mhat,hi); \
        const float f=__builtin_amdgcn_exp2f(-dl); l_reg*=f; if(hi==0)wsf[r32]=f; resc=true; } } \
    SBAR(); \
    GAPB(o[0]=__builtin_amdgcn_mfma_f32_32x32x16_bf16(PAF(0),VFR(0),o[0],0,0,0), C0,0); \
    GAPB(o[1]=__builtin_amdgcn_mfma_f32_32x32x16_bf16(PAF(0),VFR(4),o[1],0,0,0), C0,4); \
    KRD(GL,0); GAPB(o[0]=__builtin_amdgcn_mfma_f32_32x32x16_bf16(PAF(1),VFR(1),o[0],0,0,0), C0,8); \
    KRD(GL,1); GAPB(o[1]=__builtin_amdgcn_mfma_f32_32x32x16_bf16(PAF(1),VFR(5),o[1],0,0,0), C0,12); \
    KRD(GL,2); GAPB(o[0]=__builtin_amdgcn_mfma_f32_32x32x16_bf16(PAF(2),VFR(2),o[0],0,0,0), C1,0); \
    KRD(GL,3); GAPB(o[1]=__builtin_amdgcn_mfma_f32_32x32x16_bf16(PAF(2),VFR(6),o[1],0,0,0), C1,4); \
    GAPB(o[0]=__builtin_amdgcn_mfma_f32_32x32x16_bf16(PAF(3),VFR(3),o[0],0,0,0), C1,8); \
    GAPB(o[1]=__builtin_amdgcn_mfma_f32_32x32x16_bf16(PAF(3),VFR(7),o[1],0,0,0), C1,12); \
    }while(0)
  int t=1;
  #undef CMASK
  #define CMASK(P0,P1,t) do{}while(0)
  for(;t+5<NT;t+=2){
    STEP(pB0,pB1,pA0,pA1,t,true,true,true);     WAIT_BAR(2); RESC(); ROT();
    STEP(pA0,pA1,pB0,pB1,t+1,true,true,true);   WAIT_BAR(2); RESC(); ROT();
  }
  #undef CMASK
  #define CMASK(P0,P1,t) do{int jb_=(t)-(NT-4); if(jb_>=0)cmask(P0,P1,jb_,qrel,hi);}while(0)
  #define ENDW(tt) do{ if((tt)+3<NT){WAIT_BAR(2);} else if((tt)+2<NT){WAIT_BAR(1);} else {WAIT_BAR(0);} }while(0)
  for(;t+1<NT;t+=2){
    STEP(pB0,pB1,pA0,pA1,t,(t+3<NT),(t+1<NT),(t+1<NT));       ENDW(t);   RESC(); ROT();
    STEP(pA0,pA1,pB0,pB1,t+1,(t+4<NT),(t+2<NT),(t+2<NT));     ENDW(t+1); RESC(); ROT();
  }
  STEP(pB0,pB1,pA0,pA1,NT-1,false,false,false); RESC();
  { float sacc=pB0[0]+pB0[1]; _Pragma("unroll") for(int r=2;r<16;++r)sacc+=pB0[r]; _Pragma("unroll") for(int r=0;r<16;++r)sacc+=pB1[r]; l_reg+=sacc;
    pw0=(u32x4){PKW(pB0,0),PKW(pB0,2),PKW(pB0,4),PKW(pB0,6)};pw1=(u32x4){PKW(pB0,8),PKW(pB0,10),PKW(pB0,12),PKW(pB0,14)};pw2=(u32x4){PKW(pB1,0),PKW(pB1,2),PKW(pB1,4),PKW(pB1,6)};pw3=(u32x4){PKW(pB1,8),PKW(pB1,10),PKW(pB1,12),PKW(pB1,14)};
    SBAR(); pv(o,vb0+sl_cur,PAF(0),PAF(1),PAF(2),PAF(3)); }
  #undef PKW
  #undef PAF
  #undef VFR
  #undef PIN
  #undef MX3
  #undef GAPA
  #undef GAPB
  #undef EX
  #undef VRD
  #undef KRD
  #undef STEP
  #undef ENDW
  {auto rr=__builtin_amdgcn_permlane32_swap(__float_as_uint(l_reg),__float_as_uint(l_reg),false,false);l_reg=__uint_as_float(rr[0])+__uint_as_float(rr[1]);}
  if(hi==0)wsf[32+r32]=l_reg;asm volatile("s_waitcnt lgkmcnt(0)":::"memory");
  float rli[16];
  #pragma unroll
  for(int r=0;r<16;++r)rli[r]=__builtin_amdgcn_rcpf(wsf[32+crow(r,hi)]);
  bf16*Ow=O+(rowbase+q0+wid*QBLK)*DM+h*D;
  { bf16*stg=(bf16*)(shm+LDS_OST)+wid*2048;
    #pragma unroll
    for(int r=0;r<16;++r){const int orow=crow(r,hi);
      #pragma unroll
      for(int d0=0;d0<2;++d0)stg[orow*64+d0*32+r32]=__float2bfloat16(o[d0][r]*rli[r]);}
    asm volatile("s_waitcnt lgkmcnt(0)":::"memory");
    #pragma unroll
    for(int i=0;i<4;++i){const int row=i*8+(lane>>3),ch=lane&7; const u32x4 v=*(const u32x4*)(stg+row*64+ch*8); ATTN_STORE16(Ow+(long)row*DM+ch*8,v);} }
  asm volatile("s_waitcnt lgkmcnt(0)\n\ts_barrier":::"memory");
  #undef DMA_K
  #undef DMA_V
  #undef MKB
  #undef CMASK
  #undef START
  #undef RESC
  #undef ROT
}
constexpr int ATTN_LDS_BYTES=LDS_BYTES;
struct AttnTensors { const bf16* Q; const bf16* K; const bf16* V; bf16* O; const float* FL2; };
struct AttnUnit { int bh; int qb; };
struct StaticOrder {
  int vcu;
  __device__ __forceinline__ explicit StaticOrder(int grid,int block):vcu((block%8)*(grid/8)+block/8){}
  __device__ __forceinline__ bool next(int i,AttnUnit&u)const{ if(i>=2)return false; const int s=vcu&31; u.bh=vcu>>5; u.qb=(i==0)?s:63-s; return true; }
  __device__ __forceinline__ void a_ready(const AttnUnit&)const{}
  __device__ __forceinline__ void done(const AttnUnit&)const{}
};
template<class Sched,int THRL=8> __device__ __forceinline__ void attn_phase(char*lds,const AttnTensors&T,const Sched&S,int tid_in){
  AttnUnit u;
  for(int i=0;S.next(i,u);++i){ S.a_ready(u); attn_unit<THRL>(u.bh/NHEAD,u.bh%NHEAD,u.qb,T.Q,T.K,T.V,T.O,T.FL2,lds,tid_in); S.done(u); }
}
#undef SBAR
#undef WAIT_BAR
}
#define LAS __attribute__((address_space(3)))
typedef unsigned short bf16;
typedef unsigned v4u __attribute__((ext_vector_type(4)));
typedef unsigned v2u __attribute__((ext_vector_type(2)));
typedef float f32x4 __attribute__((ext_vector_type(4)));
typedef short bf16x8 __attribute__((ext_vector_type(8)));
typedef const __attribute__((address_space(4))) unsigned* cu32p;
typedef const __attribute__((address_space(4))) float* cf32p;

constexpr int M = 16384, D = 1024, DFF = 2816, ZP = 8704, NL = 4, NWAVES = 8, NTHR = 512;
constexpr int ZQ = 0, ZK = 512, ZV = 1024, ZXB = 1536, ZYB = 2560, ZRW = 3584, ZGT = 5376, ZFL = 8448;
constexpr float ALPHA = 1.6817928305074292f, LN_EPS = 1e-5f, GN_EPS = 64e-5f, LOG2E = 1.4426950408889634f;
constexpr int NCH = 256, LC = 64;

constexpr size_t MiB = 1u << 20;
constexpr size_t WS_ADA = 1 * MiB, WS_FL2 = 2 * MiB, WS_LAEND = 3 * MiB, WS_LHEND = 4 * MiB, WS_LCAR = 5 * MiB, WS_BON = 6 * MiB;
constexpr size_t WS_W = 8 * MiB;
constexpr size_t W_UP0 = WS_W, W_UP1 = WS_W + 11 * MiB, W_DN0 = WS_W + 22 * MiB, W_DN1 = WS_W + 22 * MiB + 5632 * 1024, W_IN = WS_W + 33 * MiB,
                 W_PA = WS_W + 50 * MiB, W_PB = WS_W + 51 * MiB, W_PC = WS_W + 53 * MiB, W_OUT = WS_W + 54 * MiB, W_LORA = WS_W + 56 * MiB;
constexpr size_t WS_HB = 65 * MiB, WS_Y = 97 * MiB, WS_HLOC = 97 * MiB, WS_ACUM = 129 * MiB, WS_P = 97 * MiB, WS_G = 129 * MiB;
constexpr size_t WS_RWO = 161 * MiB, WS_CODES = 177 * MiB, WS_LORA = 185 * MiB, WS_S0 = 185 * MiB;
constexpr size_t WS_RW_W = 233 * MiB, WS_RW_R = 265 * MiB, WS_RW_KF = 281 * MiB, WS_RW_V = 297 * MiB, WS_RW_KK = 313 * MiB, WS_RW_B = 329 * MiB, WS_GB = 345 * MiB;
constexpr size_t WS_Z = 361 * MiB, WS_ACT = 361 * MiB, WS_END = 697 * MiB;
struct RwSet { size_t w, r, kf, kk, b; };
__device__ __forceinline__ RwSet rw_set(int l) { return (l & 1) ? RwSet{WS_HB, 633 * MiB, 649 * MiB, 665 * MiB, 681 * MiB} : RwSet{WS_RW_W, WS_RW_R, WS_RW_KF, WS_RW_KK, WS_RW_B}; }
constexpr int MISC_OFF = attn_body::ATTN_LDS_BYTES, LDS_BYTES = attn_body::ATTN_LDS_BYTES + 64;
constexpr size_t CTL_ZERO_BYTES = 16384;
constexpr int LDS_PHASE_BYTES = attn_body::ATTN_LDS_BYTES;
static_assert(LDS_BYTES >= pg8::STAGE_BYTES && LDS_BYTES <= 160 * 1024, "LDS map");

__device__ __forceinline__ unsigned f2bf(float f) { unsigned u = __builtin_bit_cast(unsigned, f); return (u + 0x7fffu + ((u >> 16) & 1u)) >> 16; }
__device__ __forceinline__ unsigned pk2(float lo, float hi) { return f2bf(lo) | (f2bf(hi) << 16); }
__device__ __forceinline__ float bflo(unsigned u) { return __uint_as_float(u << 16); }
__device__ __forceinline__ float bfhi(unsigned u) { return __uint_as_float(u & 0xffff0000u); }
__device__ __forceinline__ float bf1(bf16 b) { return __uint_as_float(((unsigned)b) << 16); }
__device__ __forceinline__ float shx(float v, int o, int lane) { return __builtin_bit_cast(float, __builtin_amdgcn_ds_bpermute((lane ^ o) << 2, __builtin_bit_cast(int, v))); }
__device__ __forceinline__ float wave_sum(float v, int lane) {
#pragma unroll
    for (int o = 1; o < 64; o <<= 1) v += shx(v, o, lane);
    return v;
}
__device__ __forceinline__ float sigm(float x) { return __builtin_amdgcn_rcpf(1.f + __expf(-x)); }
__device__ __forceinline__ float tanh_(float z) { return 1.f - 2.f * __builtin_amdgcn_rcpf(1.f + __expf(2.f * z)); }
__device__ __forceinline__ float gelu_tanh(float x) { return 0.5f * x * (1.f + tanh_(0.7978845608028654f * (x + 0.044715f * x * x * x))); }
__device__ __forceinline__ float softplus_(float x) { return fmaxf(x, 0.f) + log1pf(__expf(-fabsf(x))); }
#define LDS_WAIT() asm volatile("s_waitcnt lgkmcnt(0)" ::: "memory")

struct Args { const float* in[32]; float* out; unsigned char* ws; };
typedef const __attribute__((address_space(4))) Args* CA;

struct EpiSwiGLU {
    static constexpr bool PERM = true, AFTER_DRAIN = false; bf16* O; int ldc;
    __device__ __forceinline__ void operator()(const pg8::f32x4 (&acc)[2][2][4][2], const pg8::Unit& u, int wr, int wc, int fr, int fq) const {
        const int row0 = u.pm * 256 + wr * 64 + fr, col0 = u.pn * 128 + wc * 32 + 8 * fq;
#pragma unroll
        for (int ai = 0; ai < 2; ++ai)
#pragma unroll
            for (int m = 0; m < 4; ++m) {
                bf16* rowp = O + (size_t)(row0 + ai * 128 + m * 16) * ldc + col0; float o[8];
#pragma unroll
                for (int n = 0; n < 2; ++n)
#pragma unroll
                    for (int i = 0; i < 4; ++i) { const float uu = acc[ai][0][m][n][i], gg = acc[ai][1][m][n][i]; o[n * 4 + i] = uu * sigm(uu) * gg; }
                v4u w; w.x = pk2(o[0], o[1]); w.y = pk2(o[2], o[3]); w.z = pk2(o[4], o[5]); w.w = pk2(o[6], o[7]); *(v4u*)rowp = w; }
    }
};
struct EpiGateF32 {
    static constexpr bool PERM = false, AFTER_DRAIN = false; float* Y; const float* gate; float mul;
    __device__ __forceinline__ void operator()(const pg8::f32x4 (&acc)[2][2][4][2], const pg8::Unit& u, int wr, int wc, int fr, int fq) const {
        const int row0 = u.pm * 256 + wr * 64 + fr, col0 = u.pn * 256 + wc * 32 + 4 * fq;
#pragma unroll
        for (int bj = 0; bj < 2; ++bj)
#pragma unroll
            for (int n = 0; n < 2; ++n) { const int c = col0 + bj * 128 + n * 16; const f32x4 gv = *(const f32x4*)(gate + c) * mul;
#pragma unroll
                for (int ai = 0; ai < 2; ++ai)
#pragma unroll
                    for (int m = 0; m < 4; ++m) *(f32x4*)(Y + (size_t)(row0 + ai * 128 + m * 16) * D + c) = acc[ai][bj][m][n] * gv; }
    }
};
struct EpiIn {
    static constexpr bool PERM = true, AFTER_DRAIN = false; bf16* Z;
    __device__ __forceinline__ void operator()(const pg8::f32x4 (&acc)[2][2][4][2], const pg8::Unit& u, int wr, int wc, int fr, int fq) const {
        const int row0 = u.pm * 256 + wr * 64 + fr, col0 = u.pn * 256 + wc * 32 + 8 * fq;
        const int mode = (u.pn < 2) ? 1 : ((u.pn >= 21 && u.pn < 33) ? 2 : 0);
#pragma unroll
        for (int ai = 0; ai < 2; ++ai)
#pragma unroll
            for (int m = 0; m < 4; ++m) { bf16* rowp = Z + (size_t)(row0 + ai * 128 + m * 16) * ZP + col0;
#pragma unroll
                for (int bj = 0; bj < 2; ++bj) { float o[8];
#pragma unroll
                    for (int n = 0; n < 2; ++n)
#pragma unroll
                        for (int i = 0; i < 4; ++i) { float v = acc[ai][bj][m][n][i]; if (mode == 1) v *= attn_body::C2; else if (mode == 2) v = sigm(v); o[n * 4 + i] = v; }
                    v4u w; w.x = pk2(o[0], o[1]); w.y = pk2(o[2], o[3]); w.z = pk2(o[4], o[5]); w.w = pk2(o[6], o[7]); *(v4u*)(rowp + bj * 128) = w; } }
    }
};
struct EpiPlain {
    static constexpr bool PERM = true, AFTER_DRAIN = false; bf16* O; int ldc;
    __device__ __forceinline__ void operator()(const pg8::f32x4 (&acc)[2][2][4][2], const pg8::Unit& u, int wr, int wc, int fr, int fq) const {
        const int row0 = u.pm * 256 + wr * 64 + fr, col0 = u.pn * 256 + wc * 32 + 8 * fq;
#pragma unroll
        for (int ai = 0; ai < 2; ++ai)
#pragma unroll
            for (int m = 0; m < 4; ++m) { bf16* rowp = O + (size_t)(row0 + ai * 128 + m * 16) * ldc + col0;
#pragma unroll
                for (int bj = 0; bj < 2; ++bj) { const pg8::f32x4 v0 = acc[ai][bj][m][0], v1 = acc[ai][bj][m][1];
                    v4u w; w.x = pk2(v0[0], v0[1]); w.y = pk2(v0[2], v0[3]); w.z = pk2(v1[0], v1[1]); w.w = pk2(v1[2], v1[3]); *(v4u*)(rowp + bj * 128) = w; } }
    }
};
template <int PASS> struct EpiProj {
    static constexpr bool PERM = false, AFTER_DRAIN = false; float* Y; const bf16* Z; bf16* MIX;
    __device__ __forceinline__ void operator()(const pg8::f32x4 (&acc)[2][2][4][2], const pg8::Unit& u, int wr, int wc, int fr, int fq) const {
        const int row0 = u.pm * 256 + wr * 64 + fr, col0 = u.pn * 256 + wc * 32 + 4 * fq;
#pragma unroll
        for (int ai = 0; ai < 2; ++ai)
#pragma unroll
            for (int m = 0; m < 4; ++m) { const size_t row = (size_t)(row0 + ai * 128 + m * 16);
#pragma unroll
                for (int bj = 0; bj < 2; ++bj)
#pragma unroll
                    for (int n = 0; n < 2; ++n) { const int c = col0 + bj * 128 + n * 16;
                        const v2u gw = *(const v2u*)(Z + row * ZP + ZGT + PASS * 1024 + c);
                        f32x4 gv; gv.x = bflo(gw.x); gv.y = bfhi(gw.x); gv.z = bflo(gw.y); gv.w = bfhi(gw.y);
                        f32x4 v = acc[ai][bj][m][n] * gv; float* yp = Y + row * D + c;
                        if (PASS > 0) v += *(const f32x4*)yp;
                        if (PASS < 2) *(f32x4*)yp = v; else { v2u w; w.x = pk2(v.x, v.y); w.y = pk2(v.z, v.w); *(v2u*)(MIX + row * D + c) = w; } } }
    }
};

__device__ __forceinline__ void cvt_item(const float* W, int ldw, int sk0, int sn0, int nvalid, bf16* WT, int ldo, int orow0, int dk0, LAS float* scr, int lane) {
    const int n_ = lane & 31;
#pragma unroll 8
    for (int i = 0; i < 32; ++i) { const int kk = 2 * i + (lane >> 5); scr[kk * 33 + n_] = (n_ < nvalid) ? W[(size_t)(sk0 + kk) * ldw + sn0 + n_] : 0.f; }
    LDS_WAIT(); asm volatile("" ::: "memory");
    const int c = lane & 7;
#pragma unroll
    for (int j = 0; j < 4; ++j) { const int n = (lane >> 3) + 8 * j; const LAS float* s = scr + (8 * c) * 33 + n;
        v4u o; o.x = pk2(s[0 * 33], s[1 * 33]); o.y = pk2(s[2 * 33], s[3 * 33]); o.z = pk2(s[4 * 33], s[5 * 33]); o.w = pk2(s[6 * 33], s[7 * 33]);
        *(v4u*)(WT + (size_t)(orow0 + n) * ldo + dk0 + 8 * c) = o; }
    LDS_WAIT(); asm volatile("" ::: "memory");
}
__device__ __forceinline__ void convert_layer(CA a, int l, LAS unsigned char* lds, int gw, int NGW, int wave, int lane) {
    LAS float* scr = (LAS float*)(lds + wave * 16384);
    unsigned char* ws = a->ws;
    constexpr int I_UP = 16 * 176, I_DN = 44 * 32, I_IN = 16 * 272, I_PA = 8 * 32, I_PB = 16 * 32, I_LO = 4 * 48;
    constexpr int NITEMS = 2 * I_UP + 2 * I_DN + I_IN + 2 * I_PA + 2 * I_PB + I_LO;
    for (int it = gw; it < NITEMS; it += NGW) {
        int r = it;
        if (r < 2 * I_UP) { const int s = r / I_UP; r -= s * I_UP; const int kb = r / 176, ob = r % 176, orow0 = 32 * ob, pn = orow0 >> 8, wi = orow0 & 255;
            const int sn0 = (wi < 128) ? (128 * pn + wi) : (DFF + 128 * pn + wi - 128);
            cvt_item(a->in[6] + (size_t)(l * 2 + s) * D * 2 * DFF, 2 * DFF, 64 * kb, sn0, 32, (bf16*)(ws + (s ? W_UP1 : W_UP0)), D, orow0, 64 * kb, scr, lane); continue; }
        r -= 2 * I_UP;
        if (r < 2 * I_DN) { const int s = r / I_DN; r -= s * I_DN; const int kb = r / 32, ob = r % 32;
            cvt_item(a->in[7] + (size_t)(l * 2 + s) * DFF * D, D, 64 * kb, 32 * ob, 32, (bf16*)(ws + (s ? W_DN1 : W_DN0)), DFF, 32 * ob, 64 * kb, scr, lane); continue; }
        r -= 2 * I_DN;
        if (r < I_IN) { const int kb = r / 272, ob = r % 272, orow0 = 32 * ob; int sn0, nv;
            if (orow0 < 1536) { sn0 = orow0; nv = 32; } else if (orow0 < ZFL) { sn0 = orow0 + 8; nv = 32; } else if (orow0 == ZFL) { sn0 = 1536; nv = 8; } else { sn0 = 0; nv = 0; }
            cvt_item(a->in[8] + (size_t)l * D * 8456, 8456, 64 * kb, sn0, nv, (bf16*)(ws + W_IN), D, orow0, 64 * kb, scr, lane); continue; }
        r -= I_IN;
        if (r < I_PA) { const int kb = r / 32, ob = r % 32; cvt_item(a->in[28] + (size_t)l * 512 * D, D, 64 * kb, 32 * ob, 32, (bf16*)(ws + W_PA), 512, 32 * ob, 64 * kb, scr, lane); continue; }
        r -= I_PA;
        if (r < I_PB) { const int kb = r / 32, ob = r % 32; cvt_item(a->in[29] + (size_t)l * D * D, D, 64 * kb, 32 * ob, 32, (bf16*)(ws + W_PB), D, 32 * ob, 64 * kb, scr, lane); continue; }
        r -= I_PB;
        if (r < I_PA) { const int kb = r / 32, ob = r % 32; cvt_item(a->in[30] + (size_t)l * 512 * D, D, 64 * kb, 32 * ob, 32, (bf16*)(ws + W_PC), 512, 32 * ob, 64 * kb, scr, lane); continue; }
        r -= I_PA;
        if (r < I_PB) { const int kb = r / 32, ob = r % 32; cvt_item(a->in[31] + (size_t)l * D * D, D, 64 * kb, 32 * ob, 32, (bf16*)(ws + W_OUT), D, 32 * ob, 64 * kb, scr, lane); continue; }
        r -= I_PB;
        {
            const int kb = r / 48, ob = r % 48, reg = ob / 16, nb = ob % 16; const float* W = a->in[19]; int sk0 = 0, nv = 0;
            if (reg == 0 && kb == 0) { W = a->in[19] + (size_t)l * 64 * 512; nv = 32; }
            else if (reg == 1 && kb == 1) { W = a->in[21] + (size_t)l * 64 * 512; nv = 32; }
            else if (reg == 2 && kb >= 2) { W = a->in[22] + (size_t)l * 128 * 512; sk0 = 64 * (kb - 2); nv = 32; }
            cvt_item(W, 512, sk0, 32 * nb, nv, (bf16*)(ws + W_LORA), 256, 32 * ob, 64 * kb, scr, lane); }
    }
}

__device__ __forceinline__ void row_stats(const f32x4 (&v)[4], float& mean, float& rstd, int lane) {
    float s = 0.f;
#pragma unroll
    for (int j = 0; j < 4; ++j) s += (v[j].x + v[j].y) + (v[j].z + v[j].w);
    mean = wave_sum(s, lane) * (1.f / D); float s2 = 0.f;
#pragma unroll
    for (int j = 0; j < 4; ++j) { const f32x4 d = v[j] - mean; s2 += (d.x * d.x + d.y * d.y) + (d.z * d.z + d.w * d.w); }
    rstd = 1.f / sqrtf(wave_sum(s2, lane) * (1.f / D) + LN_EPS);
}
__device__ __forceinline__ void store_mod(const f32x4 (&v)[4], float mean, float rstd, const float* sh, const float* sc, bf16* hrow, int lane) {
#pragma unroll
    for (int j = 0; j < 4; ++j) { const int c = 4 * lane + 256 * j; const f32x4 s1 = *(const f32x4*)(sc + c) + 1.f, s0 = *(const f32x4*)(sh + c);
        const f32x4 h = (v[j] - mean) * rstd * s1 + s0; v2u w; w.x = pk2(h.x, h.y); w.y = pk2(h.z, h.w); *(v2u*)(hrow + c) = w; }
}
__device__ __forceinline__ void ln_phase(const float* xsrc, const float* Y, float* xout, bf16* H, const float* lng, const float* lnb, const float* sh, const float* sc, bool do_mod, int gw, int NGW, int lane) {
    for (int m = gw; m < M; m += NGW) {
        f32x4 v[4];
#pragma unroll
        for (int j = 0; j < 4; ++j) { const size_t o = (size_t)m * D + 4 * lane + 256 * j; v[j] = *(const f32x4*)(xsrc + o) * ALPHA + *(const f32x4*)(Y + o); }
        float mean, rstd; row_stats(v, mean, rstd, lane);
#pragma unroll
        for (int j = 0; j < 4; ++j) { const int c = 4 * lane + 256 * j; v[j] = (v[j] - mean) * rstd * *(const f32x4*)(lng + c) + *(const f32x4*)(lnb + c); *(f32x4*)(xout + (size_t)m * D + c) = v[j]; }
        if (do_mod) { row_stats(v, mean, rstd, lane); store_mod(v, mean, rstd, sh, sc, H + (size_t)m * D, lane); }
    }
}
__device__ __forceinline__ void mod_phase(const float* x, bf16* H, const float* sh, const float* sc, int gw, int NGW, int lane) {
    for (int m = gw; m < M; m += NGW) {
        f32x4 v[4];
#pragma unroll
        for (int j = 0; j < 4; ++j) v[j] = *(const f32x4*)(x + (size_t)m * D + 4 * lane + 256 * j);
        float mean, rstd; row_stats(v, mean, rstd, lane); store_mod(v, mean, rstd, sh, sc, H + (size_t)m * D, lane);
    }
}
__device__ __forceinline__ void ada_phase(CA a, LAS unsigned char* lds, int tid, int lane, int wave, int bid) {
    LAS float* cact = (LAS float*)lds; LAS float* part = cact + 1024;
    for (int i = tid; i < D; i += NTHR) { const float c = a->in[1][i]; cact[i] = c * sigm(c); }
    __syncthreads();
    float* ADA = (float*)(a->ws + WS_ADA);
    for (int task = bid; task < NL * 144; task += gridDim.x) {
        const int l = task / 144, col = (task % 144) * 64 + lane; const float* W = a->in[2] + (size_t)l * D * 9216 + col; float s = 0.f;
#pragma unroll 16
        for (int k = wave * 128; k < wave * 128 + 128; ++k) s += cact[k] * W[(size_t)k * 9216];
        part[wave * 64 + lane] = s; __syncthreads();
        if (wave == 0) { float t = 0.f;
#pragma unroll
            for (int w = 0; w < 8; ++w) t += part[w * 64 + lane];
            ADA[l * 9216 + col] = t + a->in[3][l * 9216 + col]; }
        __syncthreads();
    }
}

__device__ __forceinline__ void fscan_head(const bf16* Z, const float* fbias, float* FL2, int h, LAS unsigned char* lds, int tid, int lane, int wave) {
    LAS float* wt = (LAS float*)lds; const float fb = fbias[h]; float lf[32]; float run = 0.f;
#pragma unroll
    for (int i = 0; i < 32; ++i) { const float x = bf1(Z[(size_t)(tid * 32 + i) * ZP + ZFL + h]) + fb; run += -softplus_(-x); lf[i] = run; }
    float inc = run;
#pragma unroll
    for (int o = 1; o < 64; o <<= 1) { const float t = __builtin_bit_cast(float, __builtin_amdgcn_ds_bpermute(((lane - o) & 63) << 2, __builtin_bit_cast(int, inc))); if (lane >= o) inc += t; }
    if (lane == 63) wt[wave] = inc;
    __syncthreads();
    float base = inc - run;
    for (int w = 0; w < wave; ++w) base += wt[w];
#pragma unroll
    for (int i = 0; i < 32; ++i) FL2[(size_t)h * M + tid * 32 + i] = (base + lf[i]) * LOG2E;
    __syncthreads();
}
__device__ __forceinline__ void codes_phase(const bf16* Z, const float* mu, bf16* CODES, int gtid, int NGT) {
    for (int it = gtid; it < M * 32; it += NGT) { const int t = it >> 5, j0 = (it & 31) * 8;
        const v4u z = *(const v4u*)(Z + (size_t)t * ZP + ZRW + 1536 + j0); v4u zp = (v4u){0u, 0u, 0u, 0u};
        if (t > 0) zp = *(const v4u*)(Z + (size_t)(t - 1) * ZP + ZRW + 1536 + j0);
        float o[8];
#pragma unroll
        for (int q = 0; q < 4; ++q) { const float a0 = bflo(z[q]), a1 = bfhi(z[q]), p0 = bflo(zp[q]), p1 = bfhi(zp[q]); const float m0 = mu[1536 + j0 + 2 * q], m1 = mu[1536 + j0 + 2 * q + 1];
            o[2 * q] = a0 + (p0 - a0) * m0; o[2 * q + 1] = a1 + (p1 - a1) * m1; }
#pragma unroll
        for (int q = 0; q < 8; ++q) { if (j0 < 64) o[q] = tanh_(o[q]); else if (j0 >= 128) o[q] = sigm(o[q]); }
        v4u w; w.x = pk2(o[0], o[1]); w.y = pk2(o[2], o[3]); w.z = pk2(o[4], o[5]); w.w = pk2(o[6], o[7]); *(v4u*)(CODES + (size_t)t * 256 + j0) = w; }
}
__device__ __forceinline__ void lru_l1(CA a, int l, const bf16* Z, bf16* HLOC, bf16* ACUM, float* AEND, float* HEND, LAS unsigned char* lds, int tid, int lane, int wave, int bid) {
    LAS float* xcf = (LAS float*)lds; LAS bf16* xcb = (LAS bf16*)(lds + 16640); LAS bf16* wga = (LAS bf16*)(lds + 25856); LAS bf16* wgx = (LAS bf16*)(lds + 35072);
    LAS float* la = (LAS float*)(lds + 44288); LAS float* lu = (LAS float*)(lds + 60928); LAS float* agg = (LAS float*)(lds + 77568);
    const float* cw = a->in[10] + (size_t)l * 4 * D; const float* cb = a->in[11] + (size_t)l * D;
    const float* gaw = a->in[12] + (size_t)l * 16 * 4096; const float* gab = a->in[13] + (size_t)l * D;
    const float* gxw = a->in[14] + (size_t)l * 16 * 4096; const float* gxb = a->in[15] + (size_t)l * D; const float* lam = a->in[16] + (size_t)l * D;
    int nprev = -1;
    for (int task = bid; task < NCH * 16; task += gridDim.x) {
        const int c = task >> 4, n = task & 15, t0 = c * LC;
        {
            const int tok = tid >> 3, cg8 = (tid & 7) * 8, ch0 = n * 64 + cg8; float acc[8];
#pragma unroll
            for (int q = 0; q < 8; ++q) acc[q] = cb[ch0 + q];
#pragma unroll
            for (int j = 0; j < 4; ++j) { const int tt = t0 + tok - 3 + j;
                if (tt >= 0) { const v4u x = *(const v4u*)(Z + (size_t)tt * ZP + ZXB + ch0);
#pragma unroll
                    for (int q = 0; q < 4; ++q) { acc[2 * q] += cw[j * D + ch0 + 2 * q] * bflo(x[q]); acc[2 * q + 1] += cw[j * D + ch0 + 2 * q + 1] * bfhi(x[q]); } } }
#pragma unroll
            for (int q = 0; q < 8; ++q) xcf[tok * 65 + cg8 + q] = acc[q];
            v4u w; w.x = pk2(acc[0], acc[1]); w.y = pk2(acc[2], acc[3]); w.z = pk2(acc[4], acc[5]); w.w = pk2(acc[6], acc[7]); *(LAS v4u*)(xcb + tok * 72 + cg8) = w;
        }
        if (n != nprev) {
            const int i = tid >> 3, j0 = (tid & 7) * 8;
#pragma unroll
            for (int q = 0; q < 8; ++q) { wga[(j0 + q) * 72 + i] = (bf16)f2bf(gaw[(size_t)n * 4096 + i * 64 + j0 + q]); wgx[(j0 + q) * 72 + i] = (bf16)f2bf(gxw[(size_t)n * 4096 + i * 64 + j0 + q]); }
            nprev = n;
        }
        __syncthreads();
        {
            const int tb = wave & 3, cbp = wave >> 2, fr = lane & 15, fq = lane >> 4;
            bf16x8 af[2];
#pragma unroll
            for (int kk = 0; kk < 2; ++kk) af[kk] = *(const LAS bf16x8*)(xcb + (tb * 16 + fr) * 72 + kk * 32 + fq * 8);
#pragma unroll
            for (int c2 = 0; c2 < 2; ++c2) { const int cbk = 2 * cbp + c2; f32x4 ar = (f32x4){0.f, 0.f, 0.f, 0.f}, ai = ar;
#pragma unroll
                for (int kk = 0; kk < 2; ++kk) { const bf16x8 b0 = *(const LAS bf16x8*)(wga + (cbk * 16 + fr) * 72 + kk * 32 + fq * 8), b1 = *(const LAS bf16x8*)(wgx + (cbk * 16 + fr) * 72 + kk * 32 + fq * 8);
                    ar = __builtin_amdgcn_mfma_f32_16x16x32_bf16(af[kk], b0, ar, 0, 0, 0); ai = __builtin_amdgcn_mfma_f32_16x16x32_bf16(af[kk], b1, ai, 0, 0, 0); }
                const int ch = cbk * 16 + fr, gch = n * 64 + ch; const float bga = gab[gch], bgx = gxb[gch], sp = log1pf(__expf(-lam[gch]));
#pragma unroll
                for (int rg = 0; rg < 4; ++rg) { const int tok = tb * 16 + fq * 4 + rg; const float r = sigm(ar[rg] + bga), ig = sigm(ai[rg] + bgx);
                    const float log_a = -8.f * r * sp, av = __expf(log_a), uv = sqrtf(-expm1f(2.f * log_a)) * (ig * xcf[tok * 65 + ch]);
                    la[tok * 65 + ch] = av; lu[tok * 65 + ch] = uv; } }
        }
        __syncthreads();
        {
            float hl[8], al[8]; float A = 1.f, h = 0.f;
#pragma unroll
            for (int s = 0; s < 8; ++s) { const float av = la[(wave * 8 + s) * 65 + lane], uv = lu[(wave * 8 + s) * 65 + lane]; h = av * h + uv; A *= av; hl[s] = h; al[s] = A; }
            agg[(wave * 2 + 0) * 64 + lane] = A; agg[(wave * 2 + 1) * 64 + lane] = h;
            __syncthreads();
            float cA = 1.f, cH = 0.f;
            for (int w = 0; w < wave; ++w) { const float A2 = agg[(w * 2 + 0) * 64 + lane], h2 = agg[(w * 2 + 1) * 64 + lane]; cH = A2 * cH + h2; cA *= A2; }
            float hf = 0.f, Af = 1.f;
#pragma unroll
            for (int s = 0; s < 8; ++s) { hf = hl[s] + al[s] * cH; Af = al[s] * cA; const size_t o = (size_t)(t0 + wave * 8 + s) * D + n * 64 + lane; HLOC[o] = (bf16)f2bf(hf); ACUM[o] = (bf16)f2bf(Af); }
            if (wave == 7) { AEND[c * D + n * 64 + lane] = Af; HEND[c * D + n * 64 + lane] = hf; }
        }
        __syncthreads();
    }
}
__device__ __forceinline__ void lru_l2(const float* AEND, const float* HEND, float* CAR, int gw, int lane) {
    if (gw < 16) { const int ch = gw * 64 + lane; float carry = 0.f;
#pragma unroll 8
        for (int c = 0; c < NCH; ++c) { CAR[c * D + ch] = carry; carry = AEND[c * D + ch] * carry + HEND[c * D + ch]; } }
}
__device__ __forceinline__ void lru_l3(bf16* Z, const bf16* HLOC, const bf16* ACUM, const float* CAR, int gtid, int NGT) {
    for (int it = gtid; it < M * 128; it += NGT) { const int t = it >> 7, ch0 = (it & 127) * 8; const size_t o = (size_t)t * D + ch0;
        const v4u hl = *(const v4u*)(HLOC + o), ac = *(const v4u*)(ACUM + o), yb = *(const v4u*)(Z + (size_t)t * ZP + ZYB + ch0);
        const f32x4 c0 = *(const f32x4*)(CAR + (t >> 6) * D + ch0), c1 = *(const f32x4*)(CAR + (t >> 6) * D + ch0 + 4); float o8[8];
#pragma unroll
        for (int q = 0; q < 4; ++q) { const float ca = (q < 2) ? c0[2 * q] : c1[2 * q - 4], cb_ = (q < 2) ? c0[2 * q + 1] : c1[2 * q - 3];
            o8[2 * q] = (bflo(hl[q]) + bflo(ac[q]) * ca) * gelu_tanh(bflo(yb[q])); o8[2 * q + 1] = (bfhi(hl[q]) + bfhi(ac[q]) * cb_) * gelu_tanh(bfhi(yb[q])); }
        v4u w; w.x = pk2(o8[0], o8[1]); w.y = pk2(o8[2], o8[3]); w.z = pk2(o8[4], o8[5]); w.w = pk2(o8[6], o8[7]); *(v4u*)(Z + (size_t)t * ZP + ZYB + ch0) = w; }
}
__device__ __forceinline__ void ld8bf(const bf16* p, float (&o)[8]) { const v4u u = *(const v4u*)p;
#pragma unroll
    for (int q = 0; q < 4; ++q) { o[2 * q] = bflo(u[q]); o[2 * q + 1] = bfhi(u[q]); } }
__device__ __forceinline__ void ld8f(const float* p, float (&o)[8]) { const f32x4 a = *(const f32x4*)p, b = *(const f32x4*)(p + 4); o[0] = a.x; o[1] = a.y; o[2] = a.z; o[3] = a.w; o[4] = b.x; o[5] = b.y; o[6] = b.z; o[7] = b.w; }
__device__ __forceinline__ void st8bf(bf16* p, const float (&v)[8]) { v4u w; w.x = pk2(v[0], v[1]); w.y = pk2(v[2], v[3]); w.z = pk2(v[4], v[5]); w.w = pk2(v[6], v[7]); *(v4u*)p = w; }
__device__ __forceinline__ float sum8lanes(float v, int lane) { v += shx(v, 1, lane); v += shx(v, 2, lane); v += shx(v, 4, lane); return v; }
__device__ __forceinline__ void rw_prep(CA a, int l, const bf16* Z, const bf16* LORA, float* Wd, bf16* R, bf16* KF, bf16* V, bf16* KK, bf16* Bv, bf16* GB, float* BON, int gw, int NGW, int lane) {
    const int c0 = 8 * lane;
    float mur[8], muk[8], muv[8], w0[8], a0[8], kk_[8], ka_[8], rk_[8];
    ld8f(a->in[17] + (size_t)l * 1792 + c0, mur); ld8f(a->in[17] + (size_t)l * 1792 + 512 + c0, muk); ld8f(a->in[17] + (size_t)l * 1792 + 1024 + c0, muv);
    ld8f(a->in[18] + (size_t)l * 512 + c0, w0); ld8f(a->in[20] + (size_t)l * 512 + c0, a0); ld8f(a->in[23] + (size_t)l * 512 + c0, kk_); ld8f(a->in[24] + (size_t)l * 512 + c0, ka_); ld8f(a->in[25] + (size_t)l * 512 + c0, rk_);
    for (int tb = gw * 8; tb < M; tb += NGW * 8) {
        float rp[8], kp[8], vp[8];
        if (tb > 0) { const bf16* zp = Z + (size_t)(tb - 1) * ZP + ZRW + c0; ld8bf(zp, rp); ld8bf(zp + 512, kp); ld8bf(zp + 1024, vp); }
        else {
#pragma unroll
            for (int q = 0; q < 8; ++q) { rp[q] = 0.f; kp[q] = 0.f; vp[q] = 0.f; } }
#pragma unroll 2
        for (int tt = 0; tt < 8; ++tt) { const int t = tb + tt; const bf16* zc = Z + (size_t)t * ZP + ZRW + c0; float rc[8], kc[8], vc[8], lw[8], la[8];
            ld8bf(zc, rc); ld8bf(zc + 512, kc); ld8bf(zc + 1024, vc);
            const bf16* lo = LORA + (size_t)t * 1536 + c0; ld8bf(lo, lw); ld8bf(lo + 512, la); const v4u lg = *(const v4u*)(lo + 1024);
            float r[8], k[8], v[8], dec[8], av[8], kk[8], kf[8], bb[8]; float n2 = 0.f, bs = 0.f;
#pragma unroll
            for (int q = 0; q < 8; ++q) { r[q] = rc[q] + (rp[q] - rc[q]) * mur[q]; k[q] = kc[q] + (kp[q] - kc[q]) * muk[q]; v[q] = vc[q] + (vp[q] - vc[q]) * muv[q];
                const float wv = -softplus_(-(w0[q] + lw[q])) - 0.5f; dec[q] = __expf(-__expf(wv)); av[q] = sigm(a0[q] + la[q]);
                kk[q] = k[q] * kk_[q]; n2 += kk[q] * kk[q]; kf[q] = k[q] * (1.f + (av[q] - 1.f) * ka_[q]); bs += r[q] * kf[q] * rk_[q];
                rp[q] = rc[q]; kp[q] = kc[q]; vp[q] = vc[q]; }
            n2 = sum8lanes(n2, lane); bs = sum8lanes(bs, lane); const float inv = 1.f / fmaxf(sqrtf(n2), 1e-12f);
#pragma unroll
            for (int q = 0; q < 8; ++q) { kk[q] *= inv; bb[q] = kk[q] * av[q]; }
            const size_t o = (size_t)t * 512 + c0;
            *(f32x4*)(Wd + o) = (f32x4){dec[0], dec[1], dec[2], dec[3]}; *(f32x4*)(Wd + o + 4) = (f32x4){dec[4], dec[5], dec[6], dec[7]};
            st8bf(R + o, r); st8bf(KF + o, kf); st8bf(V + o, v); st8bf(KK + o, kk); st8bf(Bv + o, bb); *(v4u*)(GB + o) = lg;
            if ((lane & 7) == 0) BON[t * 8 + (lane >> 3)] = bs; }
    }
}
constexpr int RW_PF = 4;
struct RwOps { unsigned kk[2], b[2], kf[2], r[2]; float w[4]; unsigned v; };
template <bool WITH_R> __device__ __forceinline__ RwOps rw_load(const unsigned char* ws, const RwSet rs, size_t o  , int lane) {
    RwOps x; const int i4 = (lane & 15) * 4;
#pragma unroll
    for (int j = 0; j < 2; ++j) { x.kk[j] = *(const unsigned*)(ws + rs.kk + o * 2 + 64 * j + i4); x.b[j] = *(const unsigned*)(ws + rs.b + o * 2 + 64 * j + i4); x.kf[j] = *(const unsigned*)(ws + rs.kf + o * 2 + 64 * j + i4);
        x.r[j] = WITH_R ? *(const unsigned*)(ws + rs.r + o * 2 + 64 * j + i4) : 0u; }
#pragma unroll
    for (int j = 0; j < 4; ++j) x.w[j] = *(const float*)(ws + rs.w + o * 4 + 64 * j + i4);
    x.v = *(const bf16*)(ws + WS_RW_V + o * 2 + lane * 2);
    return x;
}
#define FMAC_BC(acc, opv, y, n) asm("v_fmac_f32_dpp %0, %1, %2 row_newbcast:" #n " row_mask:0xf bank_mask:0xf" : "+v"(acc) : "v"(opv), "v"(y))
#define MUL_BC(dst, opv, y, n) asm("v_mul_f32_dpp %0, %1, %2 row_newbcast:" #n " row_mask:0xf bank_mask:0xf" : "=v"(dst) : "v"(opv), "v"(y))
#define RW_UNPACK(A, src) float A##l0 = __uint_as_float((src)[0] << 16), A##h0 = __uint_as_float((src)[0] & 0xffff0000u), A##l1 = __uint_as_float((src)[1] << 16), A##h1 = __uint_as_float((src)[1] & 0xffff0000u); \
    asm volatile("s_nop 1" : "+v"(A##l0), "+v"(A##h0), "+v"(A##l1), "+v"(A##h1))
template <int MODE> __device__ __forceinline__ float rw_step(float (&st)[64], const RwOps x) {
    RW_UNPACK(kk, x.kk); RW_UNPACK(bb, x.b); RW_UNPACK(kf, x.kf); RW_UNPACK(rr, x.r);
    float w0 = x.w[0], w1 = x.w[1], w2 = x.w[2], w3 = x.w[3]; asm volatile("" : "+v"(w0), "+v"(w1), "+v"(w2), "+v"(w3));
    float s0 = 0.f, s1 = 0.f, y0 = 0.f, y1 = 0.f; const float vv = __uint_as_float(x.v << 16);
    FMAC_BC(s0, kkl0, st[0], 0);
    FMAC_BC(s1, kkh0, st[1], 0);
    FMAC_BC(s0, kkl0, st[2], 1);
    FMAC_BC(s1, kkh0, st[3], 1);
    FMAC_BC(s0, kkl0, st[4], 2);
    FMAC_BC(s1, kkh0, st[5], 2);
    FMAC_BC(s0, kkl0, st[6], 3);
    FMAC_BC(s1, kkh0, st[7], 3);
    FMAC_BC(s0, kkl0, st[8], 4);
    FMAC_BC(s1, kkh0, st[9], 4);
    FMAC_BC(s0, kkl0, st[10], 5);
    FMAC_BC(s1, kkh0, st[11], 5);
    FMAC_BC(s0, kkl0, st[12], 6);
    FMAC_BC(s1, kkh0, st[13], 6);
    FMAC_BC(s0, kkl0, st[14], 7);
    FMAC_BC(s1, kkh0, st[15], 7);
    FMAC_BC(s0, kkl0, st[16], 8);
    FMAC_BC(s1, kkh0, st[17], 8);
    FMAC_BC(s0, kkl0, st[18], 9);
    FMAC_BC(s1, kkh0, st[19], 9);
    FMAC_BC(s0, kkl0, st[20], 10);
    FMAC_BC(s1, kkh0, st[21], 10);
    FMAC_BC(s0, kkl0, st[22], 11);
    FMAC_BC(s1, kkh0, st[23], 11);
    FMAC_BC(s0, kkl0, st[24], 12);
    FMAC_BC(s1, kkh0, st[25], 12);
    FMAC_BC(s0, kkl0, st[26], 13);
    FMAC_BC(s1, kkh0, st[27], 13);
    FMAC_BC(s0, kkl0, st[28], 14);
    FMAC_BC(s1, kkh0, st[29], 14);
    FMAC_BC(s0, kkl0, st[30], 15);
    FMAC_BC(s1, kkh0, st[31], 15);
    FMAC_BC(s0, kkl1, st[32], 0);
    FMAC_BC(s1, kkh1, st[33], 0);
    FMAC_BC(s0, kkl1, st[34], 1);
    FMAC_BC(s1, kkh1, st[35], 1);
    FMAC_BC(s0, kkl1, st[36], 2);
    FMAC_BC(s1, kkh1, st[37], 2);
    FMAC_BC(s0, kkl1, st[38], 3);
    FMAC_BC(s1, kkh1, st[39], 3);
    FMAC_BC(s0, kkl1, st[40], 4);
    FMAC_BC(s1, kkh1, st[41], 4);
    FMAC_BC(s0, kkl1, st[42], 5);
    FMAC_BC(s1, kkh1, st[43], 5);
    FMAC_BC(s0, kkl1, st[44], 6);
    FMAC_BC(s1, kkh1, st[45], 6);
    FMAC_BC(s0, kkl1, st[46], 7);
    FMAC_BC(s1, kkh1, st[47], 7);
    FMAC_BC(s0, kkl1, st[48], 8);
    FMAC_BC(s1, kkh1, st[49], 8);
    FMAC_BC(s0, kkl1, st[50], 9);
    FMAC_BC(s1, kkh1, st[51], 9);
    FMAC_BC(s0, kkl1, st[52], 10);
    FMAC_BC(s1, kkh1, st[53], 10);
    FMAC_BC(s0, kkl1, st[54], 11);
    FMAC_BC(s1, kkh1, st[55], 11);
    FMAC_BC(s0, kkl1, st[56], 12);
    FMAC_BC(s1, kkh1, st[57], 12);
    FMAC_BC(s0, kkl1, st[58], 13);
    FMAC_BC(s1, kkh1, st[59], 13);
    FMAC_BC(s0, kkl1, st[60], 14);
    FMAC_BC(s1, kkh1, st[61], 14);
    FMAC_BC(s0, kkl1, st[62], 15);
    FMAC_BC(s1, kkh1, st[63], 15);
    const float sa = -(s0 + s1);
    float t;
    MUL_BC(t, bbl0, sa, 0); if (MODE != 0) FMAC_BC(t, kfl0, vv, 0); FMAC_BC(t, w0, st[0], 0); st[0] = t; if (MODE == 2) FMAC_BC(y0, rrl0, t, 0);
    MUL_BC(t, bbh0, sa, 0); if (MODE != 0) FMAC_BC(t, kfh0, vv, 0); FMAC_BC(t, w0, st[1], 1); st[1] = t; if (MODE == 2) FMAC_BC(y1, rrh0, t, 0);
    MUL_BC(t, bbl0, sa, 1); if (MODE != 0) FMAC_BC(t, kfl0, vv, 1); FMAC_BC(t, w0, st[2], 2); st[2] = t; if (MODE == 2) FMAC_BC(y0, rrl0, t, 1);
    MUL_BC(t, bbh0, sa, 1); if (MODE != 0) FMAC_BC(t, kfh0, vv, 1); FMAC_BC(t, w0, st[3], 3); st[3] = t; if (MODE == 2) FMAC_BC(y1, rrh0, t, 1);
    MUL_BC(t, bbl0, sa, 2); if (MODE != 0) FMAC_BC(t, kfl0, vv, 2); FMAC_BC(t, w0, st[4], 4); st[4] = t; if (MODE == 2) FMAC_BC(y0, rrl0, t, 2);
    MUL_BC(t, bbh0, sa, 2); if (MODE != 0) FMAC_BC(t, kfh0, vv, 2); FMAC_BC(t, w0, st[5], 5); st[5] = t; if (MODE == 2) FMAC_BC(y1, rrh0, t, 2);
    MUL_BC(t, bbl0, sa, 3); if (MODE != 0) FMAC_BC(t, kfl0, vv, 3); FMAC_BC(t, w0, st[6], 6); st[6] = t; if (MODE == 2) FMAC_BC(y0, rrl0, t, 3);
    MUL_BC(t, bbh0, sa, 3); if (MODE != 0) FMAC_BC(t, kfh0, vv, 3); FMAC_BC(t, w0, st[7], 7); st[7] = t; if (MODE == 2) FMAC_BC(y1, rrh0, t, 3);
    MUL_BC(t, bbl0, sa, 4); if (MODE != 0) FMAC_BC(t, kfl0, vv, 4); FMAC_BC(t, w0, st[8], 8); st[8] = t; if (MODE == 2) FMAC_BC(y0, rrl0, t, 4);
    MUL_BC(t, bbh0, sa, 4); if (MODE != 0) FMAC_BC(t, kfh0, vv, 4); FMAC_BC(t, w0, st[9], 9); st[9] = t; if (MODE == 2) FMAC_BC(y1, rrh0, t, 4);
    MUL_BC(t, bbl0, sa, 5); if (MODE != 0) FMAC_BC(t, kfl0, vv, 5); FMAC_BC(t, w0, st[10], 10); st[10] = t; if (MODE == 2) FMAC_BC(y0, rrl0, t, 5);
    MUL_BC(t, bbh0, sa, 5); if (MODE != 0) FMAC_BC(t, kfh0, vv, 5); FMAC_BC(t, w0, st[11], 11); st[11] = t; if (MODE == 2) FMAC_BC(y1, rrh0, t, 5);
    MUL_BC(t, bbl0, sa, 6); if (MODE != 0) FMAC_BC(t, kfl0, vv, 6); FMAC_BC(t, w0, st[12], 12); st[12] = t; if (MODE == 2) FMAC_BC(y0, rrl0, t, 6);
    MUL_BC(t, bbh0, sa, 6); if (MODE != 0) FMAC_BC(t, kfh0, vv, 6); FMAC_BC(t, w0, st[13], 13); st[13] = t; if (MODE == 2) FMAC_BC(y1, rrh0, t, 6);
    MUL_BC(t, bbl0, sa, 7); if (MODE != 0) FMAC_BC(t, kfl0, vv, 7); FMAC_BC(t, w0, st[14], 14); st[14] = t; if (MODE == 2) FMAC_BC(y0, rrl0, t, 7);
    MUL_BC(t, bbh0, sa, 7); if (MODE != 0) FMAC_BC(t, kfh0, vv, 7); FMAC_BC(t, w0, st[15], 15); st[15] = t; if (MODE == 2) FMAC_BC(y1, rrh0, t, 7);
    MUL_BC(t, bbl0, sa, 8); if (MODE != 0) FMAC_BC(t, kfl0, vv, 8); FMAC_BC(t, w1, st[16], 0); st[16] = t; if (MODE == 2) FMAC_BC(y0, rrl0, t, 8);
    MUL_BC(t, bbh0, sa, 8); if (MODE != 0) FMAC_BC(t, kfh0, vv, 8); FMAC_BC(t, w1, st[17], 1); st[17] = t; if (MODE == 2) FMAC_BC(y1, rrh0, t, 8);
    MUL_BC(t, bbl0, sa, 9); if (MODE != 0) FMAC_BC(t, kfl0, vv, 9); FMAC_BC(t, w1, st[18], 2); st[18] = t; if (MODE == 2) FMAC_BC(y0, rrl0, t, 9);
    MUL_BC(t, bbh0, sa, 9); if (MODE != 0) FMAC_BC(t, kfh0, vv, 9); FMAC_BC(t, w1, st[19], 3); st[19] = t; if (MODE == 2) FMAC_BC(y1, rrh0, t, 9);
    MUL_BC(t, bbl0, sa, 10); if (MODE != 0) FMAC_BC(t, kfl0, vv, 10); FMAC_BC(t, w1, st[20], 4); st[20] = t; if (MODE == 2) FMAC_BC(y0, rrl0, t, 10);
    MUL_BC(t, bbh0, sa, 10); if (MODE != 0) FMAC_BC(t, kfh0, vv, 10); FMAC_BC(t, w1, st[21], 5); st[21] = t; if (MODE == 2) FMAC_BC(y1, rrh0, t, 10);
    MUL_BC(t, bbl0, sa, 11); if (MODE != 0) FMAC_BC(t, kfl0, vv, 11); FMAC_BC(t, w1, st[22], 6); st[22] = t; if (MODE == 2) FMAC_BC(y0, rrl0, t, 11);
    MUL_BC(t, bbh0, sa, 11); if (MODE != 0) FMAC_BC(t, kfh0, vv, 11); FMAC_BC(t, w1, st[23], 7); st[23] = t; if (MODE == 2) FMAC_BC(y1, rrh0, t, 11);
    MUL_BC(t, bbl0, sa, 12); if (MODE != 0) FMAC_BC(t, kfl0, vv, 12); FMAC_BC(t, w1, st[24], 8); st[24] = t; if (MODE == 2) FMAC_BC(y0, rrl0, t, 12);
    MUL_BC(t, bbh0, sa, 12); if (MODE != 0) FMAC_BC(t, kfh0, vv, 12); FMAC_BC(t, w1, st[25], 9); st[25] = t; if (MODE == 2) FMAC_BC(y1, rrh0, t, 12);
    MUL_BC(t, bbl0, sa, 13); if (MODE != 0) FMAC_BC(t, kfl0, vv, 13); FMAC_BC(t, w1, st[26], 10); st[26] = t; if (MODE == 2) FMAC_BC(y0, rrl0, t, 13);
    MUL_BC(t, bbh0, sa, 13); if (MODE != 0) FMAC_BC(t, kfh0, vv, 13); FMAC_BC(t, w1, st[27], 11); st[27] = t; if (MODE == 2) FMAC_BC(y1, rrh0, t, 13);
    MUL_BC(t, bbl0, sa, 14); if (MODE != 0) FMAC_BC(t, kfl0, vv, 14); FMAC_BC(t, w1, st[28], 12); st[28] = t; if (MODE == 2) FMAC_BC(y0, rrl0, t, 14);
    MUL_BC(t, bbh0, sa, 14); if (MODE != 0) FMAC_BC(t, kfh0, vv, 14); FMAC_BC(t, w1, st[29], 13); st[29] = t; if (MODE == 2) FMAC_BC(y1, rrh0, t, 14);
    MUL_BC(t, bbl0, sa, 15); if (MODE != 0) FMAC_BC(t, kfl0, vv, 15); FMAC_BC(t, w1, st[30], 14); st[30] = t; if (MODE == 2) FMAC_BC(y0, rrl0, t, 15);
    MUL_BC(t, bbh0, sa, 15); if (MODE != 0) FMAC_BC(t, kfh0, vv, 15); FMAC_BC(t, w1, st[31], 15); st[31] = t; if (MODE == 2) FMAC_BC(y1, rrh0, t, 15);
    MUL_BC(t, bbl1, sa, 0); if (MODE != 0) FMAC_BC(t, kfl1, vv, 0); FMAC_BC(t, w2, st[32], 0); st[32] = t; if (MODE == 2) FMAC_BC(y0, rrl1, t, 0);
    MUL_BC(t, bbh1, sa, 0); if (MODE != 0) FMAC_BC(t, kfh1, vv, 0); FMAC_BC(t, w2, st[33], 1); st[33] = t; if (MODE == 2) FMAC_BC(y1, rrh1, t, 0);
    MUL_BC(t, bbl1, sa, 1); if (MODE != 0) FMAC_BC(t, kfl1, vv, 1); FMAC_BC(t, w2, st[34], 2); st[34] = t; if (MODE == 2) FMAC_BC(y0, rrl1, t, 1);
    MUL_BC(t, bbh1, sa, 1); if (MODE != 0) FMAC_BC(t, kfh1, vv, 1); FMAC_BC(t, w2, st[35], 3); st[35] = t; if (MODE == 2) FMAC_BC(y1, rrh1, t, 1);
    MUL_BC(t, bbl1, sa, 2); if (MODE != 0) FMAC_BC(t, kfl1, vv, 2); FMAC_BC(t, w2, st[36], 4); st[36] = t; if (MODE == 2) FMAC_BC(y0, rrl1, t, 2);
    MUL_BC(t, bbh1, sa, 2); if (MODE != 0) FMAC_BC(t, kfh1, vv, 2); FMAC_BC(t, w2, st[37], 5); st[37] = t; if (MODE == 2) FMAC_BC(y1, rrh1, t, 2);
    MUL_BC(t, bbl1, sa, 3); if (MODE != 0) FMAC_BC(t, kfl1, vv, 3); FMAC_BC(t, w2, st[38], 6); st[38] = t; if (MODE == 2) FMAC_BC(y0, rrl1, t, 3);
    MUL_BC(t, bbh1, sa, 3); if (MODE != 0) FMAC_BC(t, kfh1, vv, 3); FMAC_BC(t, w2, st[39], 7); st[39] = t; if (MODE == 2) FMAC_BC(y1, rrh1, t, 3);
    MUL_BC(t, bbl1, sa, 4); if (MODE != 0) FMAC_BC(t, kfl1, vv, 4); FMAC_BC(t, w2, st[40], 8); st[40] = t; if (MODE == 2) FMAC_BC(y0, rrl1, t, 4);
    MUL_BC(t, bbh1, sa, 4); if (MODE != 0) FMAC_BC(t, kfh1, vv, 4); FMAC_BC(t, w2, st[41], 9); st[41] = t; if (MODE == 2) FMAC_BC(y1, rrh1, t, 4);
    MUL_BC(t, bbl1, sa, 5); if (MODE != 0) FMAC_BC(t, kfl1, vv, 5); FMAC_BC(t, w2, st[42], 10); st[42] = t; if (MODE == 2) FMAC_BC(y0, rrl1, t, 5);
    MUL_BC(t, bbh1, sa, 5); if (MODE != 0) FMAC_BC(t, kfh1, vv, 5); FMAC_BC(t, w2, st[43], 11); st[43] = t; if (MODE == 2) FMAC_BC(y1, rrh1, t, 5);
    MUL_BC(t, bbl1, sa, 6); if (MODE != 0) FMAC_BC(t, kfl1, vv, 6); FMAC_BC(t, w2, st[44], 12); st[44] = t; if (MODE == 2) FMAC_BC(y0, rrl1, t, 6);
    MUL_BC(t, bbh1, sa, 6); if (MODE != 0) FMAC_BC(t, kfh1, vv, 6); FMAC_BC(t, w2, st[45], 13); st[45] = t; if (MODE == 2) FMAC_BC(y1, rrh1, t, 6);
    MUL_BC(t, bbl1, sa, 7); if (MODE != 0) FMAC_BC(t, kfl1, vv, 7); FMAC_BC(t, w2, st[46], 14); st[46] = t; if (MODE == 2) FMAC_BC(y0, rrl1, t, 7);
    MUL_BC(t, bbh1, sa, 7); if (MODE != 0) FMAC_BC(t, kfh1, vv, 7); FMAC_BC(t, w2, st[47], 15); st[47] = t; if (MODE == 2) FMAC_BC(y1, rrh1, t, 7);
    MUL_BC(t, bbl1, sa, 8); if (MODE != 0) FMAC_BC(t, kfl1, vv, 8); FMAC_BC(t, w3, st[48], 0); st[48] = t; if (MODE == 2) FMAC_BC(y0, rrl1, t, 8);
    MUL_BC(t, bbh1, sa, 8); if (MODE != 0) FMAC_BC(t, kfh1, vv, 8); FMAC_BC(t, w3, st[49], 1); st[49] = t; if (MODE == 2) FMAC_BC(y1, rrh1, t, 8);
    MUL_BC(t, bbl1, sa, 9); if (MODE != 0) FMAC_BC(t, kfl1, vv, 9); FMAC_BC(t, w3, st[50], 2); st[50] = t; if (MODE == 2) FMAC_BC(y0, rrl1, t, 9);
    MUL_BC(t, bbh1, sa, 9); if (MODE != 0) FMAC_BC(t, kfh1, vv, 9); FMAC_BC(t, w3, st[51], 3); st[51] = t; if (MODE == 2) FMAC_BC(y1, rrh1, t, 9);
    MUL_BC(t, bbl1, sa, 10); if (MODE != 0) FMAC_BC(t, kfl1, vv, 10); FMAC_BC(t, w3, st[52], 4); st[52] = t; if (MODE == 2) FMAC_BC(y0, rrl1, t, 10);
    MUL_BC(t, bbh1, sa, 10); if (MODE != 0) FMAC_BC(t, kfh1, vv, 10); FMAC_BC(t, w3, st[53], 5); st[53] = t; if (MODE == 2) FMAC_BC(y1, rrh1, t, 10);
    MUL_BC(t, bbl1, sa, 11); if (MODE != 0) FMAC_BC(t, kfl1, vv, 11); FMAC_BC(t, w3, st[54], 6); st[54] = t; if (MODE == 2) FMAC_BC(y0, rrl1, t, 11);
    MUL_BC(t, bbh1, sa, 11); if (MODE != 0) FMAC_BC(t, kfh1, vv, 11); FMAC_BC(t, w3, st[55], 7); st[55] = t; if (MODE == 2) FMAC_BC(y1, rrh1, t, 11);
    MUL_BC(t, bbl1, sa, 12); if (MODE != 0) FMAC_BC(t, kfl1, vv, 12); FMAC_BC(t, w3, st[56], 8); st[56] = t; if (MODE == 2) FMAC_BC(y0, rrl1, t, 12);
    MUL_BC(t, bbh1, sa, 12); if (MODE != 0) FMAC_BC(t, kfh1, vv, 12); FMAC_BC(t, w3, st[57], 9); st[57] = t; if (MODE == 2) FMAC_BC(y1, rrh1, t, 12);
    MUL_BC(t, bbl1, sa, 13); if (MODE != 0) FMAC_BC(t, kfl1, vv, 13); FMAC_BC(t, w3, st[58], 10); st[58] = t; if (MODE == 2) FMAC_BC(y0, rrl1, t, 13);
    MUL_BC(t, bbh1, sa, 13); if (MODE != 0) FMAC_BC(t, kfh1, vv, 13); FMAC_BC(t, w3, st[59], 11); st[59] = t; if (MODE == 2) FMAC_BC(y1, rrh1, t, 13);
    MUL_BC(t, bbl1, sa, 14); if (MODE != 0) FMAC_BC(t, kfl1, vv, 14); FMAC_BC(t, w3, st[60], 12); st[60] = t; if (MODE == 2) FMAC_BC(y0, rrl1, t, 14);
    MUL_BC(t, bbh1, sa, 14); if (MODE != 0) FMAC_BC(t, kfh1, vv, 14); FMAC_BC(t, w3, st[61], 13); st[61] = t; if (MODE == 2) FMAC_BC(y1, rrh1, t, 14);
    MUL_BC(t, bbl1, sa, 15); if (MODE != 0) FMAC_BC(t, kfl1, vv, 15); FMAC_BC(t, w3, st[62], 14); st[62] = t; if (MODE == 2) FMAC_BC(y0, rrl1, t, 15);
    MUL_BC(t, bbh1, sa, 15); if (MODE != 0) FMAC_BC(t, kfh1, vv, 15); FMAC_BC(t, w3, st[63], 15); st[63] = t; if (MODE == 2) FMAC_BC(y1, rrh1, t, 15);
    return y0 + y1;
}
__device__ __forceinline__ void rw_r1(const unsigned char* ws, const RwSet rs, float* P, float* G, int gw, int NGW, int lane) {
    for (int T = gw; T < NCH * 8 * 2; T += NGW) { const int kind = T & 1, h = (T >> 1) & 7, c = T >> 4; float st[64];
        int ln_ = lane; asm volatile("" : "+v"(ln_));
#pragma unroll
        for (int k = 0; k < 64; ++k) st[k] = (kind == 0 && k == ln_) ? 1.f : 0.f;
        const size_t o0 = (size_t)(c * LC) * 512 + h * 64; RwOps q[RW_PF];
#pragma unroll
        for (int d = 0; d < RW_PF; ++d) q[d] = rw_load<false>(ws, rs, o0 + (size_t)d * 512, ln_);
        for (int tb = 0; tb < LC; tb += RW_PF) {
#pragma unroll
            for (int d = 0; d < RW_PF; ++d) { const RwOps x = q[d]; if (tb + d + RW_PF < LC) q[d] = rw_load<false>(ws, rs, o0 + (size_t)(tb + d + RW_PF) * 512, ln_);
                if (kind == 0) (void)rw_step<0>(st, x); else (void)rw_step<1>(st, x); } }
        float* dst = (kind == 0 ? P : G) + ((size_t)(h * NCH + c) * 64 + ln_) * 64;
#pragma unroll
        for (int k = 0; k < 64; k += 4) *(f32x4*)(dst + k) = (f32x4){st[k], st[k + 1], st[k + 2], st[k + 3]}; }
}
__device__ __forceinline__ void rw_r2(const float* P, const float* G, float* S0, LAS unsigned char* lds, int lane, int wave, int bid) {
    LAS float* red = (LAS float*)lds;
    for (int rp = bid; rp < 256; rp += gridDim.x) { const int h = rp >> 5, v0 = (rp & 31) * 2; float s0 = 0.f, s1 = 0.f;
        const float* Ph = P + (size_t)h * NCH * 4096 + (size_t)(8 * wave) * 64 + lane; const float* Gh = G + (size_t)h * NCH * 4096 + (size_t)v0 * 64 + lane; float* Sh = S0 + (size_t)h * NCH * 4096 + (size_t)v0 * 64 + lane;
        float pq[8][8], gq[8][2];
#pragma unroll
        for (int d = 0; d < 8; ++d) {
#pragma unroll
            for (int jj = 0; jj < 8; ++jj) pq[d][jj] = Ph[(size_t)d * 4096 + jj * 64];
            gq[d][0] = Gh[(size_t)d * 4096]; gq[d][1] = Gh[(size_t)d * 4096 + 64]; }
        for (int c0 = 0; c0 < NCH; c0 += 8) {
#pragma unroll
            for (int d = 0; d < 8; ++d) { const int c = c0 + d;
                if (wave == 0) { Sh[(size_t)c * 4096] = s0; Sh[(size_t)c * 4096 + 64] = s1; }
                float p0 = 0.f, p1 = 0.f;
#pragma unroll
                for (int jj = 0; jj < 8; ++jj) { const float a0 = __builtin_bit_cast(float, __builtin_amdgcn_readlane(__builtin_bit_cast(int, s0), 8 * wave + jj)), a1 = __builtin_bit_cast(float, __builtin_amdgcn_readlane(__builtin_bit_cast(int, s1), 8 * wave + jj));
                    p0 += a0 * pq[d][jj]; p1 += a1 * pq[d][jj]; }
                LAS float* rd = red + (c & 1) * 1024;
                rd[(0 * 64 + lane) * 8 + wave] = p0; rd[(1 * 64 + lane) * 8 + wave] = p1;
                const float g0 = gq[d][0], g1 = gq[d][1];
                { const int cn = (c + 8 < NCH) ? c + 8 : NCH - 1;
#pragma unroll
                    for (int jj = 0; jj < 8; ++jj) pq[d][jj] = Ph[(size_t)cn * 4096 + jj * 64];
                    gq[d][0] = Gh[(size_t)cn * 4096]; gq[d][1] = Gh[(size_t)cn * 4096 + 64]; }
                asm volatile("s_waitcnt lgkmcnt(0)\n\ts_barrier" ::: "memory");
                const f32x4 a0 = *(const LAS f32x4*)(rd + (0 * 64 + lane) * 8), a1 = *(const LAS f32x4*)(rd + (0 * 64 + lane) * 8 + 4), b0 = *(const LAS f32x4*)(rd + (1 * 64 + lane) * 8), b1 = *(const LAS f32x4*)(rd + (1 * 64 + lane) * 8 + 4);
                s0 = g0 + (((a0.x + a0.y) + (a0.z + a0.w)) + ((a1.x + a1.y) + (a1.z + a1.w))); s1 = g1 + (((b0.x + b0.y) + (b0.z + b0.w)) + ((b1.x + b1.y) + (b1.z + b1.w))); }
        }
        __syncthreads();
    }
}
__device__ __forceinline__ void rw_r3(CA a, int l, const unsigned char* ws, const RwSet rs, const float* S0, const float* BON, bf16* RWO, LAS unsigned char* lds, int gw, int NGW, int lane, int wave) {
    LAS float* yl = (LAS float*)(lds + wave * 16640);
    const float* gnw = a->in[26] + (size_t)l * 512; const float* gnb = a->in[27] + (size_t)l * 512;
    const bf16* Vb = (const bf16*)(ws + WS_RW_V); const bf16* GB = (const bf16*)(ws + WS_GB);
    for (int T = gw; T < NCH * 8; T += NGW) { const int h = T & 7, c = T >> 3; float st[64];
        const float* src = S0 + ((size_t)(h * NCH + c) * 64 + lane) * 64;
#pragma unroll
        for (int k = 0; k < 64; k += 4) { const f32x4 v4 = *(const f32x4*)(src + k); st[k] = v4.x; st[k + 1] = v4.y; st[k + 2] = v4.z; st[k + 3] = v4.w; }
        {   const size_t o0 = (size_t)(c * LC) * 512 + h * 64; RwOps q[RW_PF];
#pragma unroll
            for (int d = 0; d < RW_PF; ++d) q[d] = rw_load<true>(ws, rs, o0 + (size_t)d * 512, lane);
            for (int tb = 0; tb < LC; tb += RW_PF) {
#pragma unroll
                for (int d = 0; d < RW_PF; ++d) { const RwOps x = q[d]; if (tb + d + RW_PF < LC) q[d] = rw_load<true>(ws, rs, o0 + (size_t)(tb + d + RW_PF) * 512, lane); yl[(tb + d) * 65 + lane] = rw_step<2>(st, x); } } }
        LDS_WAIT(); asm volatile("" ::: "memory");
        {
            const int t = c * LC + lane; float y[64]; float s = 0.f;
#pragma unroll
            for (int v = 0; v < 64; ++v) { y[v] = yl[lane * 65 + v]; s += y[v]; }
            const float mean = s * (1.f / 64.f); float q = 0.f;
#pragma unroll
            for (int v = 0; v < 64; ++v) { const float d = y[v] - mean; q += d * d; }
            const float rstd = 1.f / sqrtf(q * (1.f / 64.f) + GN_EPS); const float bon = BON[t * 8 + h];
            const size_t o = (size_t)t * 512 + h * 64;
#pragma unroll
            for (int v8 = 0; v8 < 64; v8 += 8) { const v4u vv = *(const v4u*)(Vb + o + v8), gg = *(const v4u*)(GB + o + v8); float ov[8];
#pragma unroll
                for (int q2 = 0; q2 < 4; ++q2) { const int v = v8 + 2 * q2;
                    ov[2 * q2] = ((y[v] - mean) * rstd * gnw[h * 64 + v] + gnb[h * 64 + v] + bon * bflo(vv[q2])) * bflo(gg[q2]);
                    ov[2 * q2 + 1] = ((y[v + 1] - mean) * rstd * gnw[h * 64 + v + 1] + gnb[h * 64 + v + 1] + bon * bfhi(vv[q2])) * bfhi(gg[q2]); }
                v4u w; w.x = pk2(ov[0], ov[1]); w.y = pk2(ov[2], ov[3]); w.z = pk2(ov[4], ov[5]); w.w = pk2(ov[6], ov[7]); *(v4u*)(RWO + o + v8) = w; }
        }
        LDS_WAIT(); asm volatile("" ::: "memory");
    }
}

#define XB_TMO      128
#define XB_XCNT(j)  (256  + 64 * (j))
#define XB_XSUB(j)  (1280 + 64 * (j))
#define XB_XGEN(j)  (2304 + 64 * (j))
#define XB_TOP      3328
#define XB_TOPGEN   3392
#define XCD_BAR_WORDS 3456
#define XB_SPIN_CAP (1u << 18)

__device__ __forceinline__ unsigned xb_ld(unsigned* p)              { return __hip_atomic_load(p, __ATOMIC_RELAXED, __HIP_MEMORY_SCOPE_AGENT); }
__device__ __forceinline__ unsigned xb_add(unsigned* p, unsigned v) { return __hip_atomic_fetch_add(p, v, __ATOMIC_RELAXED, __HIP_MEMORY_SCOPE_AGENT); }
__device__ __forceinline__ unsigned xb_xcc_id() { return (unsigned)__builtin_amdgcn_s_getreg((3 << 11) | 20) & 0xFu; }
#define XB_SPIN(cond, bar) do { unsigned _sp = 0; while (cond) { __builtin_amdgcn_s_sleep(1); \
    if ((++_sp & 255u) == 0u) { if (xb_ld(&(bar)[XB_TMO])) break; if (_sp > XB_SPIN_CAP) { atomicAdd(&(bar)[XB_TMO], 1u); break; } } } } while (0)

struct XcdBarrier {
    unsigned* bar; unsigned x;
    volatile LAS unsigned* st;
};

__device__ __forceinline__ XcdBarrier xcd_barrier_post(unsigned* bar, volatile LAS unsigned* st, unsigned xb_tid) {
    XcdBarrier b; b.bar = bar; b.x = xb_xcc_id(); b.st = st;
    if (xb_tid == 0) (void)xb_add(&bar[XB_XCNT(b.x)], 1u);
    return b;
}
__device__ __forceinline__ void xcd_barrier_complete(unsigned* bar, unsigned x, unsigned& nloc, unsigned& nx) {
    const unsigned G = gridDim.x * gridDim.y * gridDim.z;
    unsigned sum, cnt, mine, sp = 0u;
    for (;;) {
        sum = 0u; cnt = 0u; mine = 0u;
#pragma unroll
        for (unsigned j = 0; j < 16; ++j) { const unsigned c = xb_ld(&bar[XB_XCNT(j)]); sum += c; cnt += (c > 0u) ? 1u : 0u; mine = (j == x) ? c : mine; }
        if (sum == G) break;
        __builtin_amdgcn_s_sleep(1);
        if ((++sp & 255u) == 0u) { if (xb_ld(&bar[XB_TMO])) break; if (sp > XB_SPIN_CAP) { atomicAdd(&bar[XB_TMO], 1u); break; } }
    }
    nloc = mine > 0u ? mine : 1u; nx = cnt > 0u ? cnt : 1u;
}

__device__ __forceinline__ void xcd_barrier(const XcdBarrier& b, unsigned xb_tid) {
    asm volatile("s_waitcnt vmcnt(0)" ::: "memory");
    __syncthreads();
    if (xb_tid == 0) {
        unsigned* bar = b.bar;
        __builtin_amdgcn_s_waitcnt(0);
        unsigned nloc = b.st[0], nx = b.st[1];
        if (nloc == 0u) { xcd_barrier_complete(bar, b.x, nloc, nx); b.st[0] = nloc; b.st[1] = nx; }
        const unsigned old = xb_add(&bar[XB_XSUB(b.x)], 1u);
        const unsigned gen = old / nloc;
        if (old + 1u == (gen + 1u) * nloc) {
            __builtin_amdgcn_fence(__ATOMIC_RELEASE, "agent");
            asm volatile("s_waitcnt vmcnt(0)" ::: "memory");
            const unsigned og = xb_add(&bar[XB_TOP], 1u);
            const unsigned tg = og / nx;
            if (og + 1u == (tg + 1u) * nx) xb_add(&bar[XB_TOPGEN], 1u);
            else XB_SPIN(xb_ld(&bar[XB_TOPGEN]) == tg, bar);
            __builtin_amdgcn_fence(__ATOMIC_ACQUIRE, "agent");
            xb_add(&bar[XB_XGEN(b.x)], 1u);
            asm volatile("s_waitcnt vmcnt(0)" ::: "memory");
        } else {
            XB_SPIN(xb_ld(&bar[XB_XGEN(b.x)]) == gen, bar);
            __builtin_amdgcn_fence(__ATOMIC_ACQUIRE, "agent");
            asm volatile("s_waitcnt vmcnt(0)" ::: "memory");
        }
    }
    __syncthreads();
}

__device__ __forceinline__ unsigned char* args_ws_ptr() { CA a = (CA)__builtin_amdgcn_kernarg_segment_ptr(); return a->ws; }
__global__ void __launch_bounds__(NTHR, 2) fwd_mega(Args args_unused) {
    extern __shared__ __attribute__((aligned(16))) unsigned char lds_raw[];
    LAS unsigned char* lds = (LAS unsigned char*)lds_raw;
    cg::grid_group grid = cg::this_grid();
    const int G = gridDim.x, NGW = G * NWAVES, NGT = G * NTHR;
    const int wave_s = __builtin_amdgcn_readfirstlane((int)threadIdx.x >> 6);
#define FRESH_LANE() ({ unsigned m_ = ~0u; asm volatile("" : "+s"(m_)); (int)__builtin_amdgcn_mbcnt_hi(m_, __builtin_amdgcn_mbcnt_lo(m_, 0u)); })
#define CUR_TID() (wave_s * 64 + FRESH_LANE())
    if (CUR_TID() < 16) ((LAS unsigned*)(lds + MISC_OFF))[CUR_TID()] = 0u;
    __syncthreads();
    (void)xcd_barrier_post((unsigned*)args_ws_ptr(), (volatile LAS unsigned*)(lds + MISC_OFF), (unsigned)CUR_TID());
#define SYNC() do { XcdBarrier b_; { CA a_ = (CA)__builtin_amdgcn_kernarg_segment_ptr(); asm volatile("" : "+s"(a_)); b_.bar = (unsigned*)a_->ws; } b_.x = xb_xcc_id(); b_.st = (volatile LAS unsigned*)(lds + MISC_OFF); xcd_barrier(b_, (unsigned)CUR_TID()); } while (0)
#define PH_BEGIN { CA a = (CA)__builtin_amdgcn_kernarg_segment_ptr(); asm volatile("" : "+s"(a)); unsigned char* ws = a->ws; (void)ws; \
        int lane_l = FRESH_LANE(); asm volatile("" : "+v"(lane_l)); int bid_l = blockIdx.x; asm volatile("" : "+s"(bid_l)); int wave_l = wave_s; asm volatile("" : "+s"(wave_l)); \
        const int lane = lane_l, wave = wave_l, tid = wave * 64 + lane, bid = bid_l, gw = bid * NWAVES + wave, gtid = bid * NTHR + tid; (void)lane; (void)gtid; (void)gw; (void)wave;
#define PH_END }
#define WSP(T, off) ((T*)(ws + (off)))
#define ADA_L (WSP(float, WS_ADA) + l * 9216)
#define GEMM(EPI, Aptr, LDA, Bptr, N_, K_, ...) do { int kk_ = (K_); asm volatile("" : "+s"(kk_));   pg8::Gemm g_{(const pg8::bf16_t*)(Aptr), (const pg8::bf16_t*)(Bptr), M, (N_), kk_, (LDA)}; pg8::StaticOrder S_; S_.init(M, (N_), G, bid); \
        EPI E_{__VA_ARGS__}; pg8::gemm_phase<EPI, pg8::StaticOrder, PG8_ALIGN, PG8_SP2>(lds, g_, S_, E_, tid); } while (0)

    PH_BEGIN ada_phase(a, lds, tid, lane, wave, bid); PH_END
    grid.sync();
    PH_BEGIN mod_phase(a->in[0], WSP(bf16, WS_HB), WSP(float, WS_ADA), WSP(float, WS_ADA) + D, gw, NGW, lane); convert_layer(a, 0, lds, gw, NGW, wave, lane); PH_END
    SYNC();

    for (int l = 0; l < NL; ++l) {
        PH_BEGIN GEMM(EpiSwiGLU, WSP(bf16, WS_HB), D, ws + W_UP0, 2 * DFF, D, WSP(bf16, WS_ACT), DFF); PH_END
        SYNC();
        PH_BEGIN GEMM(EpiGateF32, WSP(bf16, WS_ACT), DFF, ws + W_DN0, D, DFF, WSP(float, WS_Y), ADA_L + 2 * D, 0.5f); PH_END
        SYNC();
        PH_BEGIN ln_phase(l == 0 ? a->in[0] : a->out, WSP(float, WS_Y), a->out, WSP(bf16, WS_HB), a->in[4] + (size_t)l * 3 * D, a->in[5] + (size_t)l * 3 * D, ADA_L + 3 * D, ADA_L + 4 * D, true, gw, NGW, lane); PH_END
        SYNC();
        PH_BEGIN GEMM(EpiIn, WSP(bf16, WS_HB), D, ws + W_IN, ZP, D, WSP(bf16, WS_Z)); PH_END
        SYNC();
        PH_BEGIN if (bid < 8) fscan_head(WSP(bf16, WS_Z), a->in[9] + l * 8, WSP(float, WS_FL2), bid, lds, tid, lane, wave); PH_END
        PH_BEGIN codes_phase(WSP(bf16, WS_Z), a->in[17] + (size_t)l * 1792, WSP(bf16, WS_CODES), gtid, NGT); PH_END
        PH_BEGIN lru_l1(a, l, WSP(bf16, WS_Z), WSP(bf16, WS_HLOC), WSP(bf16, WS_ACUM), WSP(float, WS_LAEND), WSP(float, WS_LHEND), lds, tid, lane, wave, bid); PH_END
        SYNC();
        PH_BEGIN GEMM(EpiPlain, ws + WS_CODES, 256, ws + W_LORA, 1536, 256, WSP(bf16, WS_LORA), 1536); PH_END
        PH_BEGIN lru_l2(WSP(const float, WS_LAEND), WSP(const float, WS_LHEND), WSP(float, WS_LCAR), gw, lane); PH_END
        SYNC();
        PH_BEGIN const RwSet rs = rw_set(l); rw_prep(a, l, WSP(bf16, WS_Z), WSP(const bf16, WS_LORA), WSP(float, rs.w), WSP(bf16, rs.r), WSP(bf16, rs.kf), WSP(bf16, WS_RW_V), WSP(bf16, rs.kk), WSP(bf16, rs.b), WSP(bf16, WS_GB), WSP(float, WS_BON), gw, NGW, lane); PH_END
        PH_BEGIN lru_l3(WSP(bf16, WS_Z), WSP(const bf16, WS_HLOC), WSP(const bf16, WS_ACUM), WSP(const float, WS_LCAR), gtid, NGT); PH_END
        SYNC();
        PH_BEGIN rw_r1(ws, rw_set(l), WSP(float, WS_P), WSP(float, WS_G), gw, NGW, lane); PH_END
        SYNC();
        PH_BEGIN rw_r2(WSP(const float, WS_P), WSP(const float, WS_G), WSP(float, WS_S0), lds, lane, wave, bid); PH_END
        SYNC();
        PH_BEGIN rw_r3(a, l, ws, rw_set(l), WSP(const float, WS_S0), WSP(const float, WS_BON), WSP(bf16, WS_RWO), lds, gw, NGW, lane, wave); PH_END
        __syncthreads();
        PH_BEGIN
            bf16* Zb = WSP(bf16, WS_Z);
            const attn_body::AttnTensors AT{(const attn_body::bf16*)(Zb + ZQ), (const attn_body::bf16*)(Zb + ZK), (const attn_body::bf16*)(Zb + ZV), (attn_body::bf16*)(Zb + ZXB), WSP(const float, WS_FL2)};
            const attn_body::StaticOrder S((int)G, bid);
            attn_body::attn_phase<attn_body::StaticOrder>((char*)lds_raw, AT, S, tid);
        PH_END
        SYNC();
        PH_BEGIN GEMM(EpiProj<0>, WSP(bf16, WS_Z) + ZXB, ZP, ws + W_PA, D, 512, WSP(float, WS_Y), WSP(bf16, WS_Z), WSP(bf16, WS_HB)); PH_END

        PH_BEGIN GEMM(EpiProj<1>, WSP(bf16, WS_Z) + ZYB, ZP, ws + W_PB, D, D, WSP(float, WS_Y), WSP(bf16, WS_Z), WSP(bf16, WS_HB)); PH_END

        PH_BEGIN GEMM(EpiProj<2>, ws + WS_RWO, 512, ws + W_PC, D, 512, WSP(float, WS_Y), WSP(bf16, WS_Z), WSP(bf16, WS_HB)); PH_END
        SYNC();
        PH_BEGIN GEMM(EpiGateF32, WSP(bf16, WS_HB), D, ws + W_OUT, D, D, WSP(float, WS_Y), ADA_L + 5 * D, 1.0f); PH_END
        SYNC();
        PH_BEGIN ln_phase(a->out, WSP(float, WS_Y), a->out, WSP(bf16, WS_HB), a->in[4] + (size_t)(l * 3 + 1) * D, a->in[5] + (size_t)(l * 3 + 1) * D, ADA_L + 6 * D, ADA_L + 7 * D, true, gw, NGW, lane); PH_END
        SYNC();
        PH_BEGIN GEMM(EpiSwiGLU, WSP(bf16, WS_HB), D, ws + W_UP1, 2 * DFF, D, WSP(bf16, WS_ACT), DFF); PH_END
        SYNC();
        PH_BEGIN GEMM(EpiGateF32, WSP(bf16, WS_ACT), DFF, ws + W_DN1, D, DFF, WSP(float, WS_Y), ADA_L + 8 * D, 0.5f); PH_END
        SYNC();
        PH_BEGIN ln_phase(a->out, WSP(float, WS_Y), a->out, WSP(bf16, WS_HB), a->in[4] + (size_t)(l * 3 + 2) * D, a->in[5] + (size_t)(l * 3 + 2) * D, ADA_L + 9216, ADA_L + 9216 + D, l + 1 < NL, gw, NGW, lane); PH_END
        if (l + 1 < NL) { PH_BEGIN convert_layer(a, l + 1, lds, gw, NGW, wave, lane); PH_END SYNC(); }
    }
#undef SYNC
#undef GEMM
}

extern "C" void kernel_launch(void* const* d_in, const int* in_sizes, int n_in, void* d_out, int out_size, void* d_ws, size_t ws_size, hipStream_t stream) {
    static int grid = 0;
    if (grid == 0) {
        if (n_in != 32 || out_size != M * D || ws_size < WS_END) { fprintf(stderr, "kernel_launch: unexpected shapes (n_in %d, out %d, ws %zu)\n", n_in, out_size, ws_size); grid = -1; return; }
        int dev = 0, cus = 0, per_cu = 0;
        hipGetDevice(&dev); hipDeviceGetAttribute(&cus, hipDeviceAttributeMultiprocessorCount, dev);
        hipFuncSetAttribute((const void*)fwd_mega, hipFuncAttributeMaxDynamicSharedMemorySize, LDS_BYTES);
        if (hipOccupancyMaxActiveBlocksPerMultiprocessor(&per_cu, (const void*)fwd_mega, NTHR, LDS_BYTES) != hipSuccess || per_cu < 1) { fprintf(stderr, "kernel_launch: occupancy query says %d blocks per CU\n", per_cu); per_cu = 1; }
        (void)hipGetLastError();
        grid = cus * per_cu;
        fprintf(stderr, "kernel_launch: grid %d (cus %d x %d), lds %d\n", grid, cus, per_cu, LDS_BYTES);
    }
    if (grid < 0) return;
    Args a{};
    for (int i = 0; i < 32; ++i) a.in[i] = (const float*)d_in[i];
    a.out = (float*)d_out; a.ws = (unsigned char*)d_ws;
    if (hipMemsetAsync(d_ws, 0, CTL_ZERO_BYTES, stream) != hipSuccess) { fprintf(stderr, "kernel_launch: memset of the barrier words failed\n"); return; }
    void* kargs[] = {&a};
    hipError_t e = hipLaunchCooperativeKernel((const void*)fwd_mega, dim3(grid), dim3(NTHR), kargs, LDS_BYTES, stream);
    if (e != hipSuccess) fprintf(stderr, "kernel_launch: cooperative launch failed: %s (grid %d)\n", hipGetErrorString(e), grid);
}
```

```cpp
#include <hip/hip_runtime.h>
#include <hip/hip_cooperative_groups.h>
#include <cstdio>
#include <cstdint>
namespace cg = cooperative_groups;
namespace pg8 {
#define PG8_LAS __attribute__((address_space(3)))
typedef unsigned short bf16_t;
typedef short bf16x8 __attribute__((ext_vector_type(8)));
typedef float f32x4 __attribute__((ext_vector_type(4)));
typedef unsigned u32x4 __attribute__((ext_vector_type(4)));
constexpr int BM = 256, BK = 64, HALF = 128, HTB = HALF * BK * 2  , STAGE_BYTES = 8 * HTB, NXCD = 8, WGM = 8;

__host__ __device__ __forceinline__ int lds_byte(int r, int c) { const int st = (r >> 4) * 2 + (c >> 5), rr = r & 15, cc = c & 31, ob = rr * 64 + cc * 2; return st * 1024 + (ob ^ (((ob >> 9) & 1) << 5)); }
__host__ __device__ __forceinline__ void stage_rc(int b, int& R, int& C) { const int st = b / 1024, sb = b % 1024, swz = sb ^ (((sb >> 9) & 1) << 5); R = (st >> 1) * 16 + swz / 64; C = (st & 1) * 32 + (swz % 64) / 2; }
__host__ __device__ __forceinline__ int perm32(int rho) { const int n = rho >> 4, i = rho & 15; return 8 * (i >> 2) + 4 * n + (i & 3); }

struct Unit { int pm, pn; };
struct Gemm { const bf16_t* A; const bf16_t* Bt; int M, N, K, lda; };

struct StaticOrder {
    int nM, nN, nwg, G, c;
    __host__ __device__ void init(int M, int N, int G_, int c_) { nM = M / BM; nN = N / BM; nwg = nM * nN; G = G_; c = c_; }
    __host__ __device__ bool next(int i, Unit& u) const {
        const long L = (long)i * G + c; if (L >= nwg) return false;
        int wgid = (int)L; { const int q = nwg / NXCD, r = nwg % NXCD, xcd = wgid % NXCD, off = wgid / NXCD; wgid = (xcd < r ? xcd * (q + 1) : r * (q + 1) + (xcd - r) * q) + off; }
        const int nig = WGM * nN, gid = wgid / nig, fm = gid * WGM, gsz = (nM - fm) < WGM ? (nM - fm) : WGM;
        u.pm = fm + ((wgid % nig) % gsz); u.pn = (wgid % nig) / gsz; return true;
    }
    __device__ __forceinline__ void a_ready(const Unit&) const {}
    __device__ __forceinline__ void done(const Unit&) const {}
};

__device__ __forceinline__ unsigned cvt_pk_bf16(float lo, float hi) { unsigned r; asm volatile("v_cvt_pk_bf16_f32 %0, %1, %2" : "=v"(r) : "v"(lo), "v"(hi)); return r; }
typedef float f32x2 __attribute__((ext_vector_type(2)));
__device__ __forceinline__ f32x2 gelu_pk(f32x2 v) {
    const f32x2 av = __builtin_elementwise_abs(v), d = av * 0.2316418882f + 1.0f;
    f32x2 t; t.x = __builtin_amdgcn_rcpf(d.x); t.y = __builtin_amdgcn_rcpf(d.y);
    f32x2 q = t * 0.5307027145f + (-0.7265760135f); q = q * t + 0.7107068705f; q = q * t + (-0.142248368f); q = q * t + 0.127414796f; q = q * t;
    const f32x2 s = (v * v) * (-0.72134752044f);
    f32x2 e; e.x = __builtin_amdgcn_exp2f(s.x); e.y = __builtin_amdgcn_exp2f(s.y);
    const f32x2 m = v * (q * e), r = v - m;
    f32x2 o; o.x = v.x < 0.f ? m.x : r.x; o.y = v.y < 0.f ? m.y : r.y; return o;
}

template <int ACT  > struct EpiBf16 {
    static constexpr bool PERM = true, AFTER_DRAIN = false; static_assert(ACT == 0 || ACT == 1, "EpiBf16: ACT is 0 (none) or 1 (gelu_pk)");
    bf16_t* O; int ldc; const float* bias; int split_cols; size_t split_stride; float scale0;
    __device__ __forceinline__ void operator()(const f32x4 (&acc)[2][2][4][2], const Unit& u, int wr, int wc, int fr, int fq) const {
        const int row0 = u.pm * BM + wr * 64 + fr; int colt = u.pn * BM; bf16_t* base = O;
        float sc = 1.f; if (split_cols) { const int t = colt / split_cols; base += (size_t)t * split_stride; colt -= t * split_cols; if (t == 0) sc = scale0; }
        const int col0 = colt + wc * 32 + 8 * fq, bcol0 = u.pn * BM + wc * 32 + 8 * fq;
        f32x4 bv[2][2];
#pragma unroll
        for (int bj = 0; bj < 2; ++bj)
#pragma unroll
            for (int n = 0; n < 2; ++n) bv[bj][n] = bias ? *(const f32x4*)(bias + bcol0 + bj * HALF + 4 * n) : (f32x4){0.f, 0.f, 0.f, 0.f};
#pragma unroll
        for (int ai = 0; ai < 2; ++ai)
#pragma unroll
            for (int m = 0; m < 4; ++m) { bf16_t* rowp = base + (size_t)(row0 + ai * HALF + m * 16) * ldc + col0;
#pragma unroll
                for (int bj = 0; bj < 2; ++bj) { f32x4 v0 = acc[ai][bj][m][0] + bv[bj][0], v1 = acc[ai][bj][m][1] + bv[bj][1];
                    if (ACT == 1) { f32x2 a = gelu_pk((f32x2){v0[0], v0[1]}), b = gelu_pk((f32x2){v0[2], v0[3]}), c = gelu_pk((f32x2){v1[0], v1[1]}), d = gelu_pk((f32x2){v1[2], v1[3]});
                        v0 = (f32x4){a.x, a.y, b.x, b.y}; v1 = (f32x4){c.x, c.y, d.x, d.y}; }
                    v0 = v0 * sc; v1 = v1 * sc; u32x4 w; w.x = cvt_pk_bf16(v0[0], v0[1]); w.y = cvt_pk_bf16(v0[2], v0[3]); w.z = cvt_pk_bf16(v1[0], v1[1]); w.w = cvt_pk_bf16(v1[2], v1[3]);
                    *(u32x4*)(rowp + bj * HALF) = w; } }
    }
};

struct PanelStats {
    unsigned* xbuf;
    unsigned* cnt;
    unsigned* tmo;
    int ntn; float eps;
    unsigned code;
    __device__ __forceinline__ bool run(const f32x4 (&v)[2][2][4][2], const Unit& u, int wr, int wc, int fr, int fq, PG8_LAS unsigned char* lds, int wid, int lane) const {
        typedef float f32x2v __attribute__((ext_vector_type(2)));
        PG8_LAS f32x2v* P = (PG8_LAS f32x2v*)lds;
        PG8_LAS f32x2v* S = (PG8_LAS f32x2v*)(lds + 8192);
        PG8_LAS unsigned* flag = (PG8_LAS unsigned*)(lds + 8192 + 2048);
#pragma unroll
        for (int ai = 0; ai < 2; ++ai)
#pragma unroll
            for (int m = 0; m < 4; ++m) {
                float s = 0.f;
#pragma unroll
                for (int bj = 0; bj < 2; ++bj)
#pragma unroll
                    for (int n = 0; n < 2; ++n) { const f32x4 x = v[ai][bj][m][n]; s += (x[0] + x[1]) + (x[2] + x[3]); }
                s += __shfl_xor(s, 16); s += __shfl_xor(s, 32);
                const float mw = s * (1.0f / 64.0f); float q = 0.f;
#pragma unroll
                for (int bj = 0; bj < 2; ++bj)
#pragma unroll
                    for (int n = 0; n < 2; ++n) { const f32x4 d = v[ai][bj][m][n] - mw; q += (d[0] * d[0] + d[1] * d[1]) + (d[2] * d[2] + d[3] * d[3]); }
                q += __shfl_xor(q, 16); q += __shfl_xor(q, 32);
                if (fq == 0) P[(ai * HALF + wr * 64 + m * 16 + fr) * 4 + wc] = (f32x2v){mw, q};
            }
        asm volatile("s_waitcnt lgkmcnt(0)" ::: "memory"); __builtin_amdgcn_s_barrier(); asm volatile("" ::: "memory");
#if defined(BROKEN_EXCHANGE_NO_WAIT)
#warning BROKEN CONTROL BUILD: the row-statistics exchange does not wait; results are wrong by design
        if (blockIdx.x >= 64) { const long long t0_ = clock64(); while (clock64() - t0_ < 60000) __builtin_amdgcn_s_sleep(8); }
#endif
        const int row = wid * 32 + (lane & 31);
        if (lane < 32) {
            const f32x2v a = P[row * 4 + 0], b = P[row * 4 + 1], c = P[row * 4 + 2], d = P[row * 4 + 3];
            const float mt = (a.x + b.x + c.x + d.x) * 0.25f;
            const float da = a.x - mt, db = b.x - mt, dc = c.x - mt, dd = d.x - mt;
            const float m2 = (a.y + b.y) + (c.y + d.y) + 64.0f * ((da * da + db * db) + (dc * dc + dd * dd));
            unsigned long long* slot = (unsigned long long*)xbuf + ((size_t)(u.pm * BM + row) * 4 + u.pn);
            __hip_atomic_store(slot, ((unsigned long long)__float_as_uint(m2) << 32) | __float_as_uint(mt), __ATOMIC_RELAXED, __HIP_MEMORY_SCOPE_AGENT);
        }
        asm volatile("s_waitcnt vmcnt(0)" ::: "memory");
        if (lane == 0) __hip_atomic_fetch_add(cnt + 64 * u.pm, 1u, __ATOMIC_RELAXED, __HIP_MEMORY_SCOPE_AGENT);
        if (wid == 0) {
            bool dead = false; const unsigned long long t0 = __builtin_amdgcn_s_memrealtime(); const unsigned want = 8u * (unsigned)ntn;
            for (;;) {
#if defined(BROKEN_EXCHANGE_NO_WAIT)
                break;
#endif
                if ((unsigned)__builtin_amdgcn_readfirstlane(__hip_atomic_load(cnt + 64 * u.pm, __ATOMIC_RELAXED, __HIP_MEMORY_SCOPE_AGENT)) >= want) break;
                if (__builtin_amdgcn_s_memrealtime() - t0 > 2000000ull) {
                    if (lane == 0) { unsigned expect = 0u; __hip_atomic_compare_exchange_strong(tmo + 1, &expect, code | (unsigned)(u.pm & 0xff), __ATOMIC_RELAXED, __ATOMIC_RELAXED, __HIP_MEMORY_SCOPE_AGENT);
                                     __hip_atomic_store(tmo, 1u, __ATOMIC_RELAXED, __HIP_MEMORY_SCOPE_AGENT); }
                    dead = true; break; }
                __builtin_amdgcn_s_sleep(2);
            }
            __builtin_amdgcn_fence(__ATOMIC_ACQUIRE, "agent");
            if (lane == 0) flag[0] = dead ? 1u : 0u;
        }
        asm volatile("s_waitcnt vmcnt(0) lgkmcnt(0)" ::: "memory"); __builtin_amdgcn_s_barrier(); asm volatile("" ::: "memory");
        const bool bad = flag[0] != 0u;
        if (lane < 32) {
            const unsigned long long* slot = (const unsigned long long*)xbuf + (size_t)(u.pm * BM + row) * 4; float mt[4], m2[4]; float ms = 0.f;
#pragma unroll
            for (int t = 0; t < 4; ++t) { if (t < ntn) { const unsigned long long w = __hip_atomic_load(slot + t, __ATOMIC_RELAXED, __HIP_MEMORY_SCOPE_AGENT); mt[t] = __uint_as_float((unsigned)w); m2[t] = __uint_as_float((unsigned)(w >> 32)); } else { mt[t] = 0.f; m2[t] = 0.f; } ms += mt[t]; }
            const float mean = ms / (float)ntn; float q = 0.f;
#pragma unroll
            for (int t = 0; t < 4; ++t) if (t < ntn) { const float dm = mt[t] - mean; q += m2[t] + 256.0f * dm * dm; }
            S[row] = (f32x2v){mean, 1.0f / sqrtf(q / (256.0f * (float)ntn) + eps)};
        }
        asm volatile("s_waitcnt lgkmcnt(0)" ::: "memory"); __builtin_amdgcn_s_barrier(); asm volatile("" ::: "memory");
        return bad;
    }
};
struct EpiLnRes {
    static constexpr bool PERM = false, AFTER_DRAIN = true;
    const float* base; float* out; int ldc; const float* bias; PanelStats st; unsigned poison;
    __device__ __forceinline__ void fused(f32x4 (&acc)[2][2][4][2], const Unit& u, int wr, int wc, int fr, int fq, PG8_LAS unsigned char* lds, int wid, int lane) const {
        typedef float f32x2v __attribute__((ext_vector_type(2)));
        const PG8_LAS f32x2v* S = (const PG8_LAS f32x2v*)(lds + 8192);
        const int col0 = u.pn * BM + wc * 32 + 4 * fq;
#pragma unroll
        for (int bj = 0; bj < 2; ++bj)
#pragma unroll
            for (int n = 0; n < 2; ++n) { const f32x4 bv = bias ? *(const f32x4*)(bias + col0 + bj * HALF + n * 16) : (f32x4){0.f, 0.f, 0.f, 0.f};
#pragma unroll
                for (int ai = 0; ai < 2; ++ai)
#pragma unroll
                    for (int m = 0; m < 4; ++m) acc[ai][bj][m][n] += bv; }
        f32x4 pre[4][2][2];
#pragma unroll
        for (int m = 0; m < 4; ++m) { const size_t off = (size_t)(u.pm * BM + wr * 64 + m * 16 + fr) * ldc + col0;
#pragma unroll
            for (int bj = 0; bj < 2; ++bj)
#pragma unroll
                for (int n = 0; n < 2; ++n) pre[m][bj][n] = *(const f32x4*)(base + off + bj * HALF + n * 16); }
        const bool bad = st.run(acc, u, wr, wc, fr, fq, lds, wid, lane) || poison != 0u;
        const float qnan = __builtin_nanf("");
#pragma unroll
        for (int ai = 0; ai < 2; ++ai)
#pragma unroll
            for (int m = 0; m < 4; ++m) { const int r = ai * HALF + wr * 64 + m * 16 + fr; const f32x2v sr = S[r]; const size_t off = (size_t)(u.pm * BM + r) * ldc + col0;
#pragma unroll
                for (int bj = 0; bj < 2; ++bj)
#pragma unroll
                    for (int n = 0; n < 2; ++n) { const f32x4 bs = ai == 0 ? pre[m][bj][n] : *(const f32x4*)(base + off + bj * HALF + n * 16); f32x4 o = bs + (acc[ai][bj][m][n] - sr.x) * sr.y;
                        if (bad) o = (f32x4){qnan, qnan, qnan, qnan}; *(f32x4*)(out + off + bj * HALF + n * 16) = o; }
                if (m & 1) asm volatile("" ::: "memory"); }
    }
};
struct EpiLnResLn {
    static constexpr bool PERM = false, AFTER_DRAIN = true;
    const float* base; float* out; bf16_t* xn; int ldc; const float* bias; PanelStats st1, st2; unsigned poison;
    __device__ __forceinline__ void fused(f32x4 (&acc)[2][2][4][2], const Unit& u, int wr, int wc, int fr, int fq, PG8_LAS unsigned char* lds, int wid, int lane) const {
        typedef float f32x2v __attribute__((ext_vector_type(2))); typedef unsigned u32x2v __attribute__((ext_vector_type(2)));
        const PG8_LAS f32x2v* S = (const PG8_LAS f32x2v*)(lds + 8192);
        const int col0 = u.pn * BM + wc * 32 + 4 * fq;
#pragma unroll
        for (int bj = 0; bj < 2; ++bj)
#pragma unroll
            for (int n = 0; n < 2; ++n) { const f32x4 bv = bias ? *(const f32x4*)(bias + col0 + bj * HALF + n * 16) : (f32x4){0.f, 0.f, 0.f, 0.f};
#pragma unroll
                for (int ai = 0; ai < 2; ++ai)
#pragma unroll
                    for (int m = 0; m < 4; ++m) acc[ai][bj][m][n] += bv; }
        bool bad = st1.run(acc, u, wr, wc, fr, fq, lds, wid, lane) || poison != 0u;
        const float qnan = __builtin_nanf("");
#pragma unroll
        for (int ai = 0; ai < 2; ++ai)
#pragma unroll
            for (int m = 0; m < 4; ++m) { const int r = ai * HALF + wr * 64 + m * 16 + fr; const f32x2v sr = S[r]; const size_t off = (size_t)(u.pm * BM + r) * ldc + col0;
#pragma unroll
                for (int bj = 0; bj < 2; ++bj)
#pragma unroll
                    for (int n = 0; n < 2; ++n) { const f32x4 bs = *(const f32x4*)(base + off + bj * HALF + n * 16); acc[ai][bj][m][n] = bs + (acc[ai][bj][m][n] - sr.x) * sr.y; }
                asm volatile("" : "+v"(acc[ai][0][m][0]), "+v"(acc[ai][0][m][1]), "+v"(acc[ai][1][m][0]), "+v"(acc[ai][1][m][1]));
                if (m & 1) asm volatile("" ::: "memory"); }
        const bool bad1 = bad;
        bad = st2.run(acc, u, wr, wc, fr, fq, lds, wid, lane) || bad;
#pragma unroll
        for (int ai = 0; ai < 2; ++ai)
#pragma unroll
            for (int m = 0; m < 4; ++m) { const int r = ai * HALF + wr * 64 + m * 16 + fr; const f32x2v sr = S[r]; const size_t off = (size_t)(u.pm * BM + r) * ldc + col0;
#pragma unroll
                for (int bj = 0; bj < 2; ++bj)
#pragma unroll
                    for (int n = 0; n < 2; ++n) { const f32x4 x1 = acc[ai][bj][m][n]; *(f32x4*)(out + off + bj * HALF + n * 16) = bad1 ? (f32x4){qnan, qnan, qnan, qnan} : x1;
                        const f32x4 o = (x1 - sr.x) * sr.y; u32x2v w; w.x = cvt_pk_bf16(o[0], o[1]); w.y = cvt_pk_bf16(o[2], o[3]);
                        if (bad) { w.x = 0x7fc07fc0u; w.y = 0x7fc07fc0u; } *(u32x2v*)(xn + off + bj * HALF + n * 16) = w; }
                asm volatile("" ::: "memory"); }
    }
};

template <class Epi, class Sched, bool ALIGN_EPI = false, bool SP2 = false>
__device__ __forceinline__ void gemm_phase(PG8_LAS unsigned char* lds, const Gemm g, const Sched& S, const Epi& E, int tid_in) {
    int tid_l = tid_in; asm volatile("" : "+v"(tid_l));
    const int tid = tid_l, wid = __builtin_amdgcn_readfirstlane(tid >> 6), lane = tid & 63, wr = wid >> 2, wc = wid & 3, fr = lane & 15, fq = lane >> 4;
    const int K = g.K, nt = K / BK;
    unsigned voffA[2], voffB[2];
#pragma unroll
    for (int i = 0; i < 2; ++i) { int R, C; stage_rc(tid * 16 + i * 8192, R, C); const int Rb = Epi::PERM ? ((R & ~31) + perm32(R & 31)) : R;
        voffA[i] = (unsigned)(R * g.lda + C) * 2u; voffB[i] = (unsigned)(Rb * K + C) * 2u; }
    const size_t kstep = (size_t)(BK * 2);
    const size_t hstep = (size_t)HALF * K * 2;
    const size_t tstep = 2 * hstep; const size_t hstepA = (size_t)HALF * g.lda * 2, tstepA = 2 * hstepA;
    const unsigned ldsw = (unsigned)wid * 1024u;
    const int aoff = lds_byte(wr * 64 + fr, fq * 8), boff = lds_byte(wc * 32 + fr, fq * 8);
#define PG8_SA(b, h) (((b) * 2 + (h)) * HTB)
#define PG8_SB(b, h) ((4 + (b) * 2 + (h)) * HTB)
#define PG8_STAGE(bufoff, gbase, voff) do { _Pragma("unroll") for (int _i = 0; _i < 2; ++_i) \
        __builtin_amdgcn_global_load_lds((const unsigned*)((const char*)(gbase) + (voff)[_i]), (PG8_LAS unsigned*)(lds + (bufoff) + ldsw + _i * 8192), 16, 0, 0); } while (0)
#define PG8_LDA(dst, b, h) do { _Pragma("unroll") for (int m = 0; m < 4; ++m) _Pragma("unroll") for (int k = 0; k < 2; ++k) dst[m][k] = *(const PG8_LAS bf16x8*)(lds + PG8_SA(b, h) + aoff + m * 2048 + k * 1024); } while (0)
#define PG8_LDB(dst, b, h) do { _Pragma("unroll") for (int n = 0; n < 2; ++n) _Pragma("unroll") for (int k = 0; k < 2; ++k) dst[n][k] = *(const PG8_LAS bf16x8*)(lds + PG8_SB(b, h) + boff + n * 2048 + k * 1024); } while (0)
#define PG8_MMA(ai, bj, At, Bt) do { __builtin_amdgcn_s_setprio(1); _Pragma("unroll") for (int m = 0; m < 4; ++m) _Pragma("unroll") for (int n = 0; n < 2; ++n) _Pragma("unroll") for (int k = 0; k < 2; ++k) \
        acc[ai][bj][m][n] = __builtin_amdgcn_mfma_f32_16x16x32_bf16(Bt[n][k], At[m][k], acc[ai][bj][m][n], 0, 0, 0); __builtin_amdgcn_s_setprio(0); } while (0)
#define PG8_WAIT_V(n) asm volatile("s_waitcnt vmcnt(" #n ")" ::: "memory")
#define PG8_WAIT_L(n) asm volatile("s_waitcnt lgkmcnt(" #n ")" ::: "memory")
#define PG8_BAR __builtin_amdgcn_s_barrier()
#define PG8_SCHED __builtin_amdgcn_sched_barrier(0)
    Unit cur, nxt; int ui = 0;
    if (!S.next(0, cur)) return;
    f32x4 acc[2][2][4][2];
#pragma unroll
    for (int a = 0; a < 2; ++a)
#pragma unroll
        for (int b = 0; b < 2; ++b)
#pragma unroll
            for (int m = 0; m < 4; ++m)
#pragma unroll
                for (int n = 0; n < 2; ++n) acc[a][b][m][n] = (f32x4){0.f, 0.f, 0.f, 0.f};
    bf16x8 At[4][2], B0[2][2], B1[2][2];
    const char* cA = (const char*)g.A + (size_t)cur.pm * tstepA; const char* cB = (const char*)g.Bt + (size_t)cur.pn * tstep;
    S.a_ready(cur);
    if constexpr (SP2) {
        PG8_STAGE(PG8_SB(0, 0), cB, voffB); PG8_STAGE(PG8_SB(0, 1), cB + hstep, voffB); PG8_STAGE(PG8_SA(0, 0), cA, voffA); PG8_STAGE(PG8_SA(0, 1), cA + hstepA, voffA);
        if (wr == 1) PG8_BAR;
        PG8_WAIT_V(2); PG8_BAR;
        PG8_STAGE(PG8_SB(1, 0), cB + kstep, voffB); PG8_STAGE(PG8_SA(1, 0), cA + kstep, voffA); PG8_STAGE(PG8_SB(1, 1), cB + hstep + kstep, voffB);
        PG8_WAIT_V(6); PG8_BAR;
    } else {
        PG8_STAGE(PG8_SB(0, 0), cB, voffB); PG8_STAGE(PG8_SA(0, 0), cA, voffA); PG8_STAGE(PG8_SB(0, 1), cB + hstep, voffB); PG8_STAGE(PG8_SA(0, 1), cA + hstepA, voffA);
        if (wr == 1) PG8_BAR;
        PG8_WAIT_V(4); PG8_BAR;
        PG8_STAGE(PG8_SB(1, 0), cB + kstep, voffB); PG8_STAGE(PG8_SA(1, 0), cA + kstep, voffA); PG8_STAGE(PG8_SB(1, 1), cB + hstep + kstep, voffB);
        PG8_WAIT_V(6); PG8_BAR;
    }
    for (;;) {
        const bool has_next = S.next(ui + 1, nxt);
        const char* nA = has_next ? (const char*)g.A + (size_t)nxt.pm * tstepA : cA; const char* nB = has_next ? (const char*)g.Bt + (size_t)nxt.pn * tstep : cB;
        for (int t = 0; t < nt; t += 2) {
            const bool last = (t == nt - 2);
            const char* a1 = cA + (size_t)(t + 1) * kstep;
            const char* a2 = last ? nA : cA + (size_t)(t + 2) * kstep; const char* b2 = last ? nB : cB + (size_t)(t + 2) * kstep;
            const char* a3 = a2 + kstep; const char* b3 = b2 + kstep;
            if (last && has_next) S.a_ready(nxt);
            if constexpr (SP2) {
            PG8_LDB(B0, 0, 0); PG8_LDB(B1, 0, 1); PG8_SCHED; PG8_LDA(At, 0, 0); PG8_STAGE(PG8_SA(1, 1), a1 + hstepA, voffA);
            PG8_WAIT_V(8); PG8_WAIT_L(0); PG8_BAR; PG8_MMA(0, 0, At, B0); PG8_MMA(0, 1, At, B1); PG8_BAR; PG8_SCHED;
            PG8_LDA(At, 0, 1); PG8_STAGE(PG8_SB(0, 0), b2, voffB); PG8_STAGE(PG8_SB(0, 1), b2 + hstep, voffB); PG8_STAGE(PG8_SA(0, 0), a2, voffA);
            PG8_WAIT_V(8); PG8_WAIT_L(0); PG8_BAR; PG8_MMA(1, 0, At, B0); PG8_MMA(1, 1, At, B1); PG8_BAR; PG8_SCHED;
            PG8_LDB(B0, 1, 0); PG8_LDB(B1, 1, 1); PG8_SCHED; PG8_LDA(At, 1, 0); PG8_STAGE(PG8_SA(0, 1), a2 + hstepA, voffA);
            PG8_WAIT_V(8); PG8_WAIT_L(0); PG8_BAR; PG8_MMA(0, 0, At, B0); PG8_MMA(0, 1, At, B1); PG8_BAR; PG8_SCHED;
            PG8_LDA(At, 1, 1); PG8_STAGE(PG8_SB(1, 0), b3, voffB); PG8_STAGE(PG8_SB(1, 1), b3 + hstep, voffB); PG8_STAGE(PG8_SA(1, 0), a3, voffA);
            PG8_WAIT_V(8); PG8_WAIT_L(0); PG8_BAR; PG8_MMA(1, 0, At, B0); PG8_MMA(1, 1, At, B1); PG8_BAR; PG8_SCHED;
            } else {
            PG8_LDB(B0, 0, 0); PG8_SCHED; PG8_LDA(At, 0, 0); PG8_STAGE(PG8_SA(1, 1), a1 + hstepA, voffA);
            PG8_WAIT_L(8); PG8_BAR; PG8_WAIT_L(0); PG8_MMA(0, 0, At, B0); PG8_BAR; PG8_SCHED;
            PG8_LDB(B1, 0, 1); PG8_STAGE(PG8_SB(0, 0), b2, voffB);
            PG8_BAR; PG8_WAIT_L(0); PG8_MMA(0, 1, At, B1); PG8_BAR;
            PG8_LDA(At, 0, 1); PG8_STAGE(PG8_SA(0, 0), a2, voffA);
            PG8_BAR; PG8_WAIT_L(0); PG8_MMA(1, 0, At, B0); PG8_BAR; PG8_SCHED;
            PG8_STAGE(PG8_SB(0, 1), b2 + hstep, voffB);
            PG8_WAIT_V(6); PG8_BAR; PG8_MMA(1, 1, At, B1); PG8_BAR;
            PG8_LDB(B0, 1, 0); PG8_SCHED; PG8_LDA(At, 1, 0); PG8_STAGE(PG8_SA(0, 1), a2 + hstepA, voffA);
            PG8_WAIT_L(8); PG8_BAR; PG8_WAIT_L(0); PG8_MMA(0, 0, At, B0); PG8_BAR; PG8_SCHED;
            PG8_LDB(B1, 1, 1); PG8_STAGE(PG8_SB(1, 0), b3, voffB);
            PG8_BAR; PG8_WAIT_L(0); PG8_MMA(0, 1, At, B1); PG8_BAR;
            PG8_LDA(At, 1, 1); PG8_STAGE(PG8_SA(1, 0), a3, voffA);
            PG8_BAR; PG8_WAIT_L(0); PG8_MMA(1, 0, At, B0); PG8_BAR; PG8_SCHED;
            PG8_STAGE(PG8_SB(1, 1), b3 + hstep, voffB);
            PG8_WAIT_V(6); PG8_BAR; PG8_MMA(1, 1, At, B1); PG8_BAR;
            }
        }
        if constexpr (ALIGN_EPI) { if (wr == 0) PG8_BAR; }
        if constexpr (!Epi::AFTER_DRAIN) { E(acc, cur, wr, wc, fr, fq); S.done(cur); }
        if (!has_next) break;
#pragma unroll
        for (int a = 0; a < 2; ++a)
#pragma unroll
            for (int b = 0; b < 2; ++b)
#pragma unroll
                for (int m = 0; m < 4; ++m)
#pragma unroll
                    for (int n = 0; n < 2; ++n) acc[a][b][m][n] = (f32x4){0.f, 0.f, 0.f, 0.f};
        cur = nxt; cA = nA; cB = nB; ++ui;
        if constexpr (ALIGN_EPI) { if (wr == 1) PG8_BAR; }
    }
    PG8_WAIT_V(0);
    if constexpr (!ALIGN_EPI) { if (wr == 0) PG8_BAR; }
    PG8_BAR;
    if constexpr (Epi::AFTER_DRAIN) { E.fused(acc, cur, wr, wc, fr, fq, lds, wid, lane); S.done(cur); }
#undef PG8_SA
#undef PG8_SB
#undef PG8_STAGE
#undef PG8_LDA
#undef PG8_LDB
#undef PG8_MMA
#undef PG8_WAIT_V
#undef PG8_WAIT_L
#undef PG8_BAR
#undef PG8_SCHED
}
}

#ifndef PG8_SP2
#define PG8_SP2 true
#endif
#ifndef PG8_ALIGN
#define PG8_ALIGN true
#endif
#include <hip/hip_bf16.h>
#include <cmath>
namespace attn_body {
using bf16=__hip_bfloat16;
using bf16x8=__attribute__((ext_vector_type(8)))short;
using s16x4=__attribute__((ext_vector_type(4)))short;
using f32x16=__attribute__((ext_vector_type(16)))float;
using u32x4=__attribute__((ext_vector_type(4)))unsigned;
using f32x4v=__attribute__((ext_vector_type(4)))float;
constexpr int BATCH=1,NHEAD=8,SEQ=16384,D=64,DM=8704;
constexpr int NW=8,QBLK=32,QB=QBLK*NW,KVBLK=64,NQB=SEQ/QB;
constexpr int ATTN_PITCH=DM, ATTN_UNIT_ROWS=QB;
__device__ __forceinline__ int crow(int r,int hi){return (r&3)+8*(r>>2)+4*hi;}
#define SBAR() __builtin_amdgcn_sched_barrier(0)
__device__ __forceinline__ void cmask(f32x16&p0,f32x16&p1,int jb,int qrel,int hi){
  const float NEG=-INFINITY; int kb=64*jb+4*hi;
  #pragma unroll
  for(int r=0;r<16;++r){int kv=kb+(r&3)+8*(r>>2); if(kv>qrel)p0[r]=NEG; if(kv+32>qrel)p1[r]=NEG;}
}

constexpr int NSLOT=3, SLOTB=8192;
constexpr int LDS_K=0, LDS_V=NSLOT*SLOTB, LDS_WS=2*NSLOT*SLOTB, LDS_OST=LDS_WS+NW*64*4, LDS_F=LDS_OST+NW*4096, LDS_BYTES=LDS_F+SEQ*4;
constexpr float C2=0.125f*1.4426950408889634f;
__device__ __forceinline__ void glds16(const void*gsrc,unsigned lds_dst){unsigned keep;
  asm volatile("s_mov_b32 %0, m0\n\ts_mov_b32 m0, %2\n\ts_nop 0\n\tglobal_load_lds_dwordx4 %1, off\n\ts_mov_b32 m0, %0":"=&s"(keep):"v"(gsrc),"s"(lds_dst):"memory");}
__device__ __forceinline__ float max3f(float a,float b,float c){float r;asm("v_max3_f32 %0, %1, %2, %3":"=v"(r):"v"(a),"v"(b),"v"(c));return r;}
__device__ __forceinline__ float max2f(float a,float b){float r;asm("v_max_f32_e32 %0, %1, %2":"=v"(r):"v"(a),"v"(b));return r;}
__device__ __forceinline__ float fadd_s(float a,float b){float r;asm("v_add_f32_e32 %0, %1, %2":"=v"(r):"v"(a),"v"(b));return r;}
__device__ __forceinline__ float fsub_s(float a,float b){float r;asm("v_sub_f32_e32 %0, %1, %2":"=v"(r):"v"(a),"v"(b));return r;}
typedef float f32x2_t __attribute__((ext_vector_type(2))); typedef __bf16 bf16x2_t __attribute__((ext_vector_type(2)));
__device__ __forceinline__ unsigned cvtpk_s(float lo,float hi){f32x2_t v={lo,hi};bf16x2_t b=__builtin_convertvector(v,bf16x2_t);return __builtin_bit_cast(unsigned,b);}
#define WAIT_BAR(N) asm volatile("s_waitcnt vmcnt(" #N ") lgkmcnt(0)\n\ts_barrier":::"memory")


__device__ __forceinline__ bf16x8 mkbias(float x,int hi){
  const unsigned xb=__float_as_uint(x); const unsigned hb=xb&0xffff0000u; const float r1=x-__uint_as_float(hb);
  const unsigned mb=__float_as_uint(r1)&0xffff0000u; const float r2=r1-__uint_as_float(mb); const unsigned lb=__float_as_uint(r2)&0xffff0000u;
  u32x4 w; w.x=(hb>>16)|mb; w.y=(lb>>16)|0x3f800000u; w.z=0x3f803f80u; w.w=0u; if(hi){w.x=0u;w.y=0u;w.z=0u;}
  return __builtin_bit_cast(bf16x8,w);
}
__device__ __forceinline__ bf16x8 mkq(float x,int hi){
  const unsigned xb=__float_as_uint(x); const unsigned hb=xb&0xffff0000u; const float r1=x-__uint_as_float(hb);
  const unsigned mb=__float_as_uint(r1)&0xffff0000u; const float r2=r1-__uint_as_float(mb); const unsigned lb=__float_as_uint(r2)&0xffff0000u;
  u32x4 w; w.x=0x3f803f80u; w.y=0x3f80u|hb; w.z=(mb>>16)|lb; w.w=0u; if(hi){w.x=0u;w.y=0u;w.z=0u;}
  return __builtin_bit_cast(bf16x8,w);
}
__device__ __forceinline__ void qkt(f32x16&p0,f32x16&p1,const char*Kslot,const bf16x8*qr,int r32,int hi,bf16x8 kb0,bf16x8 kb1,bf16x8 qone){ const f32x16 negm=f32x16{};
  const char*kb=Kslot+hi*1024+r32*16;
  #pragma unroll
  for(int d0=0;d0<4;++d0){
    const bf16x8 b0=*reinterpret_cast<const bf16x8*>(kb+d0*2048);
    const bf16x8 b1=*reinterpret_cast<const bf16x8*>(kb+d0*2048+512);
    if(d0==0){p0=__builtin_amdgcn_mfma_f32_32x32x16_bf16(b0,qr[0],negm,0,0,0);p1=__builtin_amdgcn_mfma_f32_32x32x16_bf16(b1,qr[0],negm,0,0,0);}
    else{p0=__builtin_amdgcn_mfma_f32_32x32x16_bf16(b0,qr[d0],p0,0,0,0);p1=__builtin_amdgcn_mfma_f32_32x32x16_bf16(b1,qr[d0],p1,0,0,0);}}
  p0=__builtin_amdgcn_mfma_f32_32x32x16_bf16(kb0,qone,p0,0,0,0);p1=__builtin_amdgcn_mfma_f32_32x32x16_bf16(kb1,qone,p1,0,0,0);
}
typedef __attribute__((address_space(3))) const char* lds_cptr;
typedef short v4i16_t __attribute__((ext_vector_type(4)));
__device__ __forceinline__ void kload8(bf16x8*kf,lds_cptr kp){
  kf[0]=*(const __attribute__((address_space(3))) bf16x8*)(kp);      kf[1]=*(const __attribute__((address_space(3))) bf16x8*)(kp+512);
  kf[2]=*(const __attribute__((address_space(3))) bf16x8*)(kp+2048); kf[3]=*(const __attribute__((address_space(3))) bf16x8*)(kp+2560);
  kf[4]=*(const __attribute__((address_space(3))) bf16x8*)(kp+4096); kf[5]=*(const __attribute__((address_space(3))) bf16x8*)(kp+4608);
  kf[6]=*(const __attribute__((address_space(3))) bf16x8*)(kp+6144); kf[7]=*(const __attribute__((address_space(3))) bf16x8*)(kp+6656);
}
__device__ __forceinline__ void kload2(bf16x8*kf,lds_cptr kp,int j){ kf[2*j]=*(const __attribute__((address_space(3))) bf16x8*)(kp+j*2048); kf[2*j+1]=*(const __attribute__((address_space(3))) bf16x8*)(kp+j*2048+512); }
__device__ __forceinline__ s16x4 vtr(lds_cptr p){ return __builtin_bit_cast(s16x4,__builtin_amdgcn_ds_read_tr16_b64_v4i16((__attribute__((address_space(3))) v4i16_t*)p)); }
__device__ __forceinline__ float rowmax(const f32x16&p0,const f32x16&p1){
  float a=max3f(p0[0],p0[1],p1[0]),b=max3f(p0[2],p0[3],p1[1]);a=max3f(a,p1[2],p1[3]);
  #pragma unroll
  for(int r=4;r<16;r+=4){a=max3f(a,p0[r],p0[r+1]);b=max3f(b,p0[r+2],p0[r+3]);a=max3f(a,p1[r],p1[r+1]);b=max3f(b,p1[r+2],p1[r+3]);}
  const float m=max2f(a,b);
  auto rr=__builtin_amdgcn_permlane32_swap(__float_as_uint(m),__float_as_uint(m),false,false);
  return max2f(__uint_as_float(rr[0]),__uint_as_float(rr[1]));
}
__device__ __forceinline__ void pv(f32x16*o,int vb,bf16x8 pa0,bf16x8 pa1,bf16x8 pa2,bf16x8 pa3){
  #pragma unroll
  for(int d0=0;d0<2;++d0){s16x4 lo[4],hi[4];
    #pragma unroll
    for(int ks=0;ks<4;++ks){
      asm volatile("ds_read_b64_tr_b16 %0,%1 offset:%c2":"=&v"(lo[ks]):"v"(vb),"i"(d0*4096+ks*1024):"memory");
      asm volatile("ds_read_b64_tr_b16 %0,%1 offset:%c2":"=&v"(hi[ks]):"v"(vb),"i"(d0*4096+ks*1024+512):"memory");}
    asm volatile("s_waitcnt lgkmcnt(0)":::"memory");SBAR();
    #define PK(k) (bf16x8){lo[k][0],lo[k][1],lo[k][2],lo[k][3],hi[k][0],hi[k][1],hi[k][2],hi[k][3]}
    o[d0]=__builtin_amdgcn_mfma_f32_32x32x16_bf16(pa0,PK(0),o[d0],0,0,0);
    o[d0]=__builtin_amdgcn_mfma_f32_32x32x16_bf16(pa1,PK(1),o[d0],0,0,0);
    o[d0]=__builtin_amdgcn_mfma_f32_32x32x16_bf16(pa2,PK(2),o[d0],0,0,0);
    o[d0]=__builtin_amdgcn_mfma_f32_32x32x16_bf16(pa3,PK(3),o[d0],0,0,0);
    #undef PK
  }
}

#ifndef ATTN_STORE16
#define ATTN_STORE16(p,v) (*(u32x4*)(p)=(v))
#endif
template<int THRL> __device__ __forceinline__ void attn_unit(int b,int h,int qb,const bf16*Q,const bf16*__restrict__ K,const bf16*__restrict__ V,bf16*O,const float*FL2,char*shm,int tid_in){
  int tid_l=tid_in; asm volatile("":"+v"(tid_l));
  const int tid=tid_l,lane=tid&63,r32=lane&31,hi=lane>>5; const int wid=__builtin_amdgcn_readfirstlane(tid>>6);
  const long rowbase=(long)b*SEQ; const int q0=qb*QB;
  const bf16*Qw=Q+(rowbase+q0+wid*QBLK)*DM+h*D;
  const bf16*Kh=K+rowbase*DM+h*D,*Vh=V+rowbase*DM+h*D;
  const lds_cptr shm3=(lds_cptr)shm;
  const unsigned lds0=(unsigned)(uintptr_t)shm;
  float*wsf=(float*)(shm+LDS_WS)+wid*64;
  const bf16*ksrc=Kh+(long)lane*DM+wid*8;
  const bf16*vsrc=Vh+(long)(16*(wid&3)+(lane>>2))*DM+(wid>>2)*32+(lane&3)*8;
  const unsigned kdst=lds0+LDS_K+wid*1024, vdst=lds0+LDS_V+wid*1024;
  #define DMA_K(t,slot) glds16(ksrc+(long)(t)*KVBLK*DM,(unsigned)__builtin_amdgcn_readfirstlane(kdst+(slot)))
  #define DMA_V(t,slot) glds16(vsrc+(long)(t)*KVBLK*DM,(unsigned)__builtin_amdgcn_readfirstlane(vdst+(slot)))
  const int vb0=(int)(lds0+LDS_V)+((lane>>4)&1)*32+(lane&3)*8+(4*hi+((lane&15)>>2))*64;
  const char*Kbase=shm+LDS_K; bf16x8 kf[8];
  const lds_cptr kp0=shm3+LDS_K+hi*1024+r32*16; const lds_cptr vp0=shm3+LDS_V+((lane>>4)&1)*32+(lane&3)*8+(4*hi+((lane&15)>>2))*64;
  const int NT=(q0+QB)/KVBLK;
  const __attribute__((address_space(3))) float* Fl=(const __attribute__((address_space(3))) float*)(shm3+LDS_F);
  float fref;
  { const float*Fg=FL2+(long)h*SEQ; const int nF=q0+QB;
    for(int i=tid*4;i<nF;i+=NW*64*4){ const f32x4v v4=*reinterpret_cast<const f32x4v*>(Fg+i); *(__attribute__((address_space(3))) f32x4v*)(shm3+LDS_F+i*4)=v4; }
    fref=Fg[nF-1]; }
  asm volatile("s_waitcnt vmcnt(0) lgkmcnt(0)":::"memory");
  bf16x8 qone=mkq(0.f,hi);
  #define MKB(t,off) mkbias(fref-Fl[(t)*KVBLK+(off)+r32],hi)
  DMA_K(0,0);DMA_V(0,0);DMA_K(1,SLOTB);
  bf16x8 qr[4];
  #pragma unroll
  for(int d0=0;d0<4;++d0)qr[d0]=*reinterpret_cast<const bf16x8*>(&Qw[(long)r32*DM+d0*16+hi*8]);
  float mhat=0.f,l_reg=0.f;f32x16 o[2];o[0]=f32x16{};o[1]=f32x16{};
  const int qrel=wid*QBLK+r32;
  #define CMASK(P0,P1,t) do{int jb_=(t)-(NT-4); if(jb_>=0)cmask(P0,P1,jb_,qrel,hi);}while(0)
  bool resc=false;
  #define START(P0,P1) do{ const float rm=rowmax(P0,P1); resc=false; \
    { const float dl=rm; mhat=fadd_s(mhat,dl); \
      _Pragma("unroll") for(int r=0;r<16;++r){P0[r]=fsub_s(P0[r],dl);P1[r]=fsub_s(P1[r],dl);} \
      qone=mkq(-mhat,hi); } \
    _Pragma("unroll") for(int r=0;r<16;++r)P0[r]=__builtin_amdgcn_exp2f(P0[r]); }while(0)
  #define RESC() do{ if(resc){ asm volatile("s_waitcnt lgkmcnt(0)":::"memory"); \
      _Pragma("unroll") for(int d_=0;d_<2;++d_) _Pragma("unroll") for(int r=0;r<16;++r)o[d_][r]*=wsf[crow(r,hi)]; } }while(0)
  f32x16 pA0,pA1,pB0,pB1;
  int sl_prev=0,sl_cur=0,sl_next=SLOTB;
  #define ROT() do{sl_prev=sl_cur;sl_cur=sl_next;sl_next=(sl_next==(NSLOT-1)*SLOTB)?0:sl_next+SLOTB;}while(0)
  DMA_K(2,2*SLOTB);
  WAIT_BAR(3);
  qkt(pA0,pA1,Kbase,qr,r32,hi,MKB(0,0),MKB(0,32),qone);asm volatile("s_nop 15\n\ts_nop 7":"+v"(pA0),"+v"(pA1));CMASK(pA0,pA1,0);
  START(pA0,pA1);
  _Pragma("unroll") for(int r=0;r<16;++r)pA1[r]=__builtin_amdgcn_exp2f(pA1[r]);
  WAIT_BAR(0);
  DMA_K(3,0);DMA_V(1,SLOTB);
  ROT();
  kload8(kf,kp0+sl_cur);
  WAIT_BAR(2);
  s16x4 vlo[8],vhi[8]; u32x4 pw0,pw1,pw2,pw3;
  #define PKW(P,B) cvtpk_s(P[B],P[B+1])
  #define PAF(k) __builtin_bit_cast(bf16x8,pw##k)
  #define VFR(i) (bf16x8){vlo[i][0],vlo[i][1],vlo[i][2],vlo[i][3],vhi[i][0],vhi[i][1],vhi[i][2],vhi[i][3]}
  #define PIN(x) asm volatile("":"+v"(x))
  #define MX3(a,b,c) __builtin_fmaxf(__builtin_fmaxf((a),(b)),(c))
  #define GAPA(MF,A0,A1,A2,A3,W0,W1,PW) do{ MF; sacc+=A0; sacc+=A1; sacc+=A2; sacc+=A3; PIN(sacc); W0; W1; PIN(PW); SBAR(); }while(0)
  #define EX(v) __builtin_amdgcn_exp2f(v)
  #define GAPB(MF,X,B) do{ MF; X[B]=EX(X[B]); X[B+1]=EX(X[B+1]); X[B+2]=EX(X[B+2]); X[B+3]=EX(X[B+3]); PIN(X); SBAR(); }while(0)
  #define VRD(i) do{ vlo[i]=vtr(vp_+(((i)>>2)*4096+((i)&3)*1024)); vhi[i]=vtr(vp_+(((i)>>2)*4096+((i)&3)*1024+512)); }while(0)
  #define KRD(G,j) do{ if(G){ kload2(kf,kp0+sl_next,j); SBAR(); } }while(0)
  #define STEP(C0,C1,P0,P1,t,GK,GV,GL) do{ SBAR(); \
    const bf16x8 kbA_=MKB(t,0), kbB_=MKB(t,32); \
    const lds_cptr vp_=vp0+sl_prev; \
    VRD(0); SBAR(); float sacc=(P0[0]+P0[1]); \
    GAPA(C0=__builtin_amdgcn_mfma_f32_32x32x16_bf16(kf[0],qr[0],f32x16{},0,0,0), P0[2],P0[3],P0[4],P0[5],     pw0[0]=PKW(P0,0), pw0[1]=PKW(P0,2), pw0); \
    VRD(4); SBAR(); GAPA(C1=__builtin_amdgcn_mfma_f32_32x32x16_bf16(kf[1],qr[0],f32x16{},0,0,0), P0[6],P0[7],P0[8],P0[9],     pw0[2]=PKW(P0,4), pw0[3]=PKW(P0,6), pw0); \
    VRD(1); SBAR(); GAPA(C0=__builtin_amdgcn_mfma_f32_32x32x16_bf16(kf[2],qr[1],C0,0,0,0),   P0[10],P0[11],P0[12],P0[13], pw1[0]=PKW(P0,8), pw1[1]=PKW(P0,10), pw1); \
    VRD(5); SBAR(); GAPA(C1=__builtin_amdgcn_mfma_f32_32x32x16_bf16(kf[3],qr[1],C1,0,0,0),   P0[14],P0[15],P1[0],P1[1],   pw1[2]=PKW(P0,12),pw1[3]=PKW(P0,14), pw1); \
    VRD(2); SBAR(); GAPA(C0=__builtin_amdgcn_mfma_f32_32x32x16_bf16(kf[4],qr[2],C0,0,0,0),   P1[2],P1[3],P1[4],P1[5],     pw2[0]=PKW(P1,0), pw2[1]=PKW(P1,2), pw2); \
    VRD(6); SBAR(); GAPA(C1=__builtin_amdgcn_mfma_f32_32x32x16_bf16(kf[5],qr[2],C1,0,0,0),   P1[6],P1[7],P1[8],P1[9],     pw2[2]=PKW(P1,4), pw2[3]=PKW(P1,6), pw2); \
    VRD(3); SBAR(); GAPA(C0=__builtin_amdgcn_mfma_f32_32x32x16_bf16(kf[6],qr[3],C0,0,0,0),   P1[10],P1[11],P1[12],P1[13], pw3[0]=PKW(P1,8), pw3[1]=PKW(P1,10), pw3); \
    VRD(7); SBAR(); GAPA(C1=__builtin_amdgcn_mfma_f32_32x32x16_bf16(kf[7],qr[3],C1,0,0,0),   P1[14],P1[15],0.f,0.f,       pw3[2]=PKW(P1,12),pw3[3]=PKW(P1,14), pw3); \
    C0=__builtin_amdgcn_mfma_f32_32x32x16_bf16(kbA_,qone,C0,0,0,0); C1=__builtin_amdgcn_mfma_f32_32x32x16_bf16(kbB_,qone,C1,0,0,0); \
    l_reg+=sacc; \
    if(GK){DMA_K((t)+3,sl_cur);} if(GV){DMA_V((t)+1,sl_next);} \
    CMASK(C0,C1,t); \
    { float a=MX3(C0[0],C0[1],C1[0]),b=MX3(C0[2],C0[3],C1[1]); a=MX3(a,C1[2],C1[3]); \
      _Pragma("unroll") for(int r=4;r<16;r+=4){a=MX3(a,C0[r],C0[r+1]);b=MX3(b,C0[r+2],C0[r+3]);a=MX3(a,C1[r],C1[r+1]);b=MX3(b,C1[r+2],C1[r+3]);} \
      float rm=__builtin_fmaxf(a,b); { auto rr=__builtin_amdgcn_permlane32_swap(__float_as_uint(rm),__float_as_uint(rm),false,false); rm=__builtin_fmaxf(__uint_as_float(rr[0]),__uint_as_float(rr[1])); } \
      resc=false; \
      if(__builtin_expect(__any(rm>(float)THRL),0)){ const float dl=__builtin_fmaxf(rm,0.f); mhat+=dl; \
        _Pragma("unroll") for(int r=0;r<16;++r){C0[r]-=dl;C1[r]-=dl;} \
        qone=mkq(-mhat,hi); \
        const float f=__builtin_amdgcn_exp2f(-dl); l_reg*=f; if(hi==0)wsf[r32]=f; resc=true; } } \
    SBAR(); \
    GAPB(o[0]=__builtin_amdgcn_mfma_f32_32x32x16_bf16(PAF(0),VFR(0),o[0],0,0,0), C0,0); \
    GAPB(o[1]=__builtin_amdgcn_mfma_f32_32x32x16_bf16(PAF(0),VFR(4),o[1],0,0,0), C0,4); \
    KRD(GL,0); GAPB(o[0]=__builtin_amdgcn_mfma_f32_32x32x16_bf16(PAF(1),VFR(1),o[0],0,0,0), C0,8); \
    KRD(GL,1); GAPB(o[1]=__builtin_amdgcn_mfma_f32_32x32x16_bf16(PAF(1),VFR(5),o[1],0,0,0), C0,12); \
    KRD(GL,2); GAPB(o[0]=__builtin_amdgcn_mfma_f32_32x32x16_bf16(PAF(2),VFR(2),o[0],0,0,0), C1,0); \
    KRD(GL,3); GAPB(o[1]=__builtin_amdgcn_mfma_f32_32x32x16_bf16(PAF(2),VFR(6),o[1],0,0,0), C1,4); \
    GAPB(o[0]=__builtin_amdgcn_mfma_f32_32x32x16_bf16(PAF(3),VFR(3),o[0],0,0,0), C1,8); \
    GAPB(o[1]=__builtin_amdgcn_mfma_f32_32x32x16_bf16(PAF(3),VFR(7),o[1],0,0,0), C1,12); \
    }while(0)
  int t=1;
  #undef CMASK
  #define CMASK(P0,P1,t) do{}while(0)
  for(;t+5<NT;t+=2){
    STEP(pB0,pB1,pA0,pA1,t,true,true,true);     WAIT_BAR(2); RESC(); ROT();
    STEP(pA0,pA1,pB0,pB1,t+1,true,true,true);   WAIT_BAR(2); RESC(); ROT();
  }
  #undef CMASK
  #define CMASK(P0,P1,t) do{int jb_=(t)-(NT-4); if(jb_>=0)cmask(P0,P1,jb_,qrel,hi);}while(0)
  #define ENDW(tt) do{ if((tt)+3<NT){WAIT_BAR(2);} else if((tt)+2<NT){WAIT_BAR(1);} else {WAIT_BAR(0);} }while(0)
  for(;t+1<NT;t+=2){
    STEP(pB0,pB1,pA0,pA1,t,(t+3<NT),(t+1<NT),(t+1<NT));       ENDW(t);   RESC(); ROT();
    STEP(pA0,pA1,pB0,pB1,t+1,(t+4<NT),(t+2<NT),(t+2<NT));     ENDW(t+1); RESC(); ROT();
  }
  STEP(pB0,pB1,pA0,pA1,NT-1,false,false,false); RESC();
  { float sacc=pB0[0]+pB0[1]; _Pragma("unroll") for(int r=2;r<16;++r)sacc+=pB0[r]; _Pragma("unroll") for(int r=0;r<16;++r)sacc+=pB1[r]; l_reg+=sacc;
    pw0=(u32x4){PKW(pB0,0),PKW(pB0,2),PKW(pB0,4),PKW(pB0,6)};pw1=(u32x4){PKW(pB0,8),PKW(pB0,10),PKW(pB0,12),PKW(pB0,14)};pw2=(u32x4){PKW(pB1,0),PKW(pB1,2),PKW(pB1,4),PKW(pB1,6)};pw3=(u32x4){PKW(pB1,8),PKW(pB1,10),PKW(pB1,12),PKW(pB1,14)};
    SBAR(); pv(o,vb0+sl_cur,PAF(0),PAF(1),PAF(2),PAF(3)); }
  #undef PKW
  #undef PAF
  #undef VFR
  #undef PIN
  #undef MX3
  #undef GAPA
  #undef GAPB
  #undef EX
  #undef VRD
  #undef KRD
  #undef STEP
  #undef ENDW
  {auto rr=__builtin_amdgcn_permlane32_swap(__float_as_uint(l_reg),__float_as_uint(l_reg),false,false);l_reg=__uint_as_float(rr[0])+__uint_as_float(rr[1]);}
  if(hi==0)wsf[32+r32]=l_reg;asm volatile("s_waitcnt lgkmcnt(0)":::"memory");
  float rli[16];
  #pragma unroll
  for(int r=0;r<16;++r)rli[r]=__builtin_amdgcn_rcpf(wsf[32+crow(r,hi)]);
  bf16*Ow=O+(rowbase+q0+wid*QBLK)*DM+h*D;
  { bf16*stg=(bf16*)(shm+LDS_OST)+wid*2048;
    #pragma unroll
    for(int r=0;r<16;++r){const int orow=crow(r,hi);
      #pragma unroll
      for(int d0=0;d0<2;++d0)stg[orow*64+d0*32+r32]=__float2bfloat16(o[d0][r]*rli[r]);}
    asm volatile("s_waitcnt lgkmcnt(0)":::"memory");
    #pragma unroll
    for(int i=0;i<4;++i){const int row=i*8+(lane>>3),ch=lane&7; const u32x4 v=*(const u32x4*)(stg+row*64+ch*8); ATTN_STORE16(Ow+(long)row*DM+ch*8,v);} }
  asm volatile("s_waitcnt lgkmcnt(0)\n\ts_barrier":::"memory");
  #undef DMA_K
  #undef DMA_V
  #undef MKB
  #undef CMASK
  #undef START
  #undef RESC
  #undef ROT
}
constexpr int ATTN_LDS_BYTES=LDS_BYTES;
struct AttnTensors { const bf16* Q; const bf16* K; const bf16* V; bf16* O; const float* FL2; };
struct AttnUnit { int bh; int qb; };
struct StaticOrder {
  int vcu;
  __device__ __forceinline__ explicit StaticOrder(int grid,int block):vcu((block%8)*(grid/8)+block/8){}
  __device__ __forceinline__ bool next(int i,AttnUnit&u)const{ if(i>=2)return false; const int s=vcu&31; u.bh=vcu>>5; u.qb=(i==0)?s:63-s; return true; }
  __device__ __forceinline__ void a_ready(const AttnUnit&)const{}
  __device__ __forceinline__ void done(const AttnUnit&)const{}
};
template<class Sched,int THRL=8> __device__ __forceinline__ void attn_phase(char*lds,const AttnTensors&T,const Sched&S,int tid_in){
  AttnUnit u;
  for(int i=0;S.next(i,u);++i){ S.a_ready(u); attn_unit<THRL>(u.bh/NHEAD,u.bh%NHEAD,u.qb,T.Q,T.K,T.V,T.O,T.FL2,lds,tid_in); S.done(u); }
}
#undef SBAR
#undef WAIT_BAR
}
#define LAS __attribute__((address_space(3)))
typedef unsigned short bf16;
typedef unsigned v4u __attribute__((ext_vector_type(4)));
typedef unsigned v2u __attribute__((ext_vector_type(2)));
typedef float f32x4 __attribute__((ext_vector_type(4)));
typedef short bf16x8 __attribute__((ext_vector_type(8)));
typedef const __attribute__((address_space(4))) unsigned* cu32p;
typedef const __attribute__((address_space(4))) float* cf32p;

constexpr int M = 16384, D = 1024, DFF = 2816, ZP = 8704, NL = 4, NWAVES = 8, NTHR = 512;
constexpr int ZQ = 0, ZK = 512, ZV = 1024, ZXB = 1536, ZYB = 2560, ZRW = 3584, ZGT = 5376, ZFL = 8448;
constexpr float ALPHA = 1.6817928305074292f, LN_EPS = 1e-5f, GN_EPS = 64e-5f, LOG2E = 1.4426950408889634f;
constexpr int NCH = 256, LC = 64;

constexpr size_t MiB = 1u << 20;
constexpr size_t WS_ADA = 1 * MiB, WS_FL2 = 2 * MiB, WS_LAEND = 3 * MiB, WS_LHEND = 4 * MiB, WS_LCAR = 5 * MiB, WS_BON = 6 * MiB;
constexpr size_t WS_W = 8 * MiB;
constexpr size_t W_UP0 = WS_W, W_UP1 = WS_W + 11 * MiB, W_DN0 = WS_W + 22 * MiB, W_DN1 = WS_W + 22 * MiB + 5632 * 1024, W_IN = WS_W + 33 * MiB,
                 W_PA = WS_W + 50 * MiB, W_PB = WS_W + 51 * MiB, W_PC = WS_W + 53 * MiB, W_OUT = WS_W + 54 * MiB, W_LORA = WS_W + 56 * MiB;
constexpr size_t WS_HB = 65 * MiB, WS_Y = 97 * MiB, WS_HLOC = 97 * MiB, WS_ACUM = 129 * MiB, WS_P = 97 * MiB, WS_G = 129 * MiB;
constexpr size_t WS_RWO = 161 * MiB, WS_CODES = 177 * MiB, WS_LORA = 185 * MiB, WS_S0 = 185 * MiB;
constexpr size_t WS_RW_W = 233 * MiB, WS_RW_R = 265 * MiB, WS_RW_KF = 281 * MiB, WS_RW_V = 297 * MiB, WS_RW_KK = 313 * MiB, WS_RW_B = 329 * MiB, WS_GB = 345 * MiB;
constexpr size_t WS_Z = 361 * MiB, WS_ACT = 361 * MiB, WS_END = 697 * MiB;
struct RwSet { size_t w, r, kf, kk, b; };
__device__ __forceinline__ RwSet rw_set(int l) { return (l & 1) ? RwSet{WS_HB, 633 * MiB, 649 * MiB, 665 * MiB, 681 * MiB} : RwSet{WS_RW_W, WS_RW_R, WS_RW_KF, WS_RW_KK, WS_RW_B}; }
constexpr int MISC_OFF = attn_body::ATTN_LDS_BYTES, LDS_BYTES = attn_body::ATTN_LDS_BYTES + 64;
constexpr size_t CTL_ZERO_BYTES = 16384;
constexpr int LDS_PHASE_BYTES = attn_body::ATTN_LDS_BYTES;
static_assert(LDS_BYTES >= pg8::STAGE_BYTES && LDS_BYTES <= 160 * 1024, "LDS map");

__device__ __forceinline__ unsigned f2bf(float f) { unsigned u = __builtin_bit_cast(unsigned, f); return (u + 0x7fffu + ((u >> 16) & 1u)) >> 16; }
__device__ __forceinline__ unsigned pk2(float lo, float hi) { return f2bf(lo) | (f2bf(hi) << 16); }
__device__ __forceinline__ float bflo(unsigned u) { return __uint_as_float(u << 16); }
__device__ __forceinline__ float bfhi(unsigned u) { return __uint_as_float(u & 0xffff0000u); }
__device__ __forceinline__ float bf1(bf16 b) { return __uint_as_float(((unsigned)b) << 16); }
__device__ __forceinline__ float shx(float v, int o, int lane) { return __builtin_bit_cast(float, __builtin_amdgcn_ds_bpermute((lane ^ o) << 2, __builtin_bit_cast(int, v))); }
__device__ __forceinline__ float wave_sum(float v, int lane) {
#pragma unroll
    for (int o = 1; o < 64; o <<= 1) v += shx(v, o, lane);
    return v;
}
__device__ __forceinline__ float sigm(float x) { return __builtin_amdgcn_rcpf(1.f + __expf(-x)); }
__device__ __forceinline__ float tanh_(float z) { return 1.f - 2.f * __builtin_amdgcn_rcpf(1.f + __expf(2.f * z)); }
__device__ __forceinline__ float gelu_tanh(float x) { return 0.5f * x * (1.f + tanh_(0.7978845608028654f * (x + 0.044715f * x * x * x))); }
__device__ __forceinline__ float softplus_(float x) { return fmaxf(x, 0.f) + log1pf(__expf(-fabsf(x))); }
#define LDS_WAIT() asm volatile("s_waitcnt lgkmcnt(0)" ::: "memory")

struct Args { const float* in[32]; float* out; unsigned char* ws; };
typedef const __attribute__((address_space(4))) Args* CA;

struct EpiSwiGLU {
    static constexpr bool PERM = true, AFTER_DRAIN = false; bf16* O; int ldc;
    __device__ __forceinline__ void operator()(const pg8::f32x4 (&acc)[2][2][4][2], const pg8::Unit& u, int wr, int wc, int fr, int fq) const {
        const int row0 = u.pm * 256 + wr * 64 + fr, col0 = u.pn * 128 + wc * 32 + 8 * fq;
#pragma unroll
        for (int ai = 0; ai < 2; ++ai)
#pragma unroll
            for (int m = 0; m < 4; ++m) {
                bf16* rowp = O + (size_t)(row0 + ai * 128 + m * 16) * ldc + col0; float o[8];
#pragma unroll
                for (int n = 0; n < 2; ++n)
#pragma unroll
                    for (int i = 0; i < 4; ++i) { const float uu = acc[ai][0][m][n][i], gg = acc[ai][1][m][n][i]; o[n * 4 + i] = uu * sigm(uu) * gg; }
                v4u w; w.x = pk2(o[0], o[1]); w.y = pk2(o[2], o[3]); w.z = pk2(o[4], o[5]); w.w = pk2(o[6], o[7]); *(v4u*)rowp = w; }
    }
};
struct EpiGateF32 {
    static constexpr bool PERM = false, AFTER_DRAIN = false; float* Y; const float* gate; float mul;
    __device__ __forceinline__ void operator()(const pg8::f32x4 (&acc)[2][2][4][2], const pg8::Unit& u, int wr, int wc, int fr, int fq) const {
        const int row0 = u.pm * 256 + wr * 64 + fr, col0 = u.pn * 256 + wc * 32 + 4 * fq;
#pragma unroll
        for (int bj = 0; bj < 2; ++bj)
#pragma unroll
            for (int n = 0; n < 2; ++n) { const int c = col0 + bj * 128 + n * 16; const f32x4 gv = *(const f32x4*)(gate + c) * mul;
#pragma unroll
                for (int ai = 0; ai < 2; ++ai)
#pragma unroll
                    for (int m = 0; m < 4; ++m) *(f32x4*)(Y + (size_t)(row0 + ai * 128 + m * 16) * D + c) = acc[ai][bj][m][n] * gv; }
    }
};
struct EpiIn {
    static constexpr bool PERM = true, AFTER_DRAIN = false; bf16* Z;
    __device__ __forceinline__ void operator()(const pg8::f32x4 (&acc)[2][2][4][2], const pg8::Unit& u, int wr, int wc, int fr, int fq) const {
        const int row0 = u.pm * 256 + wr * 64 + fr, col0 = u.pn * 256 + wc * 32 + 8 * fq;
        const int mode = (u.pn < 2) ? 1 : ((u.pn >= 21 && u.pn < 33) ? 2 : 0);
#pragma unroll
        for (int ai = 0; ai < 2; ++ai)
#pragma unroll
            for (int m = 0; m < 4; ++m) { bf16* rowp = Z + (size_t)(row0 + ai * 128 + m * 16) * ZP + col0;
#pragma unroll
                for (int bj = 0; bj < 2; ++bj) { float o[8];
#pragma unroll
                    for (int n = 0; n < 2; ++n)
#pragma unroll
                        for (int i = 0; i < 4; ++i) { float v = acc[ai][bj][m][n][i]; if (mode == 1) v *= attn_body::C2; else if (mode == 2) v = sigm(v); o[n * 4 + i] = v; }
                    v4u w; w.x = pk2(o[0], o[1]); w.y = pk2(o[2], o[3]); w.z = pk2(o[4], o[5]); w.w = pk2(o[6], o[7]); *(v4u*)(rowp + bj * 128) = w; } }
    }
};
struct EpiPlain {
    static constexpr bool PERM = true, AFTER_DRAIN = false; bf16* O; int ldc;
    __device__ __forceinline__ void operator()(const pg8::f32x4 (&acc)[2][2][4][2], const pg8::Unit& u, int wr, int wc, int fr, int fq) const {
        const int row0 = u.pm * 256 + wr * 64 + fr, col0 = u.pn * 256 + wc * 32 + 8 * fq;
#pragma unroll
        for (int ai = 0; ai < 2; ++ai)
#pragma unroll
            for (int m = 0; m < 4; ++m) { bf16* rowp = O + (size_t)(row0 + ai * 128 + m * 16) * ldc + col0;
#pragma unroll
                for (int bj = 0; bj < 2; ++bj) { const pg8::f32x4 v0 = acc[ai][bj][m][0], v1 = acc[ai][bj][m][1];
                    v4u w; w.x = pk2(v0[0], v0[1]); w.y = pk2(v0[2], v0[3]); w.z = pk2(v1[0], v1[1]); w.w = pk2(v1[2], v1[3]); *(v4u*)(rowp + bj * 128) = w; } }
    }
};
template <int PASS> struct EpiProj {
    static constexpr bool PERM = false, AFTER_DRAIN = false; float* Y; const bf16* Z; bf16* MIX;
    __device__ __forceinline__ void operator()(const pg8::f32x4 (&acc)[2][2][4][2], const pg8::Unit& u, int wr, int wc, int fr, int fq) const {
        const int row0 = u.pm * 256 + wr * 64 + fr, col0 = u.pn * 256 + wc * 32 + 4 * fq;
#pragma unroll
        for (int ai = 0; ai < 2; ++ai)
#pragma unroll
            for (int m = 0; m < 4; ++m) { const size_t row = (size_t)(row0 + ai * 128 + m * 16);
#pragma unroll
                for (int bj = 0; bj < 2; ++bj)
#pragma unroll
                    for (int n = 0; n < 2; ++n) { const int c = col0 + bj * 128 + n * 16;
                        const v2u gw = *(const v2u*)(Z + row * ZP + ZGT + PASS * 1024 + c);
                        f32x4 gv; gv.x = bflo(gw.x); gv.y = bfhi(gw.x); gv.z = bflo(gw.y); gv.w = bfhi(gw.y);
                        f32x4 v = acc[ai][bj][m][n] * gv; float* yp = Y + row * D + c;
                        if (PASS > 0) v += *(const f32x4*)yp;
                        if (PASS < 2) *(f32x4*)yp = v; else { v2u w; w.x = pk2(v.x, v.y); w.y = pk2(v.z, v.w); *(v2u*)(MIX + row * D + c) = w; } } }
    }
};

__device__ __forceinline__ void cvt_item(const float* W, int ldw, int sk0, int sn0, int nvalid, bf16* WT, int ldo, int orow0, int dk0, LAS float* scr, int lane) {
    const int n_ = lane & 31;
#pragma unroll 8
    for (int i = 0; i < 32; ++i) { const int kk = 2 * i + (lane >> 5); scr[kk * 33 + n_] = (n_ < nvalid) ? W[(size_t)(sk0 + kk) * ldw + sn0 + n_] : 0.f; }
    LDS_WAIT(); asm volatile("" ::: "memory");
    const int c = lane & 7;
#pragma unroll
    for (int j = 0; j < 4; ++j) { const int n = (lane >> 3) + 8 * j; const LAS float* s = scr + (8 * c) * 33 + n;
        v4u o; o.x = pk2(s[0 * 33], s[1 * 33]); o.y = pk2(s[2 * 33], s[3 * 33]); o.z = pk2(s[4 * 33], s[5 * 33]); o.w = pk2(s[6 * 33], s[7 * 33]);
        *(v4u*)(WT + (size_t)(orow0 + n) * ldo + dk0 + 8 * c) = o; }
    LDS_WAIT(); asm volatile("" ::: "memory");
}
__device__ __forceinline__ void convert_layer(CA a, int l, LAS unsigned char* lds, int gw, int NGW, int wave, int lane) {
    LAS float* scr = (LAS float*)(lds + wave * 16384);
    unsigned char* ws = a->ws;
    constexpr int I_UP = 16 * 176, I_DN = 44 * 32, I_IN = 16 * 272, I_PA = 8 * 32, I_PB = 16 * 32, I_LO = 4 * 48;
    constexpr int NITEMS = 2 * I_UP + 2 * I_DN + I_IN + 2 * I_PA + 2 * I_PB + I_LO;
    for (int it = gw; it < NITEMS; it += NGW) {
        int r = it;
        if (r < 2 * I_UP) { const int s = r / I_UP; r -= s * I_UP; const int kb = r / 176, ob = r % 176, orow0 = 32 * ob, pn = orow0 >> 8, wi = orow0 & 255;
            const int sn0 = (wi < 128) ? (128 * pn + wi) : (DFF + 128 * pn + wi - 128);
            cvt_item(a->in[6] + (size_t)(l * 2 + s) * D * 2 * DFF, 2 * DFF, 64 * kb, sn0, 32, (bf16*)(ws + (s ? W_UP1 : W_UP0)), D, orow0, 64 * kb, scr, lane); continue; }
        r -= 2 * I_UP;
        if (r < 2 * I_DN) { const int s = r / I_DN; r -= s * I_DN; const int kb = r / 32, ob = r % 32;
            cvt_item(a->in[7] + (size_t)(l * 2 + s) * DFF * D, D, 64 * kb, 32 * ob, 32, (bf16*)(ws + (s ? W_DN1 : W_DN0)), DFF, 32 * ob, 64 * kb, scr, lane); continue; }
        r -= 2 * I_DN;
        if (r < I_IN) { const int kb = r / 272, ob = r % 272, orow0 = 32 * ob; int sn0, nv;
            if (orow0 < 1536) { sn0 = orow0; nv = 32; } else if (orow0 < ZFL) { sn0 = orow0 + 8; nv = 32; } else if (orow0 == ZFL) { sn0 = 1536; nv = 8; } else { sn0 = 0; nv = 0; }
            cvt_item(a->in[8] + (size_t)l * D * 8456, 8456, 64 * kb, sn0, nv, (bf16*)(ws + W_IN), D, orow0, 64 * kb, scr, lane); continue; }
        r -= I_IN;
        if (r < I_PA) { const int kb = r / 32, ob = r % 32; cvt_item(a->in[28] + (size_t)l * 512 * D, D, 64 * kb, 32 * ob, 32, (bf16*)(ws + W_PA), 512, 32 * ob, 64 * kb, scr, lane); continue; }
        r -= I_PA;
        if (r < I_PB) { const int kb = r / 32, ob = r % 32; cvt_item(a->in[29] + (size_t)l * D * D, D, 64 * kb, 32 * ob, 32, (bf16*)(ws + W_PB), D, 32 * ob, 64 * kb, scr, lane); continue; }
        r -= I_PB;
        if (r < I_PA) { const int kb = r / 32, ob = r % 32; cvt_item(a->in[30] + (size_t)l * 512 * D, D, 64 * kb, 32 * ob, 32, (bf16*)(ws + W_PC), 512, 32 * ob, 64 * kb, scr, lane); continue; }
        r -= I_PA;
        if (r < I_PB) { const int kb = r / 32, ob = r % 32; cvt_item(a->in[31] + (size_t)l * D * D, D, 64 * kb, 32 * ob, 32, (bf16*)(ws + W_OUT), D, 32 * ob, 64 * kb, scr, lane); continue; }
        r -= I_PB;
        {
            const int kb = r / 48, ob = r % 48, reg = ob / 16, nb = ob % 16; const float* W = a->in[19]; int sk0 = 0, nv = 0;
            if (reg == 0 && kb == 0) { W = a->in[19] + (size_t)l * 64 * 512; nv = 32; }
            else if (reg == 1 && kb == 1) { W = a->in[21] + (size_t)l * 64 * 512; nv = 32; }
            else if (reg == 2 && kb >= 2) { W = a->in[22] + (size_t)l * 128 * 512; sk0 = 64 * (kb - 2); nv = 32; }
            cvt_item(W, 512, sk0, 32 * nb, nv, (bf16*)(ws + W_LORA), 256, 32 * ob, 64 * kb, scr, lane); }
    }
}

__device__ __forceinline__ void row_stats(const f32x4 (&v)[4], float& mean, float& rstd, int lane) {
    float s = 0.f;
#pragma unroll
    for (int j = 0; j < 4; ++j) s += (v[j].x + v[j].y) + (v[j].z + v[j].w);
    mean = wave_sum(s, lane) * (1.f / D); float s2 = 0.f;
#pragma unroll
    for (int j = 0; j < 4; ++j) { const f32x4 d = v[j] - mean; s2 += (d.x * d.x + d.y * d.y) + (d.z * d.z + d.w * d.w); }
    rstd = 1.f / sqrtf(wave_sum(s2, lane) * (1.f / D) + LN_EPS);
}
__device__ __forceinline__ void store_mod(const f32x4 (&v)[4], float mean, float rstd, const float* sh, const float* sc, bf16* hrow, int lane) {
#pragma unroll
    for (int j = 0; j < 4; ++j) { const int c = 4 * lane + 256 * j; const f32x4 s1 = *(const f32x4*)(sc + c) + 1.f, s0 = *(const f32x4*)(sh + c);
        const f32x4 h = (v[j] - mean) * rstd * s1 + s0; v2u w; w.x = pk2(h.x, h.y); w.y = pk2(h.z, h.w); *(v2u*)(hrow + c) = w; }
}
__device__ __forceinline__ void wave_sum2(float& a, float& b, int lane) {
#pragma unroll
    for (int o = 1; o < 64; o <<= 1) { const float ta = shx(a, o, lane), tb = shx(b, o, lane); a += ta; b += tb; }
}
__device__ __forceinline__ void row_stats2(const f32x4 (&v)[2][4], float (&mean)[2], float (&rstd)[2], int lane) {
    float s[2], q[2];
#pragma unroll
    for (int r = 0; r < 2; ++r) { s[r] = 0.f;
#pragma unroll
        for (int j = 0; j < 4; ++j) s[r] += (v[r][j].x + v[r][j].y) + (v[r][j].z + v[r][j].w); }
    wave_sum2(s[0], s[1], lane);
#pragma unroll
    for (int r = 0; r < 2; ++r) { mean[r] = s[r] * (1.f / D); q[r] = 0.f;
#pragma unroll
        for (int j = 0; j < 4; ++j) { const f32x4 d = v[r][j] - mean[r]; q[r] += (d.x * d.x + d.y * d.y) + (d.z * d.z + d.w * d.w); } }
    wave_sum2(q[0], q[1], lane);
#pragma unroll
    for (int r = 0; r < 2; ++r) rstd[r] = 1.f / sqrtf(q[r] * (1.f / D) + LN_EPS);
}
__device__ __forceinline__ void ln_phase(const float* xsrc, const float* Y, float* xout, bf16* H, const float* lng, const float* lnb, const float* sh, const float* sc, bool do_mod, int gw, int NGW, int lane) {
    for (int m = gw * 2; m < M; m += NGW * 2) {
        f32x4 v[2][4];
#pragma unroll
        for (int r = 0; r < 2; ++r)
#pragma unroll
            for (int j = 0; j < 4; ++j) { const size_t o = (size_t)(m + r) * D + 4 * lane + 256 * j; v[r][j] = *(const f32x4*)(xsrc + o) * ALPHA + *(const f32x4*)(Y + o); }
        float mean[2], rstd[2]; row_stats2(v, mean, rstd, lane);
#pragma unroll
        for (int j = 0; j < 4; ++j) { const int c = 4 * lane + 256 * j; const f32x4 g4 = *(const f32x4*)(lng + c), b4 = *(const f32x4*)(lnb + c);
#pragma unroll
            for (int r = 0; r < 2; ++r) { v[r][j] = (v[r][j] - mean[r]) * rstd[r] * g4 + b4; *(f32x4*)(xout + (size_t)(m + r) * D + c) = v[r][j]; } }
        if (do_mod) { row_stats2(v, mean, rstd, lane);
#pragma unroll
            for (int r = 0; r < 2; ++r) store_mod(v[r], mean[r], rstd[r], sh, sc, H + (size_t)(m + r) * D, lane); }
    }
}
__device__ __forceinline__ void mod_phase(const float* x, bf16* H, const float* sh, const float* sc, int gw, int NGW, int lane) {
    for (int m = gw; m < M; m += NGW) {
        f32x4 v[4];
#pragma unroll
        for (int j = 0; j < 4; ++j) v[j] = *(const f32x4*)(x + (size_t)m * D + 4 * lane + 256 * j);
        float mean, rstd; row_stats(v, mean, rstd, lane); store_mod(v, mean, rstd, sh, sc, H + (size_t)m * D, lane);
    }
}
__device__ __forceinline__ void ada_phase(CA a, LAS unsigned char* lds, int tid, int lane, int wave, int bid) {
    LAS float* cact = (LAS float*)lds; LAS float* part = cact + 1024;
    for (int i = tid; i < D; i += NTHR) { const float c = a->in[1][i]; cact[i] = c * sigm(c); }
    __syncthreads();
    float* ADA = (float*)(a->ws + WS_ADA);
    for (int task = bid; task < NL * 144; task += gridDim.x) {
        const int l = task / 144, col = (task % 144) * 64 + lane; const float* W = a->in[2] + (size_t)l * D * 9216 + col; float s = 0.f;
#pragma unroll 16
        for (int k = wave * 128; k < wave * 128 + 128; ++k) s += cact[k] * W[(size_t)k * 9216];
        part[wave * 64 + lane] = s; __syncthreads();
        if (wave == 0) { float t = 0.f;
#pragma unroll
            for (int w = 0; w < 8; ++w) t += part[w * 64 + lane];
            ADA[l * 9216 + col] = t + a->in[3][l * 9216 + col]; }
        __syncthreads();
    }
}

__device__ __forceinline__ void fscan_head(const bf16* Z, const float* fbias, float* FL2, int h, LAS unsigned char* lds, int tid, int lane, int wave) {
    LAS float* wt = (LAS float*)lds; const float fb = fbias[h]; float lf[32]; float run = 0.f;
#pragma unroll
    for (int i = 0; i < 32; ++i) { const float x = bf1(Z[(size_t)(tid * 32 + i) * ZP + ZFL + h]) + fb; run += -softplus_(-x); lf[i] = run; }
    float inc = run;
#pragma unroll
    for (int o = 1; o < 64; o <<= 1) { const float t = __builtin_bit_cast(float, __builtin_amdgcn_ds_bpermute(((lane - o) & 63) << 2, __builtin_bit_cast(int, inc))); if (lane >= o) inc += t; }
    if (lane == 63) wt[wave] = inc;
    __syncthreads();
    float base = inc - run;
    for (int w = 0; w < wave; ++w) base += wt[w];
#pragma unroll
    for (int i = 0; i < 32; ++i) FL2[(size_t)h * M + tid * 32 + i] = (base + lf[i]) * LOG2E;
    __syncthreads();
}
__device__ __forceinline__ void codes_phase(const bf16* Z, const float* mu, bf16* CODES, int gtid, int NGT) {
    for (int it = gtid; it < M * 32; it += NGT) { const int t = it >> 5, j0 = (it & 31) * 8;
        const v4u z = *(const v4u*)(Z + (size_t)t * ZP + ZRW + 1536 + j0); v4u zp = (v4u){0u, 0u, 0u, 0u};
        if (t > 0) zp = *(const v4u*)(Z + (size_t)(t - 1) * ZP + ZRW + 1536 + j0);
        float o[8];
#pragma unroll
        for (int q = 0; q < 4; ++q) { const float a0 = bflo(z[q]), a1 = bfhi(z[q]), p0 = bflo(zp[q]), p1 = bfhi(zp[q]); const float m0 = mu[1536 + j0 + 2 * q], m1 = mu[1536 + j0 + 2 * q + 1];
            o[2 * q] = a0 + (p0 - a0) * m0; o[2 * q + 1] = a1 + (p1 - a1) * m1; }
#pragma unroll
        for (int q = 0; q < 8; ++q) { if (j0 < 64) o[q] = tanh_(o[q]); else if (j0 >= 128) o[q] = sigm(o[q]); }
        v4u w; w.x = pk2(o[0], o[1]); w.y = pk2(o[2], o[3]); w.z = pk2(o[4], o[5]); w.w = pk2(o[6], o[7]); *(v4u*)(CODES + (size_t)t * 256 + j0) = w; }
}
__device__ __forceinline__ void lru_l1(CA a, int l, const bf16* Z, bf16* HLOC, bf16* ACUM, float* AEND, float* HEND, LAS unsigned char* lds, int tid, int lane, int wave, int bid) {
    LAS float* xcf = (LAS float*)lds; LAS bf16* xcb = (LAS bf16*)(lds + 16640); LAS bf16* wga = (LAS bf16*)(lds + 25856); LAS bf16* wgx = (LAS bf16*)(lds + 35072);
    LAS float* la = (LAS float*)(lds + 44288); LAS float* lu = (LAS float*)(lds + 60928); LAS float* agg = (LAS float*)(lds + 77568);
    const float* cw = a->in[10] + (size_t)l * 4 * D; const float* cb = a->in[11] + (size_t)l * D;
    const float* gaw = a->in[12] + (size_t)l * 16 * 4096; const float* gab = a->in[13] + (size_t)l * D;
    const float* gxw = a->in[14] + (size_t)l * 16 * 4096; const float* gxb = a->in[15] + (size_t)l * D; const float* lam = a->in[16] + (size_t)l * D;
    int nprev = -1;
    for (int task = bid; task < NCH * 16; task += gridDim.x) {
        const int c = task >> 4, n = task & 15, t0 = c * LC;
        {
            const int tok = tid >> 3, cg8 = (tid & 7) * 8, ch0 = n * 64 + cg8; float acc[8];
#pragma unroll
            for (int q = 0; q < 8; ++q) acc[q] = cb[ch0 + q];
#pragma unroll
            for (int j = 0; j < 4; ++j) { const int tt = t0 + tok - 3 + j;
                if (tt >= 0) { const v4u x = *(const v4u*)(Z + (size_t)tt * ZP + ZXB + ch0);
#pragma unroll
                    for (int q = 0; q < 4; ++q) { acc[2 * q] += cw[j * D + ch0 + 2 * q] * bflo(x[q]); acc[2 * q + 1] += cw[j * D + ch0 + 2 * q + 1] * bfhi(x[q]); } } }
#pragma unroll
            for (int q = 0; q < 8; ++q) xcf[tok * 65 + cg8 + q] = acc[q];
            v4u w; w.x = pk2(acc[0], acc[1]); w.y = pk2(acc[2], acc[3]); w.z = pk2(acc[4], acc[5]); w.w = pk2(acc[6], acc[7]); *(LAS v4u*)(xcb + tok * 72 + cg8) = w;
        }
        if (n != nprev) {
            const int i = tid >> 3, j0 = (tid & 7) * 8;
#pragma unroll
            for (int q = 0; q < 8; ++q) { wga[(j0 + q) * 72 + i] = (bf16)f2bf(gaw[(size_t)n * 4096 + i * 64 + j0 + q]); wgx[(j0 + q) * 72 + i] = (bf16)f2bf(gxw[(size_t)n * 4096 + i * 64 + j0 + q]); }
            nprev = n;
        }
        __syncthreads();
        {
            const int tb = wave & 3, cbp = wave >> 2, fr = lane & 15, fq = lane >> 4;
            bf16x8 af[2];
#pragma unroll
            for (int kk = 0; kk < 2; ++kk) af[kk] = *(const LAS bf16x8*)(xcb + (tb * 16 + fr) * 72 + kk * 32 + fq * 8);
#pragma unroll
            for (int c2 = 0; c2 < 2; ++c2) { const int cbk = 2 * cbp + c2; f32x4 ar = (f32x4){0.f, 0.f, 0.f, 0.f}, ai = ar;
#pragma unroll
                for (int kk = 0; kk < 2; ++kk) { const bf16x8 b0 = *(const LAS bf16x8*)(wga + (cbk * 16 + fr) * 72 + kk * 32 + fq * 8), b1 = *(const LAS bf16x8*)(wgx + (cbk * 16 + fr) * 72 + kk * 32 + fq * 8);
                    ar = __builtin_amdgcn_mfma_f32_16x16x32_bf16(af[kk], b0, ar, 0, 0, 0); ai = __builtin_amdgcn_mfma_f32_16x16x32_bf16(af[kk], b1, ai, 0, 0, 0); }
                const int ch = cbk * 16 + fr, gch = n * 64 + ch; const float bga = gab[gch], bgx = gxb[gch], sp = log1pf(__expf(-lam[gch]));
#pragma unroll
                for (int rg = 0; rg < 4; ++rg) { const int tok = tb * 16 + fq * 4 + rg; const float r = sigm(ar[rg] + bga), ig = sigm(ai[rg] + bgx);
                    const float log_a = -8.f * r * sp, av = __expf(log_a), uv = sqrtf((1.f - av) * (1.f + av)) * (ig * xcf[tok * 65 + ch]);
                    la[tok * 65 + ch] = av; lu[tok * 65 + ch] = uv; } }
        }
        __syncthreads();
        {
            float hl[8], al[8]; float A = 1.f, h = 0.f;
#pragma unroll
            for (int s = 0; s < 8; ++s) { const float av = la[(wave * 8 + s) * 65 + lane], uv = lu[(wave * 8 + s) * 65 + lane]; h = av * h + uv; A *= av; hl[s] = h; al[s] = A; }
            agg[(wave * 2 + 0) * 64 + lane] = A; agg[(wave * 2 + 1) * 64 + lane] = h;
            __syncthreads();
            float cA = 1.f, cH = 0.f;
            for (int w = 0; w < wave; ++w) { const float A2 = agg[(w * 2 + 0) * 64 + lane], h2 = agg[(w * 2 + 1) * 64 + lane]; cH = A2 * cH + h2; cA *= A2; }
            float hf = 0.f, Af = 1.f;
#pragma unroll
            for (int s = 0; s < 8; ++s) { hf = hl[s] + al[s] * cH; Af = al[s] * cA; const size_t o = (size_t)(t0 + wave * 8 + s) * D + n * 64 + lane; HLOC[o] = (bf16)f2bf(hf); ACUM[o] = (bf16)f2bf(Af); }
            if (wave == 7) { AEND[c * D + n * 64 + lane] = Af; HEND[c * D + n * 64 + lane] = hf; }
        }
        __syncthreads();
    }
}
__device__ __forceinline__ void lru_l2(const float* AEND, const float* HEND, float* CAR, int gw, int lane) {
    if (gw < 16) { const int ch = gw * 64 + lane; float carry = 0.f;
#pragma unroll 8
        for (int c = 0; c < NCH; ++c) { CAR[c * D + ch] = carry; carry = AEND[c * D + ch] * carry + HEND[c * D + ch]; } }
}
__device__ __forceinline__ void lru_l3(bf16* Z, const bf16* HLOC, const bf16* ACUM, const float* CAR, int gtid, int NGT) {
    for (int it = gtid; it < M * 128; it += NGT) { const int t = it >> 7, ch0 = (it & 127) * 8; const size_t o = (size_t)t * D + ch0;
        const v4u hl = *(const v4u*)(HLOC + o), ac = *(const v4u*)(ACUM + o), yb = *(const v4u*)(Z + (size_t)t * ZP + ZYB + ch0);
        const f32x4 c0 = *(const f32x4*)(CAR + (t >> 6) * D + ch0), c1 = *(const f32x4*)(CAR + (t >> 6) * D + ch0 + 4); float o8[8];
#pragma unroll
        for (int q = 0; q < 4; ++q) { const float ca = (q < 2) ? c0[2 * q] : c1[2 * q - 4], cb_ = (q < 2) ? c0[2 * q + 1] : c1[2 * q - 3];
            o8[2 * q] = (bflo(hl[q]) + bflo(ac[q]) * ca) * gelu_tanh(bflo(yb[q])); o8[2 * q + 1] = (bfhi(hl[q]) + bfhi(ac[q]) * cb_) * gelu_tanh(bfhi(yb[q])); }
        v4u w; w.x = pk2(o8[0], o8[1]); w.y = pk2(o8[2], o8[3]); w.z = pk2(o8[4], o8[5]); w.w = pk2(o8[6], o8[7]); *(v4u*)(Z + (size_t)t * ZP + ZYB + ch0) = w; }
}
__device__ __forceinline__ void ld8bf(const bf16* p, float (&o)[8]) { const v4u u = *(const v4u*)p;
#pragma unroll
    for (int q = 0; q < 4; ++q) { o[2 * q] = bflo(u[q]); o[2 * q + 1] = bfhi(u[q]); } }
__device__ __forceinline__ void ld8f(const float* p, float (&o)[8]) { const f32x4 a = *(const f32x4*)p, b = *(const f32x4*)(p + 4); o[0] = a.x; o[1] = a.y; o[2] = a.z; o[3] = a.w; o[4] = b.x; o[5] = b.y; o[6] = b.z; o[7] = b.w; }
__device__ __forceinline__ void st8bf(bf16* p, const float (&v)[8]) { v4u w; w.x = pk2(v[0], v[1]); w.y = pk2(v[2], v[3]); w.z = pk2(v[4], v[5]); w.w = pk2(v[6], v[7]); *(v4u*)p = w; }
__device__ __forceinline__ float sum8lanes(float v, int lane) { v += shx(v, 1, lane); v += shx(v, 2, lane); v += shx(v, 4, lane); return v; }
__device__ __forceinline__ void rw_prep(CA a, int l, const bf16* Z, const bf16* LORA, float* Wd, bf16* R, bf16* KF, bf16* V, bf16* KK, bf16* Bv, bf16* GB, float* BON, int gw, int NGW, int lane) {
    const int c0 = 8 * lane;
    float mur[8], muk[8], muv[8], w0[8], a0[8], kk_[8], ka_[8], rk_[8];
    ld8f(a->in[17] + (size_t)l * 1792 + c0, mur); ld8f(a->in[17] + (size_t)l * 1792 + 512 + c0, muk); ld8f(a->in[17] + (size_t)l * 1792 + 1024 + c0, muv);
    ld8f(a->in[18] + (size_t)l * 512 + c0, w0); ld8f(a->in[20] + (size_t)l * 512 + c0, a0); ld8f(a->in[23] + (size_t)l * 512 + c0, kk_); ld8f(a->in[24] + (size_t)l * 512 + c0, ka_); ld8f(a->in[25] + (size_t)l * 512 + c0, rk_);
    for (int tb = gw * 8; tb < M; tb += NGW * 8) {
        float rp[8], kp[8], vp[8];
        if (tb > 0) { const bf16* zp = Z + (size_t)(tb - 1) * ZP + ZRW + c0; ld8bf(zp, rp); ld8bf(zp + 512, kp); ld8bf(zp + 1024, vp); }
        else {
#pragma unroll
            for (int q = 0; q < 8; ++q) { rp[q] = 0.f; kp[q] = 0.f; vp[q] = 0.f; } }
#pragma unroll 2
        for (int tt = 0; tt < 8; ++tt) { const int t = tb + tt; const bf16* zc = Z + (size_t)t * ZP + ZRW + c0; float rc[8], kc[8], vc[8], lw[8], la[8];
            ld8bf(zc, rc); ld8bf(zc + 512, kc); ld8bf(zc + 1024, vc);
            const bf16* lo = LORA + (size_t)t * 1536 + c0; ld8bf(lo, lw); ld8bf(lo + 512, la); const v4u lg = *(const v4u*)(lo + 1024);
            float r[8], k[8], v[8], dec[8], av[8], kk[8], kf[8], bb[8]; float n2 = 0.f, bs = 0.f;
#pragma unroll
            for (int q = 0; q < 8; ++q) { r[q] = rc[q] + (rp[q] - rc[q]) * mur[q]; k[q] = kc[q] + (kp[q] - kc[q]) * muk[q]; v[q] = vc[q] + (vp[q] - vc[q]) * muv[q];
                const float wv = -softplus_(-(w0[q] + lw[q])) - 0.5f; dec[q] = __expf(-__expf(wv)); av[q] = sigm(a0[q] + la[q]);
                kk[q] = k[q] * kk_[q]; n2 += kk[q] * kk[q]; kf[q] = k[q] * (1.f + (av[q] - 1.f) * ka_[q]); bs += r[q] * kf[q] * rk_[q];
                rp[q] = rc[q]; kp[q] = kc[q]; vp[q] = vc[q]; }
            n2 = sum8lanes(n2, lane); bs = sum8lanes(bs, lane); const float inv = 1.f / fmaxf(sqrtf(n2), 1e-12f);
#pragma unroll
            for (int q = 0; q < 8; ++q) { kk[q] *= inv; bb[q] = kk[q] * av[q]; }
            const size_t o = (size_t)t * 512 + c0;
            *(f32x4*)(Wd + o) = (f32x4){dec[0], dec[1], dec[2], dec[3]}; *(f32x4*)(Wd + o + 4) = (f32x4){dec[4], dec[5], dec[6], dec[7]};
            st8bf(R + o, r); st8bf(KF + o, kf); st8bf(V + o, v); st8bf(KK + o, kk); st8bf(Bv + o, bb); *(v4u*)(GB + o) = lg;
            if ((lane & 7) == 0) BON[t * 8 + (lane >> 3)] = bs; }
    }
}
constexpr int RW_PF = 4;
struct RwOps { unsigned kk[2], b[2], kf[2], r[2]; float w[4]; unsigned v; };
template <bool WITH_R> __device__ __forceinline__ RwOps rw_load(const unsigned char* ws, const RwSet rs, size_t o  , int lane) {
    RwOps x; const int i4 = (lane & 15) * 4;
#pragma unroll
    for (int j = 0; j < 2; ++j) { x.kk[j] = *(const unsigned*)(ws + rs.kk + o * 2 + 64 * j + i4); x.b[j] = *(const unsigned*)(ws + rs.b + o * 2 + 64 * j + i4); x.kf[j] = *(const unsigned*)(ws + rs.kf + o * 2 + 64 * j + i4);
        x.r[j] = WITH_R ? *(const unsigned*)(ws + rs.r + o * 2 + 64 * j + i4) : 0u; }
#pragma unroll
    for (int j = 0; j < 4; ++j) x.w[j] = *(const float*)(ws + rs.w + o * 4 + 64 * j + i4);
    x.v = *(const bf16*)(ws + WS_RW_V + o * 2 + lane * 2);
    return x;
}
#define FMAC_BC(acc, opv, y, n) asm("v_fmac_f32_dpp %0, %1, %2 row_newbcast:" #n " row_mask:0xf bank_mask:0xf" : "+v"(acc) : "v"(opv), "v"(y))
#define MUL_BC(dst, opv, y, n) asm("v_mul_f32_dpp %0, %1, %2 row_newbcast:" #n " row_mask:0xf bank_mask:0xf" : "=v"(dst) : "v"(opv), "v"(y))
#define RW_UNPACK(A, src) float A##l0 = __uint_as_float((src)[0] << 16), A##h0 = __uint_as_float((src)[0] & 0xffff0000u), A##l1 = __uint_as_float((src)[1] << 16), A##h1 = __uint_as_float((src)[1] & 0xffff0000u); \
    asm volatile("s_nop 1" : "+v"(A##l0), "+v"(A##h0), "+v"(A##l1), "+v"(A##h1))
template <int MODE> __device__ __forceinline__ float rw_step(float (&st)[64], const RwOps x) {
    RW_UNPACK(kk, x.kk); RW_UNPACK(bb, x.b); RW_UNPACK(kf, x.kf); RW_UNPACK(rr, x.r);
    float w0 = x.w[0], w1 = x.w[1], w2 = x.w[2], w3 = x.w[3]; asm volatile("" : "+v"(w0), "+v"(w1), "+v"(w2), "+v"(w3));
    float s0 = 0.f, s1 = 0.f, y0 = 0.f, y1 = 0.f; const float vv = __uint_as_float(x.v << 16);
    FMAC_BC(s0, kkl0, st[0], 0);
    FMAC_BC(s1, kkh0, st[1], 0);
    FMAC_BC(s0, kkl0, st[2], 1);
    FMAC_BC(s1, kkh0, st[3], 1);
    FMAC_BC(s0, kkl0, st[4], 2);
    FMAC_BC(s1, kkh0, st[5], 2);
    FMAC_BC(s0, kkl0, st[6], 3);
    FMAC_BC(s1, kkh0, st[7], 3);
    FMAC_BC(s0, kkl0, st[8], 4);
    FMAC_BC(s1, kkh0, st[9], 4);
    FMAC_BC(s0, kkl0, st[10], 5);
    FMAC_BC(s1, kkh0, st[11], 5);
    FMAC_BC(s0, kkl0, st[12], 6);
    FMAC_BC(s1, kkh0, st[13], 6);
    FMAC_BC(s0, kkl0, st[14], 7);
    FMAC_BC(s1, kkh0, st[15], 7);
    FMAC_BC(s0, kkl0, st[16], 8);
    FMAC_BC(s1, kkh0, st[17], 8);
    FMAC_BC(s0, kkl0, st[18], 9);
    FMAC_BC(s1, kkh0, st[19], 9);
    FMAC_BC(s0, kkl0, st[20], 10);
    FMAC_BC(s1, kkh0, st[21], 10);
    FMAC_BC(s0, kkl0, st[22], 11);
    FMAC_BC(s1, kkh0, st[23], 11);
    FMAC_BC(s0, kkl0, st[24], 12);
    FMAC_BC(s1, kkh0, st[25], 12);
    FMAC_BC(s0, kkl0, st[26], 13);
    FMAC_BC(s1, kkh0, st[27], 13);
    FMAC_BC(s0, kkl0, st[28], 14);
    FMAC_BC(s1, kkh0, st[29], 14);
    FMAC_BC(s0, kkl0, st[30], 15);
    FMAC_BC(s1, kkh0, st[31], 15);
    FMAC_BC(s0, kkl1, st[32], 0);
    FMAC_BC(s1, kkh1, st[33], 0);
    FMAC_BC(s0, kkl1, st[34], 1);
    FMAC_BC(s1, kkh1, st[35], 1);
    FMAC_BC(s0, kkl1, st[36], 2);
    FMAC_BC(s1, kkh1, st[37], 2);
    FMAC_BC(s0, kkl1, st[38], 3);
    FMAC_BC(s1, kkh1, st[39], 3);
    FMAC_BC(s0, kkl1, st[40], 4);
    FMAC_BC(s1, kkh1, st[41], 4);
    FMAC_BC(s0, kkl1, st[42], 5);
    FMAC_BC(s1, kkh1, st[43], 5);
    FMAC_BC(s0, kkl1, st[44], 6);
    FMAC_BC(s1, kkh1, st[45], 6);
    FMAC_BC(s0, kkl1, st[46], 7);
    FMAC_BC(s1, kkh1, st[47], 7);
    FMAC_BC(s0, kkl1, st[48], 8);
    FMAC_BC(s1, kkh1, st[49], 8);
    FMAC_BC(s0, kkl1, st[50], 9);
    FMAC_BC(s1, kkh1, st[51], 9);
    FMAC_BC(s0, kkl1, st[52], 10);
    FMAC_BC(s1, kkh1, st[53], 10);
    FMAC_BC(s0, kkl1, st[54], 11);
    FMAC_BC(s1, kkh1, st[55], 11);
    FMAC_BC(s0, kkl1, st[56], 12);
    FMAC_BC(s1, kkh1, st[57], 12);
    FMAC_BC(s0, kkl1, st[58], 13);
    FMAC_BC(s1, kkh1, st[59], 13);
    FMAC_BC(s0, kkl1, st[60], 14);
    FMAC_BC(s1, kkh1, st[61], 14);
    FMAC_BC(s0, kkl1, st[62], 15);
    FMAC_BC(s1, kkh1, st[63], 15);
    const float sa = -(s0 + s1);
    float t;
    MUL_BC(t, bbl0, sa, 0); if (MODE != 0) FMAC_BC(t, kfl0, vv, 0); FMAC_BC(t, w0, st[0], 0); st[0] = t; if (MODE == 2) FMAC_BC(y0, rrl0, t, 0);
    MUL_BC(t, bbh0, sa, 0); if (MODE != 0) FMAC_BC(t, kfh0, vv, 0); FMAC_BC(t, w0, st[1], 1); st[1] = t; if (MODE == 2) FMAC_BC(y1, rrh0, t, 0);
    MUL_BC(t, bbl0, sa, 1); if (MODE != 0) FMAC_BC(t, kfl0, vv, 1); FMAC_BC(t, w0, st[2], 2); st[2] = t; if (MODE == 2) FMAC_BC(y0, rrl0, t, 1);
    MUL_BC(t, bbh0, sa, 1); if (MODE != 0) FMAC_BC(t, kfh0, vv, 1); FMAC_BC(t, w0, st[3], 3); st[3] = t; if (MODE == 2) FMAC_BC(y1, rrh0, t, 1);
    MUL_BC(t, bbl0, sa, 2); if (MODE != 0) FMAC_BC(t, kfl0, vv, 2); FMAC_BC(t, w0, st[4], 4); st[4] = t; if (MODE == 2) FMAC_BC(y0, rrl0, t, 2);
    MUL_BC(t, bbh0, sa, 2); if (MODE != 0) FMAC_BC(t, kfh0, vv, 2); FMAC_BC(t, w0, st[5], 5); st[5] = t; if (MODE == 2) FMAC_BC(y1, rrh0, t, 2);
    MUL_BC(t, bbl0, sa, 3); if (MODE != 0) FMAC_BC(t, kfl0, vv, 3); FMAC_BC(t, w0, st[6], 6); st[6] = t; if (MODE == 2) FMAC_BC(y0, rrl0, t, 3);
    MUL_BC(t, bbh0, sa, 3); if (MODE != 0) FMAC_BC(t, kfh0, vv, 3); FMAC_BC(t, w0, st[7], 7); st[7] = t; if (MODE == 2) FMAC_BC(y1, rrh0, t, 3);
    MUL_BC(t, bbl0, sa, 4); if (MODE != 0) FMAC_BC(t, kfl0, vv, 4); FMAC_BC(t, w0, st[8], 8); st[8] = t; if (MODE == 2) FMAC_BC(y0, rrl0, t, 4);
    MUL_BC(t, bbh0, sa, 4); if (MODE != 0) FMAC_BC(t, kfh0, vv, 4); FMAC_BC(t, w0, st[9], 9); st[9] = t; if (MODE == 2) FMAC_BC(y1, rrh0, t, 4);
    MUL_BC(t, bbl0, sa, 5); if (MODE != 0) FMAC_BC(t, kfl0, vv, 5); FMAC_BC(t, w0, st[10], 10); st[10] = t; if (MODE == 2) FMAC_BC(y0, rrl0, t, 5);
    MUL_BC(t, bbh0, sa, 5); if (MODE != 0) FMAC_BC(t, kfh0, vv, 5); FMAC_BC(t, w0, st[11], 11); st[11] = t; if (MODE == 2) FMAC_BC(y1, rrh0, t, 5);
    MUL_BC(t, bbl0, sa, 6); if (MODE != 0) FMAC_BC(t, kfl0, vv, 6); FMAC_BC(t, w0, st[12], 12); st[12] = t; if (MODE == 2) FMAC_BC(y0, rrl0, t, 6);
    MUL_BC(t, bbh0, sa, 6); if (MODE != 0) FMAC_BC(t, kfh0, vv, 6); FMAC_BC(t, w0, st[13], 13); st[13] = t; if (MODE == 2) FMAC_BC(y1, rrh0, t, 6);
    MUL_BC(t, bbl0, sa, 7); if (MODE != 0) FMAC_BC(t, kfl0, vv, 7); FMAC_BC(t, w0, st[14], 14); st[14] = t; if (MODE == 2) FMAC_BC(y0, rrl0, t, 7);
    MUL_BC(t, bbh0, sa, 7); if (MODE != 0) FMAC_BC(t, kfh0, vv, 7); FMAC_BC(t, w0, st[15], 15); st[15] = t; if (MODE == 2) FMAC_BC(y1, rrh0, t, 7);
    MUL_BC(t, bbl0, sa, 8); if (MODE != 0) FMAC_BC(t, kfl0, vv, 8); FMAC_BC(t, w1, st[16], 0); st[16] = t; if (MODE == 2) FMAC_BC(y0, rrl0, t, 8);
    MUL_BC(t, bbh0, sa, 8); if (MODE != 0) FMAC_BC(t, kfh0, vv, 8); FMAC_BC(t, w1, st[17], 1); st[17] = t; if (MODE == 2) FMAC_BC(y1, rrh0, t, 8);
    MUL_BC(t, bbl0, sa, 9); if (MODE != 0) FMAC_BC(t, kfl0, vv, 9); FMAC_BC(t, w1, st[18], 2); st[18] = t; if (MODE == 2) FMAC_BC(y0, rrl0, t, 9);
    MUL_BC(t, bbh0, sa, 9); if (MODE != 0) FMAC_BC(t, kfh0, vv, 9); FMAC_BC(t, w1, st[19], 3); st[19] = t; if (MODE == 2) FMAC_BC(y1, rrh0, t, 9);
    MUL_BC(t, bbl0, sa, 10); if (MODE != 0) FMAC_BC(t, kfl0, vv, 10); FMAC_BC(t, w1, st[20], 4); st[20] = t; if (MODE == 2) FMAC_BC(y0, rrl0, t, 10);
    MUL_BC(t, bbh0, sa, 10); if (MODE != 0) FMAC_BC(t, kfh0, vv, 10); FMAC_BC(t, w1, st[21], 5); st[21] = t; if (MODE == 2) FMAC_BC(y1, rrh0, t, 10);
    MUL_BC(t, bbl0, sa, 11); if (MODE != 0) FMAC_BC(t, kfl0, vv, 11); FMAC_BC(t, w1, st[22], 6); st[22] = t; if (MODE == 2) FMAC_BC(y0, rrl0, t, 11);
    MUL_BC(t, bbh0, sa, 11); if (MODE != 0) FMAC_BC(t, kfh0, vv, 11); FMAC_BC(t, w1, st[23], 7); st[23] = t; if (MODE == 2) FMAC_BC(y1, rrh0, t, 11);
    MUL_BC(t, bbl0, sa, 12); if (MODE != 0) FMAC_BC(t, kfl0, vv, 12); FMAC_BC(t, w1, st[24], 8); st[24] = t; if (MODE == 2) FMAC_BC(y0, rrl0, t, 12);
    MUL_BC(t, bbh0, sa, 12); if (MODE != 0) FMAC_BC(t, kfh0, vv, 12); FMAC_BC(t, w1, st[25], 9); st[25] = t; if (MODE == 2) FMAC_BC(y1, rrh0, t, 12);
    MUL_BC(t, bbl0, sa, 13); if (MODE != 0) FMAC_BC(t, kfl0, vv, 13); FMAC_BC(t, w1, st[26], 10); st[26] = t; if (MODE == 2) FMAC_BC(y0, rrl0, t, 13);
    MUL_BC(t, bbh0, sa, 13); if (MODE != 0) FMAC_BC(t, kfh0, vv, 13); FMAC_BC(t, w1, st[27], 11); st[27] = t; if (MODE == 2) FMAC_BC(y1, rrh0, t, 13);
    MUL_BC(t, bbl0, sa, 14); if (MODE != 0) FMAC_BC(t, kfl0, vv, 14); FMAC_BC(t, w1, st[28], 12); st[28] = t; if (MODE == 2) FMAC_BC(y0, rrl0, t, 14);
    MUL_BC(t, bbh0, sa, 14); if (MODE != 0) FMAC_BC(t, kfh0, vv, 14); FMAC_BC(t, w1, st[29], 13); st[29] = t; if (MODE == 2) FMAC_BC(y1, rrh0, t, 14);
    MUL_BC(t, bbl0, sa, 15); if (MODE != 0) FMAC_BC(t, kfl0, vv, 15); FMAC_BC(t, w1, st[30], 14); st[30] = t; if (MODE == 2) FMAC_BC(y0, rrl0, t, 15);
    MUL_BC(t, bbh0, sa, 15); if (MODE != 0) FMAC_BC(t, kfh0, vv, 15); FMAC_BC(t, w1, st[31], 15); st[31] = t; if (MODE == 2) FMAC_BC(y1, rrh0, t, 15);
    MUL_BC(t, bbl1, sa, 0); if (MODE != 0) FMAC_BC(t, kfl1, vv, 0); FMAC_BC(t, w2, st[32], 0); st[32] = t; if (MODE == 2) FMAC_BC(y0, rrl1, t, 0);
    MUL_BC(t, bbh1, sa, 0); if (MODE != 0) FMAC_BC(t, kfh1, vv, 0); FMAC_BC(t, w2, st[33], 1); st[33] = t; if (MODE == 2) FMAC_BC(y1, rrh1, t, 0);
    MUL_BC(t, bbl1, sa, 1); if (MODE != 0) FMAC_BC(t, kfl1, vv, 1); FMAC_BC(t, w2, st[34], 2); st[34] = t; if (MODE == 2) FMAC_BC(y0, rrl1, t, 1);
    MUL_BC(t, bbh1, sa, 1); if (MODE != 0) FMAC_BC(t, kfh1, vv, 1); FMAC_BC(t, w2, st[35], 3); st[35] = t; if (MODE == 2) FMAC_BC(y1, rrh1, t, 1);
    MUL_BC(t, bbl1, sa, 2); if (MODE != 0) FMAC_BC(t, kfl1, vv, 2); FMAC_BC(t, w2, st[36], 4); st[36] = t; if (MODE == 2) FMAC_BC(y0, rrl1, t, 2);
    MUL_BC(t, bbh1, sa, 2); if (MODE != 0) FMAC_BC(t, kfh1, vv, 2); FMAC_BC(t, w2, st[37], 5); st[37] = t; if (MODE == 2) FMAC_BC(y1, rrh1, t, 2);
    MUL_BC(t, bbl1, sa, 3); if (MODE != 0) FMAC_BC(t, kfl1, vv, 3); FMAC_BC(t, w2, st[38], 6); st[38] = t; if (MODE == 2) FMAC_BC(y0, rrl1, t, 3);
    MUL_BC(t, bbh1, sa, 3); if (MODE != 0) FMAC_BC(t, kfh1, vv, 3); FMAC_BC(t, w2, st[39], 7); st[39] = t; if (MODE == 2) FMAC_BC(y1, rrh1, t, 3);
    MUL_BC(t, bbl1, sa, 4); if (MODE != 0) FMAC_BC(t, kfl1, vv, 4); FMAC_BC(t, w2, st[40], 8); st[40] = t; if (MODE == 2) FMAC_BC(y0, rrl1, t, 4);
    MUL_BC(t, bbh1, sa, 4); if (MODE != 0) FMAC_BC(t, kfh1, vv, 4); FMAC_BC(t, w2, st[41], 9); st[41] = t; if (MODE == 2) FMAC_BC(y1, rrh1, t, 4);
    MUL_BC(t, bbl1, sa, 5); if (MODE != 0) FMAC_BC(t, kfl1, vv, 5); FMAC_BC(t, w2, st[42], 10); st[42] = t; if (MODE == 2) FMAC_BC(y0, rrl1, t, 5);
    MUL_BC(t, bbh1, sa, 5); if (MODE != 0) FMAC_BC(t, kfh1, vv, 5); FMAC_BC(t, w2, st[43], 11); st[43] = t; if (MODE == 2) FMAC_BC(y1, rrh1, t, 5);
    MUL_BC(t, bbl1, sa, 6); if (MODE != 0) FMAC_BC(t, kfl1, vv, 6); FMAC_BC(t, w2, st[44], 12); st[44] = t; if (MODE == 2) FMAC_BC(y0, rrl1, t, 6);
    MUL_BC(t, bbh1, sa, 6); if (MODE != 0) FMAC_BC(t, kfh1, vv, 6); FMAC_BC(t, w2, st[45], 13); st[45] = t; if (MODE == 2) FMAC_BC(y1, rrh1, t, 6);
    MUL_BC(t, bbl1, sa, 7); if (MODE != 0) FMAC_BC(t, kfl1, vv, 7); FMAC_BC(t, w2, st[46], 14); st[46] = t; if (MODE == 2) FMAC_BC(y0, rrl1, t, 7);
    MUL_BC(t, bbh1, sa, 7); if (MODE != 0) FMAC_BC(t, kfh1, vv, 7); FMAC_BC(t, w2, st[47], 15); st[47] = t; if (MODE == 2) FMAC_BC(y1, rrh1, t, 7);
    MUL_BC(t, bbl1, sa, 8); if (MODE != 0) FMAC_BC(t, kfl1, vv, 8); FMAC_BC(t, w3, st[48], 0); st[48] = t; if (MODE == 2) FMAC_BC(y0, rrl1, t, 8);
    MUL_BC(t, bbh1, sa, 8); if (MODE != 0) FMAC_BC(t, kfh1, vv, 8); FMAC_BC(t, w3, st[49], 1); st[49] = t; if (MODE == 2) FMAC_BC(y1, rrh1, t, 8);
    MUL_BC(t, bbl1, sa, 9); if (MODE != 0) FMAC_BC(t, kfl1, vv, 9); FMAC_BC(t, w3, st[50], 2); st[50] = t; if (MODE == 2) FMAC_BC(y0, rrl1, t, 9);
    MUL_BC(t, bbh1, sa, 9); if (MODE != 0) FMAC_BC(t, kfh1, vv, 9); FMAC_BC(t, w3, st[51], 3); st[51] = t; if (MODE == 2) FMAC_BC(y1, rrh1, t, 9);
    MUL_BC(t, bbl1, sa, 10); if (MODE != 0) FMAC_BC(t, kfl1, vv, 10); FMAC_BC(t, w3, st[52], 4); st[52] = t; if (MODE == 2) FMAC_BC(y0, rrl1, t, 10);
    MUL_BC(t, bbh1, sa, 10); if (MODE != 0) FMAC_BC(t, kfh1, vv, 10); FMAC_BC(t, w3, st[53], 5); st[53] = t; if (MODE == 2) FMAC_BC(y1, rrh1, t, 10);
    MUL_BC(t, bbl1, sa, 11); if (MODE != 0) FMAC_BC(t, kfl1, vv, 11); FMAC_BC(t, w3, st[54], 6); st[54] = t; if (MODE == 2) FMAC_BC(y0, rrl1, t, 11);
    MUL_BC(t, bbh1, sa, 11); if (MODE != 0) FMAC_BC(t, kfh1, vv, 11); FMAC_BC(t, w3, st[55], 7); st[55] = t; if (MODE == 2) FMAC_BC(y1, rrh1, t, 11);
    MUL_BC(t, bbl1, sa, 12); if (MODE != 0) FMAC_BC(t, kfl1, vv, 12); FMAC_BC(t, w3, st[56], 8); st[56] = t; if (MODE == 2) FMAC_BC(y0, rrl1, t, 12);
    MUL_BC(t, bbh1, sa, 12); if (MODE != 0) FMAC_BC(t, kfh1, vv, 12); FMAC_BC(t, w3, st[57], 9); st[57] = t; if (MODE == 2) FMAC_BC(y1, rrh1, t, 12);
    MUL_BC(t, bbl1, sa, 13); if (MODE != 0) FMAC_BC(t, kfl1, vv, 13); FMAC_BC(t, w3, st[58], 10); st[58] = t; if (MODE == 2) FMAC_BC(y0, rrl1, t, 13);
    MUL_BC(t, bbh1, sa, 13); if (MODE != 0) FMAC_BC(t, kfh1, vv, 13); FMAC_BC(t, w3, st[59], 11); st[59] = t; if (MODE == 2) FMAC_BC(y1, rrh1, t, 13);
    MUL_BC(t, bbl1, sa, 14); if (MODE != 0) FMAC_BC(t, kfl1, vv, 14); FMAC_BC(t, w3, st[60], 12); st[60] = t; if (MODE == 2) FMAC_BC(y0, rrl1, t, 14);
    MUL_BC(t, bbh1, sa, 14); if (MODE != 0) FMAC_BC(t, kfh1, vv, 14); FMAC_BC(t, w3, st[61], 13); st[61] = t; if (MODE == 2) FMAC_BC(y1, rrh1, t, 14);
    MUL_BC(t, bbl1, sa, 15); if (MODE != 0) FMAC_BC(t, kfl1, vv, 15); FMAC_BC(t, w3, st[62], 14); st[62] = t; if (MODE == 2) FMAC_BC(y0, rrl1, t, 15);
    MUL_BC(t, bbh1, sa, 15); if (MODE != 0) FMAC_BC(t, kfh1, vv, 15); FMAC_BC(t, w3, st[63], 15); st[63] = t; if (MODE == 2) FMAC_BC(y1, rrh1, t, 15);
    return y0 + y1;
}
__device__ __forceinline__ void rw_r1(const unsigned char* ws, const RwSet rs, float* P, float* G, int gw, int NGW, int lane) {
    for (int T = gw; T < NCH * 8 * 2; T += NGW) { const int kind = T & 1, h = (T >> 1) & 7, c = T >> 4; float st[64];
        int ln_ = lane; asm volatile("" : "+v"(ln_));
#pragma unroll
        for (int k = 0; k < 64; ++k) st[k] = (kind == 0 && k == ln_) ? 1.f : 0.f;
        const size_t o0 = (size_t)(c * LC) * 512 + h * 64; RwOps q[RW_PF];
#pragma unroll
        for (int d = 0; d < RW_PF; ++d) q[d] = rw_load<false>(ws, rs, o0 + (size_t)d * 512, ln_);
        for (int tb = 0; tb < LC; tb += RW_PF) {
#pragma unroll
            for (int d = 0; d < RW_PF; ++d) { const RwOps x = q[d]; if (tb + d + RW_PF < LC) q[d] = rw_load<false>(ws, rs, o0 + (size_t)(tb + d + RW_PF) * 512, ln_);
                if (kind == 0) (void)rw_step<0>(st, x); else (void)rw_step<1>(st, x); } }
        float* dst = (kind == 0 ? P : G) + ((size_t)(h * NCH + c) * 64 + ln_) * 64;
#pragma unroll
        for (int k = 0; k < 64; k += 4) *(f32x4*)(dst + k) = (f32x4){st[k], st[k + 1], st[k + 2], st[k + 3]}; }
}
__device__ __forceinline__ void rw_r2(const float* P, const float* G, float* S0, LAS unsigned char* lds, int lane, int wave, int bid) {
    LAS float* red = (LAS float*)lds;
    for (int rp = bid; rp < 256; rp += gridDim.x) { const int h = rp >> 5, v0 = (rp & 31) * 2; float s0 = 0.f, s1 = 0.f;
        const float* Ph = P + (size_t)h * NCH * 4096 + (size_t)(8 * wave) * 64 + lane; const float* Gh = G + (size_t)h * NCH * 4096 + (size_t)v0 * 64 + lane; float* Sh = S0 + (size_t)h * NCH * 4096 + (size_t)v0 * 64 + lane;
        float pq[8][8], gq[8][2];
#pragma unroll
        for (int d = 0; d < 8; ++d) {
#pragma unroll
            for (int jj = 0; jj < 8; ++jj) pq[d][jj] = Ph[(size_t)d * 4096 + jj * 64];
            gq[d][0] = Gh[(size_t)d * 4096]; gq[d][1] = Gh[(size_t)d * 4096 + 64]; }
        for (int c0 = 0; c0 < NCH; c0 += 8) {
#pragma unroll
            for (int d = 0; d < 8; ++d) { const int c = c0 + d;
                if (wave == 0) { Sh[(size_t)c * 4096] = s0; Sh[(size_t)c * 4096 + 64] = s1; }
                float p0 = 0.f, p1 = 0.f;
#pragma unroll
                for (int jj = 0; jj < 8; ++jj) { const float a0 = __builtin_bit_cast(float, __builtin_amdgcn_readlane(__builtin_bit_cast(int, s0), 8 * wave + jj)), a1 = __builtin_bit_cast(float, __builtin_amdgcn_readlane(__builtin_bit_cast(int, s1), 8 * wave + jj));
                    p0 += a0 * pq[d][jj]; p1 += a1 * pq[d][jj]; }
                LAS float* rd = red + (c & 1) * 1024;
                rd[(0 * 64 + lane) * 8 + wave] = p0; rd[(1 * 64 + lane) * 8 + wave] = p1;
                const float g0 = gq[d][0], g1 = gq[d][1];
                { const int cn = (c + 8 < NCH) ? c + 8 : NCH - 1;
#pragma unroll
                    for (int jj = 0; jj < 8; ++jj) pq[d][jj] = Ph[(size_t)cn * 4096 + jj * 64];
                    gq[d][0] = Gh[(size_t)cn * 4096]; gq[d][1] = Gh[(size_t)cn * 4096 + 64]; }
                asm volatile("s_waitcnt lgkmcnt(0)\n\ts_barrier" ::: "memory");
                const f32x4 a0 = *(const LAS f32x4*)(rd + (0 * 64 + lane) * 8), a1 = *(const LAS f32x4*)(rd + (0 * 64 + lane) * 8 + 4), b0 = *(const LAS f32x4*)(rd + (1 * 64 + lane) * 8), b1 = *(const LAS f32x4*)(rd + (1 * 64 + lane) * 8 + 4);
                s0 = g0 + (((a0.x + a0.y) + (a0.z + a0.w)) + ((a1.x + a1.y) + (a1.z + a1.w))); s1 = g1 + (((b0.x + b0.y) + (b0.z + b0.w)) + ((b1.x + b1.y) + (b1.z + b1.w))); }
        }
        __syncthreads();
    }
}
__device__ __forceinline__ void rw_r3(CA a, int l, const unsigned char* ws, const RwSet rs, const float* S0, const float* BON, bf16* RWO, LAS unsigned char* lds, int gw, int NGW, int lane, int wave) {
    LAS float* yl = (LAS float*)(lds + wave * 16640);
    const float* gnw = a->in[26] + (size_t)l * 512; const float* gnb = a->in[27] + (size_t)l * 512;
    const bf16* Vb = (const bf16*)(ws + WS_RW_V); const bf16* GB = (const bf16*)(ws + WS_GB);
    for (int T = gw; T < NCH * 8; T += NGW) { const int h = T & 7, c = T >> 3; float st[64];
        const float* src = S0 + ((size_t)(h * NCH + c) * 64 + lane) * 64;
#pragma unroll
        for (int k = 0; k < 64; k += 4) { const f32x4 v4 = *(const f32x4*)(src + k); st[k] = v4.x; st[k + 1] = v4.y; st[k + 2] = v4.z; st[k + 3] = v4.w; }
        {   const size_t o0 = (size_t)(c * LC) * 512 + h * 64; RwOps q[RW_PF];
#pragma unroll
            for (int d = 0; d < RW_PF; ++d) q[d] = rw_load<true>(ws, rs, o0 + (size_t)d * 512, lane);
            for (int tb = 0; tb < LC; tb += RW_PF) {
#pragma unroll
                for (int d = 0; d < RW_PF; ++d) { const RwOps x = q[d]; if (tb + d + RW_PF < LC) q[d] = rw_load<true>(ws, rs, o0 + (size_t)(tb + d + RW_PF) * 512, lane); yl[(tb + d) * 65 + lane] = rw_step<2>(st, x); } } }
        LDS_WAIT(); asm volatile("" ::: "memory");
        {
            const int t = c * LC + lane; float y[64]; float s = 0.f;
#pragma unroll
            for (int v = 0; v < 64; ++v) { y[v] = yl[lane * 65 + v]; s += y[v]; }
            const float mean = s * (1.f / 64.f); float q = 0.f;
#pragma unroll
            for (int v = 0; v < 64; ++v) { const float d = y[v] - mean; q += d * d; }
            const float rstd = 1.f / sqrtf(q * (1.f / 64.f) + GN_EPS); const float bon = BON[t * 8 + h];
            const size_t o = (size_t)t * 512 + h * 64;
#pragma unroll
            for (int v8 = 0; v8 < 64; v8 += 8) { const v4u vv = *(const v4u*)(Vb + o + v8), gg = *(const v4u*)(GB + o + v8); float ov[8];
#pragma unroll
                for (int q2 = 0; q2 < 4; ++q2) { const int v = v8 + 2 * q2;
                    ov[2 * q2] = ((y[v] - mean) * rstd * gnw[h * 64 + v] + gnb[h * 64 + v] + bon * bflo(vv[q2])) * bflo(gg[q2]);
                    ov[2 * q2 + 1] = ((y[v + 1] - mean) * rstd * gnw[h * 64 + v + 1] + gnb[h * 64 + v + 1] + bon * bfhi(vv[q2])) * bfhi(gg[q2]); }
                v4u w; w.x = pk2(ov[0], ov[1]); w.y = pk2(ov[2], ov[3]); w.z = pk2(ov[4], ov[5]); w.w = pk2(ov[6], ov[7]); *(v4u*)(RWO + o + v8) = w; }
        }
        LDS_WAIT(); asm volatile("" ::: "memory");
    }
}

#define XB_TMO      128
#define XB_XCNT(j)  (256  + 64 * (j))
#define XB_XSUB(j)  (1280 + 64 * (j))
#define XB_XGEN(j)  (2304 + 64 * (j))
#define XB_TOP      3328
#define XB_TOPGEN   3392
#define XCD_BAR_WORDS 3456
#define XB_SPIN_CAP (1u << 18)

__device__ __forceinline__ unsigned xb_ld(unsigned* p)              { return __hip_atomic_load(p, __ATOMIC_RELAXED, __HIP_MEMORY_SCOPE_AGENT); }
__device__ __forceinline__ unsigned xb_add(unsigned* p, unsigned v) { return __hip_atomic_fetch_add(p, v, __ATOMIC_RELAXED, __HIP_MEMORY_SCOPE_AGENT); }
__device__ __forceinline__ unsigned xb_xcc_id() { return (unsigned)__builtin_amdgcn_s_getreg((3 << 11) | 20) & 0xFu; }
#define XB_SPIN(cond, bar) do { unsigned _sp = 0; while (cond) { __builtin_amdgcn_s_sleep(1); \
    if ((++_sp & 255u) == 0u) { if (xb_ld(&(bar)[XB_TMO])) break; if (_sp > XB_SPIN_CAP) { atomicAdd(&(bar)[XB_TMO], 1u); break; } } } } while (0)

struct XcdBarrier {
    unsigned* bar; unsigned x;
    volatile LAS unsigned* st;
};

__device__ __forceinline__ XcdBarrier xcd_barrier_post(unsigned* bar, volatile LAS unsigned* st, unsigned xb_tid) {
    XcdBarrier b; b.bar = bar; b.x = xb_xcc_id(); b.st = st;
    if (xb_tid == 0) (void)xb_add(&bar[XB_XCNT(b.x)], 1u);
    return b;
}
__device__ __forceinline__ void xcd_barrier_complete(unsigned* bar, unsigned x, unsigned& nloc, unsigned& nx) {
    const unsigned G = gridDim.x * gridDim.y * gridDim.z;
    unsigned sum, cnt, mine, sp = 0u;
    for (;;) {
        sum = 0u; cnt = 0u; mine = 0u;
#pragma unroll
        for (unsigned j = 0; j < 16; ++j) { const unsigned c = xb_ld(&bar[XB_XCNT(j)]); sum += c; cnt += (c > 0u) ? 1u : 0u; mine = (j == x) ? c : mine; }
        if (sum == G) break;
        __builtin_amdgcn_s_sleep(1);
        if ((++sp & 255u) == 0u) { if (xb_ld(&bar[XB_TMO])) break; if (sp > XB_SPIN_CAP) { atomicAdd(&bar[XB_TMO], 1u); break; } }
    }
    nloc = mine > 0u ? mine : 1u; nx = cnt > 0u ? cnt : 1u;
}

__device__ __forceinline__ void xcd_barrier(const XcdBarrier& b, unsigned xb_tid) {
    asm volatile("s_waitcnt vmcnt(0)" ::: "memory");
    __syncthreads();
    if (xb_tid == 0) {
        unsigned* bar = b.bar;
        __builtin_amdgcn_s_waitcnt(0);
        unsigned nloc = b.st[0], nx = b.st[1];
        if (nloc == 0u) { xcd_barrier_complete(bar, b.x, nloc, nx); b.st[0] = nloc; b.st[1] = nx; }
        const unsigned old = xb_add(&bar[XB_XSUB(b.x)], 1u);
        const unsigned gen = old / nloc;
        if (old + 1u == (gen + 1u) * nloc) {
            __builtin_amdgcn_fence(__ATOMIC_RELEASE, "agent");
            asm volatile("s_waitcnt vmcnt(0)" ::: "memory");
            const unsigned og = xb_add(&bar[XB_TOP], 1u);
            const unsigned tg = og / nx;
            if (og + 1u == (tg + 1u) * nx) xb_add(&bar[XB_TOPGEN], 1u);
            else XB_SPIN(xb_ld(&bar[XB_TOPGEN]) == tg, bar);
            __builtin_amdgcn_fence(__ATOMIC_ACQUIRE, "agent");
            xb_add(&bar[XB_XGEN(b.x)], 1u);
            asm volatile("s_waitcnt vmcnt(0)" ::: "memory");
        } else {
            XB_SPIN(xb_ld(&bar[XB_XGEN(b.x)]) == gen, bar);
            __builtin_amdgcn_fence(__ATOMIC_ACQUIRE, "agent");
            asm volatile("s_waitcnt vmcnt(0)" ::: "memory");
        }
    }
    __syncthreads();
}

__device__ __forceinline__ unsigned char* args_ws_ptr() { CA a = (CA)__builtin_amdgcn_kernarg_segment_ptr(); return a->ws; }
__global__ void __launch_bounds__(NTHR, 2) fwd_mega(Args args_unused) {
    extern __shared__ __attribute__((aligned(16))) unsigned char lds_raw[];
    LAS unsigned char* lds = (LAS unsigned char*)lds_raw;
    cg::grid_group grid = cg::this_grid();
    const int G = gridDim.x, NGW = G * NWAVES, NGT = G * NTHR;
    const int wave_s = __builtin_amdgcn_readfirstlane((int)threadIdx.x >> 6);
#define FRESH_LANE() ({ unsigned m_ = ~0u; asm volatile("" : "+s"(m_)); (int)__builtin_amdgcn_mbcnt_hi(m_, __builtin_amdgcn_mbcnt_lo(m_, 0u)); })
#define CUR_TID() (wave_s * 64 + FRESH_LANE())
    if (CUR_TID() < 16) ((LAS unsigned*)(lds + MISC_OFF))[CUR_TID()] = 0u;
    __syncthreads();
    (void)xcd_barrier_post((unsigned*)args_ws_ptr(), (volatile LAS unsigned*)(lds + MISC_OFF), (unsigned)CUR_TID());
#define SYNC() do { XcdBarrier b_; { CA a_ = (CA)__builtin_amdgcn_kernarg_segment_ptr(); asm volatile("" : "+s"(a_)); b_.bar = (unsigned*)a_->ws; } b_.x = xb_xcc_id(); b_.st = (volatile LAS unsigned*)(lds + MISC_OFF); xcd_barrier(b_, (unsigned)CUR_TID()); } while (0)
#define PH_BEGIN { CA a = (CA)__builtin_amdgcn_kernarg_segment_ptr(); asm volatile("" : "+s"(a)); unsigned char* ws = a->ws; (void)ws; \
        int lane_l = FRESH_LANE(); asm volatile("" : "+v"(lane_l)); int bid_l = blockIdx.x; asm volatile("" : "+s"(bid_l)); int wave_l = wave_s; asm volatile("" : "+s"(wave_l)); \
        const int lane = lane_l, wave = wave_l, tid = wave * 64 + lane, bid = bid_l, gw = bid * NWAVES + wave, gtid = bid * NTHR + tid; (void)lane; (void)gtid; (void)gw; (void)wave;
#define PH_END }
#define WSP(T, off) ((T*)(ws + (off)))
#define ADA_L (WSP(float, WS_ADA) + l * 9216)
#define GEMM(EPI, Aptr, LDA, Bptr, N_, K_, ...) do { int kk_ = (K_); asm volatile("" : "+s"(kk_));   pg8::Gemm g_{(const pg8::bf16_t*)(Aptr), (const pg8::bf16_t*)(Bptr), M, (N_), kk_, (LDA)}; pg8::StaticOrder S_; S_.init(M, (N_), G, bid); \
        EPI E_{__VA_ARGS__}; pg8::gemm_phase<EPI, pg8::StaticOrder, PG8_ALIGN, PG8_SP2>(lds, g_, S_, E_, tid); } while (0)

    PH_BEGIN ada_phase(a, lds, tid, lane, wave, bid); PH_END
    PH_BEGIN convert_layer(a, 0, lds, gw, NGW, wave, lane); PH_END
    grid.sync();
    PH_BEGIN mod_phase(a->in[0], WSP(bf16, WS_HB), WSP(float, WS_ADA), WSP(float, WS_ADA) + D, gw, NGW, lane); PH_END
    SYNC();

    for (int l = 0; l < NL; ++l) {
        PH_BEGIN GEMM(EpiSwiGLU, WSP(bf16, WS_HB), D, ws + W_UP0, 2 * DFF, D, WSP(bf16, WS_ACT), DFF); PH_END
        SYNC();
        PH_BEGIN GEMM(EpiGateF32, WSP(bf16, WS_ACT), DFF, ws + W_DN0, D, DFF, WSP(float, WS_Y), ADA_L + 2 * D, 0.5f); PH_END
        SYNC();
        PH_BEGIN ln_phase(l == 0 ? a->in[0] : a->out, WSP(float, WS_Y), a->out, WSP(bf16, WS_HB), a->in[4] + (size_t)l * 3 * D, a->in[5] + (size_t)l * 3 * D, ADA_L + 3 * D, ADA_L + 4 * D, true, gw, NGW, lane); PH_END
        SYNC();
        PH_BEGIN GEMM(EpiIn, WSP(bf16, WS_HB), D, ws + W_IN, ZP, D, WSP(bf16, WS_Z)); PH_END
        SYNC();
        PH_BEGIN if (bid < 8) fscan_head(WSP(bf16, WS_Z), a->in[9] + l * 8, WSP(float, WS_FL2), bid, lds, tid, lane, wave); PH_END
        PH_BEGIN codes_phase(WSP(bf16, WS_Z), a->in[17] + (size_t)l * 1792, WSP(bf16, WS_CODES), gtid, NGT); PH_END
        PH_BEGIN lru_l1(a, l, WSP(bf16, WS_Z), WSP(bf16, WS_HLOC), WSP(bf16, WS_ACUM), WSP(float, WS_LAEND), WSP(float, WS_LHEND), lds, tid, lane, wave, bid); PH_END
        SYNC();
        PH_BEGIN GEMM(EpiPlain, ws + WS_CODES, 256, ws + W_LORA, 1536, 256, WSP(bf16, WS_LORA), 1536); PH_END
        PH_BEGIN lru_l2(WSP(const float, WS_LAEND), WSP(const float, WS_LHEND), WSP(float, WS_LCAR), gw, lane); PH_END
        SYNC();
        PH_BEGIN const RwSet rs = rw_set(l); rw_prep(a, l, WSP(bf16, WS_Z), WSP(const bf16, WS_LORA), WSP(float, rs.w), WSP(bf16, rs.r), WSP(bf16, rs.kf), WSP(bf16, WS_RW_V), WSP(bf16, rs.kk), WSP(bf16, rs.b), WSP(bf16, WS_GB), WSP(float, WS_BON), gw, NGW, lane); PH_END
        PH_BEGIN lru_l3(WSP(bf16, WS_Z), WSP(const bf16, WS_HLOC), WSP(const bf16, WS_ACUM), WSP(const float, WS_LCAR), gtid, NGT); PH_END
        SYNC();
        PH_BEGIN rw_r1(ws, rw_set(l), WSP(float, WS_P), WSP(float, WS_G), gw, NGW, lane); PH_END
        SYNC();
        PH_BEGIN rw_r2(WSP(const float, WS_P), WSP(const float, WS_G), WSP(float, WS_S0), lds, lane, wave, bid); PH_END
        SYNC();
        PH_BEGIN rw_r3(a, l, ws, rw_set(l), WSP(const float, WS_S0), WSP(const float, WS_BON), WSP(bf16, WS_RWO), lds, gw, NGW, lane, wave); PH_END
        __syncthreads();
        PH_BEGIN
            bf16* Zb = WSP(bf16, WS_Z);
            const attn_body::AttnTensors AT{(const attn_body::bf16*)(Zb + ZQ), (const attn_body::bf16*)(Zb + ZK), (const attn_body::bf16*)(Zb + ZV), (attn_body::bf16*)(Zb + ZXB), WSP(const float, WS_FL2)};
            const attn_body::StaticOrder S((int)G, bid);
            attn_body::attn_phase<attn_body::StaticOrder, 12>((char*)lds_raw, AT, S, tid);
        PH_END
        SYNC();
        PH_BEGIN GEMM(EpiProj<0>, WSP(bf16, WS_Z) + ZXB, ZP, ws + W_PA, D, 512, WSP(float, WS_Y), WSP(bf16, WS_Z), WSP(bf16, WS_HB)); PH_END

        PH_BEGIN GEMM(EpiProj<1>, WSP(bf16, WS_Z) + ZYB, ZP, ws + W_PB, D, D, WSP(float, WS_Y), WSP(bf16, WS_Z), WSP(bf16, WS_HB)); PH_END

        PH_BEGIN GEMM(EpiProj<2>, ws + WS_RWO, 512, ws + W_PC, D, 512, WSP(float, WS_Y), WSP(bf16, WS_Z), WSP(bf16, WS_HB)); PH_END
        SYNC();
        PH_BEGIN GEMM(EpiGateF32, WSP(bf16, WS_HB), D, ws + W_OUT, D, D, WSP(float, WS_Y), ADA_L + 5 * D, 1.0f); PH_END
        SYNC();
        PH_BEGIN ln_phase(a->out, WSP(float, WS_Y), a->out, WSP(bf16, WS_HB), a->in[4] + (size_t)(l * 3 + 1) * D, a->in[5] + (size_t)(l * 3 + 1) * D, ADA_L + 6 * D, ADA_L + 7 * D, true, gw, NGW, lane); PH_END
        SYNC();
        PH_BEGIN GEMM(EpiSwiGLU, WSP(bf16, WS_HB), D, ws + W_UP1, 2 * DFF, D, WSP(bf16, WS_ACT), DFF); PH_END
        SYNC();
        PH_BEGIN GEMM(EpiGateF32, WSP(bf16, WS_ACT), DFF, ws + W_DN1, D, DFF, WSP(float, WS_Y), ADA_L + 8 * D, 0.5f); PH_END
        SYNC();
        PH_BEGIN ln_phase(a->out, WSP(float, WS_Y), a->out, WSP(bf16, WS_HB), a->in[4] + (size_t)(l * 3 + 2) * D, a->in[5] + (size_t)(l * 3 + 2) * D, ADA_L + 9216, ADA_L + 9216 + D, l + 1 < NL, gw, NGW, lane); PH_END
        if (l + 1 < NL) { PH_BEGIN convert_layer(a, l + 1, lds, gw, NGW, wave, lane); PH_END SYNC(); }
    }
#undef SYNC
#undef GEMM
}

extern "C" void kernel_launch(void* const* d_in, const int* in_sizes, int n_in, void* d_out, int out_size, void* d_ws, size_t ws_size, hipStream_t stream) {
    static int grid = 0;
    if (grid == 0) {
        if (n_in != 32 || out_size != M * D || ws_size < WS_END) { fprintf(stderr, "kernel_launch: unexpected shapes (n_in %d, out %d, ws %zu)\n", n_in, out_size, ws_size); grid = -1; return; }
        int dev = 0, cus = 0, per_cu = 0;
        hipGetDevice(&dev); hipDeviceGetAttribute(&cus, hipDeviceAttributeMultiprocessorCount, dev);
        hipFuncSetAttribute((const void*)fwd_mega, hipFuncAttributeMaxDynamicSharedMemorySize, LDS_BYTES);
        if (hipOccupancyMaxActiveBlocksPerMultiprocessor(&per_cu, (const void*)fwd_mega, NTHR, LDS_BYTES) != hipSuccess || per_cu < 1) { fprintf(stderr, "kernel_launch: occupancy query says %d blocks per CU\n", per_cu); per_cu = 1; }
        (void)hipGetLastError();
        grid = cus * per_cu;
        fprintf(stderr, "kernel_launch: grid %d (cus %d x %d), lds %d\n", grid, cus, per_cu, LDS_BYTES);
    }
    if (grid < 0) return;
    Args a{};
    for (int i = 0; i < 32; ++i) a.in[i] = (const float*)d_in[i];
    a.out = (float*)d_out; a.ws = (unsigned char*)d_ws;
    if (hipMemsetAsync(d_ws, 0, CTL_ZERO_BYTES, stream) != hipSuccess) { fprintf(stderr, "kernel_launch: memset of the barrier words failed\n"); return; }
    void* kargs[] = {&a};
    hipError_t e = hipLaunchCooperativeKernel((const void*)fwd_mega, dim3(grid), dim3(NTHR), kargs, LDS_BYTES, stream);
    if (e != hipSuccess) fprintf(stderr, "kernel_launch: cooperative launch failed: %s (grid %d)\n", hipGetErrorString(e), grid);
}
```
